# Optimizing an MI355X kernel written in HIP

```python
import math
import jax, jax.numpy as jnp
from jax import lax
import numpy as np

D_MODEL = 1024
BATCH = 32
SEQ = 256
DEPTH = 4
DEC_BATCH = 8
DEC_SEQ = 2048
PAST_LEN = 256

GRID_W = 64
EPS = 1e-6
N_EVEN = (DEPTH + 1) // 2
N_ODD = DEPTH // 2
MIX_W = D_MODEL
CHUNK = 64
H_A = 4
DK_A = 64
DV_A = 128
W_A = H_A * DV_A
W_B = MIX_W - W_A
SC_K = 3
H_C = 4
DK_C = 128
DV_C = 128
W_C = H_C * DV_C
QKV_K = 3
W_D = MIX_W - W_C
CF_K = 31
EV_IN = 2 * H_A * DK_A + 2 * W_A + 3 * W_B
OD_IN = 2 * H_C * DK_C + 2 * W_C + 2 * 2 * H_C + 2 * W_D
ROPE_BASE = 10000.0
N_KEYS = 128
N_EXP = N_KEYS * N_KEYS
H_P = 8
D_KEY = 256
TOPK = 16
PEER_BLOCK = 128

kernel_name = 'hybrid_retention_gdn_peer_diffusion_step'


def rmsnorm(x, g):
    xf = x.astype(jnp.float32)
    y = xf * lax.rsqrt(jnp.mean(xf * xf, axis=-1, keepdims=True) + EPS)
    return (y * g.astype(jnp.float32)).astype(x.dtype)


def layernorm(x, g, b):
    xf = x.astype(jnp.float32)
    mu = jnp.mean(xf, axis=-1, keepdims=True)
    xc = xf - mu
    y = xc * lax.rsqrt(jnp.mean(xc * xc, axis=-1, keepdims=True) + EPS)
    return (y * g.astype(jnp.float32) + b.astype(jnp.float32)).astype(x.dtype)


def dwconv(x, w):
    k, ch = w.shape
    return lax.conv_general_dilated(x, w[:, None, :].astype(x.dtype), window_strides=(1,),
                                    padding=[(k // 2, k // 2)],
                                    dimension_numbers=('NWC', 'WIO', 'NWC'),
                                    feature_group_count=ch)


def modulation(cvec, w, b):
    m = jax.nn.silu(cvec) @ w + b
    return jnp.split(m[:, None, :], 6, axis=-1)


def axial_rope(x):
    L, dk = x.shape[1], x.shape[-1]
    rows = L // GRID_W
    row = jnp.repeat(jnp.arange(rows, dtype=jnp.float32), GRID_W)
    col = jnp.tile(jnp.arange(GRID_W, dtype=jnp.float32), rows)
    nf = dk // 4
    freqs = ROPE_BASE ** (-jnp.arange(nf, dtype=jnp.float32) / nf)
    ang = jnp.concatenate([row[:, None] * freqs, col[:, None] * freqs], axis=-1)
    cos = jnp.cos(ang)[None, :, None, :]
    sin = jnp.sin(ang)[None, :, None, :]
    x1, x2 = x[..., : dk // 2], x[..., dk // 2:]
    return jnp.concatenate([x1 * cos - x2 * sin, x2 * cos + x1 * sin], axis=-1)


def retention_scan(q, k, v, log_gamma, s0):
    B, L, H, dk = q.shape
    nc = L // CHUNK
    qc = q.reshape(B, nc, CHUNK, H, dk)
    kc = k.reshape(B, nc, CHUNK, H, dk)
    vc = v.reshape(B, nc, CHUNK, H, -1)
    pos = jnp.arange(CHUNK, dtype=jnp.float32)
    lg = log_gamma[:, None]
    diff = pos[:, None] - pos[None, :]
    dmat = jnp.where(diff >= 0, jnp.exp(lg[:, :, None] * jnp.maximum(diff, 0.0)), 0.0)
    intra = jnp.einsum('bnihd,bnjhd->bnhij', qc, kc) * dmat
    o_intra = jnp.einsum('bnhij,bnjhe->bnihe', intra, vc)
    w_end = jnp.exp(lg * (CHUNK - 1 - pos))
    kv = jnp.einsum('bnjhd,hj,bnjhe->nbhde', kc, w_end, vc)
    g_chunk = jnp.exp(log_gamma * CHUNK)[None, :, None, None]

    def step(S, kv_n):
        return S * g_chunk + kv_n, S

    s_final, s_prev = lax.scan(step, s0, kv)
    w_start = jnp.exp(lg * (pos + 1.0))
    o_cross = jnp.einsum('bnihd,hi,nbhde->bnihe', qc, w_start, s_prev)
    return (o_intra + o_cross).reshape(B, L, H, -1), s_final


def gdn_scan(q, k, v, g, beta, s0):
    B, L, H, dk = q.shape
    dv = v.shape[-1]
    nc = L // CHUNK

    def chunks(t):
        return t.reshape(B, nc, CHUNK, H, -1).transpose(1, 0, 3, 2, 4)

    qc = chunks(q * (dk ** -0.5))
    kc = chunks(k)
    vc = chunks(v)
    bc = beta.reshape(B, nc, CHUNK, H).transpose(1, 0, 3, 2)
    gc = jnp.cumsum(g.reshape(B, nc, CHUNK, H).transpose(1, 0, 3, 2), axis=-1)
    idx = jnp.arange(CHUNK)
    incl = idx[:, None] >= idx[None, :]
    strict = idx[:, None] > idx[None, :]
    diff = gc[..., :, None] - gc[..., None, :]
    decay = jnp.where(incl, jnp.exp(jnp.where(incl, diff, 0.0)), 0.0)
    kb = kc * bc[..., None]
    vb = vc * bc[..., None]
    a_low = jnp.where(strict, jnp.einsum('nbhid,nbhjd->nbhij', kb, kc) * decay, 0.0)
    eye = jnp.eye(CHUNK, dtype=jnp.float32)
    t_inv = lax.linalg.triangular_solve(a_low + eye, jnp.broadcast_to(eye, a_low.shape),
                                        left_side=True, lower=True, unit_diagonal=True)
    u = jnp.einsum('nbhij,nbhje->nbhie', t_inv, vb)
    w = jnp.einsum('nbhij,nbhjd->nbhid', t_inv, kb * jnp.exp(gc)[..., None])
    attn = jnp.where(incl, jnp.einsum('nbhid,nbhjd->nbhij', qc, kc) * decay, 0.0)

    def step(S, xs):
        qn, kn, un, wn, gn, an = xs
        v_new = un - jnp.einsum('bhcd,bhde->bhce', wn, S)
        o = (jnp.einsum('bhcd,bhde->bhce', qn * jnp.exp(gn)[..., None], S)
             + jnp.einsum('bhij,bhje->bhie', an, v_new))
        gl = gn[..., -1]
        S = (S * jnp.exp(gl)[..., None, None]
             + jnp.einsum('bhcd,bhce->bhde', kn * jnp.exp(gl[..., None] - gn)[..., None], v_new))
        return S, o

    s_final, o = lax.scan(step, s0, (qc, kc, u, w, gc, attn))
    return o.transpose(1, 0, 3, 2, 4).reshape(B, L, H, dv), s_final


def even_mixer(h, w_in, w_out, gamma_logit, ret_norm_g, sc_w, s0f, s0b, latent):
    B, L, _ = h.shape
    p = h @ w_in
    q, k, v, g, bg, cg, hb = jnp.split(p, [256, 512, 1024, 1536, 2048, 2560], axis=-1)
    f32 = jnp.float32
    qh = q.reshape(B, L, H_A, DK_A).astype(f32)
    kh = k.reshape(B, L, H_A, DK_A).astype(f32) * (DK_A ** -0.5)
    vh = v.reshape(B, L, H_A, DV_A).astype(f32)
    if latent:
        qh = axial_rope(qh)
        kh = axial_rope(kh)
    log_gamma = jax.nn.log_sigmoid(gamma_logit.astype(f32))
    of, sf = retention_scan(qh, kh, vh, log_gamma[0], s0f)
    ob, sb = retention_scan(qh[:, ::-1], kh[:, ::-1], vh[:, ::-1], log_gamma[1], s0b)
    o = of + ob[:, ::-1]
    o = o * lax.rsqrt(jnp.mean(o * o, axis=-1, keepdims=True) + EPS) * ret_norm_g.astype(f32)
    ya = (jax.nn.silu(g.astype(f32)) * o.reshape(B, L, W_A)).astype(h.dtype)
    yb = bg * dwconv(cg * hb, sc_w)
    return jnp.concatenate([ya, yb], axis=-1) @ w_out, sf, sb


def odd_mixer(h, w_in, w_out, conv_w, a_log, dt_bias, gdn_norm_g, cf_w, cf_b, ln_g, ln_b, s0f, s0b):
    B, L, _ = h.shape
    f32 = jnp.float32
    p = h @ w_in
    qkv, z, a, bb, glu = jnp.split(p, [3 * W_C, 4 * W_C, 4 * W_C + 2 * H_C, 4 * W_C + 4 * H_C], axis=-1)
    qkv = jax.nn.silu(dwconv(qkv, conv_w)).astype(f32)
    q, k, v = jnp.split(qkv, 3, axis=-1)
    q = q.reshape(B, L, H_C, DK_C)
    k = k.reshape(B, L, H_C, DK_C)
    v = v.reshape(B, L, H_C, DV_C)
    q = q * lax.rsqrt(jnp.sum(q * q, axis=-1, keepdims=True) + EPS)
    k = k * lax.rsqrt(jnp.sum(k * k, axis=-1, keepdims=True) + EPS)
    a = a.reshape(B, L, 2, H_C).astype(f32)
    bb = bb.reshape(B, L, 2, H_C).astype(f32)
    g = -jnp.exp(a_log.astype(f32)) * jax.nn.softplus(a + dt_bias.astype(f32))
    beta = jax.nn.sigmoid(bb)
    of, sf = gdn_scan(q, k, v, g[:, :, 0], beta[:, :, 0], s0f)
    ob, sb = gdn_scan(q[:, ::-1], k[:, ::-1], v[:, ::-1], g[:, ::-1, 1], beta[:, ::-1, 1], s0b)
    o = of + ob[:, ::-1]
    o = o * lax.rsqrt(jnp.mean(o * o, axis=-1, keepdims=True) + EPS) * gdn_norm_g.astype(f32)
    zh = jax.nn.silu(z.astype(f32)).reshape(B, L, H_C, DV_C)
    yc = (o * zh).reshape(B, L, W_C).astype(h.dtype)
    ca, cgate = jnp.split(glu, 2, axis=-1)
    hc = ca * jax.nn.sigmoid(cgate)
    hc = dwconv(hc, cf_w) + cf_b
    yd = jax.nn.silu(layernorm(hc, ln_g, ln_b))
    return jnp.concatenate([yc, yd], axis=-1) @ w_out, sf, sb


def peer_ffn(h, wq, keys, u_tab, v_tab):
    B, L, D = h.shape
    T = B * L
    x = h.reshape(T, D)
    q = (x @ wq).reshape(T, H_P, 2, D_KEY // 2)
    s = jnp.einsum('thpd,hpnd->thpn', q, keys)
    s1, i1 = lax.top_k(s[:, :, 0], TOPK)
    s2, i2 = lax.top_k(s[:, :, 1], TOPK)
    cand_s = (s1[..., :, None] + s2[..., None, :]).reshape(T, H_P, TOPK * TOPK)
    cand_i = (i1[..., :, None] * N_KEYS + i2[..., None, :]).reshape(T, H_P, TOPK * TOPK)
    top_s, sel = lax.top_k(cand_s, TOPK)
    eidx = jnp.take_along_axis(cand_i, sel, axis=-1)
    gates = jax.nn.softmax(top_s.astype(jnp.float32), axis=-1).astype(h.dtype)
    nb = T // PEER_BLOCK
    hk = H_P * TOPK

    def block(args):
        xt, et, gt = args
        act = jax.nn.gelu(jnp.einsum('td,tkd->tk', xt, u_tab[et]))
        return jnp.einsum('tk,tkd->td', gt * act, v_tab[et])

    out = lax.map(block, (x.reshape(nb, PEER_BLOCK, D), eidx.reshape(nb, PEER_BLOCK, hk),
                          gates.reshape(nb, PEER_BLOCK, hk)))
    return out.reshape(B, L, D)


def setup_inputs(seed: int = 0) -> dict:
    key = jax.random.key(seed)
    ks = jax.random.split(key, 32)
    f32 = jnp.float32
    d = D_MODEL

    def nrm(k, shape, scale):
        return jax.random.normal(k, shape, f32) * scale

    base = jnp.log(2.0 ** (5.0 + jnp.arange(H_A, dtype=f32)) - 1.0)
    dt = jnp.exp(jax.random.uniform(ks[20], (N_ODD, 2, H_C), f32, math.log(1e-3), math.log(1e-1)))
    return {
        'x_prompt': nrm(ks[0], (BATCH, SEQ, d), 1.0),
        'x_sample': nrm(ks[1], (DEC_BATCH, DEC_SEQ, d), 1.0),
        'state_ret': nrm(ks[2], (DEC_BATCH, N_EVEN, 2, H_A, DK_A, DV_A), 0.1),
        'state_gdn': nrm(ks[3], (DEC_BATCH, N_ODD, 2, H_C, DK_C, DV_C), 0.1),
        'c': nrm(ks[4], (DEC_BATCH, d), 1.0),
        'c_ctx': nrm(ks[5], (d,), 1.0),
        'ada_w': nrm(ks[6], (DEPTH, d, 6 * d), 0.5 * d ** -0.5),
        'ada_b': nrm(ks[7], (DEPTH, 6 * d), 0.02),
        'norm_mix_g': 1.0 + nrm(ks[8], (DEPTH, d), 0.02),
        'norm_ffn_g': 1.0 + nrm(ks[9], (DEPTH, d), 0.02),
        'final_norm_g': 1.0 + nrm(ks[10], (d,), 0.02),
        'ev_w_in': nrm(ks[11], (N_EVEN, d, EV_IN), d ** -0.5),
        'ev_w_out': nrm(ks[12], (N_EVEN, MIX_W, d), MIX_W ** -0.5),
        'ret_gamma_logit': base + nrm(ks[13], (N_EVEN, 2, H_A), 0.01),
        'ret_norm_g': 1.0 + nrm(ks[14], (N_EVEN, H_A, DV_A), 0.02),
        'sc_conv_w': nrm(ks[15], (N_EVEN, SC_K, W_B), SC_K ** -0.5),
        'od_w_in': nrm(ks[16], (N_ODD, d, OD_IN), d ** -0.5),
        'od_w_out': nrm(ks[17], (N_ODD, MIX_W, d), MIX_W ** -0.5),
        'gdn_conv_w': nrm(ks[18], (N_ODD, QKV_K, 3 * W_C), QKV_K ** -0.5),
        'gdn_a_log': jnp.log(jax.random.uniform(ks[19], (N_ODD, 2, H_C), f32, 1.0, 16.0)),
        'gdn_dt_bias': dt + jnp.log(-jnp.expm1(-dt)),
        'gdn_norm_g': 1.0 + nrm(ks[21], (N_ODD, DV_C), 0.02),
        'cf_dw_w': nrm(ks[22], (N_ODD, CF_K, W_D), CF_K ** -0.5),
        'cf_dw_b': nrm(ks[23], (N_ODD, W_D), 0.02),
        'cf_ln_g': 1.0 + nrm(ks[24], (N_ODD, W_D), 0.02),
        'cf_ln_b': nrm(ks[25], (N_ODD, W_D), 0.02),
        'peer_wq': nrm(ks[26], (DEPTH, d, H_P * D_KEY), d ** -0.5),
        'peer_keys': nrm(ks[27], (DEPTH, H_P, 2, N_KEYS, D_KEY // 2), (D_KEY // 2) ** -0.5),
        'peer_u': nrm(ks[28], (DEPTH, N_EXP, d), d ** -0.5),
        'peer_v': nrm(ks[29], (DEPTH, N_EXP, d), 0.1),
    }


def reference(x_prompt, x_sample, state_ret, state_gdn, c, c_ctx, ada_w, ada_b, norm_mix_g, norm_ffn_g,
              final_norm_g, ev_w_in, ev_w_out, ret_gamma_logit, ret_norm_g, sc_conv_w, od_w_in, od_w_out,
              gdn_conv_w, gdn_a_log, gdn_dt_bias, gdn_norm_g, cf_dw_w, cf_dw_b, cf_ln_g, cf_ln_b,
              peer_wq, peer_keys, peer_u, peer_v):
    f32 = jnp.float32
    xp, xs = x_prompt, x_sample
    bp = xp.shape[0]
    ret_new = []
    gdn_new = []
    for l in range(DEPTH):
        sh1p, sc1p, ga1p, sh2p, sc2p, ga2p = modulation(c_ctx[None, :], ada_w[l], ada_b[l])
        sh1s, sc1s, ga1s, sh2s, sc2s, ga2s = modulation(c, ada_w[l], ada_b[l])
        hp = rmsnorm(xp, norm_mix_g[l]) * (1.0 + sc1p) + sh1p
        hs = rmsnorm(xs, norm_mix_g[l]) * (1.0 + sc1s) + sh1s
        i = l // 2
        if l % 2 == 0:
            z0 = jnp.zeros((bp, H_A, DK_A, DV_A), f32)
            yp, sf, sb = even_mixer(hp, ev_w_in[i], ev_w_out[i], ret_gamma_logit[i], ret_norm_g[i],
                                    sc_conv_w[i], z0, z0, False)
            ys, _, _ = even_mixer(hs, ev_w_in[i], ev_w_out[i], ret_gamma_logit[i], ret_norm_g[i],
                                  sc_conv_w[i], state_ret[:, i, 0].astype(f32), state_ret[:, i, 1].astype(f32), True)
            ret_new.append(jnp.stack([sf, sb], axis=1))
        else:
            z0 = jnp.zeros((bp, H_C, DK_C, DV_C), f32)
            yp, sf, sb = odd_mixer(hp, od_w_in[i], od_w_out[i], gdn_conv_w[i], gdn_a_log[i], gdn_dt_bias[i],
                                   gdn_norm_g[i], cf_dw_w[i], cf_dw_b[i], cf_ln_g[i], cf_ln_b[i], z0, z0)
            ys, _, _ = odd_mixer(hs, od_w_in[i], od_w_out[i], gdn_conv_w[i], gdn_a_log[i], gdn_dt_bias[i],
                                 gdn_norm_g[i], cf_dw_w[i], cf_dw_b[i], cf_ln_g[i], cf_ln_b[i],
                                 state_gdn[:, i, 0].astype(f32), state_gdn[:, i, 1].astype(f32))
            gdn_new.append(jnp.stack([sf, sb], axis=1))
        xp = xp + ga1p * yp
        xs = xs + ga1s * ys
        hp = rmsnorm(xp, norm_ffn_g[l]) * (1.0 + sc2p) + sh2p
        hs = rmsnorm(xs, norm_ffn_g[l]) * (1.0 + sc2s) + sh2s
        xp = xp + ga2p * peer_ffn(hp, peer_wq[l], peer_keys[l], peer_u[l], peer_v[l])
        xs = xs + ga2s * peer_ffn(hs, peer_wq[l], peer_keys[l], peer_u[l], peer_v[l])
    y_prompt = rmsnorm(xp, final_norm_g)
    y_sample = rmsnorm(xs, final_norm_g)
    new_state_ret = jnp.stack(ret_new, axis=1).astype(x_prompt.dtype)
    new_state_gdn = jnp.stack(gdn_new, axis=1).astype(x_prompt.dtype)
    return (y_prompt, y_sample, new_state_ret, new_state_gdn)
```

```cpp
#include <hip/hip_runtime.h>
#include <hip/hip_cooperative_groups.h>
#include <cstdio>
namespace cg = cooperative_groups;

#ifndef SINGLE_LAUNCH
#define SINGLE_LAUNCH 0
#endif

typedef unsigned short bf16_t;
using bf16x8 = __attribute__((ext_vector_type(8))) short;
using f32x4 = __attribute__((ext_vector_type(4))) float;
using u32x4 = __attribute__((ext_vector_type(4))) unsigned;

#define NTOK 24576
#define NPROMPT 8192
#define PSTRIDE 3200
#define EPSV 1e-6f
#define NPHASE 38

constexpr size_t OFF_MOD = 0;
constexpr size_t OFF_ROPE = 1u << 20;
constexpr size_t OFF_WIN_EV = OFF_ROPE + 65536;
constexpr size_t OFF_WIN_OD = OFF_WIN_EV + 2ull * 3072 * 1024 * 2;
constexpr size_t OFF_WOUT = OFF_WIN_OD + 2ull * 3200 * 1024 * 2;
constexpr size_t OFF_WQ = OFF_WOUT + 4ull * 1024 * 1024 * 2;
constexpr size_t OFF_KEYS = OFF_WQ + 4ull * 2048 * 1024 * 2;
constexpr size_t OFF_UB = OFF_KEYS + 4ull * 8 * 2 * 128 * 128 * 2;
constexpr size_t OFF_VB = OFF_UB + 4ull * 16384 * 1024 * 2;
constexpr size_t OFF_H = OFF_VB + 4ull * 16384 * 1024 * 2;
constexpr size_t OFF_P = OFF_H + (size_t)NTOK * 1024 * 2;
constexpr size_t OFF_YMIX = OFF_P + (size_t)NTOK * PSTRIDE * 2;
constexpr size_t OFF_ODIR = OFF_YMIX + (size_t)NTOK * 1024 * 2;
constexpr size_t OFF_Q = OFF_ODIR;
constexpr size_t OFF_EIDX = OFF_ODIR + 2ull * NTOK * 512 * 4;
constexpr size_t OFF_GATE = OFF_EIDX + (size_t)NTOK * 128 * 4;
constexpr size_t GP_ITEM = 73728;
constexpr size_t OFF_GPREP = OFF_GATE + (size_t)NTOK * 128 * 4;
constexpr size_t OFF_EGL = OFF_GPREP + 3072ull * GP_ITEM;
constexpr size_t OFF_CONV = OFF_EGL + 16384;
constexpr size_t WS_NEED = OFF_CONV + (size_t)NTOK * 512 * 4;

struct Params {
  const float* in[30];
  float* out;
  unsigned char* ws;
};

__device__ const unsigned char CAND_A[52] = {0,0,0,0,0,0,0,0,0,0,0,0,0,0,0,0,1,1,1,1,1,1,1,1,2,2,2,2,2,3,3,3,3,4,4,4,5,5,6,6,7,7,8,9,10,11,12,13,14,15,0,0};
__device__ const unsigned char CAND_B[52] = {0,1,2,3,4,5,6,7,8,9,10,11,12,13,14,15,0,1,2,3,4,5,6,7,0,1,2,3,4,0,1,2,3,0,1,2,0,1,0,1,0,1,0,0,0,0,0,0,0,0,0,0};

__device__ __forceinline__ int opaque_tid() { int t = threadIdx.x; asm volatile("" : "+v"(t)); return t; }
__device__ __forceinline__ bf16_t f2bf(float f) {
  unsigned u = __float_as_uint(f);
  u += 0x7fffu + ((u >> 16) & 1u);
  return (bf16_t)(u >> 16);
}
__device__ __forceinline__ float bf2f(bf16_t b) { return __uint_as_float(((unsigned)b) << 16); }
__device__ __forceinline__ float bflo(unsigned u) { return __uint_as_float(u << 16); }
__device__ __forceinline__ float bfhi(unsigned u) { return __uint_as_float(u & 0xffff0000u); }
__device__ __forceinline__ unsigned pack2(float a, float b) { return (unsigned)f2bf(a) | ((unsigned)f2bf(b) << 16); }
__device__ __forceinline__ float wave_sum(float v) {
#pragma unroll
  for (int o = 32; o > 0; o >>= 1) v += __shfl_xor(v, o);
  return v;
}
__device__ __forceinline__ f32x4 mfma16(bf16x8 a, bf16x8 b, f32x4 c) {
  return __builtin_amdgcn_mfma_f32_16x16x32_bf16(a, b, c, 0, 0, 0);
}
__device__ __forceinline__ bf16x8 ldfrag(const bf16_t* p) { return *(const bf16x8*)p; }
__device__ __forceinline__ float siluf(float v) { return v / (1.f + __expf(-v)); }
__device__ __forceinline__ int tok_mod(int t) { return t < NPROMPT ? 0 : 1 + ((t - NPROMPT) >> 11); }
__device__ __forceinline__ unsigned fkey(float f) {
  unsigned u = __float_as_uint(f);
  return (u & 0x80000000u) ? ~u : (u | 0x80000000u);
}
__device__ __forceinline__ float keyf(unsigned k) {
  unsigned b = (k & 0x80000000u) ? (k ^ 0x80000000u) : ~k;
  return __uint_as_float(b);
}
__device__ __forceinline__ void unpack8(uint4 v, float* f) {
  f[0] = bflo(v.x); f[1] = bfhi(v.x); f[2] = bflo(v.y); f[3] = bfhi(v.y);
  f[4] = bflo(v.z); f[5] = bfhi(v.z); f[6] = bflo(v.w); f[7] = bfhi(v.w);
}

__device__ __forceinline__ void prep_mod(const Params& p, float* smem) {
  float* sc = smem;
  float* red = smem + 9 * 1024;
  const int tid = opaque_tid();
  const float* c = p.in[4];
  const float* cctx = p.in[5];
  for (int i = tid; i < 9 * 1024; i += 256) {
    int m = i >> 10, k = i & 1023;
    float v = (m == 0) ? cctx[k] : c[(m - 1) * 1024 + k];
    sc[i] = v / (1.f + expf(-v));
  }
  __syncthreads();
  float* modv = (float*)(p.ws + OFF_MOD);
  const int cl = tid & 63, kg = tid >> 6;
  for (int u = blockIdx.x; u < 4 * 96; u += gridDim.x) {
    const int l = u / 96, nb = (u % 96) * 64;
    const float* W = p.in[6] + (size_t)l * 1024 * 6144 + nb + cl;
    float acc[9];
#pragma unroll
    for (int m = 0; m < 9; ++m) acc[m] = 0.f;
#pragma unroll 4
    for (int k = kg * 256; k < kg * 256 + 256; ++k) {
      float w = W[(size_t)k * 6144];
#pragma unroll
      for (int m = 0; m < 9; ++m) acc[m] += sc[m * 1024 + k] * w;
    }
#pragma unroll
    for (int m = 0; m < 9; ++m) red[(kg * 9 + m) * 64 + cl] = acc[m];
    __syncthreads();
    for (int i = tid; i < 9 * 64; i += 256) {
      int m = i >> 6, c2 = i & 63;
      float s = red[(0 * 9 + m) * 64 + c2] + red[(1 * 9 + m) * 64 + c2] + red[(2 * 9 + m) * 64 + c2] + red[(3 * 9 + m) * 64 + c2];
      int nn = nb + c2;
      modv[(size_t)(l * 9 + m) * 6144 + nn] = s + p.in[7][l * 6144 + nn];
    }
    __syncthreads();
  }
}

__device__ __forceinline__ void prep_transpose(const float* src, bf16_t* dst, int N, int Npad, float* tile) {
  const int tid = opaque_tid();
  const int ntn = Npad / 64;
  const int units = ntn * 16;
  for (int u = blockIdx.x; u < units; u += gridDim.x) {
    const int nt = u % ntn, kt = u / ntn;
    const int n0 = nt * 64, k0 = kt * 64;
#pragma unroll 4
    for (int i = 0; i < 16; ++i) {
      int r = (tid >> 6) + 4 * i, c = tid & 63;
      int n = n0 + c;
      tile[r * 65 + c] = (n < N) ? src[(size_t)(k0 + r) * N + n] : 0.f;
    }
    __syncthreads();
#pragma unroll 4
    for (int i = 0; i < 16; ++i) {
      int rr = (tid >> 6) + 4 * i, cc = tid & 63;
      dst[(size_t)(n0 + rr) * 1024 + k0 + cc] = f2bf(tile[cc * 65 + rr]);
    }
    __syncthreads();
  }
}

__device__ __forceinline__ void prep_convert(const float* src, bf16_t* dst, size_t n4) {
  const size_t stride = (size_t)gridDim.x * 256;
  for (size_t i = (size_t)blockIdx.x * 256 + threadIdx.x; i < n4; i += stride) {
    float4 v = ((const float4*)src)[i];
    uint2 o;
    o.x = pack2(v.x, v.y);
    o.y = pack2(v.z, v.w);
    ((uint2*)dst)[i] = o;
  }
}

__device__ __forceinline__ void phase_prep_a(const Params& p, unsigned char* smem) {
  float* fs = (float*)smem;
  prep_mod(p, fs);
  {
    float2* rope = (float2*)(p.ws + OFF_ROPE);
    int i = blockIdx.x * 256 + threadIdx.x;
    if (i < 64 * 16) {
      int pos = i >> 4, f = i & 15;
      float fr = powf(10000.f, -(float)f / 16.f);
      float ang = (float)pos * fr;
      rope[i] = make_float2(cosf(ang), sinf(ang));
    }
  }
  for (int i = 0; i < 2; ++i) {
    prep_transpose(p.in[11] + (size_t)i * 1024 * 3072, (bf16_t*)(p.ws + OFF_WIN_EV) + (size_t)i * 3072 * 1024, 3072, 3072, fs);
    prep_transpose(p.in[16] + (size_t)i * 1024 * 3088, (bf16_t*)(p.ws + OFF_WIN_OD) + (size_t)i * 3200 * 1024, 3088, 3200, fs);
    prep_transpose(p.in[12] + (size_t)i * 1024 * 1024, (bf16_t*)(p.ws + OFF_WOUT) + (size_t)(2 * i) * 1024 * 1024, 1024, 1024, fs);
    prep_transpose(p.in[17] + (size_t)i * 1024 * 1024, (bf16_t*)(p.ws + OFF_WOUT) + (size_t)(2 * i + 1) * 1024 * 1024, 1024, 1024, fs);
  }
  for (int l = 0; l < 4; ++l)
    prep_transpose(p.in[26] + (size_t)l * 1024 * 2048, (bf16_t*)(p.ws + OFF_WQ) + (size_t)l * 2048 * 1024, 2048, 2048, fs);
  prep_convert(p.in[27], (bf16_t*)(p.ws + OFF_KEYS), (size_t)4 * 8 * 2 * 128 * 128 / 4);
  prep_convert(p.in[28], (bf16_t*)(p.ws + OFF_UB), (size_t)4 * 16384 * 1024 / 4);
  prep_convert(p.in[29], (bf16_t*)(p.ws + OFF_VB), (size_t)4 * 16384 * 1024 / 4);
}

__device__ __forceinline__ void norm_token(const float* xrow, const float* g, const float* scale, const float* shift,
                                           bf16_t* hrow, float* copy_dst, int lane) {
  float4 v[4];
  float ss = 0.f;
#pragma unroll
  for (int i = 0; i < 4; ++i) {
    v[i] = *(const float4*)(xrow + i * 256 + lane * 4);
    ss += v[i].x * v[i].x + v[i].y * v[i].y + v[i].z * v[i].z + v[i].w * v[i].w;
  }
  ss = wave_sum(ss);
  const float rs = rsqrtf(ss * (1.f / 1024.f) + EPSV);
#pragma unroll
  for (int i = 0; i < 4; ++i) {
    const int idx = i * 256 + lane * 4;
    if (copy_dst) *(float4*)(copy_dst + idx) = v[i];
    float4 gg = *(const float4*)(g + idx);
    float4 sc = *(const float4*)(scale + idx);
    float4 sh = *(const float4*)(shift + idx);
    float a = v[i].x * rs * gg.x * (1.f + sc.x) + sh.x;
    float b = v[i].y * rs * gg.y * (1.f + sc.y) + sh.y;
    float c = v[i].z * rs * gg.z * (1.f + sc.z) + sh.z;
    float d = v[i].w * rs * gg.w * (1.f + sc.w) + sh.w;
    uint2 o;
    o.x = pack2(a, b);
    o.y = pack2(c, d);
    *(uint2*)(hrow + idx) = o;
  }
}

__device__ __forceinline__ void phase_prep_b(const Params& p) {
  const int tid_ = opaque_tid(); const int lane = tid_ & 63, wv = tid_ >> 6;
  const float* modv = (const float*)(p.ws + OFF_MOD);
  bf16_t* H = (bf16_t*)(p.ws + OFF_H);
  for (int t = blockIdx.x * 4 + wv; t < NTOK; t += gridDim.x * 4) {
    const float* xr = (t < NPROMPT) ? p.in[0] + (size_t)t * 1024 : p.in[1] + (size_t)(t - NPROMPT) * 1024;
    const float* md = modv + (size_t)(0 * 9 + tok_mod(t)) * 6144;
    norm_token(xr, p.in[8], md + 1024, md, H + (size_t)t * 1024, p.out + (size_t)t * 1024, lane);
  }
}

__device__ __forceinline__ void phase_norm2(const Params& p, int l) {
  const int tid_ = opaque_tid(); const int lane = tid_ & 63, wv = tid_ >> 6;
  const float* modv = (const float*)(p.ws + OFF_MOD);
  bf16_t* H = (bf16_t*)(p.ws + OFF_H);
  for (int t = blockIdx.x * 4 + wv; t < NTOK; t += gridDim.x * 4) {
    const float* md = modv + (size_t)(l * 9 + tok_mod(t)) * 6144;
    norm_token(p.out + (size_t)t * 1024, p.in[9] + l * 1024, md + 4096, md + 3072, H + (size_t)t * 1024, nullptr, lane);
  }
}

template <int EPI>
__device__ __forceinline__ void gemm_phase(const bf16_t* __restrict__ A, const bf16_t* __restrict__ Bt, int ntiles_n,
                           bf16_t* __restrict__ C, int ldc, float* __restrict__ X, const float* __restrict__ ga,
                           unsigned char* smem) {
  bf16_t* As = (bf16_t*)smem;
  bf16_t* Bs = As + 128 * 72;
  const int tid = opaque_tid(), lane = tid & 63, w = tid >> 6, quad = lane >> 4, l15 = lane & 15;
  const int wm = w >> 1, wn = w & 1;
  const int lr = tid >> 3, lseg = (tid & 7) * 8;
  const int units = 192 * ntiles_n;
  for (int u = blockIdx.x; u < units; u += gridDim.x) {
    const int mt = u % 192, nt = u / 192;
    const int m0 = mt * 128, n0 = nt * 128;
    f32x4 acc[4][4];
#pragma unroll
    for (int i = 0; i < 4; ++i)
#pragma unroll
      for (int j = 0; j < 4; ++j) acc[i][j] = (f32x4){0.f, 0.f, 0.f, 0.f};
    const bf16_t* Ag = A + (size_t)(m0 + lr) * 1024 + lseg;
    const bf16_t* Bg = Bt + (size_t)(n0 + lr) * 1024 + lseg;
    u32x4 ra0, ra1, ra2, ra3, rb0, rb1, rb2, rb3;
    ra0 = *(const u32x4*)(Ag); ra1 = *(const u32x4*)(Ag + 32 * 1024); ra2 = *(const u32x4*)(Ag + 64 * 1024); ra3 = *(const u32x4*)(Ag + 96 * 1024);
    rb0 = *(const u32x4*)(Bg); rb1 = *(const u32x4*)(Bg + 32 * 1024); rb2 = *(const u32x4*)(Bg + 64 * 1024); rb3 = *(const u32x4*)(Bg + 96 * 1024);
    for (int kt = 0; kt < 16; ++kt) {
      *(u32x4*)(As + (lr) * 72 + lseg) = ra0; *(u32x4*)(As + (lr + 32) * 72 + lseg) = ra1;
      *(u32x4*)(As + (lr + 64) * 72 + lseg) = ra2; *(u32x4*)(As + (lr + 96) * 72 + lseg) = ra3;
      *(u32x4*)(Bs + (lr) * 72 + lseg) = rb0; *(u32x4*)(Bs + (lr + 32) * 72 + lseg) = rb1;
      *(u32x4*)(Bs + (lr + 64) * 72 + lseg) = rb2; *(u32x4*)(Bs + (lr + 96) * 72 + lseg) = rb3;
      __syncthreads();
      if (kt + 1 < 16) {
        const bf16_t* An = Ag + (kt + 1) * 64; const bf16_t* Bn = Bg + (kt + 1) * 64;
        ra0 = *(const u32x4*)(An); ra1 = *(const u32x4*)(An + 32 * 1024); ra2 = *(const u32x4*)(An + 64 * 1024); ra3 = *(const u32x4*)(An + 96 * 1024);
        rb0 = *(const u32x4*)(Bn); rb1 = *(const u32x4*)(Bn + 32 * 1024); rb2 = *(const u32x4*)(Bn + 64 * 1024); rb3 = *(const u32x4*)(Bn + 96 * 1024);
      }
#pragma unroll
      for (int kk = 0; kk < 2; ++kk) {
        bf16x8 af[4], bfr[4];
#pragma unroll
        for (int i = 0; i < 4; ++i) af[i] = ldfrag(As + (wm * 64 + i * 16 + l15) * 72 + kk * 32 + quad * 8);
#pragma unroll
        for (int j = 0; j < 4; ++j) bfr[j] = ldfrag(Bs + (wn * 64 + j * 16 + l15) * 72 + kk * 32 + quad * 8);
#pragma unroll
        for (int i = 0; i < 4; ++i)
#pragma unroll
          for (int j = 0; j < 4; ++j) acc[i][j] = mfma16(af[i], bfr[j], acc[i][j]);
      }
      __syncthreads();
    }
    if (EPI == 0) {
#pragma unroll
      for (int i = 0; i < 4; ++i)
#pragma unroll
        for (int j = 0; j < 4; ++j)
#pragma unroll
          for (int jj = 0; jj < 4; ++jj) {
            int row = m0 + wm * 64 + i * 16 + quad * 4 + jj;
            int col = n0 + wn * 64 + j * 16 + l15;
            C[(size_t)row * ldc + col] = f2bf(acc[i][j][jj]);
          }
    } else {
      const float* gam = ga + (size_t)tok_mod(m0) * 6144;
#pragma unroll
      for (int i = 0; i < 4; ++i)
#pragma unroll
        for (int j = 0; j < 4; ++j)
#pragma unroll
          for (int jj = 0; jj < 4; ++jj) {
            int row = m0 + wm * 64 + i * 16 + quad * 4 + jj;
            int col = n0 + wn * 64 + j * 16 + l15;
            float* xp = X + (size_t)row * 1024 + col;
            *xp = *xp + gam[col] * acc[i][j][jj];
          }
    }
  }
}

struct ChainItem {
  bool lng; int sl, dir, h, sq, tok0, nc;
};
__device__ __forceinline__ ChainItem decode_item(int it) {
  ChainItem c;
  c.lng = it < 256;
  int idx = c.lng ? it : it - 256;
  c.sl = idx & 3; c.dir = (idx >> 2) & 1; c.h = (idx >> 3) & 3; c.sq = idx >> 5;
  c.tok0 = c.lng ? NPROMPT + c.sq * 2048 : c.sq * 256;
  c.nc = c.lng ? 32 : 4;
  return c;
}

__device__ __forceinline__ void phase_ret_chain(const Params& p, int l, unsigned char* smem) {
  const int il = l >> 1;
  bf16_t* qs = (bf16_t*)smem;
  bf16_t* ks = qs + 64 * 72;
  bf16_t* kT = ks + 64 * 72;
  bf16_t* vT = kT + 64 * 72;
  bf16_t* intra = vT + 32 * 72;
  bf16_t* ST = intra + 64 * 72;
  const bf16_t* P = (const bf16_t*)(p.ws + OFF_P);
  float* odir = (float*)(p.ws + OFF_ODIR);
  const float2* rope = (const float2*)(p.ws + OFF_ROPE);
  const int tid = opaque_tid(), lane = tid & 63, w = tid >> 6, quad = lane >> 4, l15 = lane & 15;
  for (int it = blockIdx.x; it < 1280; it += gridDim.x) {
    const ChainItem ci = decode_item(it);
    const int sl = ci.sl, dir = ci.dir, h = ci.h;
    const float xg = p.in[13][(il * 2 + dir) * 4 + h];
    const float lg = -log1pf(expf(-xg));
    const float g64 = expf(lg * 64.f);
    f32x4 S[2];
    if (ci.lng) {
      const float* s0 = p.in[2] + ((((size_t)ci.sq * 2 + il) * 2 + dir) * 4 + h) * 8192;
#pragma unroll
      for (int ct = 0; ct < 2; ++ct)
#pragma unroll
        for (int jj = 0; jj < 4; ++jj) S[ct][jj] = s0[(16 * w + quad * 4 + jj) * 128 + sl * 32 + ct * 16 + l15];
    } else {
      S[0] = (f32x4){0.f, 0.f, 0.f, 0.f};
      S[1] = (f32x4){0.f, 0.f, 0.f, 0.f};
    }
    for (int n = 0; n < ci.nc; ++n) {
      const int cn = dir ? ci.nc - 1 - n : n;
      const int tb = ci.tok0 + cn * 64;
      {
        const int i = tid >> 2, mq = tid & 3;
        const int t = tb + (dir ? 63 - i : i);
        const bf16_t* pr = P + (size_t)t * PSTRIDE;
        float qa[8], qb[8], ka[8], kb[8];
        unpack8(*(const uint4*)(pr + h * 64 + mq * 8), qa);
        unpack8(*(const uint4*)(pr + h * 64 + 32 + mq * 8), qb);
        unpack8(*(const uint4*)(pr + 256 + h * 64 + mq * 8), ka);
        unpack8(*(const uint4*)(pr + 256 + h * 64 + 32 + mq * 8), kb);
        if (ci.lng) {
          const int pos = (mq < 2) ? cn : (t - tb);
          const int f0 = (mq & 1) * 8;
#pragma unroll
          for (int e = 0; e < 8; ++e) {
            float2 cs = rope[pos * 16 + f0 + e];
            float a = qa[e], b = qb[e];
            qa[e] = a * cs.x - b * cs.y; qb[e] = b * cs.x + a * cs.y;
            a = ka[e]; b = kb[e];
            ka[e] = a * cs.x - b * cs.y; kb[e] = b * cs.x + a * cs.y;
          }
        }
        const float wend = expf(lg * (float)(63 - i));
        uint4 o;
        o.x = pack2(qa[0], qa[1]); o.y = pack2(qa[2], qa[3]); o.z = pack2(qa[4], qa[5]); o.w = pack2(qa[6], qa[7]);
        *(uint4*)(qs + i * 72 + mq * 8) = o;
        o.x = pack2(qb[0], qb[1]); o.y = pack2(qb[2], qb[3]); o.z = pack2(qb[4], qb[5]); o.w = pack2(qb[6], qb[7]);
        *(uint4*)(qs + i * 72 + 32 + mq * 8) = o;
#pragma unroll
        for (int e = 0; e < 8; ++e) { ka[e] *= 0.125f; kb[e] *= 0.125f; }
        o.x = pack2(ka[0], ka[1]); o.y = pack2(ka[2], ka[3]); o.z = pack2(ka[4], ka[5]); o.w = pack2(ka[6], ka[7]);
        *(uint4*)(ks + i * 72 + mq * 8) = o;
        o.x = pack2(kb[0], kb[1]); o.y = pack2(kb[2], kb[3]); o.z = pack2(kb[4], kb[5]); o.w = pack2(kb[6], kb[7]);
        *(uint4*)(ks + i * 72 + 32 + mq * 8) = o;
#pragma unroll
        for (int e = 0; e < 8; ++e) {
          kT[(mq * 8 + e) * 72 + i] = f2bf(ka[e] * wend);
          kT[(32 + mq * 8 + e) * 72 + i] = f2bf(kb[e] * wend);
        }
        uint4 v8 = *(const uint4*)(pr + 512 + h * 128 + sl * 32 + mq * 8);
        vT[(mq * 8 + 0) * 72 + i] = (bf16_t)(v8.x & 0xffff); vT[(mq * 8 + 1) * 72 + i] = (bf16_t)(v8.x >> 16);
        vT[(mq * 8 + 2) * 72 + i] = (bf16_t)(v8.y & 0xffff); vT[(mq * 8 + 3) * 72 + i] = (bf16_t)(v8.y >> 16);
        vT[(mq * 8 + 4) * 72 + i] = (bf16_t)(v8.z & 0xffff); vT[(mq * 8 + 5) * 72 + i] = (bf16_t)(v8.z >> 16);
        vT[(mq * 8 + 6) * 72 + i] = (bf16_t)(v8.w & 0xffff); vT[(mq * 8 + 7) * 72 + i] = (bf16_t)(v8.w >> 16);
      }
      __syncthreads();
      const bf16x8 a0 = ldfrag(qs + (16 * w + l15) * 72 + quad * 8);
      const bf16x8 a1 = ldfrag(qs + (16 * w + l15) * 72 + 32 + quad * 8);
#pragma unroll
      for (int ct = 0; ct < 4; ++ct) {
        bf16x8 b0 = ldfrag(ks + (ct * 16 + l15) * 72 + quad * 8);
        bf16x8 b1 = ldfrag(ks + (ct * 16 + l15) * 72 + 32 + quad * 8);
        f32x4 c = (f32x4){0.f, 0.f, 0.f, 0.f};
        c = mfma16(a0, b0, c);
        c = mfma16(a1, b1, c);
#pragma unroll
        for (int jj = 0; jj < 4; ++jj) {
          int i = 16 * w + quad * 4 + jj, j = ct * 16 + l15;
          float val = (i >= j) ? c[jj] * expf(lg * (float)(i - j)) : 0.f;
          intra[i * 72 + j] = f2bf(val);
        }
      }
#pragma unroll
      for (int ct = 0; ct < 2; ++ct)
#pragma unroll
        for (int jj = 0; jj < 4; ++jj) ST[(ct * 16 + l15) * 72 + 16 * w + quad * 4 + jj] = f2bf(S[ct][jj]);
      __syncthreads();
      const bf16x8 ai0 = ldfrag(intra + (16 * w + l15) * 72 + quad * 8);
      const bf16x8 ai1 = ldfrag(intra + (16 * w + l15) * 72 + 32 + quad * 8);
      const bf16x8 ak0 = ldfrag(kT + (16 * w + l15) * 72 + quad * 8);
      const bf16x8 ak1 = ldfrag(kT + (16 * w + l15) * 72 + 32 + quad * 8);
#pragma unroll
      for (int ct = 0; ct < 2; ++ct) {
        bf16x8 bv0 = ldfrag(vT + (ct * 16 + l15) * 72 + quad * 8);
        bf16x8 bv1 = ldfrag(vT + (ct * 16 + l15) * 72 + 32 + quad * 8);
        bf16x8 bs0 = ldfrag(ST + (ct * 16 + l15) * 72 + quad * 8);
        bf16x8 bs1 = ldfrag(ST + (ct * 16 + l15) * 72 + 32 + quad * 8);
        f32x4 ci_ = (f32x4){0.f, 0.f, 0.f, 0.f}, cc = (f32x4){0.f, 0.f, 0.f, 0.f};
        ci_ = mfma16(ai0, bv0, ci_);
        ci_ = mfma16(ai1, bv1, ci_);
        cc = mfma16(a0, bs0, cc);
        cc = mfma16(a1, bs1, cc);
#pragma unroll
        for (int jj = 0; jj < 4; ++jj) {
          int i = 16 * w + quad * 4 + jj;
          int t = tb + (dir ? 63 - i : i);
          float o = ci_[jj] + expf(lg * (float)(i + 1)) * cc[jj];
          odir[((size_t)dir * NTOK + t) * 512 + h * 128 + sl * 32 + ct * 16 + l15] = o;
        }
        f32x4 s = S[ct];
        s[0] *= g64; s[1] *= g64; s[2] *= g64; s[3] *= g64;
        s = mfma16(ak0, bv0, s);
        s = mfma16(ak1, bv1, s);
        S[ct] = s;
      }
      __syncthreads();
    }
    if (!ci.lng) {
      float* so = p.out + 25165824 + ((((size_t)ci.sq * 2 + il) * 2 + dir) * 4 + h) * 8192;
#pragma unroll
      for (int ct = 0; ct < 2; ++ct)
#pragma unroll
        for (int jj = 0; jj < 4; ++jj) so[(16 * w + quad * 4 + jj) * 128 + sl * 32 + ct * 16 + l15] = S[ct][jj];
    }
  }
}

__device__ __forceinline__ void gdn_prep_item(const Params& p, int l, int pi, unsigned char* smem) {
  const int il = l >> 1;
  bf16_t* ks = (bf16_t*)smem;
  bf16_t* vs = ks + 64 * 136;
  float* Am = (float*)(vs + 64 * 136);
  float* rq = Am + 4096;
  float* rk = rq + 64;
  float* gcs = rk + 64;
  float* bet = gcs + 64;
  float* fac = bet + 64;
  bf16_t* qs = (bf16_t*)(fac + 128);
  const bf16_t* P = (const bf16_t*)(p.ws + OFF_P);
  unsigned char* gp = p.ws + OFF_GPREP + (size_t)pi * GP_ITEM;
  bf16_t* Wb = (bf16_t*)gp;
  bf16_t* QG = Wb + 8192;
  bf16_t* KDT = QG + 8192;
  bf16_t* Ub = KDT + 8192;
  bf16_t* ATT = Ub + 8192;
  float* EGL = (float*)(p.ws + OFF_EGL);
  const int tid = opaque_tid(), lane = tid & 63, w = tid >> 6, quad = lane >> 4, l15 = lane & 15;
  const int dir = pi & 1, h = (pi >> 1) & 3, c = pi >> 3;
  int tb, seq_lo, seq_hi;
  if (c < 128) { tb = c * 64; seq_lo = (c >> 2) * 256; seq_hi = seq_lo + 256; }
  else { int cc = c - 128; tb = NPROMPT + cc * 64; seq_lo = NPROMPT + (cc >> 5) * 2048; seq_hi = seq_lo + 2048; }
  const float SCALE = 0.08838834764831845f;
  {
    const int cg_ = tid & 127, rh = tid >> 7;
    for (int mat = 0; mat < 3; ++mat) {
      const int col = mat * 512 + h * 128 + cg_;
      const float* cw = p.in[18] + (size_t)il * 3 * 1536 + col;
      const float w0 = cw[0], w1 = cw[1536], w2 = cw[3072];
      bf16_t* dst = mat == 0 ? qs : (mat == 1 ? ks : vs);
      const int t0 = tb + rh * 32;
      float xm = (t0 - 1 >= seq_lo) ? bf2f(P[(size_t)(t0 - 1) * PSTRIDE + col]) : 0.f;
      float x0 = bf2f(P[(size_t)t0 * PSTRIDE + col]);
      for (int o = 0; o < 32; ++o) {
        const int t = t0 + o;
        float xp = (t + 1 < seq_hi) ? bf2f(P[(size_t)(t + 1) * PSTRIDE + col]) : 0.f;
        float y = w0 * xm + w1 * x0 + w2 * xp;
        y = siluf(y);
        const int oi = rh * 32 + o;
        const int i = dir ? 63 - oi : oi;
        dst[i * 136 + cg_] = f2bf(y);
        xm = x0; x0 = xp;
      }
    }
  }
  __syncthreads();
  {
    const int r = tid >> 2, part = tid & 3;
    float sq_ = 0.f, sk_ = 0.f;
#pragma unroll 8
    for (int e = 0; e < 32; ++e) {
      float a = bf2f(qs[r * 136 + part * 32 + e]);
      float b = bf2f(ks[r * 136 + part * 32 + e]);
      sq_ += a * a; sk_ += b * b;
    }
    sq_ += __shfl_xor(sq_, 1); sq_ += __shfl_xor(sq_, 2);
    sk_ += __shfl_xor(sk_, 1); sk_ += __shfl_xor(sk_, 2);
    if (part == 0) {
      rq[r] = rsqrtf(sq_ + EPSV);
      rk[r] = rsqrtf(sk_ + EPSV);
      const int t = tb + (dir ? 63 - r : r);
      float a = bf2f(P[(size_t)t * PSTRIDE + 2048 + dir * 4 + h]);
      float bbv = bf2f(P[(size_t)t * PSTRIDE + 2056 + dir * 4 + h]);
      float al = p.in[19][(il * 2 + dir) * 4 + h], dtb = p.in[20][(il * 2 + dir) * 4 + h];
      float z = a + dtb;
      float sp = (z > 20.f) ? z : log1pf(expf(z));
      gcs[r] = -expf(al) * sp;
      bet[r] = 1.f / (1.f + expf(-bbv));
    }
  }
  __syncthreads();
  if (tid < 64) {
    float v = gcs[tid];
#pragma unroll
    for (int o = 1; o < 64; o <<= 1) {
      float u = __shfl_up(v, o);
      if (tid >= o) v += u;
    }
    gcs[tid] = v;
  }
  __syncthreads();
  {
    bf16x8 ak[4], aq[4];
#pragma unroll
    for (int kk = 0; kk < 4; ++kk) {
      ak[kk] = ldfrag(ks + (16 * w + l15) * 136 + kk * 32 + quad * 8);
      aq[kk] = ldfrag(qs + (16 * w + l15) * 136 + kk * 32 + quad * 8);
    }
#pragma unroll
    for (int ct = 0; ct < 4; ++ct) {
      f32x4 ckk = (f32x4){0.f, 0.f, 0.f, 0.f}, cqk = (f32x4){0.f, 0.f, 0.f, 0.f};
#pragma unroll
      for (int kk = 0; kk < 4; ++kk) {
        bf16x8 b = ldfrag(ks + (ct * 16 + l15) * 136 + kk * 32 + quad * 8);
        ckk = mfma16(ak[kk], b, ckk);
        cqk = mfma16(aq[kk], b, cqk);
      }
#pragma unroll
      for (int jj = 0; jj < 4; ++jj) {
        const int i = 16 * w + quad * 4 + jj, j = ct * 16 + l15;
        const float dec = (i >= j) ? expf(gcs[i] - gcs[j]) : 0.f;
        Am[j * 64 + i] = (i > j) ? bet[i] * rk[i] * rk[j] * ckk[jj] * dec : 0.f;
        ATT[i * 64 + j] = f2bf((i >= j) ? SCALE * rq[i] * rk[j] * cqk[jj] * dec : 0.f);
      }
    }
  }
  __syncthreads();
  const float gl = gcs[63];
  for (int e = tid; e < 64 * 128; e += 256) {
    int i = e >> 7, d = e & 127;
    QG[e] = f2bf(bf2f(qs[i * 136 + d]) * rq[i] * SCALE * __expf(gcs[i]));
  }
  for (int e = tid; e < 128 * 64; e += 256) {
    int d = e >> 6, i = e & 63;
    KDT[e] = f2bf(bf2f(ks[i * 136 + d]) * rk[i] * __expf(gl - gcs[i]));
  }
  if (tid < 64) {
    fac[tid] = bet[tid];
    fac[64 + tid] = rk[tid] * bet[tid] * __expf(gcs[tid]);
  }
  __syncthreads();
  {
    const int cidx = tid & 127;
    const bf16_t* srcm = ((tid < 128) ? vs : ks) + cidx;
    const float* fc = fac + ((tid < 128) ? 0 : 64);
    bf16_t* dstm = ((tid < 128) ? Ub : Wb) + cidx;
    bf16_t* XB = qs + tid;
#pragma unroll 1
    for (int b = 0; b < 4; ++b) {
      float x[16];
#pragma unroll
      for (int r = 0; r < 16; ++r) x[r] = bf2f(srcm[(16 * b + r) * 136]) * fc[16 * b + r];
      const float* arow = Am + 16 * b;
#pragma unroll 2
      for (int j = 0; j < 16 * b; ++j) {
        const float xv = bf2f(XB[j * 256]);
        const f32x4 a0 = *(const f32x4*)(arow + j * 64), a1 = *(const f32x4*)(arow + j * 64 + 4);
        const f32x4 a2 = *(const f32x4*)(arow + j * 64 + 8), a3 = *(const f32x4*)(arow + j * 64 + 12);
#pragma unroll
        for (int r = 0; r < 4; ++r) {
          x[r] -= a0[r] * xv; x[4 + r] -= a1[r] * xv; x[8 + r] -= a2[r] * xv; x[12 + r] -= a3[r] * xv;
        }
      }
      const float* ablk = Am + (16 * b) * 64 + 16 * b;
#pragma unroll
      for (int jj = 0; jj < 15; ++jj) {
#pragma unroll
        for (int r = jj + 1; r < 16; ++r) x[r] -= ablk[jj * 64 + r] * x[jj];
      }
#pragma unroll
      for (int r = 0; r < 16; ++r) {
        const bf16_t bb = f2bf(x[r]);
        dstm[(16 * b + r) * 128] = bb;
        if (b < 3) XB[(16 * b + r) * 256] = bb;
      }
    }
  }
  if (tid == 0) EGL[pi] = expf(gl);
  __syncthreads();
}

__device__ __forceinline__ void conf_conv_item(const Params& p, int l, int item, unsigned char* smem) {
  const int il = l >> 1;
  float* hc = (float*)smem;
  const bf16_t* P = (const bf16_t*)(p.ws + OFF_P);
  float* convout = (float*)(p.ws + OFF_CONV);
  const int tid = opaque_tid();
  const int tile = item >> 1, ch = (item & 1) * 256 + tid;
  const int t0 = tile * 32;
  int seq_lo, seq_hi;
  if (t0 < NPROMPT) { seq_lo = (t0 >> 8) << 8; seq_hi = seq_lo + 256; }
  else { seq_lo = NPROMPT + (((t0 - NPROMPT) >> 11) << 11); seq_hi = seq_lo + 2048; }
  for (int r = 0; r < 62; ++r) {
    const int tt = t0 - 15 + r;
    float v = 0.f;
    if (tt >= seq_lo && tt < seq_hi) {
      float ca = bf2f(P[(size_t)tt * PSTRIDE + 2064 + ch]);
      float cgv = bf2f(P[(size_t)tt * PSTRIDE + 2576 + ch]);
      v = ca / (1.f + __expf(-cgv));
    }
    hc[r * 256 + tid] = v;
  }
  float wk[31];
#pragma unroll
  for (int k = 0; k < 31; ++k) wk[k] = p.in[22][((size_t)il * 31 + k) * 512 + ch];
  const float bias = p.in[23][il * 512 + ch];
  for (int i = 0; i < 32; ++i) {
    float acc = bias;
#pragma unroll
    for (int k = 0; k < 31; ++k) acc += wk[k] * hc[(i + k) * 256 + tid];
    convout[(size_t)(t0 + i) * 512 + ch] = acc;
  }
}

__device__ __forceinline__ void phase_odd_prep(const Params& p, int l, unsigned char* smem) {
  for (int u = blockIdx.x; u < 3072 + 1536; u += gridDim.x) {
    if (u < 3072) gdn_prep_item(p, l, u, smem);
    else { conf_conv_item(p, l, u - 3072, smem); __syncthreads(); }
  }
}

__device__ __forceinline__ void phase_gdn_chain(const Params& p, int l, unsigned char* smem) {
  const int il = l >> 1;
  bf16_t* ST = (bf16_t*)smem;
  bf16_t* VT = ST + 32 * 136;
  float* odir = (float*)(p.ws + OFF_ODIR);
  const float* EGL = (const float*)(p.ws + OFF_EGL);
  const int tid = opaque_tid(), lane = tid & 63, w = tid >> 6, quad = lane >> 4, l15 = lane & 15;
  for (int it = blockIdx.x; it < 1280; it += gridDim.x) {
    const ChainItem ci = decode_item(it);
    const int sl = ci.sl, dir = ci.dir, h = ci.h;
    f32x4 S[2][2];
    if (ci.lng) {
      const float* s0 = p.in[3] + ((((size_t)ci.sq * 2 + il) * 2 + dir) * 4 + h) * 16384;
#pragma unroll
      for (int rb = 0; rb < 2; ++rb)
#pragma unroll
        for (int ct = 0; ct < 2; ++ct)
#pragma unroll
          for (int jj = 0; jj < 4; ++jj)
            S[rb][ct][jj] = s0[(16 * (2 * w + rb) + quad * 4 + jj) * 128 + sl * 32 + ct * 16 + l15];
    } else {
#pragma unroll
      for (int rb = 0; rb < 2; ++rb)
#pragma unroll
        for (int ct = 0; ct < 2; ++ct) S[rb][ct] = (f32x4){0.f, 0.f, 0.f, 0.f};
    }
    for (int n = 0; n < ci.nc; ++n) {
      const int cn = dir ? ci.nc - 1 - n : n;
      const int tb = ci.tok0 + cn * 64;
      const int cglob = ci.lng ? 128 + ci.sq * 32 + cn : ci.sq * 4 + cn;
      const int pi = (cglob * 4 + h) * 2 + dir;
      const unsigned char* gp = p.ws + OFF_GPREP + (size_t)pi * GP_ITEM;
      const bf16_t* Wb = (const bf16_t*)gp;
      const bf16_t* QG = Wb + 8192;
      const bf16_t* KDT = QG + 8192;
      const bf16_t* Ub = KDT + 8192;
      const bf16_t* ATT = Ub + 8192;
      bf16x8 aw[4], aqg[4], aat[2], akd[2][2];
      float uu[2][4];
#pragma unroll
      for (int kk = 0; kk < 4; ++kk) {
        aw[kk] = ldfrag(Wb + (16 * w + l15) * 128 + kk * 32 + quad * 8);
        aqg[kk] = ldfrag(QG + (16 * w + l15) * 128 + kk * 32 + quad * 8);
      }
#pragma unroll
      for (int kk = 0; kk < 2; ++kk) {
        aat[kk] = ldfrag(ATT + (16 * w + l15) * 64 + kk * 32 + quad * 8);
#pragma unroll
        for (int rb = 0; rb < 2; ++rb) akd[rb][kk] = ldfrag(KDT + (16 * (2 * w + rb) + l15) * 64 + kk * 32 + quad * 8);
      }
#pragma unroll
      for (int ct = 0; ct < 2; ++ct)
#pragma unroll
        for (int jj = 0; jj < 4; ++jj) uu[ct][jj] = bf2f(Ub[(16 * w + quad * 4 + jj) * 128 + sl * 32 + ct * 16 + l15]);
      const float egl = EGL[pi];
#pragma unroll
      for (int rb = 0; rb < 2; ++rb)
#pragma unroll
        for (int ct = 0; ct < 2; ++ct)
#pragma unroll
          for (int jj = 0; jj < 4; ++jj)
            ST[(ct * 16 + l15) * 136 + 16 * (2 * w + rb) + quad * 4 + jj] = f2bf(S[rb][ct][jj]);
      __syncthreads();
      f32x4 co[2];
#pragma unroll
      for (int ct = 0; ct < 2; ++ct) {
        f32x4 cv = (f32x4){0.f, 0.f, 0.f, 0.f};
        co[ct] = (f32x4){0.f, 0.f, 0.f, 0.f};
#pragma unroll
        for (int kk = 0; kk < 4; ++kk) {
          bf16x8 b = ldfrag(ST + (ct * 16 + l15) * 136 + kk * 32 + quad * 8);
          cv = mfma16(aw[kk], b, cv);
          co[ct] = mfma16(aqg[kk], b, co[ct]);
        }
#pragma unroll
        for (int jj = 0; jj < 4; ++jj) {
          float vn = uu[ct][jj] - cv[jj];
          VT[(ct * 16 + l15) * 72 + 16 * w + quad * 4 + jj] = f2bf(vn);
        }
      }
      __syncthreads();
#pragma unroll
      for (int ct = 0; ct < 2; ++ct) {
        bf16x8 bv[2];
#pragma unroll
        for (int kk = 0; kk < 2; ++kk) {
          bv[kk] = ldfrag(VT + (ct * 16 + l15) * 72 + kk * 32 + quad * 8);
          co[ct] = mfma16(aat[kk], bv[kk], co[ct]);
        }
#pragma unroll
        for (int jj = 0; jj < 4; ++jj) {
          int i = 16 * w + quad * 4 + jj;
          int t = tb + (dir ? 63 - i : i);
          odir[((size_t)dir * NTOK + t) * 512 + h * 128 + sl * 32 + ct * 16 + l15] = co[ct][jj];
        }
#pragma unroll
        for (int rb = 0; rb < 2; ++rb) {
          f32x4 s = S[rb][ct];
          s[0] *= egl; s[1] *= egl; s[2] *= egl; s[3] *= egl;
          s = mfma16(akd[rb][0], bv[0], s);
          s = mfma16(akd[rb][1], bv[1], s);
          S[rb][ct] = s;
        }
      }
    }
    __syncthreads();
    if (!ci.lng) {
      float* so = p.out + 29360128 + ((((size_t)ci.sq * 2 + il) * 2 + dir) * 4 + h) * 16384;
#pragma unroll
      for (int rb = 0; rb < 2; ++rb)
#pragma unroll
        for (int ct = 0; ct < 2; ++ct)
#pragma unroll
          for (int jj = 0; jj < 4; ++jj)
            so[(16 * (2 * w + rb) + quad * 4 + jj) * 128 + sl * 32 + ct * 16 + l15] = S[rb][ct][jj];
    }
  }
}

__device__ __forceinline__ void phase_mix_out(const Params& p, int l) {
  const int il = l >> 1;
  const bool odd = l & 1;
  const int tid_ = opaque_tid(); const int lane = tid_ & 63, wv = tid_ >> 6;
  const bf16_t* P = (const bf16_t*)(p.ws + OFF_P);
  const float* od0 = (const float*)(p.ws + OFF_ODIR);
  const float* od1 = od0 + (size_t)NTOK * 512;
  const float* convout = (const float*)(p.ws + OFF_CONV);
  bf16_t* Y = (bf16_t*)(p.ws + OFF_YMIX);
  for (int t = blockIdx.x * 4 + wv; t < NTOK; t += gridDim.x * 4) {
    const bf16_t* pr = P + (size_t)t * PSTRIDE;
    bf16_t* yr = Y + (size_t)t * 1024;
#pragma unroll
    for (int h = 0; h < 4; ++h) {
      const int idx = h * 128 + lane * 2;
      float2 a = *(const float2*)(od0 + (size_t)t * 512 + idx);
      float2 b = *(const float2*)(od1 + (size_t)t * 512 + idx);
      float o0 = a.x + b.x, o1 = a.y + b.y;
      float ss = wave_sum(o0 * o0 + o1 * o1);
      float rs = rsqrtf(ss * (1.f / 128.f) + EPSV);
      float n0, n1;
      unsigned gz;
      if (!odd) {
        n0 = p.in[14][il * 512 + idx]; n1 = p.in[14][il * 512 + idx + 1];
        gz = *(const unsigned*)(pr + 1024 + idx);
      } else {
        n0 = p.in[21][il * 128 + lane * 2]; n1 = p.in[21][il * 128 + lane * 2 + 1];
        gz = *(const unsigned*)(pr + 1536 + idx);
      }
      float y0 = siluf(bflo(gz)) * o0 * rs * n0;
      float y1 = siluf(bfhi(gz)) * o1 * rs * n1;
      *(unsigned*)(yr + idx) = pack2(y0, y1);
    }
    if (!odd) {
      int seq_lo, seq_hi;
      if (t < NPROMPT) { seq_lo = (t >> 8) << 8; seq_hi = seq_lo + 256; }
      else { seq_lo = NPROMPT + (((t - NPROMPT) >> 11) << 11); seq_hi = seq_lo + 2048; }
      const bool hp = (t - 1 >= seq_lo), hn = (t + 1 < seq_hi);
#pragma unroll
      for (int j = 0; j < 4; ++j) {
        const int c = j * 128 + lane * 2;
        unsigned cg0 = *(const unsigned*)(pr + 2048 + c), hb0 = *(const unsigned*)(pr + 2560 + c);
        unsigned cgm = 0, hbm = 0, cgp = 0, hbp = 0;
        if (hp) { cgm = *(const unsigned*)(pr - PSTRIDE + 2048 + c); hbm = *(const unsigned*)(pr - PSTRIDE + 2560 + c); }
        if (hn) { cgp = *(const unsigned*)(pr + PSTRIDE + 2048 + c); hbp = *(const unsigned*)(pr + PSTRIDE + 2560 + c); }
        unsigned bg = *(const unsigned*)(pr + 1536 + c);
        const float* sw = p.in[15] + (size_t)il * 3 * 512 + c;
        float y0 = bflo(bg) * (sw[0] * bflo(cgm) * bflo(hbm) + sw[512] * bflo(cg0) * bflo(hb0) + sw[1024] * bflo(cgp) * bflo(hbp));
        float y1 = bfhi(bg) * (sw[1] * bfhi(cgm) * bfhi(hbm) + sw[513] * bfhi(cg0) * bfhi(hb0) + sw[1025] * bfhi(cgp) * bfhi(hbp));
        *(unsigned*)(yr + 512 + c) = pack2(y0, y1);
      }
    } else {
      float v[8];
      float s = 0.f;
#pragma unroll
      for (int j = 0; j < 4; ++j) {
        float2 a = *(const float2*)(convout + (size_t)t * 512 + j * 128 + lane * 2);
        v[2 * j] = a.x; v[2 * j + 1] = a.y;
        s += a.x + a.y;
      }
      const float mean = wave_sum(s) * (1.f / 512.f);
      float vs = 0.f;
#pragma unroll
      for (int j = 0; j < 8; ++j) { v[j] -= mean; vs += v[j] * v[j]; }
      const float rstd = rsqrtf(wave_sum(vs) * (1.f / 512.f) + EPSV);
#pragma unroll
      for (int j = 0; j < 4; ++j) {
        const int c = j * 128 + lane * 2;
        float y0 = v[2 * j] * rstd * p.in[24][il * 512 + c] + p.in[25][il * 512 + c];
        float y1 = v[2 * j + 1] * rstd * p.in[24][il * 512 + c + 1] + p.in[25][il * 512 + c + 1];
        *(unsigned*)(yr + 512 + c) = pack2(siluf(y0), siluf(y1));
      }
    }
  }
}

__device__ __forceinline__ void phase_peer_score(const Params& p, int l, unsigned char* smem) {
  const int tid = opaque_tid(), lane = tid & 63, w = tid >> 6, quad = lane >> 4, l15 = lane & 15;
  unsigned* scw = (unsigned*)smem + w * (32 * 129 + 512);
  unsigned* sel = scw + 32 * 129;
  const bf16_t* Q = (const bf16_t*)(p.ws + OFF_Q);
  const bf16_t* KB = (const bf16_t*)(p.ws + OFF_KEYS) + (size_t)l * 8 * 2 * 128 * 128;
  int* EI = (int*)(p.ws + OFF_EIDX);
  float* GT = (float*)(p.ws + OFF_GATE);
  for (int u = blockIdx.x; u < 3072; u += gridDim.x) {
    const int tt = u >> 1, h = (u & 1) * 4 + w;
    const int t0 = tt * 16;
#pragma unroll
    for (int pp = 0; pp < 2; ++pp) {
      bf16x8 a[4];
#pragma unroll
      for (int kk = 0; kk < 4; ++kk) a[kk] = ldfrag(Q + (size_t)(t0 + l15) * 2048 + h * 256 + pp * 128 + kk * 32 + quad * 8);
      const bf16_t* kb = KB + (size_t)((h * 2 + pp) * 128) * 128;
#pragma unroll
      for (int ct = 0; ct < 8; ++ct) {
        f32x4 c = (f32x4){0.f, 0.f, 0.f, 0.f};
#pragma unroll
        for (int kk = 0; kk < 4; ++kk) {
          bf16x8 b = ldfrag(kb + (ct * 16 + l15) * 128 + kk * 32 + quad * 8);
          c = mfma16(a[kk], b, c);
        }
#pragma unroll
        for (int jj = 0; jj < 4; ++jj) {
          const int row = pp * 16 + quad * 4 + jj, col = ct * 16 + l15;
          unsigned key = (fkey(c[jj]) & ~127u) | (unsigned)(127 - col);
          scw[row * 129 + col] = key;
        }
      }
    }
    __syncthreads();
    {
      const int row = lane >> 1, hf = lane & 1;
      const unsigned* rp = scw + row * 129 + hf * 64;
      unsigned prev = 0xFFFFFFFFu;
      for (int r = 0; r < 16; ++r) {
        unsigned best = 0;
#pragma unroll 16
        for (int j = 0; j < 64; ++j) {
          unsigned k = rp[j];
          unsigned tsel = (k < prev) ? k : 0u;
          best = max(best, tsel);
        }
        unsigned ob = (unsigned)__shfl_xor((int)best, 1);
        best = max(best, ob);
        prev = best;
        if (hf == 0) sel[row * 16 + r] = best;
      }
    }
    __syncthreads();
    {
      const int tok = lane >> 2, sub = lane & 3;
      const unsigned* s1 = sel + tok * 16;
      const unsigned* s2 = sel + (16 + tok) * 16;
      unsigned ck[13];
#pragma unroll
      for (int i = 0; i < 13; ++i) {
        const int cidx = sub + 4 * i;
        const int a = CAND_A[cidx], b = CAND_B[cidx];
        float s = keyf(s1[a] & ~127u) + keyf(s2[b] & ~127u);
        unsigned k = (fkey(s) & ~255u) | (unsigned)(255 - (a * 16 + b));
        ck[i] = (cidx < 50) ? k : 0u;
      }
      unsigned prev = 0xFFFFFFFFu;
      unsigned top[16];
#pragma unroll
      for (int r = 0; r < 16; ++r) {
        unsigned best = 0;
#pragma unroll
        for (int i = 0; i < 13; ++i) {
          unsigned tsel = (ck[i] < prev) ? ck[i] : 0u;
          best = max(best, tsel);
        }
        best = max(best, (unsigned)__shfl_xor((int)best, 1));
        best = max(best, (unsigned)__shfl_xor((int)best, 2));
        prev = best;
        top[r] = best;
      }
      float sv[16];
      int ev[16];
#pragma unroll
      for (int r = 0; r < 16; ++r) {
        const int cidx = 255 - (int)(top[r] & 255u);
        const int a = cidx >> 4, b = cidx & 15;
        const unsigned k1 = s1[a], k2 = s2[b];
        sv[r] = keyf(k1 & ~127u) + keyf(k2 & ~127u);
        ev[r] = (127 - (int)(k1 & 127u)) * 128 + (127 - (int)(k2 & 127u));
      }
      float mx = sv[0];
#pragma unroll
      for (int r = 1; r < 16; ++r) mx = fmaxf(mx, sv[r]);
      float sum = 0.f;
#pragma unroll
      for (int r = 0; r < 16; ++r) { sv[r] = expf(sv[r] - mx); sum += sv[r]; }
      const float inv = 1.f / sum;
      const size_t ob = (size_t)(t0 + tok) * 128 + h * 16;
#pragma unroll
      for (int r = 0; r < 16; ++r) {
        if ((r & 3) == sub) { EI[ob + r] = ev[r]; GT[ob + r] = sv[r] * inv; }
      }
    }
    __syncthreads();
  }
}

__device__ __forceinline__ float gelu_tanh(float x) {
  return 0.5f * x * (1.f + tanhf(0.7978845608028654f * (x + 0.044715f * x * x * x)));
}
__device__ __forceinline__ void phase_peer_gather(const Params& p, int l) {
  const int tid_ = opaque_tid(); const int lane = tid_ & 63, wv = tid_ >> 6;
  const bf16_t* H = (const bf16_t*)(p.ws + OFF_H);
  bf16_t* Hw = (bf16_t*)(p.ws + OFF_H);
  const bf16_t* UB = (const bf16_t*)(p.ws + OFF_UB) + (size_t)l * 16384 * 1024;
  const bf16_t* VB = (const bf16_t*)(p.ws + OFF_VB) + (size_t)l * 16384 * 1024;
  const int* EI = (const int*)(p.ws + OFF_EIDX);
  const float* GT = (const float*)(p.ws + OFF_GATE);
  const float* modv = (const float*)(p.ws + OFF_MOD);
  for (int t = blockIdx.x * 4 + wv; t < NTOK; t += gridDim.x * 4) {
    float xf[16];
    unpack8(*(const uint4*)(H + (size_t)t * 1024 + lane * 8), xf);
    unpack8(*(const uint4*)(H + (size_t)t * 1024 + 512 + lane * 8), xf + 8);
    float out[16];
#pragma unroll
    for (int e = 0; e < 16; ++e) out[e] = 0.f;
    float coef[2];
    int eix[2];
#pragma unroll
    for (int hf = 0; hf < 2; ++hf) {
      const int ev = EI[(size_t)t * 128 + hf * 64 + lane];
      const float gv = GT[(size_t)t * 128 + hf * 64 + lane];
      float cacc = 0.f;
      for (int k = 0; k < 64; k += 4) {
        float d[4];
#pragma unroll
        for (int j = 0; j < 4; ++j) {
          const int e = __builtin_amdgcn_readlane(ev, k + j);
          const bf16_t* ur = UB + (size_t)e * 1024;
          float uf[16];
          unpack8(*(const uint4*)(ur + lane * 8), uf);
          unpack8(*(const uint4*)(ur + 512 + lane * 8), uf + 8);
          float s = 0.f;
#pragma unroll
          for (int q = 0; q < 16; ++q) s += uf[q] * xf[q];
          d[j] = s;
        }
#pragma unroll
        for (int j = 0; j < 4; ++j) {
          float s = wave_sum(d[j]);
          if (lane == k + j) cacc = gelu_tanh(s);
        }
      }
      coef[hf] = cacc * gv;
      eix[hf] = ev;
    }
#pragma unroll
    for (int hf = 0; hf < 2; ++hf) {
      for (int k = 0; k < 64; k += 4) {
#pragma unroll
        for (int j = 0; j < 4; ++j) {
          const int e = __builtin_amdgcn_readlane(eix[hf], k + j);
          const float cf = __uint_as_float((unsigned)__builtin_amdgcn_readlane((int)__float_as_uint(coef[hf]), k + j));
          const bf16_t* vr = VB + (size_t)e * 1024;
          float vf[16];
          unpack8(*(const uint4*)(vr + lane * 8), vf);
          unpack8(*(const uint4*)(vr + 512 + lane * 8), vf + 8);
#pragma unroll
          for (int q = 0; q < 16; ++q) out[q] += cf * vf[q];
        }
      }
    }
    const int m = tok_mod(t);
    const float* ga2 = modv + (size_t)(l * 9 + m) * 6144 + 5120;
    float* xr = p.out + (size_t)t * 1024;
    float xn[16];
    float ss = 0.f;
#pragma unroll
    for (int hh = 0; hh < 2; ++hh)
#pragma unroll
      for (int q4 = 0; q4 < 2; ++q4) {
        const int idx = hh * 512 + lane * 8 + q4 * 4;
        float4 xv = *(const float4*)(xr + idx);
        float4 gg = *(const float4*)(ga2 + idx);
        const int o = hh * 8 + q4 * 4;
        xn[o + 0] = xv.x + gg.x * out[o + 0];
        xn[o + 1] = xv.y + gg.y * out[o + 1];
        xn[o + 2] = xv.z + gg.z * out[o + 2];
        xn[o + 3] = xv.w + gg.w * out[o + 3];
        ss += xn[o] * xn[o] + xn[o + 1] * xn[o + 1] + xn[o + 2] * xn[o + 2] + xn[o + 3] * xn[o + 3];
      }
    ss = wave_sum(ss);
    const float rs = rsqrtf(ss * (1.f / 1024.f) + EPSV);
    if (l < 3) {
      const float* md = modv + (size_t)((l + 1) * 9 + m) * 6144;
      const float* g = p.in[8] + (l + 1) * 1024;
#pragma unroll
      for (int hh = 0; hh < 2; ++hh) {
        const int idx = hh * 512 + lane * 8;
        float hv[8];
#pragma unroll
        for (int q = 0; q < 8; ++q) hv[q] = xn[hh * 8 + q] * rs * g[idx + q] * (1.f + md[1024 + idx + q]) + md[idx + q];
        uint4 o;
        o.x = pack2(hv[0], hv[1]); o.y = pack2(hv[2], hv[3]); o.z = pack2(hv[4], hv[5]); o.w = pack2(hv[6], hv[7]);
        *(uint4*)(Hw + (size_t)t * 1024 + idx) = o;
        *(float4*)(xr + idx) = make_float4(xn[hh * 8 + 0], xn[hh * 8 + 1], xn[hh * 8 + 2], xn[hh * 8 + 3]);
        *(float4*)(xr + idx + 4) = make_float4(xn[hh * 8 + 4], xn[hh * 8 + 5], xn[hh * 8 + 6], xn[hh * 8 + 7]);
      }
    } else {
      const float* g = p.in[10];
#pragma unroll
      for (int hh = 0; hh < 2; ++hh) {
        const int idx = hh * 512 + lane * 8;
        float yv[8];
#pragma unroll
        for (int q = 0; q < 8; ++q) yv[q] = xn[hh * 8 + q] * rs * g[idx + q];
        *(float4*)(xr + idx) = make_float4(yv[0], yv[1], yv[2], yv[3]);
        *(float4*)(xr + idx + 4) = make_float4(yv[4], yv[5], yv[6], yv[7]);
      }
    }
  }
}

__global__ void __launch_bounds__(256, 2) mega(Params p, int ph_lo, int ph_hi) {
  __shared__ __attribute__((aligned(16))) unsigned char smem[77312];
  cg::grid_group grid = cg::this_grid();
  for (int ph = ph_lo; ph < ph_hi; ++ph) {
    bool did = true;
    if (ph == 0) phase_prep_a(p, smem);
    else if (ph == 1) phase_prep_b(p);
    else {
      const int l = (ph - 2) / 9, sub = (ph - 2) % 9;
      const int il = l >> 1;
      const bool odd = l & 1;
      const float* modv = (const float*)(p.ws + OFF_MOD);
      if (sub == 0 || sub == 6) {
        const bf16_t* Bt; int ntn, ldc; bf16_t* C;
        if (sub == 0) {
          Bt = odd ? (const bf16_t*)(p.ws + OFF_WIN_OD) + (size_t)il * 3200 * 1024
                   : (const bf16_t*)(p.ws + OFF_WIN_EV) + (size_t)il * 3072 * 1024;
          ntn = odd ? 25 : 24; ldc = PSTRIDE; C = (bf16_t*)(p.ws + OFF_P);
        } else {
          Bt = (const bf16_t*)(p.ws + OFF_WQ) + (size_t)l * 2048 * 1024;
          ntn = 16; ldc = 2048; C = (bf16_t*)(p.ws + OFF_Q);
        }
        gemm_phase<0>((const bf16_t*)(p.ws + OFF_H), Bt, ntn, C, ldc, nullptr, nullptr, smem);
      } else if (sub == 1) {
        if (odd) phase_odd_prep(p, l, smem); else did = false;
      } else if (sub == 2) {
        if (odd) phase_gdn_chain(p, l, smem); else phase_ret_chain(p, l, smem);
      } else if (sub == 3) {
        phase_mix_out(p, l);
      } else if (sub == 4) {
        gemm_phase<1>((const bf16_t*)(p.ws + OFF_YMIX), (const bf16_t*)(p.ws + OFF_WOUT) + (size_t)l * 1024 * 1024, 8,
                      nullptr, 0, p.out, modv + (size_t)l * 9 * 6144 + 2048, smem);
      } else if (sub == 5) {
        phase_norm2(p, l);
      } else if (sub == 7) {
        phase_peer_score(p, l, smem);
      } else {
        phase_peer_gather(p, l);
      }
    }
    if (did && ph + 1 < ph_hi) grid.sync();
  }
}

extern "C" void kernel_launch(void* const* d_in, const int* in_sizes, int n_in, void* d_out, int out_size,
                              void* d_ws, size_t ws_size, hipStream_t stream) {
  static int grid_blocks = 0;
  if (!grid_blocks) {
    int dev = 0, cus = 0, per_cu = 0;
    hipGetDevice(&dev);
    hipDeviceGetAttribute(&cus, hipDeviceAttributeMultiprocessorCount, dev);
    hipOccupancyMaxActiveBlocksPerMultiprocessor(&per_cu, mega, 256, 0);
    if (per_cu < 1) per_cu = 1;
    if (per_cu > 2) per_cu = 2;
    grid_blocks = cus * per_cu;
    if (ws_size < WS_NEED) fprintf(stderr, "kernel_launch: workspace too small: %zu < %zu\n", ws_size, (size_t)WS_NEED);
  }
  Params p{};
  for (int i = 0; i < 30; ++i) p.in[i] = (const float*)d_in[i];
  p.out = (float*)d_out;
  p.ws = (unsigned char*)d_ws;
#if SINGLE_LAUNCH
  int lo = 0, hi = NPHASE;
  void* args[] = {&p, &lo, &hi};
  hipError_t e = hipLaunchCooperativeKernel((void*)mega, dim3(grid_blocks), dim3(256), args, 0, stream);
  if (e != hipSuccess) fprintf(stderr, "cooperative launch failed: %s (grid %d)\n", hipGetErrorString(e), grid_blocks);
#else
  for (int ph = 0; ph < NPHASE; ++ph) {
    const int l = (ph - 2) / 9, sub = (ph - 2) % 9;
    if (ph >= 2 && sub == 1 && !(l & 1)) continue;
    hipLaunchKernelGGL(mega, dim3(grid_blocks), dim3(256), 0, stream, p, ph, ph + 1);
  }
#endif
}
```

```cpp
#include <hip/hip_runtime.h>
#include <hip/hip_cooperative_groups.h>
#include <cstdio>
namespace cg = cooperative_groups;

#ifndef SINGLE_LAUNCH
#define SINGLE_LAUNCH 1
#endif

typedef unsigned short bf16_t;
using bf16x8 = __attribute__((ext_vector_type(8))) short;
using f32x4 = __attribute__((ext_vector_type(4))) float;
using u32x4 = __attribute__((ext_vector_type(4))) unsigned;

#define NTOK 24576
#define NPROMPT 8192
#define PSTRIDE 3200
#define EPSV 1e-6f
#define NPHASE 38

constexpr size_t OFF_MOD = 0;
constexpr size_t OFF_ROPE = 1u << 20;
constexpr size_t OFF_WIN_EV = OFF_ROPE + 65536;
constexpr size_t OFF_WIN_OD = OFF_WIN_EV + 2ull * 3072 * 1024 * 2;
constexpr size_t OFF_WOUT = OFF_WIN_OD + 2ull * 3200 * 1024 * 2;
constexpr size_t OFF_WQ = OFF_WOUT + 4ull * 1024 * 1024 * 2;
constexpr size_t OFF_KEYS = OFF_WQ + 4ull * 2048 * 1024 * 2;
constexpr size_t OFF_UB = OFF_KEYS + 4ull * 8 * 2 * 128 * 128 * 2;
constexpr size_t OFF_VB = OFF_UB + 4ull * 16384 * 1024 * 2;
constexpr size_t OFF_H = OFF_VB + 4ull * 16384 * 1024 * 2;
constexpr size_t OFF_P = OFF_H + (size_t)NTOK * 1024 * 2;
constexpr size_t OFF_YMIX = OFF_P + (size_t)NTOK * PSTRIDE * 2;
constexpr size_t OFF_ODIR = OFF_YMIX + (size_t)NTOK * 1024 * 2;
constexpr size_t OFF_Q = OFF_ODIR;
constexpr size_t OFF_EIDX = OFF_ODIR + 2ull * NTOK * 512 * 4;
constexpr size_t OFF_GATE = OFF_EIDX + (size_t)NTOK * 128 * 4;
constexpr size_t GP_ITEM = 73728;
constexpr size_t OFF_GPREP = OFF_GATE + (size_t)NTOK * 128 * 4;
constexpr size_t OFF_EGL = OFF_GPREP + 3072ull * GP_ITEM;
constexpr size_t OFF_CONV = OFF_EGL + 16384;
constexpr size_t WS_NEED = OFF_CONV + (size_t)NTOK * 512 * 4;

struct Params {
  const float* in[30];
  float* out;
  unsigned char* ws;
};

__device__ const unsigned char CAND_A[52] = {0,0,0,0,0,0,0,0,0,0,0,0,0,0,0,0,1,1,1,1,1,1,1,1,2,2,2,2,2,3,3,3,3,4,4,4,5,5,6,6,7,7,8,9,10,11,12,13,14,15,0,0};
__device__ const unsigned char CAND_B[52] = {0,1,2,3,4,5,6,7,8,9,10,11,12,13,14,15,0,1,2,3,4,5,6,7,0,1,2,3,4,0,1,2,3,0,1,2,0,1,0,1,0,1,0,0,0,0,0,0,0,0,0,0};

__device__ __forceinline__ int opaque_tid() { int t = threadIdx.x; asm volatile("" : "+v"(t)); return t; }
__device__ __forceinline__ bf16_t f2bf(float f) {
  unsigned u = __float_as_uint(f);
  u += 0x7fffu + ((u >> 16) & 1u);
  return (bf16_t)(u >> 16);
}
__device__ __forceinline__ float bf2f(bf16_t b) { return __uint_as_float(((unsigned)b) << 16); }
__device__ __forceinline__ float bflo(unsigned u) { return __uint_as_float(u << 16); }
__device__ __forceinline__ float bfhi(unsigned u) { return __uint_as_float(u & 0xffff0000u); }
__device__ __forceinline__ unsigned pack2(float a, float b) { return (unsigned)f2bf(a) | ((unsigned)f2bf(b) << 16); }
__device__ __forceinline__ float wave_sum(float v) {
#pragma unroll
  for (int o = 32; o > 0; o >>= 1) v += __shfl_xor(v, o);
  return v;
}
__device__ __forceinline__ f32x4 mfma16(bf16x8 a, bf16x8 b, f32x4 c) {
  return __builtin_amdgcn_mfma_f32_16x16x32_bf16(a, b, c, 0, 0, 0);
}
__device__ __forceinline__ bf16x8 ldfrag(const bf16_t* p) { return *(const bf16x8*)p; }
__device__ __forceinline__ float siluf(float v) { return v / (1.f + __expf(-v)); }
__device__ __forceinline__ int tok_mod(int t) { return t < NPROMPT ? 0 : 1 + ((t - NPROMPT) >> 11); }
__device__ __forceinline__ unsigned fkey(float f) {
  unsigned u = __float_as_uint(f);
  return (u & 0x80000000u) ? ~u : (u | 0x80000000u);
}
__device__ __forceinline__ float keyf(unsigned k) {
  unsigned b = (k & 0x80000000u) ? (k ^ 0x80000000u) : ~k;
  return __uint_as_float(b);
}
__device__ __forceinline__ void unpack8(uint4 v, float* f) {
  f[0] = bflo(v.x); f[1] = bfhi(v.x); f[2] = bflo(v.y); f[3] = bfhi(v.y);
  f[4] = bflo(v.z); f[5] = bfhi(v.z); f[6] = bflo(v.w); f[7] = bfhi(v.w);
}

__device__ __forceinline__ void prep_mod(const Params& p, float* smem) {
  float* sc = smem;
  float* red = smem + 9 * 1024;
  const int tid = opaque_tid();
  const float* c = p.in[4];
  const float* cctx = p.in[5];
  for (int i = tid; i < 9 * 1024; i += 256) {
    int m = i >> 10, k = i & 1023;
    float v = (m == 0) ? cctx[k] : c[(m - 1) * 1024 + k];
    sc[i] = v / (1.f + expf(-v));
  }
  __syncthreads();
  float* modv = (float*)(p.ws + OFF_MOD);
  const int cl = tid & 63, kg = tid >> 6;
  for (int u = blockIdx.x; u < 4 * 96; u += gridDim.x) {
    const int l = u / 96, nb = (u % 96) * 64;
    const float* W = p.in[6] + (size_t)l * 1024 * 6144 + nb + cl;
    float acc[9];
#pragma unroll
    for (int m = 0; m < 9; ++m) acc[m] = 0.f;
#pragma unroll 4
    for (int k = kg * 256; k < kg * 256 + 256; ++k) {
      float w = W[(size_t)k * 6144];
#pragma unroll
      for (int m = 0; m < 9; ++m) acc[m] += sc[m * 1024 + k] * w;
    }
#pragma unroll
    for (int m = 0; m < 9; ++m) red[(kg * 9 + m) * 64 + cl] = acc[m];
    __syncthreads();
    for (int i = tid; i < 9 * 64; i += 256) {
      int m = i >> 6, c2 = i & 63;
      float s = red[(0 * 9 + m) * 64 + c2] + red[(1 * 9 + m) * 64 + c2] + red[(2 * 9 + m) * 64 + c2] + red[(3 * 9 + m) * 64 + c2];
      int nn = nb + c2;
      modv[(size_t)(l * 9 + m) * 6144 + nn] = s + p.in[7][l * 6144 + nn];
    }
    __syncthreads();
  }
}

__device__ __forceinline__ void prep_transpose(const float* src, bf16_t* dst, int N, int Npad, float* tile) {
  const int tid = opaque_tid();
  const int ntn = Npad / 64;
  const int units = ntn * 16;
  for (int u = blockIdx.x; u < units; u += gridDim.x) {
    const int nt = u % ntn, kt = u / ntn;
    const int n0 = nt * 64, k0 = kt * 64;
#pragma unroll 4
    for (int i = 0; i < 16; ++i) {
      int r = (tid >> 6) + 4 * i, c = tid & 63;
      int n = n0 + c;
      tile[r * 65 + c] = (n < N) ? src[(size_t)(k0 + r) * N + n] : 0.f;
    }
    __syncthreads();
#pragma unroll 4
    for (int i = 0; i < 16; ++i) {
      int rr = (tid >> 6) + 4 * i, cc = tid & 63;
      dst[(size_t)(n0 + rr) * 1024 + k0 + cc] = f2bf(tile[cc * 65 + rr]);
    }
    __syncthreads();
  }
}

__device__ __forceinline__ void prep_convert(const float* src, bf16_t* dst, size_t n4) {
  const size_t stride = (size_t)gridDim.x * 256;
  for (size_t i = (size_t)blockIdx.x * 256 + threadIdx.x; i < n4; i += stride) {
    float4 v = ((const float4*)src)[i];
    uint2 o;
    o.x = pack2(v.x, v.y);
    o.y = pack2(v.z, v.w);
    ((uint2*)dst)[i] = o;
  }
}

__device__ __forceinline__ void phase_prep_a(const Params& p, unsigned char* smem) {
  float* fs = (float*)smem;
  prep_mod(p, fs);
  {
    float2* rope = (float2*)(p.ws + OFF_ROPE);
    int i = blockIdx.x * 256 + threadIdx.x;
    if (i < 64 * 16) {
      int pos = i >> 4, f = i & 15;
      float fr = powf(10000.f, -(float)f / 16.f);
      float ang = (float)pos * fr;
      rope[i] = make_float2(cosf(ang), sinf(ang));
    }
  }
  for (int i = 0; i < 2; ++i) {
    prep_transpose(p.in[11] + (size_t)i * 1024 * 3072, (bf16_t*)(p.ws + OFF_WIN_EV) + (size_t)i * 3072 * 1024, 3072, 3072, fs);
    prep_transpose(p.in[16] + (size_t)i * 1024 * 3088, (bf16_t*)(p.ws + OFF_WIN_OD) + (size_t)i * 3200 * 1024, 3088, 3200, fs);
    prep_transpose(p.in[12] + (size_t)i * 1024 * 1024, (bf16_t*)(p.ws + OFF_WOUT) + (size_t)(2 * i) * 1024 * 1024, 1024, 1024, fs);
    prep_transpose(p.in[17] + (size_t)i * 1024 * 1024, (bf16_t*)(p.ws + OFF_WOUT) + (size_t)(2 * i + 1) * 1024 * 1024, 1024, 1024, fs);
  }
  for (int l = 0; l < 4; ++l)
    prep_transpose(p.in[26] + (size_t)l * 1024 * 2048, (bf16_t*)(p.ws + OFF_WQ) + (size_t)l * 2048 * 1024, 2048, 2048, fs);
  prep_convert(p.in[27], (bf16_t*)(p.ws + OFF_KEYS), (size_t)4 * 8 * 2 * 128 * 128 / 4);
  prep_convert(p.in[28], (bf16_t*)(p.ws + OFF_UB), (size_t)4 * 16384 * 1024 / 4);
  prep_convert(p.in[29], (bf16_t*)(p.ws + OFF_VB), (size_t)4 * 16384 * 1024 / 4);
}

__device__ __forceinline__ void norm_token(const float* xrow, const float* g, const float* scale, const float* shift,
                                           bf16_t* hrow, float* copy_dst, int lane) {
  float4 v[4];
  float ss = 0.f;
#pragma unroll
  for (int i = 0; i < 4; ++i) {
    v[i] = *(const float4*)(xrow + i * 256 + lane * 4);
    ss += v[i].x * v[i].x + v[i].y * v[i].y + v[i].z * v[i].z + v[i].w * v[i].w;
  }
  ss = wave_sum(ss);
  const float rs = rsqrtf(ss * (1.f / 1024.f) + EPSV);
#pragma unroll
  for (int i = 0; i < 4; ++i) {
    const int idx = i * 256 + lane * 4;
    if (copy_dst) *(float4*)(copy_dst + idx) = v[i];
    float4 gg = *(const float4*)(g + idx);
    float4 sc = *(const float4*)(scale + idx);
    float4 sh = *(const float4*)(shift + idx);
    float a = v[i].x * rs * gg.x * (1.f + sc.x) + sh.x;
    float b = v[i].y * rs * gg.y * (1.f + sc.y) + sh.y;
    float c = v[i].z * rs * gg.z * (1.f + sc.z) + sh.z;
    float d = v[i].w * rs * gg.w * (1.f + sc.w) + sh.w;
    uint2 o;
    o.x = pack2(a, b);
    o.y = pack2(c, d);
    *(uint2*)(hrow + idx) = o;
  }
}

__device__ __forceinline__ void phase_prep_b(const Params& p) {
  const int tid_ = opaque_tid(); const int lane = tid_ & 63, wv = tid_ >> 6;
  const float* modv = (const float*)(p.ws + OFF_MOD);
  bf16_t* H = (bf16_t*)(p.ws + OFF_H);
  for (int t = blockIdx.x * 4 + wv; t < NTOK; t += gridDim.x * 4) {
    const float* xr = (t < NPROMPT) ? p.in[0] + (size_t)t * 1024 : p.in[1] + (size_t)(t - NPROMPT) * 1024;
    const float* md = modv + (size_t)(0 * 9 + tok_mod(t)) * 6144;
    norm_token(xr, p.in[8], md + 1024, md, H + (size_t)t * 1024, p.out + (size_t)t * 1024, lane);
  }
}

__device__ __forceinline__ void phase_norm2(const Params& p, int l) {
  const int tid_ = opaque_tid(); const int lane = tid_ & 63, wv = tid_ >> 6;
  const float* modv = (const float*)(p.ws + OFF_MOD);
  bf16_t* H = (bf16_t*)(p.ws + OFF_H);
  for (int t = blockIdx.x * 4 + wv; t < NTOK; t += gridDim.x * 4) {
    const float* md = modv + (size_t)(l * 9 + tok_mod(t)) * 6144;
    norm_token(p.out + (size_t)t * 1024, p.in[9] + l * 1024, md + 4096, md + 3072, H + (size_t)t * 1024, nullptr, lane);
  }
}

template <int EPI>
__device__ __forceinline__ void gemm_phase(const bf16_t* __restrict__ A, const bf16_t* __restrict__ Bt, int ntiles_n,
                           bf16_t* __restrict__ C, int ldc, float* __restrict__ X, const float* __restrict__ ga,
                           unsigned char* smem) {
  bf16_t* As = (bf16_t*)smem;
  bf16_t* Bs = As + 128 * 72;
  const int tid = opaque_tid(), lane = tid & 63, w = tid >> 6, quad = lane >> 4, l15 = lane & 15;
  const int wm = w >> 1, wn = w & 1;
  const int lr = tid >> 3, lseg = (tid & 7) * 8;
  const int units = 192 * ntiles_n;
  for (int u = blockIdx.x; u < units; u += gridDim.x) {
    const int mt = u % 192, nt = u / 192;
    const int m0 = mt * 128, n0 = nt * 128;
    f32x4 acc[4][4];
#pragma unroll
    for (int i = 0; i < 4; ++i)
#pragma unroll
      for (int j = 0; j < 4; ++j) acc[i][j] = (f32x4){0.f, 0.f, 0.f, 0.f};
    const bf16_t* Ag = A + (size_t)(m0 + lr) * 1024 + lseg;
    const bf16_t* Bg = Bt + (size_t)(n0 + lr) * 1024 + lseg;
    u32x4 ra0, ra1, ra2, ra3, rb0, rb1, rb2, rb3;
    ra0 = *(const u32x4*)(Ag); ra1 = *(const u32x4*)(Ag + 32 * 1024); ra2 = *(const u32x4*)(Ag + 64 * 1024); ra3 = *(const u32x4*)(Ag + 96 * 1024);
    rb0 = *(const u32x4*)(Bg); rb1 = *(const u32x4*)(Bg + 32 * 1024); rb2 = *(const u32x4*)(Bg + 64 * 1024); rb3 = *(const u32x4*)(Bg + 96 * 1024);
    for (int kt = 0; kt < 16; ++kt) {
      *(u32x4*)(As + (lr) * 72 + lseg) = ra0; *(u32x4*)(As + (lr + 32) * 72 + lseg) = ra1;
      *(u32x4*)(As + (lr + 64) * 72 + lseg) = ra2; *(u32x4*)(As + (lr + 96) * 72 + lseg) = ra3;
      *(u32x4*)(Bs + (lr) * 72 + lseg) = rb0; *(u32x4*)(Bs + (lr + 32) * 72 + lseg) = rb1;
      *(u32x4*)(Bs + (lr + 64) * 72 + lseg) = rb2; *(u32x4*)(Bs + (lr + 96) * 72 + lseg) = rb3;
      __syncthreads();
      if (kt + 1 < 16) {
        const bf16_t* An = Ag + (kt + 1) * 64; const bf16_t* Bn = Bg + (kt + 1) * 64;
        ra0 = *(const u32x4*)(An); ra1 = *(const u32x4*)(An + 32 * 1024); ra2 = *(const u32x4*)(An + 64 * 1024); ra3 = *(const u32x4*)(An + 96 * 1024);
        rb0 = *(const u32x4*)(Bn); rb1 = *(const u32x4*)(Bn + 32 * 1024); rb2 = *(const u32x4*)(Bn + 64 * 1024); rb3 = *(const u32x4*)(Bn + 96 * 1024);
      }
#pragma unroll
      for (int kk = 0; kk < 2; ++kk) {
        bf16x8 af[4], bfr[4];
#pragma unroll
        for (int i = 0; i < 4; ++i) af[i] = ldfrag(As + (wm * 64 + i * 16 + l15) * 72 + kk * 32 + quad * 8);
#pragma unroll
        for (int j = 0; j < 4; ++j) bfr[j] = ldfrag(Bs + (wn * 64 + j * 16 + l15) * 72 + kk * 32 + quad * 8);
#pragma unroll
        for (int i = 0; i < 4; ++i)
#pragma unroll
          for (int j = 0; j < 4; ++j) acc[i][j] = mfma16(af[i], bfr[j], acc[i][j]);
      }
      __syncthreads();
    }
    if (EPI == 0) {
#pragma unroll
      for (int i = 0; i < 4; ++i)
#pragma unroll
        for (int j = 0; j < 4; ++j)
#pragma unroll
          for (int jj = 0; jj < 4; ++jj) {
            int row = m0 + wm * 64 + i * 16 + quad * 4 + jj;
            int col = n0 + wn * 64 + j * 16 + l15;
            C[(size_t)row * ldc + col] = f2bf(acc[i][j][jj]);
          }
    } else {
      const float* gam = ga + (size_t)tok_mod(m0) * 6144;
#pragma unroll
      for (int i = 0; i < 4; ++i)
#pragma unroll
        for (int j = 0; j < 4; ++j)
#pragma unroll
          for (int jj = 0; jj < 4; ++jj) {
            int row = m0 + wm * 64 + i * 16 + quad * 4 + jj;
            int col = n0 + wn * 64 + j * 16 + l15;
            float* xp = X + (size_t)row * 1024 + col;
            *xp = *xp + gam[col] * acc[i][j][jj];
          }
    }
  }
}

struct ChainItem {
  bool lng; int sl, dir, h, sq, tok0, nc;
};
__device__ __forceinline__ ChainItem decode_item(int it) {
  ChainItem c;
  c.lng = it < 256;
  int idx = c.lng ? it : it - 256;
  c.sl = idx & 3; c.dir = (idx >> 2) & 1; c.h = (idx >> 3) & 3; c.sq = idx >> 5;
  c.tok0 = c.lng ? NPROMPT + c.sq * 2048 : c.sq * 256;
  c.nc = c.lng ? 32 : 4;
  return c;
}

__device__ __forceinline__ void phase_ret_chain(const Params& p, int l, unsigned char* smem) {
  const int il = l >> 1;
  bf16_t* qs = (bf16_t*)smem;
  bf16_t* ks = qs + 64 * 72;
  bf16_t* kT = ks + 64 * 72;
  bf16_t* vT = kT + 64 * 72;
  bf16_t* intra = vT + 32 * 72;
  bf16_t* ST = intra + 64 * 72;
  const bf16_t* P = (const bf16_t*)(p.ws + OFF_P);
  float* odir = (float*)(p.ws + OFF_ODIR);
  const float2* rope = (const float2*)(p.ws + OFF_ROPE);
  const int tid = opaque_tid(), lane = tid & 63, w = tid >> 6, quad = lane >> 4, l15 = lane & 15;
  for (int it = blockIdx.x; it < 1280; it += gridDim.x) {
    const ChainItem ci = decode_item(it);
    const int sl = ci.sl, dir = ci.dir, h = ci.h;
    const float xg = p.in[13][(il * 2 + dir) * 4 + h];
    const float lg = -log1pf(expf(-xg));
    const float g64 = expf(lg * 64.f);
    f32x4 S[2];
    if (ci.lng) {
      const float* s0 = p.in[2] + ((((size_t)ci.sq * 2 + il) * 2 + dir) * 4 + h) * 8192;
#pragma unroll
      for (int ct = 0; ct < 2; ++ct)
#pragma unroll
        for (int jj = 0; jj < 4; ++jj) S[ct][jj] = s0[(16 * w + quad * 4 + jj) * 128 + sl * 32 + ct * 16 + l15];
    } else {
      S[0] = (f32x4){0.f, 0.f, 0.f, 0.f};
      S[1] = (f32x4){0.f, 0.f, 0.f, 0.f};
    }
    for (int n = 0; n < ci.nc; ++n) {
      const int cn = dir ? ci.nc - 1 - n : n;
      const int tb = ci.tok0 + cn * 64;
      {
        const int i = tid >> 2, mq = tid & 3;
        const int t = tb + (dir ? 63 - i : i);
        const bf16_t* pr = P + (size_t)t * PSTRIDE;
        float qa[8], qb[8], ka[8], kb[8];
        unpack8(*(const uint4*)(pr + h * 64 + mq * 8), qa);
        unpack8(*(const uint4*)(pr + h * 64 + 32 + mq * 8), qb);
        unpack8(*(const uint4*)(pr + 256 + h * 64 + mq * 8), ka);
        unpack8(*(const uint4*)(pr + 256 + h * 64 + 32 + mq * 8), kb);
        if (ci.lng) {
          const int pos = (mq < 2) ? cn : (t - tb);
          const int f0 = (mq & 1) * 8;
#pragma unroll
          for (int e = 0; e < 8; ++e) {
            float2 cs = rope[pos * 16 + f0 + e];
            float a = qa[e], b = qb[e];
            qa[e] = a * cs.x - b * cs.y; qb[e] = b * cs.x + a * cs.y;
            a = ka[e]; b = kb[e];
            ka[e] = a * cs.x - b * cs.y; kb[e] = b * cs.x + a * cs.y;
          }
        }
        const float wend = expf(lg * (float)(63 - i));
        uint4 o;
        o.x = pack2(qa[0], qa[1]); o.y = pack2(qa[2], qa[3]); o.z = pack2(qa[4], qa[5]); o.w = pack2(qa[6], qa[7]);
        *(uint4*)(qs + i * 72 + mq * 8) = o;
        o.x = pack2(qb[0], qb[1]); o.y = pack2(qb[2], qb[3]); o.z = pack2(qb[4], qb[5]); o.w = pack2(qb[6], qb[7]);
        *(uint4*)(qs + i * 72 + 32 + mq * 8) = o;
#pragma unroll
        for (int e = 0; e < 8; ++e) { ka[e] *= 0.125f; kb[e] *= 0.125f; }
        o.x = pack2(ka[0], ka[1]); o.y = pack2(ka[2], ka[3]); o.z = pack2(ka[4], ka[5]); o.w = pack2(ka[6], ka[7]);
        *(uint4*)(ks + i * 72 + mq * 8) = o;
        o.x = pack2(kb[0], kb[1]); o.y = pack2(kb[2], kb[3]); o.z = pack2(kb[4], kb[5]); o.w = pack2(kb[6], kb[7]);
        *(uint4*)(ks + i * 72 + 32 + mq * 8) = o;
#pragma unroll
        for (int e = 0; e < 8; ++e) {
          kT[(mq * 8 + e) * 72 + i] = f2bf(ka[e] * wend);
          kT[(32 + mq * 8 + e) * 72 + i] = f2bf(kb[e] * wend);
        }
        uint4 v8 = *(const uint4*)(pr + 512 + h * 128 + sl * 32 + mq * 8);
        vT[(mq * 8 + 0) * 72 + i] = (bf16_t)(v8.x & 0xffff); vT[(mq * 8 + 1) * 72 + i] = (bf16_t)(v8.x >> 16);
        vT[(mq * 8 + 2) * 72 + i] = (bf16_t)(v8.y & 0xffff); vT[(mq * 8 + 3) * 72 + i] = (bf16_t)(v8.y >> 16);
        vT[(mq * 8 + 4) * 72 + i] = (bf16_t)(v8.z & 0xffff); vT[(mq * 8 + 5) * 72 + i] = (bf16_t)(v8.z >> 16);
        vT[(mq * 8 + 6) * 72 + i] = (bf16_t)(v8.w & 0xffff); vT[(mq * 8 + 7) * 72 + i] = (bf16_t)(v8.w >> 16);
      }
      __syncthreads();
      const bf16x8 a0 = ldfrag(qs + (16 * w + l15) * 72 + quad * 8);
      const bf16x8 a1 = ldfrag(qs + (16 * w + l15) * 72 + 32 + quad * 8);
#pragma unroll
      for (int ct = 0; ct < 4; ++ct) {
        bf16x8 b0 = ldfrag(ks + (ct * 16 + l15) * 72 + quad * 8);
        bf16x8 b1 = ldfrag(ks + (ct * 16 + l15) * 72 + 32 + quad * 8);
        f32x4 c = (f32x4){0.f, 0.f, 0.f, 0.f};
        c = mfma16(a0, b0, c);
        c = mfma16(a1, b1, c);
#pragma unroll
        for (int jj = 0; jj < 4; ++jj) {
          int i = 16 * w + quad * 4 + jj, j = ct * 16 + l15;
          float val = (i >= j) ? c[jj] * expf(lg * (float)(i - j)) : 0.f;
          intra[i * 72 + j] = f2bf(val);
        }
      }
#pragma unroll
      for (int ct = 0; ct < 2; ++ct)
#pragma unroll
        for (int jj = 0; jj < 4; ++jj) ST[(ct * 16 + l15) * 72 + 16 * w + quad * 4 + jj] = f2bf(S[ct][jj]);
      __syncthreads();
      const bf16x8 ai0 = ldfrag(intra + (16 * w + l15) * 72 + quad * 8);
      const bf16x8 ai1 = ldfrag(intra + (16 * w + l15) * 72 + 32 + quad * 8);
      const bf16x8 ak0 = ldfrag(kT + (16 * w + l15) * 72 + quad * 8);
      const bf16x8 ak1 = ldfrag(kT + (16 * w + l15) * 72 + 32 + quad * 8);
#pragma unroll
      for (int ct = 0; ct < 2; ++ct) {
        bf16x8 bv0 = ldfrag(vT + (ct * 16 + l15) * 72 + quad * 8);
        bf16x8 bv1 = ldfrag(vT + (ct * 16 + l15) * 72 + 32 + quad * 8);
        bf16x8 bs0 = ldfrag(ST + (ct * 16 + l15) * 72 + quad * 8);
        bf16x8 bs1 = ldfrag(ST + (ct * 16 + l15) * 72 + 32 + quad * 8);
        f32x4 ci_ = (f32x4){0.f, 0.f, 0.f, 0.f}, cc = (f32x4){0.f, 0.f, 0.f, 0.f};
        ci_ = mfma16(ai0, bv0, ci_);
        ci_ = mfma16(ai1, bv1, ci_);
        cc = mfma16(a0, bs0, cc);
        cc = mfma16(a1, bs1, cc);
#pragma unroll
        for (int jj = 0; jj < 4; ++jj) {
          int i = 16 * w + quad * 4 + jj;
          int t = tb + (dir ? 63 - i : i);
          float o = ci_[jj] + expf(lg * (float)(i + 1)) * cc[jj];
          odir[((size_t)dir * NTOK + t) * 512 + h * 128 + sl * 32 + ct * 16 + l15] = o;
        }
        f32x4 s = S[ct];
        s[0] *= g64; s[1] *= g64; s[2] *= g64; s[3] *= g64;
        s = mfma16(ak0, bv0, s);
        s = mfma16(ak1, bv1, s);
        S[ct] = s;
      }
      __syncthreads();
    }
    if (!ci.lng) {
      float* so = p.out + 25165824 + ((((size_t)ci.sq * 2 + il) * 2 + dir) * 4 + h) * 8192;
#pragma unroll
      for (int ct = 0; ct < 2; ++ct)
#pragma unroll
        for (int jj = 0; jj < 4; ++jj) so[(16 * w + quad * 4 + jj) * 128 + sl * 32 + ct * 16 + l15] = S[ct][jj];
    }
  }
}

__device__ __forceinline__ void gdn_prep_item(const Params& p, int l, int pi, unsigned char* smem) {
  const int il = l >> 1;
  bf16_t* ks = (bf16_t*)smem;
  bf16_t* vs = ks + 64 * 136;
  float* Am = (float*)(vs + 64 * 136);
  float* rq = Am + 4096;
  float* rk = rq + 64;
  float* gcs = rk + 64;
  float* bet = gcs + 64;
  float* fac = bet + 64;
  bf16_t* qs = (bf16_t*)(fac + 128);
  const bf16_t* P = (const bf16_t*)(p.ws + OFF_P);
  unsigned char* gp = p.ws + OFF_GPREP + (size_t)pi * GP_ITEM;
  bf16_t* Wb = (bf16_t*)gp;
  bf16_t* QG = Wb + 8192;
  bf16_t* KDT = QG + 8192;
  bf16_t* Ub = KDT + 8192;
  bf16_t* ATT = Ub + 8192;
  float* EGL = (float*)(p.ws + OFF_EGL);
  const int tid = opaque_tid(), lane = tid & 63, w = tid >> 6, quad = lane >> 4, l15 = lane & 15;
  const int dir = pi & 1, h = (pi >> 1) & 3, c = pi >> 3;
  int tb, seq_lo, seq_hi;
  if (c < 128) { tb = c * 64; seq_lo = (c >> 2) * 256; seq_hi = seq_lo + 256; }
  else { int cc = c - 128; tb = NPROMPT + cc * 64; seq_lo = NPROMPT + (cc >> 5) * 2048; seq_hi = seq_lo + 2048; }
  const float SCALE = 0.08838834764831845f;
  {
    const int cg_ = tid & 127, rh = tid >> 7;
    for (int mat = 0; mat < 3; ++mat) {
      const int col = mat * 512 + h * 128 + cg_;
      const float* cw = p.in[18] + (size_t)il * 3 * 1536 + col;
      const float w0 = cw[0], w1 = cw[1536], w2 = cw[3072];
      bf16_t* dst = mat == 0 ? qs : (mat == 1 ? ks : vs);
      const int t0 = tb + rh * 32;
      float xm = (t0 - 1 >= seq_lo) ? bf2f(P[(size_t)(t0 - 1) * PSTRIDE + col]) : 0.f;
      float x0 = bf2f(P[(size_t)t0 * PSTRIDE + col]);
      for (int o = 0; o < 32; ++o) {
        const int t = t0 + o;
        float xp = (t + 1 < seq_hi) ? bf2f(P[(size_t)(t + 1) * PSTRIDE + col]) : 0.f;
        float y = w0 * xm + w1 * x0 + w2 * xp;
        y = siluf(y);
        const int oi = rh * 32 + o;
        const int i = dir ? 63 - oi : oi;
        dst[i * 136 + cg_] = f2bf(y);
        xm = x0; x0 = xp;
      }
    }
  }
  __syncthreads();
  {
    const int r = tid >> 2, part = tid & 3;
    float sq_ = 0.f, sk_ = 0.f;
#pragma unroll 8
    for (int e = 0; e < 32; ++e) {
      float a = bf2f(qs[r * 136 + part * 32 + e]);
      float b = bf2f(ks[r * 136 + part * 32 + e]);
      sq_ += a * a; sk_ += b * b;
    }
    sq_ += __shfl_xor(sq_, 1); sq_ += __shfl_xor(sq_, 2);
    sk_ += __shfl_xor(sk_, 1); sk_ += __shfl_xor(sk_, 2);
    if (part == 0) {
      rq[r] = rsqrtf(sq_ + EPSV);
      rk[r] = rsqrtf(sk_ + EPSV);
      const int t = tb + (dir ? 63 - r : r);
      float a = bf2f(P[(size_t)t * PSTRIDE + 2048 + dir * 4 + h]);
      float bbv = bf2f(P[(size_t)t * PSTRIDE + 2056 + dir * 4 + h]);
      float al = p.in[19][(il * 2 + dir) * 4 + h], dtb = p.in[20][(il * 2 + dir) * 4 + h];
      float z = a + dtb;
      float sp = (z > 20.f) ? z : log1pf(expf(z));
      gcs[r] = -expf(al) * sp;
      bet[r] = 1.f / (1.f + expf(-bbv));
    }
  }
  __syncthreads();
  if (tid < 64) {
    float v = gcs[tid];
#pragma unroll
    for (int o = 1; o < 64; o <<= 1) {
      float u = __shfl_up(v, o);
      if (tid >= o) v += u;
    }
    gcs[tid] = v;
  }
  __syncthreads();
  {
    bf16x8 ak[4], aq[4];
#pragma unroll
    for (int kk = 0; kk < 4; ++kk) {
      ak[kk] = ldfrag(ks + (16 * w + l15) * 136 + kk * 32 + quad * 8);
      aq[kk] = ldfrag(qs + (16 * w + l15) * 136 + kk * 32 + quad * 8);
    }
#pragma unroll
    for (int ct = 0; ct < 4; ++ct) {
      f32x4 ckk = (f32x4){0.f, 0.f, 0.f, 0.f}, cqk = (f32x4){0.f, 0.f, 0.f, 0.f};
#pragma unroll
      for (int kk = 0; kk < 4; ++kk) {
        bf16x8 b = ldfrag(ks + (ct * 16 + l15) * 136 + kk * 32 + quad * 8);
        ckk = mfma16(ak[kk], b, ckk);
        cqk = mfma16(aq[kk], b, cqk);
      }
#pragma unroll
      for (int jj = 0; jj < 4; ++jj) {
        const int i = 16 * w + quad * 4 + jj, j = ct * 16 + l15;
        const float dec = (i >= j) ? expf(gcs[i] - gcs[j]) : 0.f;
        Am[j * 64 + i] = (i > j) ? bet[i] * rk[i] * rk[j] * ckk[jj] * dec : 0.f;
        ATT[i * 64 + j] = f2bf((i >= j) ? SCALE * rq[i] * rk[j] * cqk[jj] * dec : 0.f);
      }
    }
  }
  __syncthreads();
  const float gl = gcs[63];
  for (int e = tid; e < 64 * 128; e += 256) {
    int i = e >> 7, d = e & 127;
    QG[e] = f2bf(bf2f(qs[i * 136 + d]) * rq[i] * SCALE * __expf(gcs[i]));
  }
  for (int e = tid; e < 128 * 64; e += 256) {
    int d = e >> 6, i = e & 63;
    KDT[e] = f2bf(bf2f(ks[i * 136 + d]) * rk[i] * __expf(gl - gcs[i]));
  }
  if (tid < 64) {
    fac[tid] = bet[tid];
    fac[64 + tid] = rk[tid] * bet[tid] * __expf(gcs[tid]);
  }
  __syncthreads();
  {
    const int cidx = tid & 127;
    const bf16_t* srcm = ((tid < 128) ? vs : ks) + cidx;
    const float* fc = fac + ((tid < 128) ? 0 : 64);
    bf16_t* dstm = ((tid < 128) ? Ub : Wb) + cidx;
    bf16_t* XB = qs + tid;
#pragma unroll 1
    for (int b = 0; b < 4; ++b) {
      float x[16];
#pragma unroll
      for (int r = 0; r < 16; ++r) x[r] = bf2f(srcm[(16 * b + r) * 136]) * fc[16 * b + r];
      const float* arow = Am + 16 * b;
#pragma unroll 2
      for (int j = 0; j < 16 * b; ++j) {
        const float xv = bf2f(XB[j * 256]);
        const f32x4 a0 = *(const f32x4*)(arow + j * 64), a1 = *(const f32x4*)(arow + j * 64 + 4);
        const f32x4 a2 = *(const f32x4*)(arow + j * 64 + 8), a3 = *(const f32x4*)(arow + j * 64 + 12);
#pragma unroll
        for (int r = 0; r < 4; ++r) {
          x[r] -= a0[r] * xv; x[4 + r] -= a1[r] * xv; x[8 + r] -= a2[r] * xv; x[12 + r] -= a3[r] * xv;
        }
      }
      const float* ablk = Am + (16 * b) * 64 + 16 * b;
#pragma unroll
      for (int jj = 0; jj < 15; ++jj) {
#pragma unroll
        for (int r = jj + 1; r < 16; ++r) x[r] -= ablk[jj * 64 + r] * x[jj];
      }
#pragma unroll
      for (int r = 0; r < 16; ++r) {
        const bf16_t bb = f2bf(x[r]);
        dstm[(16 * b + r) * 128] = bb;
        if (b < 3) XB[(16 * b + r) * 256] = bb;
      }
    }
  }
  if (tid == 0) EGL[pi] = expf(gl);
  __syncthreads();
}

__device__ __forceinline__ void conf_conv_item(const Params& p, int l, int item, unsigned char* smem) {
  const int il = l >> 1;
  float* hc = (float*)smem;
  const bf16_t* P = (const bf16_t*)(p.ws + OFF_P);
  float* convout = (float*)(p.ws + OFF_CONV);
  const int tid = opaque_tid();
  const int tile = item >> 1, ch = (item & 1) * 256 + tid;
  const int t0 = tile * 32;
  int seq_lo, seq_hi;
  if (t0 < NPROMPT) { seq_lo = (t0 >> 8) << 8; seq_hi = seq_lo + 256; }
  else { seq_lo = NPROMPT + (((t0 - NPROMPT) >> 11) << 11); seq_hi = seq_lo + 2048; }
  for (int r = 0; r < 62; ++r) {
    const int tt = t0 - 15 + r;
    float v = 0.f;
    if (tt >= seq_lo && tt < seq_hi) {
      float ca = bf2f(P[(size_t)tt * PSTRIDE + 2064 + ch]);
      float cgv = bf2f(P[(size_t)tt * PSTRIDE + 2576 + ch]);
      v = ca / (1.f + __expf(-cgv));
    }
    hc[r * 256 + tid] = v;
  }
  float wk[31];
#pragma unroll
  for (int k = 0; k < 31; ++k) wk[k] = p.in[22][((size_t)il * 31 + k) * 512 + ch];
  const float bias = p.in[23][il * 512 + ch];
  for (int i = 0; i < 32; ++i) {
    float acc = bias;
#pragma unroll
    for (int k = 0; k < 31; ++k) acc += wk[k] * hc[(i + k) * 256 + tid];
    convout[(size_t)(t0 + i) * 512 + ch] = acc;
  }
}

__device__ __forceinline__ void phase_odd_prep(const Params& p, int l, unsigned char* smem) {
  for (int u = blockIdx.x; u < 3072 + 1536; u += gridDim.x) {
    if (u < 3072) gdn_prep_item(p, l, u, smem);
    else { conf_conv_item(p, l, u - 3072, smem); __syncthreads(); }
  }
}

__device__ __forceinline__ void phase_gdn_chain(const Params& p, int l, unsigned char* smem) {
  const int il = l >> 1;
  bf16_t* ST = (bf16_t*)smem;
  bf16_t* VT = ST + 32 * 136;
  float* odir = (float*)(p.ws + OFF_ODIR);
  const float* EGL = (const float*)(p.ws + OFF_EGL);
  const int tid = opaque_tid(), lane = tid & 63, w = tid >> 6, quad = lane >> 4, l15 = lane & 15;
  for (int it = blockIdx.x; it < 1280; it += gridDim.x) {
    const ChainItem ci = decode_item(it);
    const int sl = ci.sl, dir = ci.dir, h = ci.h;
    f32x4 S[2][2];
    if (ci.lng) {
      const float* s0 = p.in[3] + ((((size_t)ci.sq * 2 + il) * 2 + dir) * 4 + h) * 16384;
#pragma unroll
      for (int rb = 0; rb < 2; ++rb)
#pragma unroll
        for (int ct = 0; ct < 2; ++ct)
#pragma unroll
          for (int jj = 0; jj < 4; ++jj)
            S[rb][ct][jj] = s0[(16 * (2 * w + rb) + quad * 4 + jj) * 128 + sl * 32 + ct * 16 + l15];
    } else {
#pragma unroll
      for (int rb = 0; rb < 2; ++rb)
#pragma unroll
        for (int ct = 0; ct < 2; ++ct) S[rb][ct] = (f32x4){0.f, 0.f, 0.f, 0.f};
    }
    for (int n = 0; n < ci.nc; ++n) {
      const int cn = dir ? ci.nc - 1 - n : n;
      const int tb = ci.tok0 + cn * 64;
      const int cglob = ci.lng ? 128 + ci.sq * 32 + cn : ci.sq * 4 + cn;
      const int pi = (cglob * 4 + h) * 2 + dir;
      const unsigned char* gp = p.ws + OFF_GPREP + (size_t)pi * GP_ITEM;
      const bf16_t* Wb = (const bf16_t*)gp;
      const bf16_t* QG = Wb + 8192;
      const bf16_t* KDT = QG + 8192;
      const bf16_t* Ub = KDT + 8192;
      const bf16_t* ATT = Ub + 8192;
      bf16x8 aw[4], aqg[4], aat[2], akd[2][2];
      float uu[2][4];
#pragma unroll
      for (int kk = 0; kk < 4; ++kk) {
        aw[kk] = ldfrag(Wb + (16 * w + l15) * 128 + kk * 32 + quad * 8);
        aqg[kk] = ldfrag(QG + (16 * w + l15) * 128 + kk * 32 + quad * 8);
      }
#pragma unroll
      for (int kk = 0; kk < 2; ++kk) {
        aat[kk] = ldfrag(ATT + (16 * w + l15) * 64 + kk * 32 + quad * 8);
#pragma unroll
        for (int rb = 0; rb < 2; ++rb) akd[rb][kk] = ldfrag(KDT + (16 * (2 * w + rb) + l15) * 64 + kk * 32 + quad * 8);
      }
#pragma unroll
      for (int ct = 0; ct < 2; ++ct)
#pragma unroll
        for (int jj = 0; jj < 4; ++jj) uu[ct][jj] = bf2f(Ub[(16 * w + quad * 4 + jj) * 128 + sl * 32 + ct * 16 + l15]);
      const float egl = EGL[pi];
#pragma unroll
      for (int rb = 0; rb < 2; ++rb)
#pragma unroll
        for (int ct = 0; ct < 2; ++ct)
#pragma unroll
          for (int jj = 0; jj < 4; ++jj)
            ST[(ct * 16 + l15) * 136 + 16 * (2 * w + rb) + quad * 4 + jj] = f2bf(S[rb][ct][jj]);
      __syncthreads();
      f32x4 co[2];
#pragma unroll
      for (int ct = 0; ct < 2; ++ct) {
        f32x4 cv = (f32x4){0.f, 0.f, 0.f, 0.f};
        co[ct] = (f32x4){0.f, 0.f, 0.f, 0.f};
#pragma unroll
        for (int kk = 0; kk < 4; ++kk) {
          bf16x8 b = ldfrag(ST + (ct * 16 + l15) * 136 + kk * 32 + quad * 8);
          cv = mfma16(aw[kk], b, cv);
          co[ct] = mfma16(aqg[kk], b, co[ct]);
        }
#pragma unroll
        for (int jj = 0; jj < 4; ++jj) {
          float vn = uu[ct][jj] - cv[jj];
          VT[(ct * 16 + l15) * 72 + 16 * w + quad * 4 + jj] = f2bf(vn);
        }
      }
      __syncthreads();
#pragma unroll
      for (int ct = 0; ct < 2; ++ct) {
        bf16x8 bv[2];
#pragma unroll
        for (int kk = 0; kk < 2; ++kk) {
          bv[kk] = ldfrag(VT + (ct * 16 + l15) * 72 + kk * 32 + quad * 8);
          co[ct] = mfma16(aat[kk], bv[kk], co[ct]);
        }
#pragma unroll
        for (int jj = 0; jj < 4; ++jj) {
          int i = 16 * w + quad * 4 + jj;
          int t = tb + (dir ? 63 - i : i);
          odir[((size_t)dir * NTOK + t) * 512 + h * 128 + sl * 32 + ct * 16 + l15] = co[ct][jj];
        }
#pragma unroll
        for (int rb = 0; rb < 2; ++rb) {
          f32x4 s = S[rb][ct];
          s[0] *= egl; s[1] *= egl; s[2] *= egl; s[3] *= egl;
          s = mfma16(akd[rb][0], bv[0], s);
          s = mfma16(akd[rb][1], bv[1], s);
          S[rb][ct] = s;
        }
      }
    }
    __syncthreads();
    if (!ci.lng) {
      float* so = p.out + 29360128 + ((((size_t)ci.sq * 2 + il) * 2 + dir) * 4 + h) * 16384;
#pragma unroll
      for (int rb = 0; rb < 2; ++rb)
#pragma unroll
        for (int ct = 0; ct < 2; ++ct)
#pragma unroll
          for (int jj = 0; jj < 4; ++jj)
            so[(16 * (2 * w + rb) + quad * 4 + jj) * 128 + sl * 32 + ct * 16 + l15] = S[rb][ct][jj];
    }
  }
}

__device__ __forceinline__ void phase_mix_out(const Params& p, int l) {
  const int il = l >> 1;
  const bool odd = l & 1;
  const int tid_ = opaque_tid(); const int lane = tid_ & 63, wv = tid_ >> 6;
  const bf16_t* P = (const bf16_t*)(p.ws + OFF_P);
  const float* od0 = (const float*)(p.ws + OFF_ODIR);
  const float* od1 = od0 + (size_t)NTOK * 512;
  const float* convout = (const float*)(p.ws + OFF_CONV);
  bf16_t* Y = (bf16_t*)(p.ws + OFF_YMIX);
  for (int t = blockIdx.x * 4 + wv; t < NTOK; t += gridDim.x * 4) {
    const bf16_t* pr = P + (size_t)t * PSTRIDE;
    bf16_t* yr = Y + (size_t)t * 1024;
#pragma unroll
    for (int h = 0; h < 4; ++h) {
      const int idx = h * 128 + lane * 2;
      float2 a = *(const float2*)(od0 + (size_t)t * 512 + idx);
      float2 b = *(const float2*)(od1 + (size_t)t * 512 + idx);
      float o0 = a.x + b.x, o1 = a.y + b.y;
      float ss = wave_sum(o0 * o0 + o1 * o1);
      float rs = rsqrtf(ss * (1.f / 128.f) + EPSV);
      float n0, n1;
      unsigned gz;
      if (!odd) {
        n0 = p.in[14][il * 512 + idx]; n1 = p.in[14][il * 512 + idx + 1];
        gz = *(const unsigned*)(pr + 1024 + idx);
      } else {
        n0 = p.in[21][il * 128 + lane * 2]; n1 = p.in[21][il * 128 + lane * 2 + 1];
        gz = *(const unsigned*)(pr + 1536 + idx);
      }
      float y0 = siluf(bflo(gz)) * o0 * rs * n0;
      float y1 = siluf(bfhi(gz)) * o1 * rs * n1;
      *(unsigned*)(yr + idx) = pack2(y0, y1);
    }
    if (!odd) {
      int seq_lo, seq_hi;
      if (t < NPROMPT) { seq_lo = (t >> 8) << 8; seq_hi = seq_lo + 256; }
      else { seq_lo = NPROMPT + (((t - NPROMPT) >> 11) << 11); seq_hi = seq_lo + 2048; }
      const bool hp = (t - 1 >= seq_lo), hn = (t + 1 < seq_hi);
#pragma unroll
      for (int j = 0; j < 4; ++j) {
        const int c = j * 128 + lane * 2;
        unsigned cg0 = *(const unsigned*)(pr + 2048 + c), hb0 = *(const unsigned*)(pr + 2560 + c);
        unsigned cgm = 0, hbm = 0, cgp = 0, hbp = 0;
        if (hp) { cgm = *(const unsigned*)(pr - PSTRIDE + 2048 + c); hbm = *(const unsigned*)(pr - PSTRIDE + 2560 + c); }
        if (hn) { cgp = *(const unsigned*)(pr + PSTRIDE + 2048 + c); hbp = *(const unsigned*)(pr + PSTRIDE + 2560 + c); }
        unsigned bg = *(const unsigned*)(pr + 1536 + c);
        const float* sw = p.in[15] + (size_t)il * 3 * 512 + c;
        float y0 = bflo(bg) * (sw[0] * bflo(cgm) * bflo(hbm) + sw[512] * bflo(cg0) * bflo(hb0) + sw[1024] * bflo(cgp) * bflo(hbp));
        float y1 = bfhi(bg) * (sw[1] * bfhi(cgm) * bfhi(hbm) + sw[513] * bfhi(cg0) * bfhi(hb0) + sw[1025] * bfhi(cgp) * bfhi(hbp));
        *(unsigned*)(yr + 512 + c) = pack2(y0, y1);
      }
    } else {
      float v[8];
      float s = 0.f;
#pragma unroll
      for (int j = 0; j < 4; ++j) {
        float2 a = *(const float2*)(convout + (size_t)t * 512 + j * 128 + lane * 2);
        v[2 * j] = a.x; v[2 * j + 1] = a.y;
        s += a.x + a.y;
      }
      const float mean = wave_sum(s) * (1.f / 512.f);
      float vs = 0.f;
#pragma unroll
      for (int j = 0; j < 8; ++j) { v[j] -= mean; vs += v[j] * v[j]; }
      const float rstd = rsqrtf(wave_sum(vs) * (1.f / 512.f) + EPSV);
#pragma unroll
      for (int j = 0; j < 4; ++j) {
        const int c = j * 128 + lane * 2;
        float y0 = v[2 * j] * rstd * p.in[24][il * 512 + c] + p.in[25][il * 512 + c];
        float y1 = v[2 * j + 1] * rstd * p.in[24][il * 512 + c + 1] + p.in[25][il * 512 + c + 1];
        *(unsigned*)(yr + 512 + c) = pack2(siluf(y0), siluf(y1));
      }
    }
  }
}

__device__ __forceinline__ void phase_peer_score(const Params& p, int l, unsigned char* smem) {
  const int tid = opaque_tid(), lane = tid & 63, w = tid >> 6, quad = lane >> 4, l15 = lane & 15;
  unsigned* scw = (unsigned*)smem + w * (32 * 129 + 512);
  unsigned* sel = scw + 32 * 129;
  const bf16_t* Q = (const bf16_t*)(p.ws + OFF_Q);
  const bf16_t* KB = (const bf16_t*)(p.ws + OFF_KEYS) + (size_t)l * 8 * 2 * 128 * 128;
  int* EI = (int*)(p.ws + OFF_EIDX);
  float* GT = (float*)(p.ws + OFF_GATE);
  for (int u = blockIdx.x; u < 3072; u += gridDim.x) {
    const int tt = u >> 1, h = (u & 1) * 4 + w;
    const int t0 = tt * 16;
#pragma unroll
    for (int pp = 0; pp < 2; ++pp) {
      bf16x8 a[4];
#pragma unroll
      for (int kk = 0; kk < 4; ++kk) a[kk] = ldfrag(Q + (size_t)(t0 + l15) * 2048 + h * 256 + pp * 128 + kk * 32 + quad * 8);
      const bf16_t* kb = KB + (size_t)((h * 2 + pp) * 128) * 128;
#pragma unroll
      for (int ct = 0; ct < 8; ++ct) {
        f32x4 c = (f32x4){0.f, 0.f, 0.f, 0.f};
#pragma unroll
        for (int kk = 0; kk < 4; ++kk) {
          bf16x8 b = ldfrag(kb + (ct * 16 + l15) * 128 + kk * 32 + quad * 8);
          c = mfma16(a[kk], b, c);
        }
#pragma unroll
        for (int jj = 0; jj < 4; ++jj) {
          const int row = pp * 16 + quad * 4 + jj, col = ct * 16 + l15;
          unsigned key = (fkey(c[jj]) & ~127u) | (unsigned)(127 - col);
          scw[row * 129 + col] = key;
        }
      }
    }
    __syncthreads();
    {
      const int row = lane >> 1, hf = lane & 1;
      const unsigned* rp = scw + row * 129 + hf * 64;
      unsigned prev = 0xFFFFFFFFu;
      for (int r = 0; r < 16; ++r) {
        unsigned best = 0;
#pragma unroll 16
        for (int j = 0; j < 64; ++j) {
          unsigned k = rp[j];
          unsigned tsel = (k < prev) ? k : 0u;
          best = max(best, tsel);
        }
        unsigned ob = (unsigned)__shfl_xor((int)best, 1);
        best = max(best, ob);
        prev = best;
        if (hf == 0) sel[row * 16 + r] = best;
      }
    }
    __syncthreads();
    {
      const int tok = lane >> 2, sub = lane & 3;
      const unsigned* s1 = sel + tok * 16;
      const unsigned* s2 = sel + (16 + tok) * 16;
      unsigned ck[13];
#pragma unroll
      for (int i = 0; i < 13; ++i) {
        const int cidx = sub + 4 * i;
        const int a = CAND_A[cidx], b = CAND_B[cidx];
        float s = keyf(s1[a] & ~127u) + keyf(s2[b] & ~127u);
        unsigned k = (fkey(s) & ~255u) | (unsigned)(255 - (a * 16 + b));
        ck[i] = (cidx < 50) ? k : 0u;
      }
      unsigned prev = 0xFFFFFFFFu;
      unsigned top[16];
#pragma unroll
      for (int r = 0; r < 16; ++r) {
        unsigned best = 0;
#pragma unroll
        for (int i = 0; i < 13; ++i) {
          unsigned tsel = (ck[i] < prev) ? ck[i] : 0u;
          best = max(best, tsel);
        }
        best = max(best, (unsigned)__shfl_xor((int)best, 1));
        best = max(best, (unsigned)__shfl_xor((int)best, 2));
        prev = best;
        top[r] = best;
      }
      float sv[16];
      int ev[16];
#pragma unroll
      for (int r = 0; r < 16; ++r) {
        const int cidx = 255 - (int)(top[r] & 255u);
        const int a = cidx >> 4, b = cidx & 15;
        const unsigned k1 = s1[a], k2 = s2[b];
        sv[r] = keyf(k1 & ~127u) + keyf(k2 & ~127u);
        ev[r] = (127 - (int)(k1 & 127u)) * 128 + (127 - (int)(k2 & 127u));
      }
      float mx = sv[0];
#pragma unroll
      for (int r = 1; r < 16; ++r) mx = fmaxf(mx, sv[r]);
      float sum = 0.f;
#pragma unroll
      for (int r = 0; r < 16; ++r) { sv[r] = expf(sv[r] - mx); sum += sv[r]; }
      const float inv = 1.f / sum;
      const size_t ob = (size_t)(t0 + tok) * 128 + h * 16;
#pragma unroll
      for (int r = 0; r < 16; ++r) {
        if ((r & 3) == sub) { EI[ob + r] = ev[r]; GT[ob + r] = sv[r] * inv; }
      }
    }
    __syncthreads();
  }
}

__device__ __forceinline__ float gelu_tanh(float x) {
  return 0.5f * x * (1.f + tanhf(0.7978845608028654f * (x + 0.044715f * x * x * x)));
}
__device__ __forceinline__ void phase_peer_gather(const Params& p, int l) {
  const int tid_ = opaque_tid(); const int lane = tid_ & 63, wv = tid_ >> 6;
  const bf16_t* H = (const bf16_t*)(p.ws + OFF_H);
  bf16_t* Hw = (bf16_t*)(p.ws + OFF_H);
  const bf16_t* UB = (const bf16_t*)(p.ws + OFF_UB) + (size_t)l * 16384 * 1024;
  const bf16_t* VB = (const bf16_t*)(p.ws + OFF_VB) + (size_t)l * 16384 * 1024;
  const int* EI = (const int*)(p.ws + OFF_EIDX);
  const float* GT = (const float*)(p.ws + OFF_GATE);
  const float* modv = (const float*)(p.ws + OFF_MOD);
  for (int t = blockIdx.x * 4 + wv; t < NTOK; t += gridDim.x * 4) {
    float xf[16];
    unpack8(*(const uint4*)(H + (size_t)t * 1024 + lane * 8), xf);
    unpack8(*(const uint4*)(H + (size_t)t * 1024 + 512 + lane * 8), xf + 8);
    float out[16];
#pragma unroll
    for (int e = 0; e < 16; ++e) out[e] = 0.f;
    float coef[2];
    int eix[2];
#pragma unroll
    for (int hf = 0; hf < 2; ++hf) {
      const int ev = EI[(size_t)t * 128 + hf * 64 + lane];
      const float gv = GT[(size_t)t * 128 + hf * 64 + lane];
      float cacc = 0.f;
      for (int k = 0; k < 64; k += 4) {
        float d[4];
#pragma unroll
        for (int j = 0; j < 4; ++j) {
          const int e = __builtin_amdgcn_readlane(ev, k + j);
          const bf16_t* ur = UB + (size_t)e * 1024;
          float uf[16];
          unpack8(*(const uint4*)(ur + lane * 8), uf);
          unpack8(*(const uint4*)(ur + 512 + lane * 8), uf + 8);
          float s = 0.f;
#pragma unroll
          for (int q = 0; q < 16; ++q) s += uf[q] * xf[q];
          d[j] = s;
        }
#pragma unroll
        for (int j = 0; j < 4; ++j) {
          float s = wave_sum(d[j]);
          if (lane == k + j) cacc = gelu_tanh(s);
        }
      }
      coef[hf] = cacc * gv;
      eix[hf] = ev;
    }
#pragma unroll
    for (int hf = 0; hf < 2; ++hf) {
      for (int k = 0; k < 64; k += 4) {
#pragma unroll
        for (int j = 0; j < 4; ++j) {
          const int e = __builtin_amdgcn_readlane(eix[hf], k + j);
          const float cf = __uint_as_float((unsigned)__builtin_amdgcn_readlane((int)__float_as_uint(coef[hf]), k + j));
          const bf16_t* vr = VB + (size_t)e * 1024;
          float vf[16];
          unpack8(*(const uint4*)(vr + lane * 8), vf);
          unpack8(*(const uint4*)(vr + 512 + lane * 8), vf + 8);
#pragma unroll
          for (int q = 0; q < 16; ++q) out[q] += cf * vf[q];
        }
      }
    }
    const int m = tok_mod(t);
    const float* ga2 = modv + (size_t)(l * 9 + m) * 6144 + 5120;
    float* xr = p.out + (size_t)t * 1024;
    float xn[16];
    float ss = 0.f;
#pragma unroll
    for (int hh = 0; hh < 2; ++hh)
#pragma unroll
      for (int q4 = 0; q4 < 2; ++q4) {
        const int idx = hh * 512 + lane * 8 + q4 * 4;
        float4 xv = *(const float4*)(xr + idx);
        float4 gg = *(const float4*)(ga2 + idx);
        const int o = hh * 8 + q4 * 4;
        xn[o + 0] = xv.x + gg.x * out[o + 0];
        xn[o + 1] = xv.y + gg.y * out[o + 1];
        xn[o + 2] = xv.z + gg.z * out[o + 2];
        xn[o + 3] = xv.w + gg.w * out[o + 3];
        ss += xn[o] * xn[o] + xn[o + 1] * xn[o + 1] + xn[o + 2] * xn[o + 2] + xn[o + 3] * xn[o + 3];
      }
    ss = wave_sum(ss);
    const float rs = rsqrtf(ss * (1.f / 1024.f) + EPSV);
    if (l < 3) {
      const float* md = modv + (size_t)((l + 1) * 9 + m) * 6144;
      const float* g = p.in[8] + (l + 1) * 1024;
#pragma unroll
      for (int hh = 0; hh < 2; ++hh) {
        const int idx = hh * 512 + lane * 8;
        float hv[8];
#pragma unroll
        for (int q = 0; q < 8; ++q) hv[q] = xn[hh * 8 + q] * rs * g[idx + q] * (1.f + md[1024 + idx + q]) + md[idx + q];
        uint4 o;
        o.x = pack2(hv[0], hv[1]); o.y = pack2(hv[2], hv[3]); o.z = pack2(hv[4], hv[5]); o.w = pack2(hv[6], hv[7]);
        *(uint4*)(Hw + (size_t)t * 1024 + idx) = o;
        *(float4*)(xr + idx) = make_float4(xn[hh * 8 + 0], xn[hh * 8 + 1], xn[hh * 8 + 2], xn[hh * 8 + 3]);
        *(float4*)(xr + idx + 4) = make_float4(xn[hh * 8 + 4], xn[hh * 8 + 5], xn[hh * 8 + 6], xn[hh * 8 + 7]);
      }
    } else {
      const float* g = p.in[10];
#pragma unroll
      for (int hh = 0; hh < 2; ++hh) {
        const int idx = hh * 512 + lane * 8;
        float yv[8];
#pragma unroll
        for (int q = 0; q < 8; ++q) yv[q] = xn[hh * 8 + q] * rs * g[idx + q];
        *(float4*)(xr + idx) = make_float4(yv[0], yv[1], yv[2], yv[3]);
        *(float4*)(xr + idx + 4) = make_float4(yv[4], yv[5], yv[6], yv[7]);
      }
    }
  }
}

__global__ void __launch_bounds__(256, 2) mega(Params p, int ph_lo, int ph_hi) {
  __shared__ __attribute__((aligned(16))) unsigned char smem[77312];
  cg::grid_group grid = cg::this_grid();
  for (int ph = ph_lo; ph < ph_hi; ++ph) {
    bool did = true;
    if (ph == 0) phase_prep_a(p, smem);
    else if (ph == 1) phase_prep_b(p);
    else {
      const int l = (ph - 2) / 9, sub = (ph - 2) % 9;
      const int il = l >> 1;
      const bool odd = l & 1;
      const float* modv = (const float*)(p.ws + OFF_MOD);
      if (sub == 0 || sub == 6) {
        const bf16_t* Bt; int ntn, ldc; bf16_t* C;
        if (sub == 0) {
          Bt = odd ? (const bf16_t*)(p.ws + OFF_WIN_OD) + (size_t)il * 3200 * 1024
                   : (const bf16_t*)(p.ws + OFF_WIN_EV) + (size_t)il * 3072 * 1024;
          ntn = odd ? 25 : 24; ldc = PSTRIDE; C = (bf16_t*)(p.ws + OFF_P);
        } else {
          Bt = (const bf16_t*)(p.ws + OFF_WQ) + (size_t)l * 2048 * 1024;
          ntn = 16; ldc = 2048; C = (bf16_t*)(p.ws + OFF_Q);
        }
        gemm_phase<0>((const bf16_t*)(p.ws + OFF_H), Bt, ntn, C, ldc, nullptr, nullptr, smem);
      } else if (sub == 1) {
        if (odd) phase_odd_prep(p, l, smem); else did = false;
      } else if (sub == 2) {
        if (odd) phase_gdn_chain(p, l, smem); else phase_ret_chain(p, l, smem);
      } else if (sub == 3) {
        phase_mix_out(p, l);
      } else if (sub == 4) {
        gemm_phase<1>((const bf16_t*)(p.ws + OFF_YMIX), (const bf16_t*)(p.ws + OFF_WOUT) + (size_t)l * 1024 * 1024, 8,
                      nullptr, 0, p.out, modv + (size_t)l * 9 * 6144 + 2048, smem);
      } else if (sub == 5) {
        phase_norm2(p, l);
      } else if (sub == 7) {
        phase_peer_score(p, l, smem);
      } else {
        phase_peer_gather(p, l);
      }
    }
    if (did && ph + 1 < ph_hi) grid.sync();
  }
}

extern "C" void kernel_launch(void* const* d_in, const int* in_sizes, int n_in, void* d_out, int out_size,
                              void* d_ws, size_t ws_size, hipStream_t stream) {
  static int grid_blocks = 0;
  if (!grid_blocks) {
    int dev = 0, cus = 0, per_cu = 0;
    hipGetDevice(&dev);
    hipDeviceGetAttribute(&cus, hipDeviceAttributeMultiprocessorCount, dev);
    hipOccupancyMaxActiveBlocksPerMultiprocessor(&per_cu, mega, 256, 0);
    if (per_cu < 1) per_cu = 1;
    if (per_cu > 2) per_cu = 2;
    grid_blocks = cus * per_cu;
    if (ws_size < WS_NEED) fprintf(stderr, "kernel_launch: workspace too small: %zu < %zu\n", ws_size, (size_t)WS_NEED);
  }
  Params p{};
  for (int i = 0; i < 30; ++i) p.in[i] = (const float*)d_in[i];
  p.out = (float*)d_out;
  p.ws = (unsigned char*)d_ws;
#if SINGLE_LAUNCH
  int lo = 0, hi = NPHASE;
  void* args[] = {&p, &lo, &hi};
  hipError_t e = hipLaunchCooperativeKernel((void*)mega, dim3(grid_blocks), dim3(256), args, 0, stream);
  if (e != hipSuccess) fprintf(stderr, "cooperative launch failed: %s (grid %d)\n", hipGetErrorString(e), grid_blocks);
#else
  for (int ph = 0; ph < NPHASE; ++ph) {
    const int l = (ph - 2) / 9, sub = (ph - 2) % 9;
    if (ph >= 2 && sub == 1 && !(l & 1)) continue;
    hipLaunchKernelGGL(mega, dim3(grid_blocks), dim3(256), 0, stream, p, ph, ph + 1);
  }
#endif
}
```

```cpp
#include <hip/hip_runtime.h>
#include <hip/hip_cooperative_groups.h>
#include <cstdio>
namespace cg = cooperative_groups;

#ifndef PROBE_MASK
#define PROBE_MASK 0
#endif
#ifndef SINGLE_LAUNCH
#define SINGLE_LAUNCH 1
#endif

typedef unsigned short bf16_t;
using bf16x8 = __attribute__((ext_vector_type(8))) short;
using f32x4 = __attribute__((ext_vector_type(4))) float;
using u32x4 = __attribute__((ext_vector_type(4))) unsigned;

#define NTOK 24576
#define NPROMPT 8192
#define PSTRIDE 3200
#define EPSV 1e-6f
#define NPHASE 38

constexpr size_t OFF_MOD = 0;
constexpr size_t OFF_ROPE = 1u << 20;
constexpr size_t OFF_WIN_EV = OFF_ROPE + 65536;
constexpr size_t OFF_WIN_OD = OFF_WIN_EV + 2ull * 3072 * 1024 * 2;
constexpr size_t OFF_WOUT = OFF_WIN_OD + 2ull * 3200 * 1024 * 2;
constexpr size_t OFF_WQ = OFF_WOUT + 4ull * 1024 * 1024 * 2;
constexpr size_t OFF_KEYS = OFF_WQ + 4ull * 2048 * 1024 * 2;
constexpr size_t OFF_UB = OFF_KEYS + 4ull * 8 * 2 * 128 * 128 * 2;
constexpr size_t OFF_VB = OFF_UB + 4ull * 16384 * 1024 * 2;
constexpr size_t OFF_H = OFF_VB + 4ull * 16384 * 1024 * 2;
constexpr size_t OFF_P = OFF_H + (size_t)NTOK * 1024 * 2;
constexpr size_t OFF_YMIX = OFF_P + (size_t)NTOK * PSTRIDE * 2;
constexpr size_t OFF_ODIR = OFF_YMIX + (size_t)NTOK * 1024 * 2;
constexpr size_t OFF_Q = OFF_ODIR;
constexpr size_t OFF_EIDX = OFF_ODIR + 2ull * NTOK * 512 * 4;
constexpr size_t OFF_GATE = OFF_EIDX + (size_t)NTOK * 128 * 4;
constexpr size_t GP_ITEM = 73728;
constexpr size_t OFF_GPREP = OFF_GATE + (size_t)NTOK * 128 * 4;
constexpr size_t OFF_EGL = OFF_GPREP + 3072ull * GP_ITEM;
constexpr size_t OFF_CONV = OFF_EGL + 16384;
constexpr size_t WS_NEED = OFF_CONV + (size_t)NTOK * 512 * 4;

struct Params {
  const float* in[30];
  float* out;
  unsigned char* ws;
};

__device__ const unsigned char CAND_A[52] = {0,0,0,0,0,0,0,0,0,0,0,0,0,0,0,0,1,1,1,1,1,1,1,1,2,2,2,2,2,3,3,3,3,4,4,4,5,5,6,6,7,7,8,9,10,11,12,13,14,15,0,0};
__device__ const unsigned char CAND_B[52] = {0,1,2,3,4,5,6,7,8,9,10,11,12,13,14,15,0,1,2,3,4,5,6,7,0,1,2,3,4,0,1,2,3,0,1,2,0,1,0,1,0,1,0,0,0,0,0,0,0,0,0,0};

__device__ __forceinline__ int opaque_tid() { int t = threadIdx.x; asm volatile("" : "+v"(t)); return t; }
__device__ __forceinline__ bf16_t f2bf(float f) {
  unsigned u = __float_as_uint(f);
  u += 0x7fffu + ((u >> 16) & 1u);
  return (bf16_t)(u >> 16);
}
__device__ __forceinline__ float bf2f(bf16_t b) { return __uint_as_float(((unsigned)b) << 16); }
__device__ __forceinline__ float bflo(unsigned u) { return __uint_as_float(u << 16); }
__device__ __forceinline__ float bfhi(unsigned u) { return __uint_as_float(u & 0xffff0000u); }
__device__ __forceinline__ unsigned pack2(float a, float b) { return (unsigned)f2bf(a) | ((unsigned)f2bf(b) << 16); }
__device__ __forceinline__ float wave_sum(float v) {
#pragma unroll
  for (int o = 32; o > 0; o >>= 1) v += __shfl_xor(v, o);
  return v;
}
__device__ __forceinline__ f32x4 mfma16(bf16x8 a, bf16x8 b, f32x4 c) {
  return __builtin_amdgcn_mfma_f32_16x16x32_bf16(a, b, c, 0, 0, 0);
}
__device__ __forceinline__ bf16x8 ldfrag(const bf16_t* p) { return *(const bf16x8*)p; }
__device__ __forceinline__ float siluf(float v) { return v / (1.f + __expf(-v)); }
__device__ __forceinline__ int tok_mod(int t) { return t < NPROMPT ? 0 : 1 + ((t - NPROMPT) >> 11); }
__device__ __forceinline__ unsigned fkey(float f) {
  unsigned u = __float_as_uint(f);
  return (u & 0x80000000u) ? ~u : (u | 0x80000000u);
}
__device__ __forceinline__ float keyf(unsigned k) {
  unsigned b = (k & 0x80000000u) ? (k ^ 0x80000000u) : ~k;
  return __uint_as_float(b);
}
__device__ __forceinline__ void unpack8(uint4 v, float* f) {
  f[0] = bflo(v.x); f[1] = bfhi(v.x); f[2] = bflo(v.y); f[3] = bfhi(v.y);
  f[4] = bflo(v.z); f[5] = bfhi(v.z); f[6] = bflo(v.w); f[7] = bfhi(v.w);
}

__device__ __forceinline__ void prep_mod(const Params& p, float* smem) {
  float* sc = smem;
  float* red = smem + 9 * 1024;
  const int tid = opaque_tid();
  const float* c = p.in[4];
  const float* cctx = p.in[5];
  for (int i = tid; i < 9 * 1024; i += 256) {
    int m = i >> 10, k = i & 1023;
    float v = (m == 0) ? cctx[k] : c[(m - 1) * 1024 + k];
    sc[i] = v / (1.f + expf(-v));
  }
  __syncthreads();
  float* modv = (float*)(p.ws + OFF_MOD);
  const int cl = tid & 63, kg = tid >> 6;
  for (int u = blockIdx.x; u < 4 * 96; u += gridDim.x) {
    const int l = u / 96, nb = (u % 96) * 64;
    const float* W = p.in[6] + (size_t)l * 1024 * 6144 + nb + cl;
    float acc[9];
#pragma unroll
    for (int m = 0; m < 9; ++m) acc[m] = 0.f;
#pragma unroll 4
    for (int k = kg * 256; k < kg * 256 + 256; ++k) {
      float w = W[(size_t)k * 6144];
#pragma unroll
      for (int m = 0; m < 9; ++m) acc[m] += sc[m * 1024 + k] * w;
    }
#pragma unroll
    for (int m = 0; m < 9; ++m) red[(kg * 9 + m) * 64 + cl] = acc[m];
    __syncthreads();
    for (int i = tid; i < 9 * 64; i += 256) {
      int m = i >> 6, c2 = i & 63;
      float s = red[(0 * 9 + m) * 64 + c2] + red[(1 * 9 + m) * 64 + c2] + red[(2 * 9 + m) * 64 + c2] + red[(3 * 9 + m) * 64 + c2];
      int nn = nb + c2;
      modv[(size_t)(l * 9 + m) * 6144 + nn] = s + p.in[7][l * 6144 + nn];
    }
    __syncthreads();
  }
}

__device__ __forceinline__ void prep_transpose(const float* src, bf16_t* dst, int N, int Npad, float* tile) {
  const int tid = opaque_tid();
  const int ntn = Npad / 64;
  const int units = ntn * 16;
  for (int u = blockIdx.x; u < units; u += gridDim.x) {
    const int nt = u % ntn, kt = u / ntn;
    const int n0 = nt * 64, k0 = kt * 64;
#pragma unroll 4
    for (int i = 0; i < 16; ++i) {
      int r = (tid >> 6) + 4 * i, c = tid & 63;
      int n = n0 + c;
      tile[r * 65 + c] = (n < N) ? src[(size_t)(k0 + r) * N + n] : 0.f;
    }
    __syncthreads();
#pragma unroll 4
    for (int i = 0; i < 16; ++i) {
      int rr = (tid >> 6) + 4 * i, cc = tid & 63;
      dst[(size_t)(n0 + rr) * 1024 + k0 + cc] = f2bf(tile[cc * 65 + rr]);
    }
    __syncthreads();
  }
}

__device__ __forceinline__ void prep_convert(const float* src, bf16_t* dst, size_t n4) {
  const size_t stride = (size_t)gridDim.x * 256;
  for (size_t i = (size_t)blockIdx.x * 256 + threadIdx.x; i < n4; i += stride) {
    float4 v = ((const float4*)src)[i];
    uint2 o;
    o.x = pack2(v.x, v.y);
    o.y = pack2(v.z, v.w);
    ((uint2*)dst)[i] = o;
  }
}

using f32x2 = __attribute__((ext_vector_type(2))) float;
__device__ __forceinline__ void prep_convert_fp8(const float* src, unsigned* dst, size_t n4, float scale) {
  const size_t stride = (size_t)gridDim.x * 256;
  for (size_t i = (size_t)blockIdx.x * 256 + threadIdx.x; i < n4; i += stride) {
    float4 v = ((const float4*)src)[i];
    unsigned w = __builtin_amdgcn_cvt_pk_fp8_f32(v.x * scale, v.y * scale, 0, false);
    w = __builtin_amdgcn_cvt_pk_fp8_f32(v.z * scale, v.w * scale, w, true);
    dst[i] = w;
  }
}
__device__ __forceinline__ void unpack16_fp8(u32x4 v, float* f) {
#pragma unroll
  for (int i = 0; i < 4; ++i) {
    f32x2 lo = __builtin_amdgcn_cvt_pk_f32_fp8(v[i], false);
    f32x2 hi = __builtin_amdgcn_cvt_pk_f32_fp8(v[i], true);
    f[4 * i + 0] = lo.x; f[4 * i + 1] = lo.y; f[4 * i + 2] = hi.x; f[4 * i + 3] = hi.y;
  }
}
#define U_SCALE 32.f
#define V_SCALE 8.f
__device__ __forceinline__ void phase_prep_a(const Params& p, unsigned char* smem) {
  float* fs = (float*)smem;
  prep_mod(p, fs);
  {
    float2* rope = (float2*)(p.ws + OFF_ROPE);
    int i = blockIdx.x * 256 + threadIdx.x;
    if (i < 64 * 16) {
      int pos = i >> 4, f = i & 15;
      float fr = powf(10000.f, -(float)f / 16.f);
      float ang = (float)pos * fr;
      rope[i] = make_float2(cosf(ang), sinf(ang));
    }
  }
  for (int i = 0; i < 2; ++i) {
    prep_transpose(p.in[11] + (size_t)i * 1024 * 3072, (bf16_t*)(p.ws + OFF_WIN_EV) + (size_t)i * 3072 * 1024, 3072, 3072, fs);
    prep_transpose(p.in[16] + (size_t)i * 1024 * 3088, (bf16_t*)(p.ws + OFF_WIN_OD) + (size_t)i * 3200 * 1024, 3088, 3200, fs);
    prep_transpose(p.in[12] + (size_t)i * 1024 * 1024, (bf16_t*)(p.ws + OFF_WOUT) + (size_t)(2 * i) * 1024 * 1024, 1024, 1024, fs);
    prep_transpose(p.in[17] + (size_t)i * 1024 * 1024, (bf16_t*)(p.ws + OFF_WOUT) + (size_t)(2 * i + 1) * 1024 * 1024, 1024, 1024, fs);
  }
  for (int l = 0; l < 4; ++l)
    prep_transpose(p.in[26] + (size_t)l * 1024 * 2048, (bf16_t*)(p.ws + OFF_WQ) + (size_t)l * 2048 * 1024, 2048, 2048, fs);
  prep_convert(p.in[27], (bf16_t*)(p.ws + OFF_KEYS), (size_t)4 * 8 * 2 * 128 * 128 / 4);
  prep_convert_fp8(p.in[28], (unsigned*)(p.ws + OFF_UB), (size_t)4 * 16384 * 1024 / 4, U_SCALE);
  prep_convert_fp8(p.in[29], (unsigned*)(p.ws + OFF_VB), (size_t)4 * 16384 * 1024 / 4, V_SCALE);
}

__device__ __forceinline__ void norm_token(const float* xrow, const float* g, const float* scale, const float* shift,
                                           bf16_t* hrow, float* copy_dst, int lane) {
  float4 v[4];
  float ss = 0.f;
#pragma unroll
  for (int i = 0; i < 4; ++i) {
    v[i] = *(const float4*)(xrow + i * 256 + lane * 4);
    ss += v[i].x * v[i].x + v[i].y * v[i].y + v[i].z * v[i].z + v[i].w * v[i].w;
  }
  ss = wave_sum(ss);
  const float rs = rsqrtf(ss * (1.f / 1024.f) + EPSV);
#pragma unroll
  for (int i = 0; i < 4; ++i) {
    const int idx = i * 256 + lane * 4;
    if (copy_dst) *(float4*)(copy_dst + idx) = v[i];
    float4 gg = *(const float4*)(g + idx);
    float4 sc = *(const float4*)(scale + idx);
    float4 sh = *(const float4*)(shift + idx);
    float a = v[i].x * rs * gg.x * (1.f + sc.x) + sh.x;
    float b = v[i].y * rs * gg.y * (1.f + sc.y) + sh.y;
    float c = v[i].z * rs * gg.z * (1.f + sc.z) + sh.z;
    float d = v[i].w * rs * gg.w * (1.f + sc.w) + sh.w;
    uint2 o;
    o.x = pack2(a, b);
    o.y = pack2(c, d);
    *(uint2*)(hrow + idx) = o;
  }
}

__device__ __forceinline__ void phase_prep_b(const Params& p) {
  const int tid_ = opaque_tid(); const int lane = tid_ & 63, wv = tid_ >> 6;
  const float* modv = (const float*)(p.ws + OFF_MOD);
  bf16_t* H = (bf16_t*)(p.ws + OFF_H);
  for (int t = blockIdx.x * 4 + wv; t < NTOK; t += gridDim.x * 4) {
    const float* xr = (t < NPROMPT) ? p.in[0] + (size_t)t * 1024 : p.in[1] + (size_t)(t - NPROMPT) * 1024;
    const float* md = modv + (size_t)(0 * 9 + tok_mod(t)) * 6144;
    norm_token(xr, p.in[8], md + 1024, md, H + (size_t)t * 1024, p.out + (size_t)t * 1024, lane);
  }
}

__device__ __forceinline__ void phase_norm2(const Params& p, int l) {
  const int tid_ = opaque_tid(); const int lane = tid_ & 63, wv = tid_ >> 6;
  const float* modv = (const float*)(p.ws + OFF_MOD);
  bf16_t* H = (bf16_t*)(p.ws + OFF_H);
  for (int t = blockIdx.x * 4 + wv; t < NTOK; t += gridDim.x * 4) {
    const float* md = modv + (size_t)(l * 9 + tok_mod(t)) * 6144;
    norm_token(p.out + (size_t)t * 1024, p.in[9] + l * 1024, md + 4096, md + 3072, H + (size_t)t * 1024, nullptr, lane);
  }
}

template <int EPI>
__device__ __forceinline__ void gemm_phase(const bf16_t* __restrict__ A, const bf16_t* __restrict__ Bt, int ntiles_n,
                           bf16_t* __restrict__ C, int ldc, float* __restrict__ X, const float* __restrict__ ga,
                           unsigned char* smem) {
  bf16_t* As = (bf16_t*)smem;
  bf16_t* Bs = As + 128 * 72;
  const int tid = opaque_tid(), lane = tid & 63, w = tid >> 6, quad = lane >> 4, l15 = lane & 15;
  const int wm = w >> 1, wn = w & 1;
  const int lr = tid >> 3, lseg = (tid & 7) * 8;
  const int units = 192 * ntiles_n;
  for (int u = blockIdx.x; u < units; u += gridDim.x) {
    const int mt = u % 192, nt = u / 192;
    const int m0 = mt * 128, n0 = nt * 128;
    f32x4 acc[4][4];
#pragma unroll
    for (int i = 0; i < 4; ++i)
#pragma unroll
      for (int j = 0; j < 4; ++j) acc[i][j] = (f32x4){0.f, 0.f, 0.f, 0.f};
    const bf16_t* Ag = A + (size_t)(m0 + lr) * 1024 + lseg;
    const bf16_t* Bg = Bt + (size_t)(n0 + lr) * 1024 + lseg;
    u32x4 ra0, ra1, ra2, ra3, rb0, rb1, rb2, rb3;
    ra0 = *(const u32x4*)(Ag); ra1 = *(const u32x4*)(Ag + 32 * 1024); ra2 = *(const u32x4*)(Ag + 64 * 1024); ra3 = *(const u32x4*)(Ag + 96 * 1024);
    rb0 = *(const u32x4*)(Bg); rb1 = *(const u32x4*)(Bg + 32 * 1024); rb2 = *(const u32x4*)(Bg + 64 * 1024); rb3 = *(const u32x4*)(Bg + 96 * 1024);
    for (int kt = 0; kt < 16; ++kt) {
      *(u32x4*)(As + (lr) * 72 + lseg) = ra0; *(u32x4*)(As + (lr + 32) * 72 + lseg) = ra1;
      *(u32x4*)(As + (lr + 64) * 72 + lseg) = ra2; *(u32x4*)(As + (lr + 96) * 72 + lseg) = ra3;
      *(u32x4*)(Bs + (lr) * 72 + lseg) = rb0; *(u32x4*)(Bs + (lr + 32) * 72 + lseg) = rb1;
      *(u32x4*)(Bs + (lr + 64) * 72 + lseg) = rb2; *(u32x4*)(Bs + (lr + 96) * 72 + lseg) = rb3;
      __syncthreads();
      if (kt + 1 < 16) {
        const bf16_t* An = Ag + (kt + 1) * 64; const bf16_t* Bn = Bg + (kt + 1) * 64;
        ra0 = *(const u32x4*)(An); ra1 = *(const u32x4*)(An + 32 * 1024); ra2 = *(const u32x4*)(An + 64 * 1024); ra3 = *(const u32x4*)(An + 96 * 1024);
        rb0 = *(const u32x4*)(Bn); rb1 = *(const u32x4*)(Bn + 32 * 1024); rb2 = *(const u32x4*)(Bn + 64 * 1024); rb3 = *(const u32x4*)(Bn + 96 * 1024);
      }
#pragma unroll
      for (int kk = 0; kk < 2; ++kk) {
        bf16x8 af[4], bfr[4];
#pragma unroll
        for (int i = 0; i < 4; ++i) af[i] = ldfrag(As + (wm * 64 + i * 16 + l15) * 72 + kk * 32 + quad * 8);
#pragma unroll
        for (int j = 0; j < 4; ++j) bfr[j] = ldfrag(Bs + (wn * 64 + j * 16 + l15) * 72 + kk * 32 + quad * 8);
#pragma unroll
        for (int i = 0; i < 4; ++i)
#pragma unroll
          for (int j = 0; j < 4; ++j) acc[i][j] = mfma16(af[i], bfr[j], acc[i][j]);
      }
      __syncthreads();
    }
    if (EPI == 0) {
#pragma unroll
      for (int i = 0; i < 4; ++i)
#pragma unroll
        for (int j = 0; j < 4; ++j)
#pragma unroll
          for (int jj = 0; jj < 4; ++jj) {
            int row = m0 + wm * 64 + i * 16 + quad * 4 + jj;
            int col = n0 + wn * 64 + j * 16 + l15;
            C[(size_t)row * ldc + col] = f2bf(acc[i][j][jj]);
          }
    } else {
      const float* gam = ga + (size_t)tok_mod(m0) * 6144;
#pragma unroll
      for (int i = 0; i < 4; ++i)
#pragma unroll
        for (int j = 0; j < 4; ++j)
#pragma unroll
          for (int jj = 0; jj < 4; ++jj) {
            int row = m0 + wm * 64 + i * 16 + quad * 4 + jj;
            int col = n0 + wn * 64 + j * 16 + l15;
            float* xp = X + (size_t)row * 1024 + col;
            *xp = *xp + gam[col] * acc[i][j][jj];
          }
    }
  }
}

struct ChainItem {
  bool lng; int sl, dir, h, sq, tok0, nc;
};
__device__ __forceinline__ ChainItem decode_item(int it) {
  ChainItem c;
  c.lng = it < 256;
  int idx = c.lng ? it : it - 256;
  c.sl = idx & 3; c.dir = (idx >> 2) & 1; c.h = (idx >> 3) & 3; c.sq = idx >> 5;
  c.tok0 = c.lng ? NPROMPT + c.sq * 2048 : c.sq * 256;
  c.nc = c.lng ? 32 : 4;
  return c;
}

__device__ __forceinline__ void phase_ret_chain(const Params& p, int l, unsigned char* smem) {
  const int il = l >> 1;
  bf16_t* qs = (bf16_t*)smem;
  bf16_t* ks = qs + 64 * 72;
  bf16_t* kT = ks + 64 * 72;
  bf16_t* vT = kT + 64 * 72;
  bf16_t* intra = vT + 32 * 72;
  bf16_t* ST = intra + 64 * 72;
  const bf16_t* P = (const bf16_t*)(p.ws + OFF_P);
  float* odir = (float*)(p.ws + OFF_ODIR);
  const float2* rope = (const float2*)(p.ws + OFF_ROPE);
  const int tid = opaque_tid(), lane = tid & 63, w = tid >> 6, quad = lane >> 4, l15 = lane & 15;
  for (int it = blockIdx.x; it < 1280; it += gridDim.x) {
    const ChainItem ci = decode_item(it);
    const int sl = ci.sl, dir = ci.dir, h = ci.h;
    const float xg = p.in[13][(il * 2 + dir) * 4 + h];
    const float lg = -log1pf(expf(-xg));
    const float g64 = expf(lg * 64.f);
    f32x4 S[2];
    if (ci.lng) {
      const float* s0 = p.in[2] + ((((size_t)ci.sq * 2 + il) * 2 + dir) * 4 + h) * 8192;
#pragma unroll
      for (int ct = 0; ct < 2; ++ct)
#pragma unroll
        for (int jj = 0; jj < 4; ++jj) S[ct][jj] = s0[(16 * w + quad * 4 + jj) * 128 + sl * 32 + ct * 16 + l15];
    } else {
      S[0] = (f32x4){0.f, 0.f, 0.f, 0.f};
      S[1] = (f32x4){0.f, 0.f, 0.f, 0.f};
    }
    for (int n = 0; n < ci.nc; ++n) {
      const int cn = dir ? ci.nc - 1 - n : n;
      const int tb = ci.tok0 + cn * 64;
      {
        const int i = tid >> 2, mq = tid & 3;
        const int t = tb + (dir ? 63 - i : i);
        const bf16_t* pr = P + (size_t)t * PSTRIDE;
        float qa[8], qb[8], ka[8], kb[8];
        unpack8(*(const uint4*)(pr + h * 64 + mq * 8), qa);
        unpack8(*(const uint4*)(pr + h * 64 + 32 + mq * 8), qb);
        unpack8(*(const uint4*)(pr + 256 + h * 64 + mq * 8), ka);
        unpack8(*(const uint4*)(pr + 256 + h * 64 + 32 + mq * 8), kb);
        if (ci.lng) {
          const int pos = (mq < 2) ? cn : (t - tb);
          const int f0 = (mq & 1) * 8;
#pragma unroll
          for (int e = 0; e < 8; ++e) {
            float2 cs = rope[pos * 16 + f0 + e];
            float a = qa[e], b = qb[e];
            qa[e] = a * cs.x - b * cs.y; qb[e] = b * cs.x + a * cs.y;
            a = ka[e]; b = kb[e];
            ka[e] = a * cs.x - b * cs.y; kb[e] = b * cs.x + a * cs.y;
          }
        }
        const float wend = expf(lg * (float)(63 - i));
        uint4 o;
        o.x = pack2(qa[0], qa[1]); o.y = pack2(qa[2], qa[3]); o.z = pack2(qa[4], qa[5]); o.w = pack2(qa[6], qa[7]);
        *(uint4*)(qs + i * 72 + mq * 8) = o;
        o.x = pack2(qb[0], qb[1]); o.y = pack2(qb[2], qb[3]); o.z = pack2(qb[4], qb[5]); o.w = pack2(qb[6], qb[7]);
        *(uint4*)(qs + i * 72 + 32 + mq * 8) = o;
#pragma unroll
        for (int e = 0; e < 8; ++e) { ka[e] *= 0.125f; kb[e] *= 0.125f; }
        o.x = pack2(ka[0], ka[1]); o.y = pack2(ka[2], ka[3]); o.z = pack2(ka[4], ka[5]); o.w = pack2(ka[6], ka[7]);
        *(uint4*)(ks + i * 72 + mq * 8) = o;
        o.x = pack2(kb[0], kb[1]); o.y = pack2(kb[2], kb[3]); o.z = pack2(kb[4], kb[5]); o.w = pack2(kb[6], kb[7]);
        *(uint4*)(ks + i * 72 + 32 + mq * 8) = o;
#pragma unroll
        for (int e = 0; e < 8; ++e) {
          kT[(mq * 8 + e) * 72 + i] = f2bf(ka[e] * wend);
          kT[(32 + mq * 8 + e) * 72 + i] = f2bf(kb[e] * wend);
        }
        uint4 v8 = *(const uint4*)(pr + 512 + h * 128 + sl * 32 + mq * 8);
        vT[(mq * 8 + 0) * 72 + i] = (bf16_t)(v8.x & 0xffff); vT[(mq * 8 + 1) * 72 + i] = (bf16_t)(v8.x >> 16);
        vT[(mq * 8 + 2) * 72 + i] = (bf16_t)(v8.y & 0xffff); vT[(mq * 8 + 3) * 72 + i] = (bf16_t)(v8.y >> 16);
        vT[(mq * 8 + 4) * 72 + i] = (bf16_t)(v8.z & 0xffff); vT[(mq * 8 + 5) * 72 + i] = (bf16_t)(v8.z >> 16);
        vT[(mq * 8 + 6) * 72 + i] = (bf16_t)(v8.w & 0xffff); vT[(mq * 8 + 7) * 72 + i] = (bf16_t)(v8.w >> 16);
      }
      __syncthreads();
      const bf16x8 a0 = ldfrag(qs + (16 * w + l15) * 72 + quad * 8);
      const bf16x8 a1 = ldfrag(qs + (16 * w + l15) * 72 + 32 + quad * 8);
#pragma unroll
      for (int ct = 0; ct < 4; ++ct) {
        bf16x8 b0 = ldfrag(ks + (ct * 16 + l15) * 72 + quad * 8);
        bf16x8 b1 = ldfrag(ks + (ct * 16 + l15) * 72 + 32 + quad * 8);
        f32x4 c = (f32x4){0.f, 0.f, 0.f, 0.f};
        c = mfma16(a0, b0, c);
        c = mfma16(a1, b1, c);
#pragma unroll
        for (int jj = 0; jj < 4; ++jj) {
          int i = 16 * w + quad * 4 + jj, j = ct * 16 + l15;
          float val = (i >= j) ? c[jj] * expf(lg * (float)(i - j)) : 0.f;
          intra[i * 72 + j] = f2bf(val);
        }
      }
#pragma unroll
      for (int ct = 0; ct < 2; ++ct)
#pragma unroll
        for (int jj = 0; jj < 4; ++jj) ST[(ct * 16 + l15) * 72 + 16 * w + quad * 4 + jj] = f2bf(S[ct][jj]);
      __syncthreads();
      const bf16x8 ai0 = ldfrag(intra + (16 * w + l15) * 72 + quad * 8);
      const bf16x8 ai1 = ldfrag(intra + (16 * w + l15) * 72 + 32 + quad * 8);
      const bf16x8 ak0 = ldfrag(kT + (16 * w + l15) * 72 + quad * 8);
      const bf16x8 ak1 = ldfrag(kT + (16 * w + l15) * 72 + 32 + quad * 8);
#pragma unroll
      for (int ct = 0; ct < 2; ++ct) {
        bf16x8 bv0 = ldfrag(vT + (ct * 16 + l15) * 72 + quad * 8);
        bf16x8 bv1 = ldfrag(vT + (ct * 16 + l15) * 72 + 32 + quad * 8);
        bf16x8 bs0 = ldfrag(ST + (ct * 16 + l15) * 72 + quad * 8);
        bf16x8 bs1 = ldfrag(ST + (ct * 16 + l15) * 72 + 32 + quad * 8);
        f32x4 ci_ = (f32x4){0.f, 0.f, 0.f, 0.f}, cc = (f32x4){0.f, 0.f, 0.f, 0.f};
        ci_ = mfma16(ai0, bv0, ci_);
        ci_ = mfma16(ai1, bv1, ci_);
        cc = mfma16(a0, bs0, cc);
        cc = mfma16(a1, bs1, cc);
#pragma unroll
        for (int jj = 0; jj < 4; ++jj) {
          int i = 16 * w + quad * 4 + jj;
          int t = tb + (dir ? 63 - i : i);
          float o = ci_[jj] + expf(lg * (float)(i + 1)) * cc[jj];
          odir[((size_t)dir * NTOK + t) * 512 + h * 128 + sl * 32 + ct * 16 + l15] = o;
        }
        f32x4 s = S[ct];
        s[0] *= g64; s[1] *= g64; s[2] *= g64; s[3] *= g64;
        s = mfma16(ak0, bv0, s);
        s = mfma16(ak1, bv1, s);
        S[ct] = s;
      }
      __syncthreads();
    }
    if (!ci.lng) {
      float* so = p.out + 25165824 + ((((size_t)ci.sq * 2 + il) * 2 + dir) * 4 + h) * 8192;
#pragma unroll
      for (int ct = 0; ct < 2; ++ct)
#pragma unroll
        for (int jj = 0; jj < 4; ++jj) so[(16 * w + quad * 4 + jj) * 128 + sl * 32 + ct * 16 + l15] = S[ct][jj];
    }
  }
}

__device__ __forceinline__ void gdn_prep_item(const Params& p, int l, int pi, unsigned char* smem) {
  const int il = l >> 1;
  bf16_t* ks = (bf16_t*)smem;
  bf16_t* vs = ks + 64 * 136;
  float* Am = (float*)(vs + 64 * 136);
  float* rq = Am + 4096;
  float* rk = rq + 64;
  float* gcs = rk + 64;
  float* bet = gcs + 64;
  float* fac = bet + 64;
  bf16_t* qs = (bf16_t*)(fac + 128);
  const bf16_t* P = (const bf16_t*)(p.ws + OFF_P);
  unsigned char* gp = p.ws + OFF_GPREP + (size_t)pi * GP_ITEM;
  bf16_t* Wb = (bf16_t*)gp;
  bf16_t* QG = Wb + 8192;
  bf16_t* KDT = QG + 8192;
  bf16_t* Ub = KDT + 8192;
  bf16_t* ATT = Ub + 8192;
  float* EGL = (float*)(p.ws + OFF_EGL);
  const int tid = opaque_tid(), lane = tid & 63, w = tid >> 6, quad = lane >> 4, l15 = lane & 15;
  const int dir = pi & 1, h = (pi >> 1) & 3, c = pi >> 3;
  int tb, seq_lo, seq_hi;
  if (c < 128) { tb = c * 64; seq_lo = (c >> 2) * 256; seq_hi = seq_lo + 256; }
  else { int cc = c - 128; tb = NPROMPT + cc * 64; seq_lo = NPROMPT + (cc >> 5) * 2048; seq_hi = seq_lo + 2048; }
  const float SCALE = 0.08838834764831845f;
  {
    const int cg_ = tid & 127, rh = tid >> 7;
    for (int mat = 0; mat < 3; ++mat) {
      const int col = mat * 512 + h * 128 + cg_;
      const float* cw = p.in[18] + (size_t)il * 3 * 1536 + col;
      const float w0 = cw[0], w1 = cw[1536], w2 = cw[3072];
      bf16_t* dst = mat == 0 ? qs : (mat == 1 ? ks : vs);
      const int t0 = tb + rh * 32;
      bf16_t raw[34];
#pragma unroll
      for (int o = 0; o < 34; ++o) {
        const int t = t0 - 1 + o;
        raw[o] = (t >= seq_lo && t < seq_hi) ? P[(size_t)t * PSTRIDE + col] : (bf16_t)0;
      }
#pragma unroll
      for (int o = 0; o < 32; ++o) {
        float y = w0 * bf2f(raw[o]) + w1 * bf2f(raw[o + 1]) + w2 * bf2f(raw[o + 2]);
        y = siluf(y);
        const int oi = rh * 32 + o;
        const int i = dir ? 63 - oi : oi;
        dst[i * 136 + cg_] = f2bf(y);
      }
    }
  }
  __syncthreads();
  {
    const int r = tid >> 2, part = tid & 3;
    float sq_ = 0.f, sk_ = 0.f;
#pragma unroll 8
    for (int e = 0; e < 32; ++e) {
      float a = bf2f(qs[r * 136 + part * 32 + e]);
      float b = bf2f(ks[r * 136 + part * 32 + e]);
      sq_ += a * a; sk_ += b * b;
    }
    sq_ += __shfl_xor(sq_, 1); sq_ += __shfl_xor(sq_, 2);
    sk_ += __shfl_xor(sk_, 1); sk_ += __shfl_xor(sk_, 2);
    if (part == 0) {
      rq[r] = rsqrtf(sq_ + EPSV);
      rk[r] = rsqrtf(sk_ + EPSV);
      const int t = tb + (dir ? 63 - r : r);
      float a = bf2f(P[(size_t)t * PSTRIDE + 2048 + dir * 4 + h]);
      float bbv = bf2f(P[(size_t)t * PSTRIDE + 2056 + dir * 4 + h]);
      float al = p.in[19][(il * 2 + dir) * 4 + h], dtb = p.in[20][(il * 2 + dir) * 4 + h];
      float z = a + dtb;
      float sp = (z > 20.f) ? z : log1pf(expf(z));
      gcs[r] = -expf(al) * sp;
      bet[r] = 1.f / (1.f + expf(-bbv));
    }
  }
  __syncthreads();
  if (tid < 64) {
    float v = gcs[tid];
#pragma unroll
    for (int o = 1; o < 64; o <<= 1) {
      float u = __shfl_up(v, o);
      if (tid >= o) v += u;
    }
    gcs[tid] = v;
  }
  __syncthreads();
  {
    bf16x8 ak[4], aq[4];
#pragma unroll
    for (int kk = 0; kk < 4; ++kk) {
      ak[kk] = ldfrag(ks + (16 * w + l15) * 136 + kk * 32 + quad * 8);
      aq[kk] = ldfrag(qs + (16 * w + l15) * 136 + kk * 32 + quad * 8);
    }
#pragma unroll
    for (int ct = 0; ct < 4; ++ct) {
      f32x4 ckk = (f32x4){0.f, 0.f, 0.f, 0.f}, cqk = (f32x4){0.f, 0.f, 0.f, 0.f};
#pragma unroll
      for (int kk = 0; kk < 4; ++kk) {
        bf16x8 b = ldfrag(ks + (ct * 16 + l15) * 136 + kk * 32 + quad * 8);
        ckk = mfma16(ak[kk], b, ckk);
        cqk = mfma16(aq[kk], b, cqk);
      }
#pragma unroll
      for (int jj = 0; jj < 4; ++jj) {
        const int i = 16 * w + quad * 4 + jj, j = ct * 16 + l15;
        const float dec = (i >= j) ? expf(gcs[i] - gcs[j]) : 0.f;
        Am[j * 64 + i] = (i > j) ? bet[i] * rk[i] * rk[j] * ckk[jj] * dec : 0.f;
        ATT[i * 64 + j] = f2bf((i >= j) ? SCALE * rq[i] * rk[j] * cqk[jj] * dec : 0.f);
      }
    }
  }
  __syncthreads();
  const float gl = gcs[63];
  for (int e = tid; e < 64 * 128; e += 256) {
    int i = e >> 7, d = e & 127;
    QG[e] = f2bf(bf2f(qs[i * 136 + d]) * rq[i] * SCALE * __expf(gcs[i]));
  }
  for (int e = tid; e < 128 * 64; e += 256) {
    int d = e >> 6, i = e & 63;
    KDT[e] = f2bf(bf2f(ks[i * 136 + d]) * rk[i] * __expf(gl - gcs[i]));
  }
  if (tid < 64) {
    fac[tid] = bet[tid];
    fac[64 + tid] = rk[tid] * bet[tid] * __expf(gcs[tid]);
  }
  __syncthreads();
  {
    const int cidx = tid & 127;
    const bf16_t* srcm = ((tid < 128) ? vs : ks) + cidx;
    const float* fc = fac + ((tid < 128) ? 0 : 64);
    bf16_t* dstm = ((tid < 128) ? Ub : Wb) + cidx;
    bf16_t* XB = qs + tid;
#pragma unroll 1
    for (int b = 0; b < 4; ++b) {
      float x[16];
#pragma unroll
      for (int r = 0; r < 16; ++r) x[r] = bf2f(srcm[(16 * b + r) * 136]) * fc[16 * b + r];
      const float* arow = Am + 16 * b;
#pragma unroll 2
      for (int j = 0; j < 16 * b; ++j) {
        const float xv = bf2f(XB[j * 256]);
        const f32x4 a0 = *(const f32x4*)(arow + j * 64), a1 = *(const f32x4*)(arow + j * 64 + 4);
        const f32x4 a2 = *(const f32x4*)(arow + j * 64 + 8), a3 = *(const f32x4*)(arow + j * 64 + 12);
#pragma unroll
        for (int r = 0; r < 4; ++r) {
          x[r] -= a0[r] * xv; x[4 + r] -= a1[r] * xv; x[8 + r] -= a2[r] * xv; x[12 + r] -= a3[r] * xv;
        }
      }
      const float* ablk = Am + (16 * b) * 64 + 16 * b;
#pragma unroll
      for (int jj = 0; jj < 15; ++jj) {
#pragma unroll
        for (int r = jj + 1; r < 16; ++r) x[r] -= ablk[jj * 64 + r] * x[jj];
      }
#pragma unroll
      for (int r = 0; r < 16; ++r) {
        const bf16_t bb = f2bf(x[r]);
        dstm[(16 * b + r) * 128] = bb;
        if (b < 3) XB[(16 * b + r) * 256] = bb;
      }
    }
  }
  if (tid == 0) EGL[pi] = expf(gl);
  __syncthreads();
}

__device__ __forceinline__ void conf_conv_item(const Params& p, int l, int item, unsigned char* smem) {
  const int il = l >> 1;
  float* hc = (float*)smem;
  const bf16_t* P = (const bf16_t*)(p.ws + OFF_P);
  float* convout = (float*)(p.ws + OFF_CONV);
  const int tid = opaque_tid();
  const int tile = item >> 1, ch = (item & 1) * 256 + tid;
  const int t0 = tile * 32;
  int seq_lo, seq_hi;
  if (t0 < NPROMPT) { seq_lo = (t0 >> 8) << 8; seq_hi = seq_lo + 256; }
  else { seq_lo = NPROMPT + (((t0 - NPROMPT) >> 11) << 11); seq_hi = seq_lo + 2048; }
#pragma unroll 31
  for (int r = 0; r < 62; ++r) {
    const int tt = t0 - 15 + r;
    float v = 0.f;
    if (tt >= seq_lo && tt < seq_hi) {
      float ca = bf2f(P[(size_t)tt * PSTRIDE + 2064 + ch]);
      float cgv = bf2f(P[(size_t)tt * PSTRIDE + 2576 + ch]);
      v = ca / (1.f + __expf(-cgv));
    }
    hc[r * 256 + tid] = v;
  }
  float wk[31];
#pragma unroll
  for (int k = 0; k < 31; ++k) wk[k] = p.in[22][((size_t)il * 31 + k) * 512 + ch];
  const float bias = p.in[23][il * 512 + ch];
  for (int i = 0; i < 32; ++i) {
    float acc = bias;
#pragma unroll
    for (int k = 0; k < 31; ++k) acc += wk[k] * hc[(i + k) * 256 + tid];
    convout[(size_t)(t0 + i) * 512 + ch] = acc;
  }
}

__device__ __forceinline__ void phase_odd_prep(const Params& p, int l, unsigned char* smem) {
  for (int u = blockIdx.x; u < 3072 + 1536; u += gridDim.x) {
    if (u < 3072) gdn_prep_item(p, l, u, smem);
    else { conf_conv_item(p, l, u - 3072, smem); __syncthreads(); }
  }
}

__device__ __forceinline__ void phase_gdn_chain(const Params& p, int l, unsigned char* smem) {
  const int il = l >> 1;
  bf16_t* ST = (bf16_t*)smem;
  bf16_t* VT = ST + 32 * 136;
  float* odir = (float*)(p.ws + OFF_ODIR);
  const float* EGL = (const float*)(p.ws + OFF_EGL);
  const int tid = opaque_tid(), lane = tid & 63, w = tid >> 6, quad = lane >> 4, l15 = lane & 15;
  for (int it = blockIdx.x; it < 1280; it += gridDim.x) {
    const ChainItem ci = decode_item(it);
    const int sl = ci.sl, dir = ci.dir, h = ci.h;
    f32x4 S[2][2];
    if (ci.lng) {
      const float* s0 = p.in[3] + ((((size_t)ci.sq * 2 + il) * 2 + dir) * 4 + h) * 16384;
#pragma unroll
      for (int rb = 0; rb < 2; ++rb)
#pragma unroll
        for (int ct = 0; ct < 2; ++ct)
#pragma unroll
          for (int jj = 0; jj < 4; ++jj)
            S[rb][ct][jj] = s0[(16 * (2 * w + rb) + quad * 4 + jj) * 128 + sl * 32 + ct * 16 + l15];
    } else {
#pragma unroll
      for (int rb = 0; rb < 2; ++rb)
#pragma unroll
        for (int ct = 0; ct < 2; ++ct) S[rb][ct] = (f32x4){0.f, 0.f, 0.f, 0.f};
    }
    for (int n = 0; n < ci.nc; ++n) {
      const int cn = dir ? ci.nc - 1 - n : n;
      const int tb = ci.tok0 + cn * 64;
      const int cglob = ci.lng ? 128 + ci.sq * 32 + cn : ci.sq * 4 + cn;
      const int pi = (cglob * 4 + h) * 2 + dir;
      const unsigned char* gp = p.ws + OFF_GPREP + (size_t)pi * GP_ITEM;
      const bf16_t* Wb = (const bf16_t*)gp;
      const bf16_t* QG = Wb + 8192;
      const bf16_t* KDT = QG + 8192;
      const bf16_t* Ub = KDT + 8192;
      const bf16_t* ATT = Ub + 8192;
      bf16x8 aw[4], aqg[4], aat[2], akd[2][2];
      float uu[2][4];
#pragma unroll
      for (int kk = 0; kk < 4; ++kk) {
        aw[kk] = ldfrag(Wb + (16 * w + l15) * 128 + kk * 32 + quad * 8);
        aqg[kk] = ldfrag(QG + (16 * w + l15) * 128 + kk * 32 + quad * 8);
      }
#pragma unroll
      for (int kk = 0; kk < 2; ++kk) {
        aat[kk] = ldfrag(ATT + (16 * w + l15) * 64 + kk * 32 + quad * 8);
#pragma unroll
        for (int rb = 0; rb < 2; ++rb) akd[rb][kk] = ldfrag(KDT + (16 * (2 * w + rb) + l15) * 64 + kk * 32 + quad * 8);
      }
#pragma unroll
      for (int ct = 0; ct < 2; ++ct)
#pragma unroll
        for (int jj = 0; jj < 4; ++jj) uu[ct][jj] = bf2f(Ub[(16 * w + quad * 4 + jj) * 128 + sl * 32 + ct * 16 + l15]);
      const float egl = EGL[pi];
#pragma unroll
      for (int rb = 0; rb < 2; ++rb)
#pragma unroll
        for (int ct = 0; ct < 2; ++ct)
#pragma unroll
          for (int jj = 0; jj < 4; ++jj)
            ST[(ct * 16 + l15) * 136 + 16 * (2 * w + rb) + quad * 4 + jj] = f2bf(S[rb][ct][jj]);
      __syncthreads();
      f32x4 co[2];
#pragma unroll
      for (int ct = 0; ct < 2; ++ct) {
        f32x4 cv = (f32x4){0.f, 0.f, 0.f, 0.f};
        co[ct] = (f32x4){0.f, 0.f, 0.f, 0.f};
#pragma unroll
        for (int kk = 0; kk < 4; ++kk) {
          bf16x8 b = ldfrag(ST + (ct * 16 + l15) * 136 + kk * 32 + quad * 8);
          cv = mfma16(aw[kk], b, cv);
          co[ct] = mfma16(aqg[kk], b, co[ct]);
        }
#pragma unroll
        for (int jj = 0; jj < 4; ++jj) {
          float vn = uu[ct][jj] - cv[jj];
          VT[(ct * 16 + l15) * 72 + 16 * w + quad * 4 + jj] = f2bf(vn);
        }
      }
      __syncthreads();
#pragma unroll
      for (int ct = 0; ct < 2; ++ct) {
        bf16x8 bv[2];
#pragma unroll
        for (int kk = 0; kk < 2; ++kk) {
          bv[kk] = ldfrag(VT + (ct * 16 + l15) * 72 + kk * 32 + quad * 8);
          co[ct] = mfma16(aat[kk], bv[kk], co[ct]);
        }
#pragma unroll
        for (int jj = 0; jj < 4; ++jj) {
          int i = 16 * w + quad * 4 + jj;
          int t = tb + (dir ? 63 - i : i);
          odir[((size_t)dir * NTOK + t) * 512 + h * 128 + sl * 32 + ct * 16 + l15] = co[ct][jj];
        }
#pragma unroll
        for (int rb = 0; rb < 2; ++rb) {
          f32x4 s = S[rb][ct];
          s[0] *= egl; s[1] *= egl; s[2] *= egl; s[3] *= egl;
          s = mfma16(akd[rb][0], bv[0], s);
          s = mfma16(akd[rb][1], bv[1], s);
          S[rb][ct] = s;
        }
      }
    }
    __syncthreads();
    if (!ci.lng) {
      float* so = p.out + 29360128 + ((((size_t)ci.sq * 2 + il) * 2 + dir) * 4 + h) * 16384;
#pragma unroll
      for (int rb = 0; rb < 2; ++rb)
#pragma unroll
        for (int ct = 0; ct < 2; ++ct)
#pragma unroll
          for (int jj = 0; jj < 4; ++jj)
            so[(16 * (2 * w + rb) + quad * 4 + jj) * 128 + sl * 32 + ct * 16 + l15] = S[rb][ct][jj];
    }
  }
}

__device__ __forceinline__ void phase_mix_out(const Params& p, int l) {
  const int il = l >> 1;
  const bool odd = l & 1;
  const int tid_ = opaque_tid(); const int lane = tid_ & 63, wv = tid_ >> 6;
  const bf16_t* P = (const bf16_t*)(p.ws + OFF_P);
  const float* od0 = (const float*)(p.ws + OFF_ODIR);
  const float* od1 = od0 + (size_t)NTOK * 512;
  const float* convout = (const float*)(p.ws + OFF_CONV);
  bf16_t* Y = (bf16_t*)(p.ws + OFF_YMIX);
  for (int t = blockIdx.x * 4 + wv; t < NTOK; t += gridDim.x * 4) {
    const bf16_t* pr = P + (size_t)t * PSTRIDE;
    bf16_t* yr = Y + (size_t)t * 1024;
#pragma unroll
    for (int h = 0; h < 4; ++h) {
      const int idx = h * 128 + lane * 2;
      float2 a = *(const float2*)(od0 + (size_t)t * 512 + idx);
      float2 b = *(const float2*)(od1 + (size_t)t * 512 + idx);
      float o0 = a.x + b.x, o1 = a.y + b.y;
      float ss = wave_sum(o0 * o0 + o1 * o1);
      float rs = rsqrtf(ss * (1.f / 128.f) + EPSV);
      float n0, n1;
      unsigned gz;
      if (!odd) {
        n0 = p.in[14][il * 512 + idx]; n1 = p.in[14][il * 512 + idx + 1];
        gz = *(const unsigned*)(pr + 1024 + idx);
      } else {
        n0 = p.in[21][il * 128 + lane * 2]; n1 = p.in[21][il * 128 + lane * 2 + 1];
        gz = *(const unsigned*)(pr + 1536 + idx);
      }
      float y0 = siluf(bflo(gz)) * o0 * rs * n0;
      float y1 = siluf(bfhi(gz)) * o1 * rs * n1;
      *(unsigned*)(yr + idx) = pack2(y0, y1);
    }
    if (!odd) {
      int seq_lo, seq_hi;
      if (t < NPROMPT) { seq_lo = (t >> 8) << 8; seq_hi = seq_lo + 256; }
      else { seq_lo = NPROMPT + (((t - NPROMPT) >> 11) << 11); seq_hi = seq_lo + 2048; }
      const bool hp = (t - 1 >= seq_lo), hn = (t + 1 < seq_hi);
#pragma unroll
      for (int j = 0; j < 4; ++j) {
        const int c = j * 128 + lane * 2;
        unsigned cg0 = *(const unsigned*)(pr + 2048 + c), hb0 = *(const unsigned*)(pr + 2560 + c);
        unsigned cgm = 0, hbm = 0, cgp = 0, hbp = 0;
        if (hp) { cgm = *(const unsigned*)(pr - PSTRIDE + 2048 + c); hbm = *(const unsigned*)(pr - PSTRIDE + 2560 + c); }
        if (hn) { cgp = *(const unsigned*)(pr + PSTRIDE + 2048 + c); hbp = *(const unsigned*)(pr + PSTRIDE + 2560 + c); }
        unsigned bg = *(const unsigned*)(pr + 1536 + c);
        const float* sw = p.in[15] + (size_t)il * 3 * 512 + c;
        float y0 = bflo(bg) * (sw[0] * bflo(cgm) * bflo(hbm) + sw[512] * bflo(cg0) * bflo(hb0) + sw[1024] * bflo(cgp) * bflo(hbp));
        float y1 = bfhi(bg) * (sw[1] * bfhi(cgm) * bfhi(hbm) + sw[513] * bfhi(cg0) * bfhi(hb0) + sw[1025] * bfhi(cgp) * bfhi(hbp));
        *(unsigned*)(yr + 512 + c) = pack2(y0, y1);
      }
    } else {
      float v[8];
      float s = 0.f;
#pragma unroll
      for (int j = 0; j < 4; ++j) {
        float2 a = *(const float2*)(convout + (size_t)t * 512 + j * 128 + lane * 2);
        v[2 * j] = a.x; v[2 * j + 1] = a.y;
        s += a.x + a.y;
      }
      const float mean = wave_sum(s) * (1.f / 512.f);
      float vs = 0.f;
#pragma unroll
      for (int j = 0; j < 8; ++j) { v[j] -= mean; vs += v[j] * v[j]; }
      const float rstd = rsqrtf(wave_sum(vs) * (1.f / 512.f) + EPSV);
#pragma unroll
      for (int j = 0; j < 4; ++j) {
        const int c = j * 128 + lane * 2;
        float y0 = v[2 * j] * rstd * p.in[24][il * 512 + c] + p.in[25][il * 512 + c];
        float y1 = v[2 * j + 1] * rstd * p.in[24][il * 512 + c + 1] + p.in[25][il * 512 + c + 1];
        *(unsigned*)(yr + 512 + c) = pack2(siluf(y0), siluf(y1));
      }
    }
  }
}

__device__ __forceinline__ void phase_peer_score(const Params& p, int l, unsigned char* smem) {
  const int tid = opaque_tid(), lane = tid & 63, w = tid >> 6, quad = lane >> 4, l15 = lane & 15;
  unsigned* scw = (unsigned*)smem + w * (32 * 129 + 512);
  unsigned* sel = scw + 32 * 129;
  const bf16_t* Q = (const bf16_t*)(p.ws + OFF_Q);
  const bf16_t* KB = (const bf16_t*)(p.ws + OFF_KEYS) + (size_t)l * 8 * 2 * 128 * 128;
  int* EI = (int*)(p.ws + OFF_EIDX);
  float* GT = (float*)(p.ws + OFF_GATE);
  for (int u = blockIdx.x; u < 3072; u += gridDim.x) {
    const int tt = u >> 1, h = (u & 1) * 4 + w;
    const int t0 = tt * 16;
#pragma unroll
    for (int pp = 0; pp < 2; ++pp) {
      bf16x8 a[4];
#pragma unroll
      for (int kk = 0; kk < 4; ++kk) a[kk] = ldfrag(Q + (size_t)(t0 + l15) * 2048 + h * 256 + pp * 128 + kk * 32 + quad * 8);
      const bf16_t* kb = KB + (size_t)((h * 2 + pp) * 128) * 128;
#pragma unroll
      for (int ct = 0; ct < 8; ++ct) {
        f32x4 c = (f32x4){0.f, 0.f, 0.f, 0.f};
#pragma unroll
        for (int kk = 0; kk < 4; ++kk) {
          bf16x8 b = ldfrag(kb + (ct * 16 + l15) * 128 + kk * 32 + quad * 8);
          c = mfma16(a[kk], b, c);
        }
#pragma unroll
        for (int jj = 0; jj < 4; ++jj) {
          const int row = pp * 16 + quad * 4 + jj, col = ct * 16 + l15;
          unsigned key = (fkey(c[jj]) & ~127u) | (unsigned)(127 - col);
          scw[row * 129 + col] = key;
        }
      }
    }
    __syncthreads();
    {
      const int row = lane >> 1, hf = lane & 1;
      const unsigned* rp = scw + row * 129 + hf * 64;
      unsigned prev = 0xFFFFFFFFu;
      for (int r = 0; r < 16; ++r) {
        unsigned best = 0;
#pragma unroll 16
        for (int j = 0; j < 64; ++j) {
          unsigned k = rp[j];
          unsigned tsel = (k < prev) ? k : 0u;
          best = max(best, tsel);
        }
        unsigned ob = (unsigned)__shfl_xor((int)best, 1);
        best = max(best, ob);
        prev = best;
        if (hf == 0) sel[row * 16 + r] = best;
      }
    }
    __syncthreads();
    {
      const int tok = lane >> 2, sub = lane & 3;
      const unsigned* s1 = sel + tok * 16;
      const unsigned* s2 = sel + (16 + tok) * 16;
      unsigned ck[13];
#pragma unroll
      for (int i = 0; i < 13; ++i) {
        const int cidx = sub + 4 * i;
        const int a = CAND_A[cidx], b = CAND_B[cidx];
        float s = keyf(s1[a] & ~127u) + keyf(s2[b] & ~127u);
        unsigned k = (fkey(s) & ~255u) | (unsigned)(255 - (a * 16 + b));
        ck[i] = (cidx < 50) ? k : 0u;
      }
      unsigned prev = 0xFFFFFFFFu;
      unsigned top[16];
#pragma unroll
      for (int r = 0; r < 16; ++r) {
        unsigned best = 0;
#pragma unroll
        for (int i = 0; i < 13; ++i) {
          unsigned tsel = (ck[i] < prev) ? ck[i] : 0u;
          best = max(best, tsel);
        }
        best = max(best, (unsigned)__shfl_xor((int)best, 1));
        best = max(best, (unsigned)__shfl_xor((int)best, 2));
        prev = best;
        top[r] = best;
      }
      float sv[16];
      int ev[16];
#pragma unroll
      for (int r = 0; r < 16; ++r) {
        const int cidx = 255 - (int)(top[r] & 255u);
        const int a = cidx >> 4, b = cidx & 15;
        const unsigned k1 = s1[a], k2 = s2[b];
        sv[r] = keyf(k1 & ~127u) + keyf(k2 & ~127u);
        ev[r] = (127 - (int)(k1 & 127u)) * 128 + (127 - (int)(k2 & 127u));
      }
      float mx = sv[0];
#pragma unroll
      for (int r = 1; r < 16; ++r) mx = fmaxf(mx, sv[r]);
      float sum = 0.f;
#pragma unroll
      for (int r = 0; r < 16; ++r) { sv[r] = expf(sv[r] - mx); sum += sv[r]; }
      const float inv = 1.f / sum;
      const size_t ob = (size_t)(t0 + tok) * 128 + h * 16;
#pragma unroll
      for (int r = 0; r < 16; ++r) {
        if ((r & 3) == sub) { EI[ob + r] = ev[r]; GT[ob + r] = sv[r] * inv; }
      }
    }
    __syncthreads();
  }
}

__device__ __forceinline__ float gelu_tanh(float x) {
  return 0.5f * x * (1.f + tanhf(0.7978845608028654f * (x + 0.044715f * x * x * x)));
}
__device__ __forceinline__ void phase_peer_gather(const Params& p, int l) {
  const int tid_ = opaque_tid(); const int lane = tid_ & 63, wv = tid_ >> 6;
  const bf16_t* H = (const bf16_t*)(p.ws + OFF_H);
  bf16_t* Hw = (bf16_t*)(p.ws + OFF_H);
  const unsigned char* UB = p.ws + OFF_UB + (size_t)l * 16384 * 1024;
  const unsigned char* VB = p.ws + OFF_VB + (size_t)l * 16384 * 1024;
  const int* EI = (const int*)(p.ws + OFF_EIDX);
  const float* GT = (const float*)(p.ws + OFF_GATE);
  const float* modv = (const float*)(p.ws + OFF_MOD);
  for (int t = blockIdx.x * 4 + wv; t < NTOK; t += gridDim.x * 4) {
    float xf[16];
    unpack8(*(const uint4*)(H + (size_t)t * 1024 + lane * 16), xf);
    unpack8(*(const uint4*)(H + (size_t)t * 1024 + lane * 16 + 8), xf + 8);
    float out[16];
#pragma unroll
    for (int e = 0; e < 16; ++e) out[e] = 0.f;
    float coef[2];
    int eix[2];
#pragma unroll
    for (int hf = 0; hf < 2; ++hf) {
      const int ev = EI[(size_t)t * 128 + hf * 64 + lane];
      const float gv = GT[(size_t)t * 128 + hf * 64 + lane];
      float cacc = 0.f;
      for (int k = 0; k < 64; k += 8) {
        u32x4 rows[8];
#pragma unroll
        for (int j = 0; j < 8; ++j) {
          const int e = __builtin_amdgcn_readlane(ev, k + j);
          rows[j] = *(const u32x4*)(UB + (size_t)e * 1024 + lane * 16);
        }
        float d[8];
#pragma unroll
        for (int j = 0; j < 8; ++j) {
          float uf[16];
          unpack16_fp8(rows[j], uf);
          float sacc = 0.f;
#pragma unroll
          for (int q = 0; q < 16; ++q) sacc += uf[q] * xf[q];
          d[j] = sacc;
        }
#pragma unroll
        for (int j = 0; j < 8; ++j) {
          float sacc = wave_sum(d[j]) * (1.f / U_SCALE);
          if (lane == k + j) cacc = gelu_tanh(sacc);
        }
      }
      coef[hf] = cacc * gv * (1.f / V_SCALE);
      eix[hf] = ev;
    }
#pragma unroll
    for (int hf = 0; hf < 2; ++hf) {
      for (int k = 0; k < 64; k += 8) {
        u32x4 rows[8];
#pragma unroll
        for (int j = 0; j < 8; ++j) {
          const int e = __builtin_amdgcn_readlane(eix[hf], k + j);
          rows[j] = *(const u32x4*)(VB + (size_t)e * 1024 + lane * 16);
        }
#pragma unroll
        for (int j = 0; j < 8; ++j) {
          const float cf = __uint_as_float((unsigned)__builtin_amdgcn_readlane((int)__float_as_uint(coef[hf]), k + j));
          float vf[16];
          unpack16_fp8(rows[j], vf);
#pragma unroll
          for (int q = 0; q < 16; ++q) out[q] += cf * vf[q];
        }
      }
    }
    const int m = tok_mod(t);
    const float* ga2 = modv + (size_t)(l * 9 + m) * 6144 + 5120;
    float* xr = p.out + (size_t)t * 1024 + lane * 16;
    float xn[16];
    float ss = 0.f;
#pragma unroll
    for (int q4 = 0; q4 < 4; ++q4) {
      float4 xv = *(const float4*)(xr + q4 * 4);
      float4 gg = *(const float4*)(ga2 + lane * 16 + q4 * 4);
      const int o = q4 * 4;
      xn[o + 0] = xv.x + gg.x * out[o + 0];
      xn[o + 1] = xv.y + gg.y * out[o + 1];
      xn[o + 2] = xv.z + gg.z * out[o + 2];
      xn[o + 3] = xv.w + gg.w * out[o + 3];
      ss += xn[o] * xn[o] + xn[o + 1] * xn[o + 1] + xn[o + 2] * xn[o + 2] + xn[o + 3] * xn[o + 3];
    }
    ss = wave_sum(ss);
    const float rs = rsqrtf(ss * (1.f / 1024.f) + EPSV);
    if (l < 3) {
      const float* md = modv + (size_t)((l + 1) * 9 + m) * 6144 + lane * 16;
      const float* g = p.in[8] + (l + 1) * 1024 + lane * 16;
      float hv[16];
#pragma unroll
      for (int q = 0; q < 16; ++q) hv[q] = xn[q] * rs * g[q] * (1.f + md[1024 + q]) + md[q];
      uint4 o;
      o.x = pack2(hv[0], hv[1]); o.y = pack2(hv[2], hv[3]); o.z = pack2(hv[4], hv[5]); o.w = pack2(hv[6], hv[7]);
      *(uint4*)(Hw + (size_t)t * 1024 + lane * 16) = o;
      o.x = pack2(hv[8], hv[9]); o.y = pack2(hv[10], hv[11]); o.z = pack2(hv[12], hv[13]); o.w = pack2(hv[14], hv[15]);
      *(uint4*)(Hw + (size_t)t * 1024 + lane * 16 + 8) = o;
#pragma unroll
      for (int q4 = 0; q4 < 4; ++q4) *(float4*)(xr + q4 * 4) = make_float4(xn[q4 * 4], xn[q4 * 4 + 1], xn[q4 * 4 + 2], xn[q4 * 4 + 3]);
    } else {
      const float* g = p.in[10] + lane * 16;
#pragma unroll
      for (int q4 = 0; q4 < 4; ++q4)
        *(float4*)(xr + q4 * 4) = make_float4(xn[q4 * 4] * rs * g[q4 * 4], xn[q4 * 4 + 1] * rs * g[q4 * 4 + 1],
                                              xn[q4 * 4 + 2] * rs * g[q4 * 4 + 2], xn[q4 * 4 + 3] * rs * g[q4 * 4 + 3]);
    }
  }
}

__global__ void __launch_bounds__(256, 2) mega(Params p, int ph_lo, int ph_hi) {
  __shared__ __attribute__((aligned(16))) unsigned char smem[77312];
  cg::grid_group grid = cg::this_grid();
  for (int ph = ph_lo; ph < ph_hi; ++ph) {
#if PROBE_MASK
    const int pcode = ph < 2 ? ph : 2 + (ph - 2) % 9;
    const int nrep = ((PROBE_MASK >> pcode) & 1) ? 2 : 1;
    for (int rep = 0; rep < nrep; ++rep) {
    if (rep) grid.sync();
#endif
    bool did = true;
    if (ph == 0) phase_prep_a(p, smem);
    else if (ph == 1) phase_prep_b(p);
    else {
      const int l = (ph - 2) / 9, sub = (ph - 2) % 9;
      const int il = l >> 1;
      const bool odd = l & 1;
      const float* modv = (const float*)(p.ws + OFF_MOD);
      if (sub == 0 || sub == 6) {
        const bf16_t* Bt; int ntn, ldc; bf16_t* C;
        if (sub == 0) {
          Bt = odd ? (const bf16_t*)(p.ws + OFF_WIN_OD) + (size_t)il * 3200 * 1024
                   : (const bf16_t*)(p.ws + OFF_WIN_EV) + (size_t)il * 3072 * 1024;
          ntn = odd ? 25 : 24; ldc = PSTRIDE; C = (bf16_t*)(p.ws + OFF_P);
        } else {
          Bt = (const bf16_t*)(p.ws + OFF_WQ) + (size_t)l * 2048 * 1024;
          ntn = 16; ldc = 2048; C = (bf16_t*)(p.ws + OFF_Q);
        }
        gemm_phase<0>((const bf16_t*)(p.ws + OFF_H), Bt, ntn, C, ldc, nullptr, nullptr, smem);
      } else if (sub == 1) {
        if (odd) phase_odd_prep(p, l, smem); else did = false;
      } else if (sub == 2) {
        if (odd) phase_gdn_chain(p, l, smem); else phase_ret_chain(p, l, smem);
      } else if (sub == 3) {
        phase_mix_out(p, l);
      } else if (sub == 4) {
        gemm_phase<1>((const bf16_t*)(p.ws + OFF_YMIX), (const bf16_t*)(p.ws + OFF_WOUT) + (size_t)l * 1024 * 1024, 8,
                      nullptr, 0, p.out, modv + (size_t)l * 9 * 6144 + 2048, smem);
      } else if (sub == 5) {
        phase_norm2(p, l);
      } else if (sub == 7) {
        phase_peer_score(p, l, smem);
      } else {
        phase_peer_gather(p, l);
      }
    }
#if PROBE_MASK
    if (rep + 1 < nrep) continue;
#endif
    if (did && ph + 1 < ph_hi) grid.sync();
#if PROBE_MASK
    }
#endif
  }
}

extern "C" void kernel_launch(void* const* d_in, const int* in_sizes, int n_in, void* d_out, int out_size,
                              void* d_ws, size_t ws_size, hipStream_t stream) {
  static int grid_blocks = 0;
  if (!grid_blocks) {
    int dev = 0, cus = 0, per_cu = 0;
    hipGetDevice(&dev);
    hipDeviceGetAttribute(&cus, hipDeviceAttributeMultiprocessorCount, dev);
    hipOccupancyMaxActiveBlocksPerMultiprocessor(&per_cu, mega, 256, 0);
    if (per_cu < 1) per_cu = 1;
    if (per_cu > 2) per_cu = 2;
    grid_blocks = cus * per_cu;
    if (ws_size < WS_NEED) fprintf(stderr, "kernel_launch: workspace too small: %zu < %zu\n", ws_size, (size_t)WS_NEED);
  }
  Params p{};
  for (int i = 0; i < 30; ++i) p.in[i] = (const float*)d_in[i];
  p.out = (float*)d_out;
  p.ws = (unsigned char*)d_ws;
#if SINGLE_LAUNCH
  int lo = 0, hi = NPHASE;
  void* args[] = {&p, &lo, &hi};
  hipError_t e = hipLaunchCooperativeKernel((void*)mega, dim3(grid_blocks), dim3(256), args, 0, stream);
  if (e != hipSuccess) fprintf(stderr, "cooperative launch failed: %s (grid %d)\n", hipGetErrorString(e), grid_blocks);
#else
  for (int ph = 0; ph < NPHASE; ++ph) {
    const int l = (ph - 2) / 9, sub = (ph - 2) % 9;
    if (ph >= 2 && sub == 1 && !(l & 1)) continue;
    hipLaunchKernelGGL(mega, dim3(grid_blocks), dim3(256), 0, stream, p, ph, ph + 1);
  }
#endif
}
```

```cpp
#include <hip/hip_runtime.h>
#include <hip/hip_cooperative_groups.h>
#include <cstdio>
namespace cg = cooperative_groups;

#ifndef PROBE_MASK
#define PROBE_MASK 0
#endif
#ifndef SINGLE_LAUNCH
#define SINGLE_LAUNCH 1
#endif

typedef unsigned short bf16_t;
using bf16x8 = __attribute__((ext_vector_type(8))) short;
using f32x4 = __attribute__((ext_vector_type(4))) float;
using f32x2 = __attribute__((ext_vector_type(2))) float;
using u32x4 = __attribute__((ext_vector_type(4))) unsigned;

#define NTOK 24576
#define NPROMPT 8192
#define PSTRIDE 3200
#define EPSV 1e-6f
#define NPHASE 38

constexpr size_t OFF_MOD = 0;
constexpr size_t OFF_ROPE = 1u << 20;
constexpr size_t OFF_WIN_EV = OFF_ROPE + 65536;
constexpr size_t OFF_WIN_OD = OFF_WIN_EV + 2ull * 3072 * 1024 * 2;
constexpr size_t OFF_WOUT = OFF_WIN_OD + 2ull * 3200 * 1024 * 2;
constexpr size_t OFF_WQ = OFF_WOUT + 4ull * 1024 * 1024 * 2;
constexpr size_t OFF_KEYS = OFF_WQ + 4ull * 2048 * 1024 * 2;
constexpr size_t OFF_UB = OFF_KEYS + 4ull * 8 * 2 * 128 * 128 * 2;
constexpr size_t OFF_VB = OFF_UB + 4ull * 16384 * 1024 * 2;
constexpr size_t OFF_H = OFF_VB + 4ull * 16384 * 1024 * 2;
constexpr size_t OFF_P = OFF_H + (size_t)NTOK * 1024 * 2;
constexpr size_t OFF_YMIX = OFF_P + (size_t)NTOK * PSTRIDE * 2;
constexpr size_t OFF_ODIR = OFF_YMIX + (size_t)NTOK * 1024 * 2;
constexpr size_t OFF_Q = OFF_ODIR;
constexpr size_t OFF_EIDX = OFF_ODIR + 2ull * NTOK * 512 * 4;
constexpr size_t OFF_GATE = OFF_EIDX + (size_t)NTOK * 128 * 4;
constexpr size_t GP_ITEM = 73728;
constexpr size_t OFF_GPREP = OFF_GATE + (size_t)NTOK * 128 * 4;
constexpr size_t OFF_EGL = OFF_GPREP + 3072ull * GP_ITEM;
constexpr size_t OFF_CONV = OFF_EGL + 16384;
constexpr size_t OFF_BAR = OFF_CONV + (size_t)NTOK * 512 * 4;
constexpr size_t WS_NEED = OFF_BAR + 16384;

struct Params {
  const float* in[30];
  float* out;
  unsigned char* ws;
};

__device__ const unsigned char CAND_A[52] = {0,0,0,0,0,0,0,0,0,0,0,0,0,0,0,0,1,1,1,1,1,1,1,1,2,2,2,2,2,3,3,3,3,4,4,4,5,5,6,6,7,7,8,9,10,11,12,13,14,15,0,0};
__device__ const unsigned char CAND_B[52] = {0,1,2,3,4,5,6,7,8,9,10,11,12,13,14,15,0,1,2,3,4,5,6,7,0,1,2,3,4,0,1,2,3,0,1,2,0,1,0,1,0,1,0,0,0,0,0,0,0,0,0,0};

__device__ __forceinline__ int opaque_tid() { int t = threadIdx.x; asm volatile("" : "+v"(t)); return t; }
typedef __bf16 hbf16x2 __attribute__((ext_vector_type(2)));
__device__ __forceinline__ bf16_t f2bf(float f) {
  return __builtin_bit_cast(unsigned short, (__bf16)f);
}
__device__ __forceinline__ float bf2f(bf16_t b) { return __uint_as_float(((unsigned)b) << 16); }
__device__ __forceinline__ float bflo(unsigned u) { return __uint_as_float(u << 16); }
__device__ __forceinline__ float bfhi(unsigned u) { return __uint_as_float(u & 0xffff0000u); }
__device__ __forceinline__ unsigned pack2(float a, float b) {
  f32x2 v = {a, b};
  return __builtin_bit_cast(unsigned, __builtin_convertvector(v, hbf16x2));
}
__device__ __forceinline__ float wave_sum(float v) {
#pragma unroll
  for (int o = 32; o > 0; o >>= 1) v += __shfl_xor(v, o);
  return v;
}
__device__ __forceinline__ f32x4 mfma16(bf16x8 a, bf16x8 b, f32x4 c) {
  return __builtin_amdgcn_mfma_f32_16x16x32_bf16(a, b, c, 0, 0, 0);
}
__device__ __forceinline__ bf16x8 ldfrag(const bf16_t* p) { return *(const bf16x8*)p; }
__device__ __forceinline__ float siluf(float v) { return v * __builtin_amdgcn_rcpf(1.f + __expf(-v)); }
__device__ __forceinline__ int tok_mod(int t) { return t < NPROMPT ? 0 : 1 + ((t - NPROMPT) >> 11); }
__device__ __forceinline__ unsigned fkey(float f) {
  unsigned u = __float_as_uint(f);
  return (u & 0x80000000u) ? ~u : (u | 0x80000000u);
}
__device__ __forceinline__ float keyf(unsigned k) {
  unsigned b = (k & 0x80000000u) ? (k ^ 0x80000000u) : ~k;
  return __uint_as_float(b);
}
__device__ __forceinline__ void unpack8(uint4 v, float* f) {
  f[0] = bflo(v.x); f[1] = bfhi(v.x); f[2] = bflo(v.y); f[3] = bfhi(v.y);
  f[4] = bflo(v.z); f[5] = bfhi(v.z); f[6] = bflo(v.w); f[7] = bfhi(v.w);
}

__device__ __forceinline__ void prep_mod(const Params& p, float* smem) {
  float* sc = smem;
  float* red = smem + 9 * 1024;
  const int tid = opaque_tid();
  const float* c = p.in[4];
  const float* cctx = p.in[5];
  for (int i = tid; i < 9 * 1024; i += 256) {
    int m = i >> 10, k = i & 1023;
    float v = (m == 0) ? cctx[k] : c[(m - 1) * 1024 + k];
    sc[i] = v / (1.f + expf(-v));
  }
  __syncthreads();
  float* modv = (float*)(p.ws + OFF_MOD);
  const int cl = tid & 63, kg = tid >> 6;
  for (int u = blockIdx.x; u < 4 * 96; u += gridDim.x) {
    const int l = u / 96, nb = (u % 96) * 64;
    const float* W = p.in[6] + (size_t)l * 1024 * 6144 + nb + cl;
    float acc[9];
#pragma unroll
    for (int m = 0; m < 9; ++m) acc[m] = 0.f;
#pragma unroll 4
    for (int k = kg * 256; k < kg * 256 + 256; ++k) {
      float w = W[(size_t)k * 6144];
#pragma unroll
      for (int m = 0; m < 9; ++m) acc[m] += sc[m * 1024 + k] * w;
    }
#pragma unroll
    for (int m = 0; m < 9; ++m) red[(kg * 9 + m) * 64 + cl] = acc[m];
    __syncthreads();
    for (int i = tid; i < 9 * 64; i += 256) {
      int m = i >> 6, c2 = i & 63;
      float s = red[(0 * 9 + m) * 64 + c2] + red[(1 * 9 + m) * 64 + c2] + red[(2 * 9 + m) * 64 + c2] + red[(3 * 9 + m) * 64 + c2];
      int nn = nb + c2;
      modv[(size_t)(l * 9 + m) * 6144 + nn] = s + p.in[7][l * 6144 + nn];
    }
    __syncthreads();
  }
}

__device__ __forceinline__ void prep_transpose(const float* src, bf16_t* dst, int N, int Npad, float* tile) {
  const int tid = opaque_tid();
  const int ntn = Npad / 64;
  const int units = ntn * 16;
  for (int u = blockIdx.x; u < units; u += gridDim.x) {
    const int nt = u % ntn, kt = u / ntn;
    const int n0 = nt * 64, k0 = kt * 64;
#pragma unroll 4
    for (int i = 0; i < 16; ++i) {
      int r = (tid >> 6) + 4 * i, c = tid & 63;
      int n = n0 + c;
      tile[r * 65 + c] = (n < N) ? src[(size_t)(k0 + r) * N + n] : 0.f;
    }
    __syncthreads();
#pragma unroll 4
    for (int i = 0; i < 16; ++i) {
      int rr = (tid >> 6) + 4 * i, cc = tid & 63;
      dst[(size_t)(n0 + rr) * 1024 + k0 + cc] = f2bf(tile[cc * 65 + rr]);
    }
    __syncthreads();
  }
}

__device__ __forceinline__ void prep_convert(const float* src, bf16_t* dst, size_t n4) {
  const size_t stride = (size_t)gridDim.x * 256;
  for (size_t i = (size_t)blockIdx.x * 256 + threadIdx.x; i < n4; i += stride) {
    float4 v = ((const float4*)src)[i];
    uint2 o;
    o.x = pack2(v.x, v.y);
    o.y = pack2(v.z, v.w);
    ((uint2*)dst)[i] = o;
  }
}

__device__ __forceinline__ void prep_convert_fp8(const float* src, unsigned* dst, size_t n4, float scale) {
  const size_t stride = (size_t)gridDim.x * 256;
  for (size_t i = (size_t)blockIdx.x * 256 + threadIdx.x; i < n4; i += stride) {
    float4 v = ((const float4*)src)[i];
    unsigned w = __builtin_amdgcn_cvt_pk_fp8_f32(v.x * scale, v.y * scale, 0, false);
    w = __builtin_amdgcn_cvt_pk_fp8_f32(v.z * scale, v.w * scale, w, true);
    dst[i] = w;
  }
}
__device__ __forceinline__ void unpack16_fp8(u32x4 v, float* f) {
#pragma unroll
  for (int i = 0; i < 4; ++i) {
    f32x2 lo = __builtin_amdgcn_cvt_pk_f32_fp8(v[i], false);
    f32x2 hi = __builtin_amdgcn_cvt_pk_f32_fp8(v[i], true);
    f[4 * i + 0] = lo.x; f[4 * i + 1] = lo.y; f[4 * i + 2] = hi.x; f[4 * i + 3] = hi.y;
  }
}
#define U_SCALE 32.f
#define V_SCALE 8.f
__device__ __forceinline__ void phase_prep_a(const Params& p, unsigned char* smem) {
  float* fs = (float*)smem;
  prep_mod(p, fs);
  {
    float2* rope = (float2*)(p.ws + OFF_ROPE);
    int i = blockIdx.x * 256 + threadIdx.x;
    if (i < 64 * 16) {
      int pos = i >> 4, f = i & 15;
      float fr = powf(10000.f, -(float)f / 16.f);
      float ang = (float)pos * fr;
      rope[i] = make_float2(cosf(ang), sinf(ang));
    }
  }
  for (int i = 0; i < 2; ++i) {
    prep_transpose(p.in[11] + (size_t)i * 1024 * 3072, (bf16_t*)(p.ws + OFF_WIN_EV) + (size_t)i * 3072 * 1024, 3072, 3072, fs);
    prep_transpose(p.in[16] + (size_t)i * 1024 * 3088, (bf16_t*)(p.ws + OFF_WIN_OD) + (size_t)i * 3200 * 1024, 3088, 3200, fs);
    prep_transpose(p.in[12] + (size_t)i * 1024 * 1024, (bf16_t*)(p.ws + OFF_WOUT) + (size_t)(2 * i) * 1024 * 1024, 1024, 1024, fs);
    prep_transpose(p.in[17] + (size_t)i * 1024 * 1024, (bf16_t*)(p.ws + OFF_WOUT) + (size_t)(2 * i + 1) * 1024 * 1024, 1024, 1024, fs);
  }
  for (int l = 0; l < 4; ++l)
    prep_transpose(p.in[26] + (size_t)l * 1024 * 2048, (bf16_t*)(p.ws + OFF_WQ) + (size_t)l * 2048 * 1024, 2048, 2048, fs);
  prep_convert(p.in[27], (bf16_t*)(p.ws + OFF_KEYS), (size_t)4 * 8 * 2 * 128 * 128 / 4);
  prep_convert_fp8(p.in[28], (unsigned*)(p.ws + OFF_UB), (size_t)4 * 16384 * 1024 / 4, U_SCALE);
  prep_convert_fp8(p.in[29], (unsigned*)(p.ws + OFF_VB), (size_t)4 * 16384 * 1024 / 4, V_SCALE);
}

__device__ __forceinline__ void norm_token(const float* xrow, const float* g, const float* scale, const float* shift,
                                           bf16_t* hrow, float* copy_dst, int lane) {
  float4 v[4];
  float ss = 0.f;
#pragma unroll
  for (int i = 0; i < 4; ++i) {
    v[i] = *(const float4*)(xrow + i * 256 + lane * 4);
    ss += v[i].x * v[i].x + v[i].y * v[i].y + v[i].z * v[i].z + v[i].w * v[i].w;
  }
  ss = wave_sum(ss);
  const float rs = rsqrtf(ss * (1.f / 1024.f) + EPSV);
#pragma unroll
  for (int i = 0; i < 4; ++i) {
    const int idx = i * 256 + lane * 4;
    if (copy_dst) *(float4*)(copy_dst + idx) = v[i];
    float4 gg = *(const float4*)(g + idx);
    float4 sc = *(const float4*)(scale + idx);
    float4 sh = *(const float4*)(shift + idx);
    float a = v[i].x * rs * gg.x * (1.f + sc.x) + sh.x;
    float b = v[i].y * rs * gg.y * (1.f + sc.y) + sh.y;
    float c = v[i].z * rs * gg.z * (1.f + sc.z) + sh.z;
    float d = v[i].w * rs * gg.w * (1.f + sc.w) + sh.w;
    uint2 o;
    o.x = pack2(a, b);
    o.y = pack2(c, d);
    *(uint2*)(hrow + idx) = o;
  }
}

__device__ __forceinline__ void phase_prep_b(const Params& p) {
  const int tid_ = opaque_tid(); const int lane = tid_ & 63, wv = tid_ >> 6;
  const float* modv = (const float*)(p.ws + OFF_MOD);
  bf16_t* H = (bf16_t*)(p.ws + OFF_H);
  for (int t = blockIdx.x * 4 + wv; t < NTOK; t += gridDim.x * 4) {
    const float* xr = (t < NPROMPT) ? p.in[0] + (size_t)t * 1024 : p.in[1] + (size_t)(t - NPROMPT) * 1024;
    const float* md = modv + (size_t)(0 * 9 + tok_mod(t)) * 6144;
    norm_token(xr, p.in[8], md + 1024, md, H + (size_t)t * 1024, p.out + (size_t)t * 1024, lane);
  }
}

__device__ __forceinline__ void phase_norm2(const Params& p, int l) {
  const int tid_ = opaque_tid(); const int lane = tid_ & 63, wv = tid_ >> 6;
  const float* modv = (const float*)(p.ws + OFF_MOD);
  bf16_t* H = (bf16_t*)(p.ws + OFF_H);
  for (int t = blockIdx.x * 4 + wv; t < NTOK; t += gridDim.x * 4) {
    const float* md = modv + (size_t)(l * 9 + tok_mod(t)) * 6144;
    norm_token(p.out + (size_t)t * 1024, p.in[9] + l * 1024, md + 4096, md + 3072, H + (size_t)t * 1024, nullptr, lane);
  }
}

template <int EPI>
__device__ __forceinline__ void gemm_phase(const bf16_t* __restrict__ A, const bf16_t* __restrict__ Bt, int ntiles_n,
                           bf16_t* __restrict__ C, int ldc, float* __restrict__ X, const float* __restrict__ ga,
                           unsigned char* smem) {
  bf16_t* As = (bf16_t*)smem;
  bf16_t* Bs = As + 128 * 72;
  const int tid = opaque_tid(), lane = tid & 63, w = tid >> 6, quad = lane >> 4, l15 = lane & 15;
  const int wm = w >> 1, wn = w & 1;
  const int lr = tid >> 3, lseg = (tid & 7) * 8;
  const int units = 192 * ntiles_n;
  for (int u = blockIdx.x; u < units; u += gridDim.x) {
    const int mt = u % 192, nt = u / 192;
    const int m0 = mt * 128, n0 = nt * 128;
    f32x4 acc[4][4];
#pragma unroll
    for (int i = 0; i < 4; ++i)
#pragma unroll
      for (int j = 0; j < 4; ++j) acc[i][j] = (f32x4){0.f, 0.f, 0.f, 0.f};
    const bf16_t* Ag = A + (size_t)(m0 + lr) * 1024 + lseg;
    const bf16_t* Bg = Bt + (size_t)(n0 + lr) * 1024 + lseg;
    u32x4 ra0, ra1, ra2, ra3, rb0, rb1, rb2, rb3;
    ra0 = *(const u32x4*)(Ag); ra1 = *(const u32x4*)(Ag + 32 * 1024); ra2 = *(const u32x4*)(Ag + 64 * 1024); ra3 = *(const u32x4*)(Ag + 96 * 1024);
    rb0 = *(const u32x4*)(Bg); rb1 = *(const u32x4*)(Bg + 32 * 1024); rb2 = *(const u32x4*)(Bg + 64 * 1024); rb3 = *(const u32x4*)(Bg + 96 * 1024);
    for (int kt = 0; kt < 16; ++kt) {
      *(u32x4*)(As + (lr) * 72 + lseg) = ra0; *(u32x4*)(As + (lr + 32) * 72 + lseg) = ra1;
      *(u32x4*)(As + (lr + 64) * 72 + lseg) = ra2; *(u32x4*)(As + (lr + 96) * 72 + lseg) = ra3;
      *(u32x4*)(Bs + (lr) * 72 + lseg) = rb0; *(u32x4*)(Bs + (lr + 32) * 72 + lseg) = rb1;
      *(u32x4*)(Bs + (lr + 64) * 72 + lseg) = rb2; *(u32x4*)(Bs + (lr + 96) * 72 + lseg) = rb3;
      __syncthreads();
      if (kt + 1 < 16) {
        const bf16_t* An = Ag + (kt + 1) * 64; const bf16_t* Bn = Bg + (kt + 1) * 64;
        ra0 = *(const u32x4*)(An); ra1 = *(const u32x4*)(An + 32 * 1024); ra2 = *(const u32x4*)(An + 64 * 1024); ra3 = *(const u32x4*)(An + 96 * 1024);
        rb0 = *(const u32x4*)(Bn); rb1 = *(const u32x4*)(Bn + 32 * 1024); rb2 = *(const u32x4*)(Bn + 64 * 1024); rb3 = *(const u32x4*)(Bn + 96 * 1024);
      }
#pragma unroll
      for (int kk = 0; kk < 2; ++kk) {
        bf16x8 af[4], bfr[4];
#pragma unroll
        for (int i = 0; i < 4; ++i) af[i] = ldfrag(As + (wm * 64 + i * 16 + l15) * 72 + kk * 32 + quad * 8);
#pragma unroll
        for (int j = 0; j < 4; ++j) bfr[j] = ldfrag(Bs + (wn * 64 + j * 16 + l15) * 72 + kk * 32 + quad * 8);
#pragma unroll
        for (int i = 0; i < 4; ++i)
#pragma unroll
          for (int j = 0; j < 4; ++j) acc[i][j] = mfma16(af[i], bfr[j], acc[i][j]);
      }
      __syncthreads();
    }
    if (EPI == 0) {
#pragma unroll
      for (int i = 0; i < 4; ++i)
#pragma unroll
        for (int j = 0; j < 4; ++j)
#pragma unroll
          for (int jj = 0; jj < 4; ++jj) {
            int row = m0 + wm * 64 + i * 16 + quad * 4 + jj;
            int col = n0 + wn * 64 + j * 16 + l15;
            C[(size_t)row * ldc + col] = f2bf(acc[i][j][jj]);
          }
    } else {
      const float* gam = ga + (size_t)tok_mod(m0) * 6144;
#pragma unroll
      for (int i = 0; i < 4; ++i)
#pragma unroll
        for (int j = 0; j < 4; ++j)
#pragma unroll
          for (int jj = 0; jj < 4; ++jj) {
            int row = m0 + wm * 64 + i * 16 + quad * 4 + jj;
            int col = n0 + wn * 64 + j * 16 + l15;
            float* xp = X + (size_t)row * 1024 + col;
            *xp = *xp + gam[col] * acc[i][j][jj];
          }
    }
  }
}

struct ChainItem {
  bool lng; int sl, dir, h, sq, tok0, nc;
};
__device__ __forceinline__ ChainItem decode_item(int it) {
  ChainItem c;
  c.lng = it < 256;
  int idx = c.lng ? it : it - 256;
  c.sl = idx & 3; c.dir = (idx >> 2) & 1; c.h = (idx >> 3) & 3; c.sq = idx >> 5;
  c.tok0 = c.lng ? NPROMPT + c.sq * 2048 : c.sq * 256;
  c.nc = c.lng ? 32 : 4;
  return c;
}

__device__ __forceinline__ void phase_ret_chain(const Params& p, int l, unsigned char* smem) {
  const int il = l >> 1;
  bf16_t* qs = (bf16_t*)smem;
  bf16_t* ks = qs + 64 * 72;
  bf16_t* kT = ks + 64 * 72;
  bf16_t* vT = kT + 64 * 72;
  bf16_t* intra = vT + 32 * 72;
  bf16_t* ST = intra + 64 * 72;
  const bf16_t* P = (const bf16_t*)(p.ws + OFF_P);
  float* odir = (float*)(p.ws + OFF_ODIR);
  const float2* rope = (const float2*)(p.ws + OFF_ROPE);
  const int tid = opaque_tid(), lane = tid & 63, w = tid >> 6, quad = lane >> 4, l15 = lane & 15;
  for (int it = blockIdx.x; it < 1280; it += gridDim.x) {
    const ChainItem ci = decode_item(it);
    const int sl = ci.sl, dir = ci.dir, h = ci.h;
    const float xg = p.in[13][(il * 2 + dir) * 4 + h];
    const float lg = -log1pf(expf(-xg));
    const float g64 = expf(lg * 64.f);
    f32x4 S[2];
    if (ci.lng) {
      const float* s0 = p.in[2] + ((((size_t)ci.sq * 2 + il) * 2 + dir) * 4 + h) * 8192;
#pragma unroll
      for (int ct = 0; ct < 2; ++ct)
#pragma unroll
        for (int jj = 0; jj < 4; ++jj) S[ct][jj] = s0[(16 * w + quad * 4 + jj) * 128 + sl * 32 + ct * 16 + l15];
    } else {
      S[0] = (f32x4){0.f, 0.f, 0.f, 0.f};
      S[1] = (f32x4){0.f, 0.f, 0.f, 0.f};
    }
    for (int n = 0; n < ci.nc; ++n) {
      const int cn = dir ? ci.nc - 1 - n : n;
      const int tb = ci.tok0 + cn * 64;
      {
        const int i = tid >> 2, mq = tid & 3;
        const int t = tb + (dir ? 63 - i : i);
        const bf16_t* pr = P + (size_t)t * PSTRIDE;
        float qa[8], qb[8], ka[8], kb[8];
        unpack8(*(const uint4*)(pr + h * 64 + mq * 8), qa);
        unpack8(*(const uint4*)(pr + h * 64 + 32 + mq * 8), qb);
        unpack8(*(const uint4*)(pr + 256 + h * 64 + mq * 8), ka);
        unpack8(*(const uint4*)(pr + 256 + h * 64 + 32 + mq * 8), kb);
        if (ci.lng) {
          const int pos = (mq < 2) ? cn : (t - tb);
          const int f0 = (mq & 1) * 8;
#pragma unroll
          for (int e = 0; e < 8; ++e) {
            float2 cs = rope[pos * 16 + f0 + e];
            float a = qa[e], b = qb[e];
            qa[e] = a * cs.x - b * cs.y; qb[e] = b * cs.x + a * cs.y;
            a = ka[e]; b = kb[e];
            ka[e] = a * cs.x - b * cs.y; kb[e] = b * cs.x + a * cs.y;
          }
        }
        const float wend = expf(lg * (float)(63 - i));
        uint4 o;
        o.x = pack2(qa[0], qa[1]); o.y = pack2(qa[2], qa[3]); o.z = pack2(qa[4], qa[5]); o.w = pack2(qa[6], qa[7]);
        *(uint4*)(qs + i * 72 + mq * 8) = o;
        o.x = pack2(qb[0], qb[1]); o.y = pack2(qb[2], qb[3]); o.z = pack2(qb[4], qb[5]); o.w = pack2(qb[6], qb[7]);
        *(uint4*)(qs + i * 72 + 32 + mq * 8) = o;
#pragma unroll
        for (int e = 0; e < 8; ++e) { ka[e] *= 0.125f; kb[e] *= 0.125f; }
        o.x = pack2(ka[0], ka[1]); o.y = pack2(ka[2], ka[3]); o.z = pack2(ka[4], ka[5]); o.w = pack2(ka[6], ka[7]);
        *(uint4*)(ks + i * 72 + mq * 8) = o;
        o.x = pack2(kb[0], kb[1]); o.y = pack2(kb[2], kb[3]); o.z = pack2(kb[4], kb[5]); o.w = pack2(kb[6], kb[7]);
        *(uint4*)(ks + i * 72 + 32 + mq * 8) = o;
#pragma unroll
        for (int e = 0; e < 8; ++e) {
          kT[(mq * 8 + e) * 72 + i] = f2bf(ka[e] * wend);
          kT[(32 + mq * 8 + e) * 72 + i] = f2bf(kb[e] * wend);
        }
        uint4 v8 = *(const uint4*)(pr + 512 + h * 128 + sl * 32 + mq * 8);
        vT[(mq * 8 + 0) * 72 + i] = (bf16_t)(v8.x & 0xffff); vT[(mq * 8 + 1) * 72 + i] = (bf16_t)(v8.x >> 16);
        vT[(mq * 8 + 2) * 72 + i] = (bf16_t)(v8.y & 0xffff); vT[(mq * 8 + 3) * 72 + i] = (bf16_t)(v8.y >> 16);
        vT[(mq * 8 + 4) * 72 + i] = (bf16_t)(v8.z & 0xffff); vT[(mq * 8 + 5) * 72 + i] = (bf16_t)(v8.z >> 16);
        vT[(mq * 8 + 6) * 72 + i] = (bf16_t)(v8.w & 0xffff); vT[(mq * 8 + 7) * 72 + i] = (bf16_t)(v8.w >> 16);
      }
      __syncthreads();
      const bf16x8 a0 = ldfrag(qs + (16 * w + l15) * 72 + quad * 8);
      const bf16x8 a1 = ldfrag(qs + (16 * w + l15) * 72 + 32 + quad * 8);
#pragma unroll
      for (int ct = 0; ct < 4; ++ct) {
        bf16x8 b0 = ldfrag(ks + (ct * 16 + l15) * 72 + quad * 8);
        bf16x8 b1 = ldfrag(ks + (ct * 16 + l15) * 72 + 32 + quad * 8);
        f32x4 c = (f32x4){0.f, 0.f, 0.f, 0.f};
        c = mfma16(a0, b0, c);
        c = mfma16(a1, b1, c);
#pragma unroll
        for (int jj = 0; jj < 4; ++jj) {
          int i = 16 * w + quad * 4 + jj, j = ct * 16 + l15;
          float val = (i >= j) ? c[jj] * expf(lg * (float)(i - j)) : 0.f;
          intra[i * 72 + j] = f2bf(val);
        }
      }
#pragma unroll
      for (int ct = 0; ct < 2; ++ct)
#pragma unroll
        for (int jj = 0; jj < 4; ++jj) ST[(ct * 16 + l15) * 72 + 16 * w + quad * 4 + jj] = f2bf(S[ct][jj]);
      __syncthreads();
      const bf16x8 ai0 = ldfrag(intra + (16 * w + l15) * 72 + quad * 8);
      const bf16x8 ai1 = ldfrag(intra + (16 * w + l15) * 72 + 32 + quad * 8);
      const bf16x8 ak0 = ldfrag(kT + (16 * w + l15) * 72 + quad * 8);
      const bf16x8 ak1 = ldfrag(kT + (16 * w + l15) * 72 + 32 + quad * 8);
#pragma unroll
      for (int ct = 0; ct < 2; ++ct) {
        bf16x8 bv0 = ldfrag(vT + (ct * 16 + l15) * 72 + quad * 8);
        bf16x8 bv1 = ldfrag(vT + (ct * 16 + l15) * 72 + 32 + quad * 8);
        bf16x8 bs0 = ldfrag(ST + (ct * 16 + l15) * 72 + quad * 8);
        bf16x8 bs1 = ldfrag(ST + (ct * 16 + l15) * 72 + 32 + quad * 8);
        f32x4 ci_ = (f32x4){0.f, 0.f, 0.f, 0.f}, cc = (f32x4){0.f, 0.f, 0.f, 0.f};
        ci_ = mfma16(ai0, bv0, ci_);
        ci_ = mfma16(ai1, bv1, ci_);
        cc = mfma16(a0, bs0, cc);
        cc = mfma16(a1, bs1, cc);
#pragma unroll
        for (int jj = 0; jj < 4; ++jj) {
          int i = 16 * w + quad * 4 + jj;
          int t = tb + (dir ? 63 - i : i);
          float o = ci_[jj] + expf(lg * (float)(i + 1)) * cc[jj];
          odir[((size_t)dir * NTOK + t) * 512 + h * 128 + sl * 32 + ct * 16 + l15] = o;
        }
        f32x4 s = S[ct];
        s[0] *= g64; s[1] *= g64; s[2] *= g64; s[3] *= g64;
        s = mfma16(ak0, bv0, s);
        s = mfma16(ak1, bv1, s);
        S[ct] = s;
      }
      __syncthreads();
    }
    if (!ci.lng) {
      float* so = p.out + 25165824 + ((((size_t)ci.sq * 2 + il) * 2 + dir) * 4 + h) * 8192;
#pragma unroll
      for (int ct = 0; ct < 2; ++ct)
#pragma unroll
        for (int jj = 0; jj < 4; ++jj) so[(16 * w + quad * 4 + jj) * 128 + sl * 32 + ct * 16 + l15] = S[ct][jj];
    }
  }
}

__device__ __forceinline__ void gdn_prep_item(const Params& p, int l, int pi, unsigned char* smem) {
  const int il = l >> 1;
  bf16_t* ks = (bf16_t*)smem;
  bf16_t* vs = ks + 64 * 136;
  float* Am = (float*)(vs + 64 * 136);
  float* rq = Am + 4096;
  float* rk = rq + 64;
  float* gcs = rk + 64;
  float* bet = gcs + 64;
  float* fac = bet + 64;
  bf16_t* qs = (bf16_t*)(fac + 128);
  const bf16_t* P = (const bf16_t*)(p.ws + OFF_P);
  unsigned char* gp = p.ws + OFF_GPREP + (size_t)pi * GP_ITEM;
  bf16_t* Wb = (bf16_t*)gp;
  bf16_t* QG = Wb + 8192;
  bf16_t* KDT = QG + 8192;
  bf16_t* Ub = KDT + 8192;
  bf16_t* ATT = Ub + 8192;
  float* EGL = (float*)(p.ws + OFF_EGL);
  const int tid = opaque_tid(), lane = tid & 63, w = tid >> 6, quad = lane >> 4, l15 = lane & 15;
  const int dir = pi & 1, h = (pi >> 1) & 3, c = pi >> 3;
  int tb, seq_lo, seq_hi;
  if (c < 128) { tb = c * 64; seq_lo = (c >> 2) * 256; seq_hi = seq_lo + 256; }
  else { int cc = c - 128; tb = NPROMPT + cc * 64; seq_lo = NPROMPT + (cc >> 5) * 2048; seq_hi = seq_lo + 2048; }
  const float SCALE = 0.08838834764831845f;
  {
    const int cg_ = tid & 127, rh = tid >> 7;
    for (int mat = 0; mat < 3; ++mat) {
      const int col = mat * 512 + h * 128 + cg_;
      const float* cw = p.in[18] + (size_t)il * 3 * 1536 + col;
      const float w0 = cw[0], w1 = cw[1536], w2 = cw[3072];
      bf16_t* dst = mat == 0 ? qs : (mat == 1 ? ks : vs);
      const int t0 = tb + rh * 32;
      bf16_t raw[34];
#pragma unroll
      for (int o = 0; o < 34; ++o) {
        const int t = t0 - 1 + o;
        raw[o] = (t >= seq_lo && t < seq_hi) ? P[(size_t)t * PSTRIDE + col] : (bf16_t)0;
      }
#pragma unroll
      for (int o = 0; o < 32; ++o) {
        float y = w0 * bf2f(raw[o]) + w1 * bf2f(raw[o + 1]) + w2 * bf2f(raw[o + 2]);
        y = siluf(y);
        const int oi = rh * 32 + o;
        const int i = dir ? 63 - oi : oi;
        dst[i * 136 + cg_] = f2bf(y);
      }
    }
  }
  __syncthreads();
  {
    const int r = tid >> 2, part = tid & 3;
    float sq_ = 0.f, sk_ = 0.f;
#pragma unroll 8
    for (int e = 0; e < 32; ++e) {
      float a = bf2f(qs[r * 136 + part * 32 + e]);
      float b = bf2f(ks[r * 136 + part * 32 + e]);
      sq_ += a * a; sk_ += b * b;
    }
    sq_ += __shfl_xor(sq_, 1); sq_ += __shfl_xor(sq_, 2);
    sk_ += __shfl_xor(sk_, 1); sk_ += __shfl_xor(sk_, 2);
    if (part == 0) {
      rq[r] = rsqrtf(sq_ + EPSV);
      rk[r] = rsqrtf(sk_ + EPSV);
      const int t = tb + (dir ? 63 - r : r);
      float a = bf2f(P[(size_t)t * PSTRIDE + 2048 + dir * 4 + h]);
      float bbv = bf2f(P[(size_t)t * PSTRIDE + 2056 + dir * 4 + h]);
      float al = p.in[19][(il * 2 + dir) * 4 + h], dtb = p.in[20][(il * 2 + dir) * 4 + h];
      float z = a + dtb;
      float sp = (z > 20.f) ? z : log1pf(expf(z));
      gcs[r] = -expf(al) * sp;
      bet[r] = 1.f / (1.f + expf(-bbv));
    }
  }
  __syncthreads();
  if (tid < 64) {
    float v = gcs[tid];
#pragma unroll
    for (int o = 1; o < 64; o <<= 1) {
      float u = __shfl_up(v, o);
      if (tid >= o) v += u;
    }
    gcs[tid] = v;
  }
  __syncthreads();
  {
    bf16x8 ak[4], aq[4];
#pragma unroll
    for (int kk = 0; kk < 4; ++kk) {
      ak[kk] = ldfrag(ks + (16 * w + l15) * 136 + kk * 32 + quad * 8);
      aq[kk] = ldfrag(qs + (16 * w + l15) * 136 + kk * 32 + quad * 8);
    }
#pragma unroll
    for (int ct = 0; ct < 4; ++ct) {
      f32x4 ckk = (f32x4){0.f, 0.f, 0.f, 0.f}, cqk = (f32x4){0.f, 0.f, 0.f, 0.f};
#pragma unroll
      for (int kk = 0; kk < 4; ++kk) {
        bf16x8 b = ldfrag(ks + (ct * 16 + l15) * 136 + kk * 32 + quad * 8);
        ckk = mfma16(ak[kk], b, ckk);
        cqk = mfma16(aq[kk], b, cqk);
      }
#pragma unroll
      for (int jj = 0; jj < 4; ++jj) {
        const int i = 16 * w + quad * 4 + jj, j = ct * 16 + l15;
        const float dec = (i >= j) ? expf(gcs[i] - gcs[j]) : 0.f;
        Am[j * 64 + i] = (i > j) ? bet[i] * rk[i] * rk[j] * ckk[jj] * dec : 0.f;
        ATT[i * 64 + j] = f2bf((i >= j) ? SCALE * rq[i] * rk[j] * cqk[jj] * dec : 0.f);
      }
    }
  }
  __syncthreads();
  const float gl = gcs[63];
  for (int e = tid; e < 64 * 128; e += 256) {
    int i = e >> 7, d = e & 127;
    QG[e] = f2bf(bf2f(qs[i * 136 + d]) * rq[i] * SCALE * __expf(gcs[i]));
  }
  for (int e = tid; e < 128 * 64; e += 256) {
    int d = e >> 6, i = e & 63;
    KDT[e] = f2bf(bf2f(ks[i * 136 + d]) * rk[i] * __expf(gl - gcs[i]));
  }
  if (tid < 64) {
    fac[tid] = bet[tid];
    fac[64 + tid] = rk[tid] * bet[tid] * __expf(gcs[tid]);
  }
  __syncthreads();
  {
    const int cidx = tid & 127;
    const bf16_t* srcm = ((tid < 128) ? vs : ks) + cidx;
    const float* fc = fac + ((tid < 128) ? 0 : 64);
    bf16_t* dstm = ((tid < 128) ? Ub : Wb) + cidx;
    bf16_t* XB = qs + tid;
#pragma unroll 1
    for (int b = 0; b < 4; ++b) {
      float x[16];
#pragma unroll
      for (int r = 0; r < 16; ++r) x[r] = bf2f(srcm[(16 * b + r) * 136]) * fc[16 * b + r];
      const float* arow = Am + 16 * b;
#pragma unroll 2
      for (int j = 0; j < 16 * b; ++j) {
        const float xv = bf2f(XB[j * 256]);
        const f32x4 a0 = *(const f32x4*)(arow + j * 64), a1 = *(const f32x4*)(arow + j * 64 + 4);
        const f32x4 a2 = *(const f32x4*)(arow + j * 64 + 8), a3 = *(const f32x4*)(arow + j * 64 + 12);
#pragma unroll
        for (int r = 0; r < 4; ++r) {
          x[r] -= a0[r] * xv; x[4 + r] -= a1[r] * xv; x[8 + r] -= a2[r] * xv; x[12 + r] -= a3[r] * xv;
        }
      }
      const float* ablk = Am + (16 * b) * 64 + 16 * b;
#pragma unroll
      for (int jj = 0; jj < 15; ++jj) {
#pragma unroll
        for (int r = jj + 1; r < 16; ++r) x[r] -= ablk[jj * 64 + r] * x[jj];
      }
#pragma unroll
      for (int r = 0; r < 16; ++r) {
        const bf16_t bb = f2bf(x[r]);
        dstm[(16 * b + r) * 128] = bb;
        if (b < 3) XB[(16 * b + r) * 256] = bb;
      }
    }
  }
  if (tid == 0) EGL[pi] = expf(gl);
  __syncthreads();
}

__device__ __forceinline__ void conf_conv_item(const Params& p, int l, int item, unsigned char* smem) {
  const int il = l >> 1;
  float* hc = (float*)smem;
  const bf16_t* P = (const bf16_t*)(p.ws + OFF_P);
  float* convout = (float*)(p.ws + OFF_CONV);
  const int tid = opaque_tid();
  const int tile = item >> 1, ch = (item & 1) * 256 + tid;
  const int t0 = tile * 32;
  int seq_lo, seq_hi;
  if (t0 < NPROMPT) { seq_lo = (t0 >> 8) << 8; seq_hi = seq_lo + 256; }
  else { seq_lo = NPROMPT + (((t0 - NPROMPT) >> 11) << 11); seq_hi = seq_lo + 2048; }
#pragma unroll 31
  for (int r = 0; r < 62; ++r) {
    const int tt = t0 - 15 + r;
    float v = 0.f;
    if (tt >= seq_lo && tt < seq_hi) {
      float ca = bf2f(P[(size_t)tt * PSTRIDE + 2064 + ch]);
      float cgv = bf2f(P[(size_t)tt * PSTRIDE + 2576 + ch]);
      v = ca / (1.f + __expf(-cgv));
    }
    hc[r * 256 + tid] = v;
  }
  float wk[31];
#pragma unroll
  for (int k = 0; k < 31; ++k) wk[k] = p.in[22][((size_t)il * 31 + k) * 512 + ch];
  const float bias = p.in[23][il * 512 + ch];
  for (int i = 0; i < 32; ++i) {
    float acc = bias;
#pragma unroll
    for (int k = 0; k < 31; ++k) acc += wk[k] * hc[(i + k) * 256 + tid];
    convout[(size_t)(t0 + i) * 512 + ch] = acc;
  }
}

__device__ __forceinline__ void phase_odd_prep(const Params& p, int l, unsigned char* smem) {
  for (int u = blockIdx.x; u < 3072 + 1536; u += gridDim.x) {
    if (u < 3072) gdn_prep_item(p, l, u, smem);
    else { conf_conv_item(p, l, u - 3072, smem); __syncthreads(); }
  }
}

__device__ __forceinline__ void phase_gdn_chain(const Params& p, int l, unsigned char* smem) {
  const int il = l >> 1;
  bf16_t* ST = (bf16_t*)smem;
  bf16_t* VT = ST + 32 * 136;
  float* odir = (float*)(p.ws + OFF_ODIR);
  const float* EGL = (const float*)(p.ws + OFF_EGL);
  const int tid = opaque_tid(), lane = tid & 63, w = tid >> 6, quad = lane >> 4, l15 = lane & 15;
  for (int it = blockIdx.x; it < 1280; it += gridDim.x) {
    const ChainItem ci = decode_item(it);
    const int sl = ci.sl, dir = ci.dir, h = ci.h;
    f32x4 S[2][2];
    if (ci.lng) {
      const float* s0 = p.in[3] + ((((size_t)ci.sq * 2 + il) * 2 + dir) * 4 + h) * 16384;
#pragma unroll
      for (int rb = 0; rb < 2; ++rb)
#pragma unroll
        for (int ct = 0; ct < 2; ++ct)
#pragma unroll
          for (int jj = 0; jj < 4; ++jj)
            S[rb][ct][jj] = s0[(16 * (2 * w + rb) + quad * 4 + jj) * 128 + sl * 32 + ct * 16 + l15];
    } else {
#pragma unroll
      for (int rb = 0; rb < 2; ++rb)
#pragma unroll
        for (int ct = 0; ct < 2; ++ct) S[rb][ct] = (f32x4){0.f, 0.f, 0.f, 0.f};
    }
    for (int n = 0; n < ci.nc; ++n) {
      const int cn = dir ? ci.nc - 1 - n : n;
      const int tb = ci.tok0 + cn * 64;
      const int cglob = ci.lng ? 128 + ci.sq * 32 + cn : ci.sq * 4 + cn;
      const int pi = (cglob * 4 + h) * 2 + dir;
      const unsigned char* gp = p.ws + OFF_GPREP + (size_t)pi * GP_ITEM;
      const bf16_t* Wb = (const bf16_t*)gp;
      const bf16_t* QG = Wb + 8192;
      const bf16_t* KDT = QG + 8192;
      const bf16_t* Ub = KDT + 8192;
      const bf16_t* ATT = Ub + 8192;
      bf16x8 aw[4], aqg[4], aat[2], akd[2][2];
      float uu[2][4];
#pragma unroll
      for (int kk = 0; kk < 4; ++kk) {
        aw[kk] = ldfrag(Wb + (16 * w + l15) * 128 + kk * 32 + quad * 8);
        aqg[kk] = ldfrag(QG + (16 * w + l15) * 128 + kk * 32 + quad * 8);
      }
#pragma unroll
      for (int kk = 0; kk < 2; ++kk) {
        aat[kk] = ldfrag(ATT + (16 * w + l15) * 64 + kk * 32 + quad * 8);
#pragma unroll
        for (int rb = 0; rb < 2; ++rb) akd[rb][kk] = ldfrag(KDT + (16 * (2 * w + rb) + l15) * 64 + kk * 32 + quad * 8);
      }
#pragma unroll
      for (int ct = 0; ct < 2; ++ct)
#pragma unroll
        for (int jj = 0; jj < 4; ++jj) uu[ct][jj] = bf2f(Ub[(16 * w + quad * 4 + jj) * 128 + sl * 32 + ct * 16 + l15]);
      const float egl = EGL[pi];
#pragma unroll
      for (int rb = 0; rb < 2; ++rb)
#pragma unroll
        for (int ct = 0; ct < 2; ++ct)
#pragma unroll
          for (int jj = 0; jj < 4; ++jj)
            ST[(ct * 16 + l15) * 136 + 16 * (2 * w + rb) + quad * 4 + jj] = f2bf(S[rb][ct][jj]);
      __syncthreads();
      f32x4 co[2];
#pragma unroll
      for (int ct = 0; ct < 2; ++ct) {
        f32x4 cv = (f32x4){0.f, 0.f, 0.f, 0.f};
        co[ct] = (f32x4){0.f, 0.f, 0.f, 0.f};
#pragma unroll
        for (int kk = 0; kk < 4; ++kk) {
          bf16x8 b = ldfrag(ST + (ct * 16 + l15) * 136 + kk * 32 + quad * 8);
          cv = mfma16(aw[kk], b, cv);
          co[ct] = mfma16(aqg[kk], b, co[ct]);
        }
#pragma unroll
        for (int jj = 0; jj < 4; ++jj) {
          float vn = uu[ct][jj] - cv[jj];
          VT[(ct * 16 + l15) * 72 + 16 * w + quad * 4 + jj] = f2bf(vn);
        }
      }
      __syncthreads();
#pragma unroll
      for (int ct = 0; ct < 2; ++ct) {
        bf16x8 bv[2];
#pragma unroll
        for (int kk = 0; kk < 2; ++kk) {
          bv[kk] = ldfrag(VT + (ct * 16 + l15) * 72 + kk * 32 + quad * 8);
          co[ct] = mfma16(aat[kk], bv[kk], co[ct]);
        }
#pragma unroll
        for (int jj = 0; jj < 4; ++jj) {
          int i = 16 * w + quad * 4 + jj;
          int t = tb + (dir ? 63 - i : i);
          odir[((size_t)dir * NTOK + t) * 512 + h * 128 + sl * 32 + ct * 16 + l15] = co[ct][jj];
        }
#pragma unroll
        for (int rb = 0; rb < 2; ++rb) {
          f32x4 s = S[rb][ct];
          s[0] *= egl; s[1] *= egl; s[2] *= egl; s[3] *= egl;
          s = mfma16(akd[rb][0], bv[0], s);
          s = mfma16(akd[rb][1], bv[1], s);
          S[rb][ct] = s;
        }
      }
    }
    __syncthreads();
    if (!ci.lng) {
      float* so = p.out + 29360128 + ((((size_t)ci.sq * 2 + il) * 2 + dir) * 4 + h) * 16384;
#pragma unroll
      for (int rb = 0; rb < 2; ++rb)
#pragma unroll
        for (int ct = 0; ct < 2; ++ct)
#pragma unroll
          for (int jj = 0; jj < 4; ++jj)
            so[(16 * (2 * w + rb) + quad * 4 + jj) * 128 + sl * 32 + ct * 16 + l15] = S[rb][ct][jj];
    }
  }
}

__device__ __forceinline__ void phase_mix_out(const Params& p, int l) {
  const int il = l >> 1;
  const bool odd = l & 1;
  const int tid_ = opaque_tid(); const int lane = tid_ & 63, wv = tid_ >> 6;
  const bf16_t* P = (const bf16_t*)(p.ws + OFF_P);
  const float* od0 = (const float*)(p.ws + OFF_ODIR);
  const float* od1 = od0 + (size_t)NTOK * 512;
  const float* convout = (const float*)(p.ws + OFF_CONV);
  bf16_t* Y = (bf16_t*)(p.ws + OFF_YMIX);
  for (int t = blockIdx.x * 4 + wv; t < NTOK; t += gridDim.x * 4) {
    const bf16_t* pr = P + (size_t)t * PSTRIDE;
    bf16_t* yr = Y + (size_t)t * 1024;
#pragma unroll
    for (int h = 0; h < 4; ++h) {
      const int idx = h * 128 + lane * 2;
      float2 a = *(const float2*)(od0 + (size_t)t * 512 + idx);
      float2 b = *(const float2*)(od1 + (size_t)t * 512 + idx);
      float o0 = a.x + b.x, o1 = a.y + b.y;
      float ss = wave_sum(o0 * o0 + o1 * o1);
      float rs = rsqrtf(ss * (1.f / 128.f) + EPSV);
      float n0, n1;
      unsigned gz;
      if (!odd) {
        n0 = p.in[14][il * 512 + idx]; n1 = p.in[14][il * 512 + idx + 1];
        gz = *(const unsigned*)(pr + 1024 + idx);
      } else {
        n0 = p.in[21][il * 128 + lane * 2]; n1 = p.in[21][il * 128 + lane * 2 + 1];
        gz = *(const unsigned*)(pr + 1536 + idx);
      }
      float y0 = siluf(bflo(gz)) * o0 * rs * n0;
      float y1 = siluf(bfhi(gz)) * o1 * rs * n1;
      *(unsigned*)(yr + idx) = pack2(y0, y1);
    }
    if (!odd) {
      int seq_lo, seq_hi;
      if (t < NPROMPT) { seq_lo = (t >> 8) << 8; seq_hi = seq_lo + 256; }
      else { seq_lo = NPROMPT + (((t - NPROMPT) >> 11) << 11); seq_hi = seq_lo + 2048; }
      const bool hp = (t - 1 >= seq_lo), hn = (t + 1 < seq_hi);
#pragma unroll
      for (int j = 0; j < 4; ++j) {
        const int c = j * 128 + lane * 2;
        unsigned cg0 = *(const unsigned*)(pr + 2048 + c), hb0 = *(const unsigned*)(pr + 2560 + c);
        unsigned cgm = 0, hbm = 0, cgp = 0, hbp = 0;
        if (hp) { cgm = *(const unsigned*)(pr - PSTRIDE + 2048 + c); hbm = *(const unsigned*)(pr - PSTRIDE + 2560 + c); }
        if (hn) { cgp = *(const unsigned*)(pr + PSTRIDE + 2048 + c); hbp = *(const unsigned*)(pr + PSTRIDE + 2560 + c); }
        unsigned bg = *(const unsigned*)(pr + 1536 + c);
        const float* sw = p.in[15] + (size_t)il * 3 * 512 + c;
        float y0 = bflo(bg) * (sw[0] * bflo(cgm) * bflo(hbm) + sw[512] * bflo(cg0) * bflo(hb0) + sw[1024] * bflo(cgp) * bflo(hbp));
        float y1 = bfhi(bg) * (sw[1] * bfhi(cgm) * bfhi(hbm) + sw[513] * bfhi(cg0) * bfhi(hb0) + sw[1025] * bfhi(cgp) * bfhi(hbp));
        *(unsigned*)(yr + 512 + c) = pack2(y0, y1);
      }
    } else {
      float v[8];
      float s = 0.f;
#pragma unroll
      for (int j = 0; j < 4; ++j) {
        float2 a = *(const float2*)(convout + (size_t)t * 512 + j * 128 + lane * 2);
        v[2 * j] = a.x; v[2 * j + 1] = a.y;
        s += a.x + a.y;
      }
      const float mean = wave_sum(s) * (1.f / 512.f);
      float vs = 0.f;
#pragma unroll
      for (int j = 0; j < 8; ++j) { v[j] -= mean; vs += v[j] * v[j]; }
      const float rstd = rsqrtf(wave_sum(vs) * (1.f / 512.f) + EPSV);
#pragma unroll
      for (int j = 0; j < 4; ++j) {
        const int c = j * 128 + lane * 2;
        float y0 = v[2 * j] * rstd * p.in[24][il * 512 + c] + p.in[25][il * 512 + c];
        float y1 = v[2 * j + 1] * rstd * p.in[24][il * 512 + c + 1] + p.in[25][il * 512 + c + 1];
        *(unsigned*)(yr + 512 + c) = pack2(siluf(y0), siluf(y1));
      }
    }
  }
}

#define CE_DESC(a, b) { unsigned _mx = max(a, b), _mn = min(a, b); a = _mx; b = _mn; }
#define CE_ASC(a, b) { unsigned _mx = max(a, b), _mn = min(a, b); a = _mn; b = _mx; }
__device__ __forceinline__ void sort16_desc(unsigned* v) {
#pragma unroll
  for (int k = 2; k <= 16; k <<= 1) {
#pragma unroll
    for (int j = k >> 1; j > 0; j >>= 1) {
#pragma unroll
      for (int i = 0; i < 16; ++i) {
        const int l = i ^ j;
        if (l > i) {
          if ((i & k) == 0) CE_DESC(v[i], v[l]) else CE_ASC(v[i], v[l])
        }
      }
    }
  }
}
__device__ __forceinline__ void merge16_top(unsigned* a, const unsigned* b) {
#pragma unroll
  for (int i = 0; i < 16; ++i) a[i] = max(a[i], b[15 - i]);
#pragma unroll
  for (int j = 8; j > 0; j >>= 1) {
#pragma unroll
    for (int i = 0; i < 16; ++i) {
      const int l = i ^ j;
      if (l > i) CE_DESC(a[i], a[l])
    }
  }
}
__device__ __forceinline__ void phase_peer_score(const Params& p, int l, unsigned char* smem) {
  const int tid = opaque_tid(), lane = tid & 63, w = tid >> 6, quad = lane >> 4, l15 = lane & 15;
  unsigned* scw = (unsigned*)smem + w * (32 * 132 + 512);
  unsigned* sel = scw + 32 * 132;
  const bf16_t* Q = (const bf16_t*)(p.ws + OFF_Q);
  const bf16_t* KB = (const bf16_t*)(p.ws + OFF_KEYS) + (size_t)l * 8 * 2 * 128 * 128;
  int* EI = (int*)(p.ws + OFF_EIDX);
  float* GT = (float*)(p.ws + OFF_GATE);
  for (int u = blockIdx.x; u < 3072; u += gridDim.x) {
    const int tt = u >> 1, h = (u & 1) * 4 + w;
    const int t0 = tt * 16;
#pragma unroll
    for (int pp = 0; pp < 2; ++pp) {
      bf16x8 a[4];
#pragma unroll
      for (int kk = 0; kk < 4; ++kk) a[kk] = ldfrag(Q + (size_t)(t0 + l15) * 2048 + h * 256 + pp * 128 + kk * 32 + quad * 8);
      const bf16_t* kb = KB + (size_t)((h * 2 + pp) * 128) * 128;
#pragma unroll
      for (int ct = 0; ct < 8; ++ct) {
        f32x4 c = (f32x4){0.f, 0.f, 0.f, 0.f};
#pragma unroll
        for (int kk = 0; kk < 4; ++kk) {
          bf16x8 b = ldfrag(kb + (ct * 16 + l15) * 128 + kk * 32 + quad * 8);
          c = mfma16(a[kk], b, c);
        }
#pragma unroll
        for (int jj = 0; jj < 4; ++jj) {
          const int row = pp * 16 + quad * 4 + jj, col = ct * 16 + l15;
          unsigned key = (fkey(c[jj]) & ~127u) | (unsigned)(127 - col);
          scw[row * 132 + col] = key;
        }
      }
    }
    __syncthreads();
    {
      const int row = lane >> 1, hf = lane & 1;
      const u32x4* rp = (const u32x4*)(scw + row * 132 + hf * 64);
      unsigned g0[16], g1[16];
#pragma unroll
      for (int q = 0; q < 4; ++q) { u32x4 t4 = rp[q]; g0[4 * q] = t4[0]; g0[4 * q + 1] = t4[1]; g0[4 * q + 2] = t4[2]; g0[4 * q + 3] = t4[3]; }
#pragma unroll
      for (int q = 0; q < 4; ++q) { u32x4 t4 = rp[4 + q]; g1[4 * q] = t4[0]; g1[4 * q + 1] = t4[1]; g1[4 * q + 2] = t4[2]; g1[4 * q + 3] = t4[3]; }
      sort16_desc(g0);
      sort16_desc(g1);
      merge16_top(g0, g1);
#pragma unroll
      for (int q = 0; q < 4; ++q) { u32x4 t4 = rp[8 + q]; g1[4 * q] = t4[0]; g1[4 * q + 1] = t4[1]; g1[4 * q + 2] = t4[2]; g1[4 * q + 3] = t4[3]; }
      sort16_desc(g1);
      merge16_top(g0, g1);
#pragma unroll
      for (int q = 0; q < 4; ++q) { u32x4 t4 = rp[12 + q]; g1[4 * q] = t4[0]; g1[4 * q + 1] = t4[1]; g1[4 * q + 2] = t4[2]; g1[4 * q + 3] = t4[3]; }
      sort16_desc(g1);
      merge16_top(g0, g1);
#pragma unroll
      for (int i = 0; i < 16; ++i) g1[i] = (unsigned)__shfl_xor((int)g0[i], 1);
      merge16_top(g0, g1);
      if (hf == 0) {
#pragma unroll
        for (int q = 0; q < 4; ++q) {
          u32x4 t4 = {g0[4 * q], g0[4 * q + 1], g0[4 * q + 2], g0[4 * q + 3]};
          *(u32x4*)(sel + row * 16 + 4 * q) = t4;
        }
      }
    }
    __syncthreads();
    {
      const int tok = lane >> 2, sub = lane & 3;
      const unsigned* s1 = sel + tok * 16;
      const unsigned* s2 = sel + (16 + tok) * 16;
      unsigned ck[13];
#pragma unroll
      for (int i = 0; i < 13; ++i) {
        const int cidx = sub + 4 * i;
        const int a = CAND_A[cidx], b = CAND_B[cidx];
        float s = keyf(s1[a] & ~127u) + keyf(s2[b] & ~127u);
        unsigned k = (fkey(s) & ~255u) | (unsigned)(255 - (a * 16 + b));
        ck[i] = (cidx < 50) ? k : 0u;
      }
      unsigned prev = 0xFFFFFFFFu;
      unsigned top[16];
#pragma unroll
      for (int r = 0; r < 16; ++r) {
        unsigned best = 0;
#pragma unroll
        for (int i = 0; i < 13; ++i) {
          unsigned tsel = (ck[i] < prev) ? ck[i] : 0u;
          best = max(best, tsel);
        }
        best = max(best, (unsigned)__shfl_xor((int)best, 1));
        best = max(best, (unsigned)__shfl_xor((int)best, 2));
        prev = best;
        top[r] = best;
      }
      float sv[16];
      int ev[16];
#pragma unroll
      for (int r = 0; r < 16; ++r) {
        const int cidx = 255 - (int)(top[r] & 255u);
        const int a = cidx >> 4, b = cidx & 15;
        const unsigned k1 = s1[a], k2 = s2[b];
        sv[r] = keyf(k1 & ~127u) + keyf(k2 & ~127u);
        ev[r] = (127 - (int)(k1 & 127u)) * 128 + (127 - (int)(k2 & 127u));
      }
      float mx = sv[0];
#pragma unroll
      for (int r = 1; r < 16; ++r) mx = fmaxf(mx, sv[r]);
      float sum = 0.f;
#pragma unroll
      for (int r = 0; r < 16; ++r) { sv[r] = expf(sv[r] - mx); sum += sv[r]; }
      const float inv = 1.f / sum;
      const size_t ob = (size_t)(t0 + tok) * 128 + h * 16;
#pragma unroll
      for (int r = 0; r < 16; ++r) {
        if ((r & 3) == sub) { EI[ob + r] = ev[r]; GT[ob + r] = sv[r] * inv; }
      }
    }
    __syncthreads();
  }
}

__device__ __forceinline__ float gelu_tanh(float x) {
  return 0.5f * x * (1.f + tanhf(0.7978845608028654f * (x + 0.044715f * x * x * x)));
}
__device__ __forceinline__ void phase_peer_gather(const Params& p, int l) {
  const int tid_ = opaque_tid(); const int lane = tid_ & 63, wv = tid_ >> 6;
  const bf16_t* H = (const bf16_t*)(p.ws + OFF_H);
  bf16_t* Hw = (bf16_t*)(p.ws + OFF_H);
  const unsigned char* UB = p.ws + OFF_UB + (size_t)l * 16384 * 1024;
  const unsigned char* VB = p.ws + OFF_VB + (size_t)l * 16384 * 1024;
  const int* EI = (const int*)(p.ws + OFF_EIDX);
  const float* GT = (const float*)(p.ws + OFF_GATE);
  const float* modv = (const float*)(p.ws + OFF_MOD);
  for (int t = blockIdx.x * 4 + wv; t < NTOK; t += gridDim.x * 4) {
    float xf[16];
    unpack8(*(const uint4*)(H + (size_t)t * 1024 + lane * 16), xf);
    unpack8(*(const uint4*)(H + (size_t)t * 1024 + lane * 16 + 8), xf + 8);
    float out[16];
#pragma unroll
    for (int e = 0; e < 16; ++e) out[e] = 0.f;
    float coef[2];
    int eix[2];
#pragma unroll
    for (int hf = 0; hf < 2; ++hf) {
      const int ev = EI[(size_t)t * 128 + hf * 64 + lane];
      const float gv = GT[(size_t)t * 128 + hf * 64 + lane];
      float cacc = 0.f;
      for (int k = 0; k < 64; k += 8) {
        u32x4 rows[8];
#pragma unroll
        for (int j = 0; j < 8; ++j) {
          const int e = __builtin_amdgcn_readlane(ev, k + j);
          rows[j] = *(const u32x4*)(UB + (size_t)e * 1024 + lane * 16);
        }
        float d[8];
#pragma unroll
        for (int j = 0; j < 8; ++j) {
          float uf[16];
          unpack16_fp8(rows[j], uf);
          float sacc = 0.f;
#pragma unroll
          for (int q = 0; q < 16; ++q) sacc += uf[q] * xf[q];
          d[j] = sacc;
        }
        {
          const bool b5 = lane & 32, b4 = lane & 16, b3 = lane & 8;
          float e4[4], e2[2], e1;
#pragma unroll
          for (int j = 0; j < 4; ++j) {
            float snd = b5 ? d[j] : d[j + 4];
            float kep = b5 ? d[j + 4] : d[j];
            e4[j] = kep + __shfl_xor(snd, 32);
          }
#pragma unroll
          for (int j = 0; j < 2; ++j) {
            float snd = b4 ? e4[j] : e4[j + 2];
            float kep = b4 ? e4[j + 2] : e4[j];
            e2[j] = kep + __shfl_xor(snd, 16);
          }
          {
            float snd = b3 ? e2[0] : e2[1];
            float kep = b3 ? e2[1] : e2[0];
            e1 = kep + __shfl_xor(snd, 8);
          }
          e1 += __shfl_xor(e1, 4);
          e1 += __shfl_xor(e1, 2);
          e1 += __shfl_xor(e1, 1);
          const int jj = lane & 7;
          const int srcl = ((jj >> 2) & 1) * 32 + ((jj >> 1) & 1) * 16 + (jj & 1) * 8;
          const float tot = __shfl(e1, srcl);
          if ((lane >> 3) == (k >> 3)) cacc = tot;
        }
      }
      coef[hf] = gelu_tanh(cacc * (1.f / U_SCALE)) * gv * (1.f / V_SCALE);
      eix[hf] = ev;
    }
#pragma unroll
    for (int hf = 0; hf < 2; ++hf) {
      for (int k = 0; k < 64; k += 8) {
        u32x4 rows[8];
#pragma unroll
        for (int j = 0; j < 8; ++j) {
          const int e = __builtin_amdgcn_readlane(eix[hf], k + j);
          rows[j] = *(const u32x4*)(VB + (size_t)e * 1024 + lane * 16);
        }
#pragma unroll
        for (int j = 0; j < 8; ++j) {
          const float cf = __uint_as_float((unsigned)__builtin_amdgcn_readlane((int)__float_as_uint(coef[hf]), k + j));
          float vf[16];
          unpack16_fp8(rows[j], vf);
#pragma unroll
          for (int q = 0; q < 16; ++q) out[q] += cf * vf[q];
        }
      }
    }
    const int m = tok_mod(t);
    const float* ga2 = modv + (size_t)(l * 9 + m) * 6144 + 5120;
    float* xr = p.out + (size_t)t * 1024 + lane * 16;
    float xn[16];
    float ss = 0.f;
#pragma unroll
    for (int q4 = 0; q4 < 4; ++q4) {
      float4 xv = *(const float4*)(xr + q4 * 4);
      float4 gg = *(const float4*)(ga2 + lane * 16 + q4 * 4);
      const int o = q4 * 4;
      xn[o + 0] = xv.x + gg.x * out[o + 0];
      xn[o + 1] = xv.y + gg.y * out[o + 1];
      xn[o + 2] = xv.z + gg.z * out[o + 2];
      xn[o + 3] = xv.w + gg.w * out[o + 3];
      ss += xn[o] * xn[o] + xn[o + 1] * xn[o + 1] + xn[o + 2] * xn[o + 2] + xn[o + 3] * xn[o + 3];
    }
    ss = wave_sum(ss);
    const float rs = rsqrtf(ss * (1.f / 1024.f) + EPSV);
    if (l < 3) {
      const float* md = modv + (size_t)((l + 1) * 9 + m) * 6144 + lane * 16;
      const float* g = p.in[8] + (l + 1) * 1024 + lane * 16;
      float hv[16];
#pragma unroll
      for (int q = 0; q < 16; ++q) hv[q] = xn[q] * rs * g[q] * (1.f + md[1024 + q]) + md[q];
      uint4 o;
      o.x = pack2(hv[0], hv[1]); o.y = pack2(hv[2], hv[3]); o.z = pack2(hv[4], hv[5]); o.w = pack2(hv[6], hv[7]);
      *(uint4*)(Hw + (size_t)t * 1024 + lane * 16) = o;
      o.x = pack2(hv[8], hv[9]); o.y = pack2(hv[10], hv[11]); o.z = pack2(hv[12], hv[13]); o.w = pack2(hv[14], hv[15]);
      *(uint4*)(Hw + (size_t)t * 1024 + lane * 16 + 8) = o;
#pragma unroll
      for (int q4 = 0; q4 < 4; ++q4) *(float4*)(xr + q4 * 4) = make_float4(xn[q4 * 4], xn[q4 * 4 + 1], xn[q4 * 4 + 2], xn[q4 * 4 + 3]);
    } else {
      const float* g = p.in[10] + lane * 16;
#pragma unroll
      for (int q4 = 0; q4 < 4; ++q4)
        *(float4*)(xr + q4 * 4) = make_float4(xn[q4 * 4] * rs * g[q4 * 4], xn[q4 * 4 + 1] * rs * g[q4 * 4 + 1],
                                              xn[q4 * 4 + 2] * rs * g[q4 * 4 + 2], xn[q4 * 4 + 3] * rs * g[q4 * 4 + 3]);
    }
  }
}

#define XB_TMO      128
#define XB_XCNT(j)  (256  + 64 * (j))
#define XB_XSUB(j)  (1280 + 64 * (j))
#define XB_XGEN(j)  (2304 + 64 * (j))
#define XB_TOP      3328
#define XB_TOPGEN   3392
#define XCD_BAR_WORDS 3456
#define XB_SPIN_CAP (1u << 18)
#define LAS __attribute__((address_space(3)))

__device__ __forceinline__ unsigned xb_ld(unsigned* p)              { return __hip_atomic_load(p, __ATOMIC_RELAXED, __HIP_MEMORY_SCOPE_AGENT); }
__device__ __forceinline__ unsigned xb_add(unsigned* p, unsigned v) { return __hip_atomic_fetch_add(p, v, __ATOMIC_RELAXED, __HIP_MEMORY_SCOPE_AGENT); }
__device__ __forceinline__ unsigned xb_xcc_id() { return (unsigned)__builtin_amdgcn_s_getreg((3 << 11) | 20) & 0xFu; }
#define XB_SPIN(cond, bar) do { unsigned _sp = 0; while (cond) { __builtin_amdgcn_s_sleep(1); \
    if ((++_sp & 255u) == 0u) { if (xb_ld(&(bar)[XB_TMO])) break; if (_sp > XB_SPIN_CAP) { atomicAdd(&(bar)[XB_TMO], 1u); break; } } } } while (0)

struct XcdBarrier {
    unsigned* bar; unsigned x;
    volatile LAS unsigned* st;
};

__device__ __forceinline__ XcdBarrier xcd_barrier_post(unsigned* bar, volatile LAS unsigned* st) {
    XcdBarrier b; b.bar = bar; b.x = xb_xcc_id(); b.st = st;
    if (threadIdx.x == 0) (void)xb_add(&bar[XB_XCNT(b.x)], 1u);
    return b;
}
__device__ __forceinline__ void xcd_barrier_complete(unsigned* bar, unsigned x, unsigned& nloc, unsigned& nx) {
    const unsigned G = gridDim.x * gridDim.y * gridDim.z;
    unsigned sum, cnt, mine, sp = 0u;
    for (;;) {
        sum = 0u; cnt = 0u; mine = 0u;
#pragma unroll
        for (unsigned j = 0; j < 16; ++j) { const unsigned c = xb_ld(&bar[XB_XCNT(j)]); sum += c; cnt += (c > 0u) ? 1u : 0u; mine = (j == x) ? c : mine; }
        if (sum == G) break;
        __builtin_amdgcn_s_sleep(1);
        if ((++sp & 255u) == 0u) { if (xb_ld(&bar[XB_TMO])) break; if (sp > XB_SPIN_CAP) { atomicAdd(&bar[XB_TMO], 1u); break; } }
    }
    nloc = mine > 0u ? mine : 1u; nx = cnt > 0u ? cnt : 1u;
}

__device__ __forceinline__ void xcd_barrier(const XcdBarrier& b) {
    asm volatile("s_waitcnt vmcnt(0)" ::: "memory");
    __syncthreads();
    if (threadIdx.x == 0) {
        unsigned* bar = b.bar;
        __builtin_amdgcn_s_waitcnt(0);
        unsigned nloc = b.st[0], nx = b.st[1];
        if (nloc == 0u) { xcd_barrier_complete(bar, b.x, nloc, nx); b.st[0] = nloc; b.st[1] = nx; }
        const unsigned old = xb_add(&bar[XB_XSUB(b.x)], 1u);
        const unsigned gen = old / nloc;
        if (old + 1u == (gen + 1u) * nloc) {
            __builtin_amdgcn_fence(__ATOMIC_RELEASE, "agent");
            asm volatile("s_waitcnt vmcnt(0)" ::: "memory");
            const unsigned og = xb_add(&bar[XB_TOP], 1u);
            const unsigned tg = og / nx;
            if (og + 1u == (tg + 1u) * nx) xb_add(&bar[XB_TOPGEN], 1u);
            else XB_SPIN(xb_ld(&bar[XB_TOPGEN]) == tg, bar);
            __builtin_amdgcn_fence(__ATOMIC_ACQUIRE, "agent");
            xb_add(&bar[XB_XGEN(b.x)], 1u);
            asm volatile("s_waitcnt vmcnt(0)" ::: "memory");
        } else {
            XB_SPIN(xb_ld(&bar[XB_XGEN(b.x)]) == gen, bar);
            __builtin_amdgcn_fence(__ATOMIC_ACQUIRE, "agent");
            asm volatile("s_waitcnt vmcnt(0)" ::: "memory");
        }
    }
    __syncthreads();
}

__global__ void __launch_bounds__(256, 2) mega(Params p, int ph_lo, int ph_hi) {
  __shared__ __attribute__((aligned(16))) unsigned char smem[77312];
  cg::grid_group grid = cg::this_grid();
  __shared__ uint4 xb_words;
  if (threadIdx.x == 0) xb_words = make_uint4(0u, 0u, 0u, 0u);
  __syncthreads();
  XcdBarrier xb = xcd_barrier_post((unsigned*)(p.ws + OFF_BAR), (volatile LAS unsigned*)&xb_words);
  if (ph_hi > 100000) grid.sync();
  for (int ph = ph_lo; ph < ph_hi; ++ph) {
#if PROBE_MASK
    const int pcode = ph < 2 ? ph : 2 + (ph - 2) % 9;
    const int nrep = ((PROBE_MASK >> pcode) & 1) ? 2 : 1;
    for (int rep = 0; rep < nrep; ++rep) {
    if (rep) xcd_barrier(xb);
#endif
    bool did = true;
    if (ph == 0) phase_prep_a(p, smem);
    else if (ph == 1) phase_prep_b(p);
    else {
      const int l = (ph - 2) / 9, sub = (ph - 2) % 9;
      const int il = l >> 1;
      const bool odd = l & 1;
      const float* modv = (const float*)(p.ws + OFF_MOD);
      if (sub == 0 || sub == 6) {
        const bf16_t* Bt; int ntn, ldc; bf16_t* C;
        if (sub == 0) {
          Bt = odd ? (const bf16_t*)(p.ws + OFF_WIN_OD) + (size_t)il * 3200 * 1024
                   : (const bf16_t*)(p.ws + OFF_WIN_EV) + (size_t)il * 3072 * 1024;
          ntn = odd ? 25 : 24; ldc = PSTRIDE; C = (bf16_t*)(p.ws + OFF_P);
        } else {
          Bt = (const bf16_t*)(p.ws + OFF_WQ) + (size_t)l * 2048 * 1024;
          ntn = 16; ldc = 2048; C = (bf16_t*)(p.ws + OFF_Q);
        }
        gemm_phase<0>((const bf16_t*)(p.ws + OFF_H), Bt, ntn, C, ldc, nullptr, nullptr, smem);
      } else if (sub == 1) {
        if (odd) phase_odd_prep(p, l, smem); else did = false;
      } else if (sub == 2) {
        if (odd) phase_gdn_chain(p, l, smem); else phase_ret_chain(p, l, smem);
      } else if (sub == 3) {
        phase_mix_out(p, l);
      } else if (sub == 4) {
        gemm_phase<1>((const bf16_t*)(p.ws + OFF_YMIX), (const bf16_t*)(p.ws + OFF_WOUT) + (size_t)l * 1024 * 1024, 8,
                      nullptr, 0, p.out, modv + (size_t)l * 9 * 6144 + 2048, smem);
      } else if (sub == 5) {
        phase_norm2(p, l);
      } else if (sub == 7) {
        phase_peer_score(p, l, smem);
      } else {
        phase_peer_gather(p, l);
      }
    }
#if PROBE_MASK
    if (rep + 1 < nrep) continue;
#endif
    if (did && ph + 1 < ph_hi) xcd_barrier(xb);
#if PROBE_MASK
    }
#endif
  }
}

extern "C" void kernel_launch(void* const* d_in, const int* in_sizes, int n_in, void* d_out, int out_size,
                              void* d_ws, size_t ws_size, hipStream_t stream) {
  static int grid_blocks = 0;
  if (!grid_blocks) {
    int dev = 0, cus = 0, per_cu = 0;
    (void)hipGetDevice(&dev);
    (void)hipDeviceGetAttribute(&cus, hipDeviceAttributeMultiprocessorCount, dev);
    (void)hipOccupancyMaxActiveBlocksPerMultiprocessor(&per_cu, mega, 256, 0);
    if (per_cu < 1) per_cu = 1;
    if (per_cu > 2) per_cu = 2;
    grid_blocks = cus * per_cu;
    if (ws_size < WS_NEED) fprintf(stderr, "kernel_launch: workspace too small: %zu < %zu\n", ws_size, (size_t)WS_NEED);
  }
  Params p{};
  for (int i = 0; i < 30; ++i) p.in[i] = (const float*)d_in[i];
  p.out = (float*)d_out;
  p.ws = (unsigned char*)d_ws;
  (void)hipMemsetAsync((unsigned char*)d_ws + OFF_BAR, 0, XCD_BAR_WORDS * sizeof(unsigned), stream);
#if SINGLE_LAUNCH
  int lo = 0, hi = NPHASE;
  void* args[] = {&p, &lo, &hi};
  hipError_t e = hipLaunchCooperativeKernel((void*)mega, dim3(grid_blocks), dim3(256), args, 0, stream);
  if (e != hipSuccess) fprintf(stderr, "cooperative launch failed: %s (grid %d)\n", hipGetErrorString(e), grid_blocks);
#else
  for (int ph = 0; ph < NPHASE; ++ph) {
    const int l = (ph - 2) / 9, sub = (ph - 2) % 9;
    if (ph >= 2 && sub == 1 && !(l & 1)) continue;
    hipLaunchKernelGGL(mega, dim3(grid_blocks), dim3(256), 0, stream, p, ph, ph + 1);
  }
#endif
}
```

```cpp
#include <hip/hip_runtime.h>
#include <hip/hip_cooperative_groups.h>
#include <cstdio>
namespace cg = cooperative_groups;

#ifndef PROBE_MASK
#define PROBE_MASK 0
#endif
#ifndef PROBE_ODD
#define PROBE_ODD 0
#endif
#ifndef SINGLE_LAUNCH
#define SINGLE_LAUNCH 1
#endif

typedef unsigned short bf16_t;
using bf16x8 = __attribute__((ext_vector_type(8))) short;
using f32x4 = __attribute__((ext_vector_type(4))) float;
using f32x2 = __attribute__((ext_vector_type(2))) float;
using u32x4 = __attribute__((ext_vector_type(4))) unsigned;

#define NTOK 24576
#define NPROMPT 8192
#define PSTRIDE 3200
#define EPSV 1e-6f
#define NPHASE 38

constexpr size_t OFF_MOD = 0;
constexpr size_t OFF_ROPE = 1u << 20;
constexpr size_t OFF_WIN_EV = OFF_ROPE + 65536;
constexpr size_t OFF_WIN_OD = OFF_WIN_EV + 2ull * 3072 * 1024 * 2;
constexpr size_t OFF_WOUT = OFF_WIN_OD + 2ull * 3200 * 1024 * 2;
constexpr size_t OFF_WQ = OFF_WOUT + 4ull * 1024 * 1024 * 2;
constexpr size_t OFF_KEYS = OFF_WQ + 4ull * 2048 * 1024 * 2;
constexpr size_t OFF_UB = OFF_KEYS + 4ull * 8 * 2 * 128 * 128 * 2;
constexpr size_t OFF_VB = OFF_UB + 4ull * 16384 * 1024 * 2;
constexpr size_t OFF_H = OFF_VB + 4ull * 16384 * 1024 * 2;
constexpr size_t OFF_P = OFF_H + (size_t)NTOK * 1024 * 2;
constexpr size_t OFF_YMIX = OFF_P + (size_t)NTOK * PSTRIDE * 2;
constexpr size_t OFF_ODIR = OFF_YMIX + (size_t)NTOK * 1024 * 2;
constexpr size_t OFF_Q = OFF_ODIR;
constexpr size_t OFF_EIDX = OFF_ODIR + 2ull * NTOK * 512 * 4;
constexpr size_t OFF_GATE = OFF_EIDX + (size_t)NTOK * 128 * 4;
constexpr size_t GP_ITEM = 73728;
constexpr size_t OFF_GPREP = OFF_GATE + (size_t)NTOK * 128 * 4;
constexpr size_t OFF_EGL = OFF_GPREP + 3072ull * GP_ITEM;
constexpr size_t OFF_CONV = OFF_EGL + 16384;
constexpr size_t OFF_BAR = OFF_CONV + (size_t)NTOK * 512 * 4;
constexpr size_t WS_NEED = OFF_BAR + 16384;

struct Params {
  const float* in[30];
  float* out;
  unsigned char* ws;
};

__device__ const unsigned char CAND_A[52] = {0,0,0,0,0,0,0,0,0,0,0,0,0,0,0,0,1,1,1,1,1,1,1,1,2,2,2,2,2,3,3,3,3,4,4,4,5,5,6,6,7,7,8,9,10,11,12,13,14,15,0,0};
__device__ const unsigned char CAND_B[52] = {0,1,2,3,4,5,6,7,8,9,10,11,12,13,14,15,0,1,2,3,4,5,6,7,0,1,2,3,4,0,1,2,3,0,1,2,0,1,0,1,0,1,0,0,0,0,0,0,0,0,0,0};

__device__ __forceinline__ int opaque_tid() { int t = threadIdx.x; asm volatile("" : "+v"(t)); return t; }
typedef __bf16 hbf16x2 __attribute__((ext_vector_type(2)));
__device__ __forceinline__ bf16_t f2bf(float f) {
  return __builtin_bit_cast(unsigned short, (__bf16)f);
}
__device__ __forceinline__ float bf2f(bf16_t b) { return __uint_as_float(((unsigned)b) << 16); }
__device__ __forceinline__ float bflo(unsigned u) { return __uint_as_float(u << 16); }
__device__ __forceinline__ float bfhi(unsigned u) { return __uint_as_float(u & 0xffff0000u); }
__device__ __forceinline__ unsigned pack2(float a, float b) {
  f32x2 v = {a, b};
  return __builtin_bit_cast(unsigned, __builtin_convertvector(v, hbf16x2));
}
__device__ __forceinline__ float wave_sum(float v) {
#pragma unroll
  for (int o = 32; o > 0; o >>= 1) v += __shfl_xor(v, o);
  return v;
}
__device__ __forceinline__ f32x4 mfma16(bf16x8 a, bf16x8 b, f32x4 c) {
  return __builtin_amdgcn_mfma_f32_16x16x32_bf16(a, b, c, 0, 0, 0);
}
__device__ __forceinline__ bf16x8 ldfrag(const bf16_t* p) { return *(const bf16x8*)p; }
__device__ __forceinline__ float siluf(float v) { return v * __builtin_amdgcn_rcpf(1.f + __expf(-v)); }
__device__ __forceinline__ int tok_mod(int t) { return t < NPROMPT ? 0 : 1 + ((t - NPROMPT) >> 11); }
__device__ __forceinline__ unsigned fkey(float f) {
  unsigned u = __float_as_uint(f);
  return (u & 0x80000000u) ? ~u : (u | 0x80000000u);
}
__device__ __forceinline__ float keyf(unsigned k) {
  unsigned b = (k & 0x80000000u) ? (k ^ 0x80000000u) : ~k;
  return __uint_as_float(b);
}
__device__ __forceinline__ void unpack8(uint4 v, float* f) {
  f[0] = bflo(v.x); f[1] = bfhi(v.x); f[2] = bflo(v.y); f[3] = bfhi(v.y);
  f[4] = bflo(v.z); f[5] = bfhi(v.z); f[6] = bflo(v.w); f[7] = bfhi(v.w);
}

__device__ __forceinline__ void prep_mod(const Params& p, float* smem) {
  float* sc = smem;
  float* red = smem + 9 * 1024;
  const int tid = opaque_tid();
  const float* c = p.in[4];
  const float* cctx = p.in[5];
  for (int i = tid; i < 9 * 1024; i += 256) {
    int m = i >> 10, k = i & 1023;
    float v = (m == 0) ? cctx[k] : c[(m - 1) * 1024 + k];
    sc[i] = v / (1.f + expf(-v));
  }
  __syncthreads();
  float* modv = (float*)(p.ws + OFF_MOD);
  const int cl = tid & 63, kg = tid >> 6;
  for (int u = blockIdx.x; u < 4 * 96; u += gridDim.x) {
    const int l = u / 96, nb = (u % 96) * 64;
    const float* W = p.in[6] + (size_t)l * 1024 * 6144 + nb + cl;
    float acc[9];
#pragma unroll
    for (int m = 0; m < 9; ++m) acc[m] = 0.f;
#pragma unroll 16
    for (int k = kg * 256; k < kg * 256 + 256; ++k) {
      float w = W[(size_t)k * 6144];
#pragma unroll
      for (int m = 0; m < 9; ++m) acc[m] += sc[m * 1024 + k] * w;
    }
#pragma unroll
    for (int m = 0; m < 9; ++m) red[(kg * 9 + m) * 64 + cl] = acc[m];
    __syncthreads();
    for (int i = tid; i < 9 * 64; i += 256) {
      int m = i >> 6, c2 = i & 63;
      float s = red[(0 * 9 + m) * 64 + c2] + red[(1 * 9 + m) * 64 + c2] + red[(2 * 9 + m) * 64 + c2] + red[(3 * 9 + m) * 64 + c2];
      int nn = nb + c2;
      modv[(size_t)(l * 9 + m) * 6144 + nn] = s + p.in[7][l * 6144 + nn];
    }
    __syncthreads();
  }
}

__device__ __forceinline__ void prep_transpose(const float* src, bf16_t* dst, int N, int Npad, float* tile) {
  const int tid = opaque_tid();
  const int ntn = Npad / 64;
  const int units = ntn * 16;
  for (int u = blockIdx.x; u < units; u += gridDim.x) {
    const int nt = u % ntn, kt = u / ntn;
    const int n0 = nt * 64, k0 = kt * 64;
    {
      const int c = tid & 63;
      const int n = n0 + c;
      const int nc = n < N ? n : N - 1;
      float tv[16];
#pragma unroll
      for (int i = 0; i < 16; ++i) tv[i] = src[(size_t)(k0 + (tid >> 6) + 4 * i) * N + nc];
#pragma unroll
      for (int i = 0; i < 16; ++i) tile[((tid >> 6) + 4 * i) * 65 + c] = (n < N) ? tv[i] : 0.f;
    }
    __syncthreads();
#pragma unroll 4
    for (int i = 0; i < 16; ++i) {
      int rr = (tid >> 6) + 4 * i, cc = tid & 63;
      dst[(size_t)(n0 + rr) * 1024 + k0 + cc] = f2bf(tile[cc * 65 + rr]);
    }
    __syncthreads();
  }
}

__device__ __forceinline__ void prep_convert(const float* src, bf16_t* dst, size_t n4) {
  const size_t stride = (size_t)gridDim.x * 256;
  for (size_t i0 = (size_t)blockIdx.x * 256 + threadIdx.x; i0 < n4; i0 += stride * 8) {
    float4 v[8];
#pragma unroll
    for (int j = 0; j < 8; ++j) { const size_t i = i0 + j * stride; const size_t ic = i < n4 ? i : n4 - 1; v[j] = ((const float4*)src)[ic]; }
#pragma unroll
    for (int j = 0; j < 8; ++j) {
      const size_t i = i0 + j * stride;
      if (i < n4) { uint2 o; o.x = pack2(v[j].x, v[j].y); o.y = pack2(v[j].z, v[j].w); ((uint2*)dst)[i] = o; }
    }
  }
}

__device__ __forceinline__ void prep_convert_fp8(const float* src, unsigned* dst, size_t n4, float scale) {
  const size_t stride = (size_t)gridDim.x * 256;
  for (size_t i0 = (size_t)blockIdx.x * 256 + threadIdx.x; i0 < n4; i0 += stride * 8) {
    float4 v[8];
#pragma unroll
    for (int j = 0; j < 8; ++j) { const size_t i = i0 + j * stride; const size_t ic = i < n4 ? i : n4 - 1; f32x4 t4 = __builtin_nontemporal_load((const f32x4*)src + ic); v[j] = make_float4(t4[0], t4[1], t4[2], t4[3]); }
#pragma unroll
    for (int j = 0; j < 8; ++j) {
      const size_t i = i0 + j * stride;
      if (i < n4) {
        unsigned w = __builtin_amdgcn_cvt_pk_fp8_f32(v[j].x * scale, v[j].y * scale, 0, false);
        w = __builtin_amdgcn_cvt_pk_fp8_f32(v[j].z * scale, v[j].w * scale, w, true);
        dst[i] = w;
      }
    }
  }
}
__device__ __forceinline__ void unpack16_fp8(u32x4 v, float* f) {
#pragma unroll
  for (int i = 0; i < 4; ++i) {
    f32x2 lo = __builtin_amdgcn_cvt_pk_f32_fp8(v[i], false);
    f32x2 hi = __builtin_amdgcn_cvt_pk_f32_fp8(v[i], true);
    f[4 * i + 0] = lo.x; f[4 * i + 1] = lo.y; f[4 * i + 2] = hi.x; f[4 * i + 3] = hi.y;
  }
}
#define U_SCALE 32.f
#define V_SCALE 8.f
__device__ __forceinline__ void phase_prep_a(const Params& p, unsigned char* smem) {
  float* fs = (float*)smem;
  prep_mod(p, fs);
  {
    float2* rope = (float2*)(p.ws + OFF_ROPE);
    int i = blockIdx.x * 256 + threadIdx.x;
    if (i < 64 * 16) {
      int pos = i >> 4, f = i & 15;
      float fr = powf(10000.f, -(float)f / 16.f);
      float ang = (float)pos * fr;
      rope[i] = make_float2(cosf(ang), sinf(ang));
    }
  }
  for (int i = 0; i < 2; ++i) {
    prep_transpose(p.in[11] + (size_t)i * 1024 * 3072, (bf16_t*)(p.ws + OFF_WIN_EV) + (size_t)i * 3072 * 1024, 3072, 3072, fs);
    prep_transpose(p.in[16] + (size_t)i * 1024 * 3088, (bf16_t*)(p.ws + OFF_WIN_OD) + (size_t)i * 3200 * 1024, 3088, 3200, fs);
    prep_transpose(p.in[12] + (size_t)i * 1024 * 1024, (bf16_t*)(p.ws + OFF_WOUT) + (size_t)(2 * i) * 1024 * 1024, 1024, 1024, fs);
    prep_transpose(p.in[17] + (size_t)i * 1024 * 1024, (bf16_t*)(p.ws + OFF_WOUT) + (size_t)(2 * i + 1) * 1024 * 1024, 1024, 1024, fs);
  }
  for (int l = 0; l < 4; ++l)
    prep_transpose(p.in[26] + (size_t)l * 1024 * 2048, (bf16_t*)(p.ws + OFF_WQ) + (size_t)l * 2048 * 1024, 2048, 2048, fs);
  prep_convert(p.in[27], (bf16_t*)(p.ws + OFF_KEYS), (size_t)4 * 8 * 2 * 128 * 128 / 4);
  prep_convert_fp8(p.in[28], (unsigned*)(p.ws + OFF_UB), (size_t)4 * 16384 * 1024 / 4, U_SCALE);
  prep_convert_fp8(p.in[29], (unsigned*)(p.ws + OFF_VB), (size_t)4 * 16384 * 1024 / 4, V_SCALE);
}

__device__ __forceinline__ void norm_token(const float* xrow, const float* g, const float* scale, const float* shift,
                                           bf16_t* hrow, float* copy_dst, int lane) {
  float4 v[4];
  float ss = 0.f;
#pragma unroll
  for (int i = 0; i < 4; ++i) {
    v[i] = *(const float4*)(xrow + i * 256 + lane * 4);
    ss += v[i].x * v[i].x + v[i].y * v[i].y + v[i].z * v[i].z + v[i].w * v[i].w;
  }
  ss = wave_sum(ss);
  const float rs = rsqrtf(ss * (1.f / 1024.f) + EPSV);
#pragma unroll
  for (int i = 0; i < 4; ++i) {
    const int idx = i * 256 + lane * 4;
    if (copy_dst) *(float4*)(copy_dst + idx) = v[i];
    float4 gg = *(const float4*)(g + idx);
    float4 sc = *(const float4*)(scale + idx);
    float4 sh = *(const float4*)(shift + idx);
    float a = v[i].x * rs * gg.x * (1.f + sc.x) + sh.x;
    float b = v[i].y * rs * gg.y * (1.f + sc.y) + sh.y;
    float c = v[i].z * rs * gg.z * (1.f + sc.z) + sh.z;
    float d = v[i].w * rs * gg.w * (1.f + sc.w) + sh.w;
    uint2 o;
    o.x = pack2(a, b);
    o.y = pack2(c, d);
    *(uint2*)(hrow + idx) = o;
  }
}

__device__ __forceinline__ void phase_prep_b(const Params& p) {
  const int tid_ = opaque_tid(); const int lane = tid_ & 63, wv = tid_ >> 6;
  const float* modv = (const float*)(p.ws + OFF_MOD);
  bf16_t* H = (bf16_t*)(p.ws + OFF_H);
  for (int t = blockIdx.x * 4 + wv; t < NTOK; t += gridDim.x * 4) {
    const float* xr = (t < NPROMPT) ? p.in[0] + (size_t)t * 1024 : p.in[1] + (size_t)(t - NPROMPT) * 1024;
    const float* md = modv + (size_t)(0 * 9 + tok_mod(t)) * 6144;
    norm_token(xr, p.in[8], md + 1024, md, H + (size_t)t * 1024, p.out + (size_t)t * 1024, lane);
  }
}

__device__ __forceinline__ void phase_norm2(const Params& p, int l) {
  const int tid_ = opaque_tid(); const int lane = tid_ & 63, wv = tid_ >> 6;
  const float* modv = (const float*)(p.ws + OFF_MOD);
  bf16_t* H = (bf16_t*)(p.ws + OFF_H);
  for (int t = blockIdx.x * 4 + wv; t < NTOK; t += gridDim.x * 4) {
    const float* md = modv + (size_t)(l * 9 + tok_mod(t)) * 6144;
    norm_token(p.out + (size_t)t * 1024, p.in[9] + l * 1024, md + 4096, md + 3072, H + (size_t)t * 1024, nullptr, lane);
  }
}

template <int EPI>
__device__ __forceinline__ void gemm_phase(const bf16_t* __restrict__ A, const bf16_t* __restrict__ Bt, int ntiles_n,
                           bf16_t* __restrict__ C, int ldc, float* __restrict__ X, const float* __restrict__ ga,
                           unsigned char* smem) {
  bf16_t* As = (bf16_t*)smem;
  bf16_t* Bs = As + 128 * 72;
  const int tid = opaque_tid(), lane = tid & 63, w = tid >> 6, quad = lane >> 4, l15 = lane & 15;
  const int wm = w >> 1, wn = w & 1;
  const int lr = tid >> 3, lseg = (tid & 7) * 8;
  const int units = 192 * ntiles_n;
  for (int u = blockIdx.x; u < units; u += gridDim.x) {
    const int mt = u % 192, nt = u / 192;
    const int m0 = mt * 128, n0 = nt * 128;
    f32x4 acc[4][4];
#pragma unroll
    for (int i = 0; i < 4; ++i)
#pragma unroll
      for (int j = 0; j < 4; ++j) acc[i][j] = (f32x4){0.f, 0.f, 0.f, 0.f};
    const bf16_t* Ag = A + (size_t)(m0 + lr) * 1024 + lseg;
    const bf16_t* Bg = Bt + (size_t)(n0 + lr) * 1024 + lseg;
    u32x4 ra0, ra1, ra2, ra3, rb0, rb1, rb2, rb3;
    ra0 = *(const u32x4*)(Ag); ra1 = *(const u32x4*)(Ag + 32 * 1024); ra2 = *(const u32x4*)(Ag + 64 * 1024); ra3 = *(const u32x4*)(Ag + 96 * 1024);
    rb0 = *(const u32x4*)(Bg); rb1 = *(const u32x4*)(Bg + 32 * 1024); rb2 = *(const u32x4*)(Bg + 64 * 1024); rb3 = *(const u32x4*)(Bg + 96 * 1024);
    for (int kt = 0; kt < 16; ++kt) {
      *(u32x4*)(As + (lr) * 72 + lseg) = ra0; *(u32x4*)(As + (lr + 32) * 72 + lseg) = ra1;
      *(u32x4*)(As + (lr + 64) * 72 + lseg) = ra2; *(u32x4*)(As + (lr + 96) * 72 + lseg) = ra3;
      *(u32x4*)(Bs + (lr) * 72 + lseg) = rb0; *(u32x4*)(Bs + (lr + 32) * 72 + lseg) = rb1;
      *(u32x4*)(Bs + (lr + 64) * 72 + lseg) = rb2; *(u32x4*)(Bs + (lr + 96) * 72 + lseg) = rb3;
      __syncthreads();
      if (kt + 1 < 16) {
        const bf16_t* An = Ag + (kt + 1) * 64; const bf16_t* Bn = Bg + (kt + 1) * 64;
        ra0 = *(const u32x4*)(An); ra1 = *(const u32x4*)(An + 32 * 1024); ra2 = *(const u32x4*)(An + 64 * 1024); ra3 = *(const u32x4*)(An + 96 * 1024);
        rb0 = *(const u32x4*)(Bn); rb1 = *(const u32x4*)(Bn + 32 * 1024); rb2 = *(const u32x4*)(Bn + 64 * 1024); rb3 = *(const u32x4*)(Bn + 96 * 1024);
      }
#pragma unroll
      for (int kk = 0; kk < 2; ++kk) {
        bf16x8 af[4], bfr[4];
#pragma unroll
        for (int i = 0; i < 4; ++i) af[i] = ldfrag(As + (wm * 64 + i * 16 + l15) * 72 + kk * 32 + quad * 8);
#pragma unroll
        for (int j = 0; j < 4; ++j) bfr[j] = ldfrag(Bs + (wn * 64 + j * 16 + l15) * 72 + kk * 32 + quad * 8);
#pragma unroll
        for (int i = 0; i < 4; ++i)
#pragma unroll
          for (int j = 0; j < 4; ++j) acc[i][j] = mfma16(af[i], bfr[j], acc[i][j]);
      }
      __syncthreads();
    }
    if (EPI == 0) {
#pragma unroll
      for (int i = 0; i < 4; ++i)
#pragma unroll
        for (int j = 0; j < 4; ++j)
#pragma unroll
          for (int jj = 0; jj < 4; ++jj) {
            int row = m0 + wm * 64 + i * 16 + quad * 4 + jj;
            int col = n0 + wn * 64 + j * 16 + l15;
            C[(size_t)row * ldc + col] = f2bf(acc[i][j][jj]);
          }
    } else {
      const float* gam = ga + (size_t)tok_mod(m0) * 6144;
#pragma unroll
      for (int i = 0; i < 4; ++i)
#pragma unroll
        for (int j = 0; j < 4; ++j)
#pragma unroll
          for (int jj = 0; jj < 4; ++jj) {
            int row = m0 + wm * 64 + i * 16 + quad * 4 + jj;
            int col = n0 + wn * 64 + j * 16 + l15;
            float* xp = X + (size_t)row * 1024 + col;
            *xp = *xp + gam[col] * acc[i][j][jj];
          }
    }
  }
}

struct ChainItem {
  bool lng; int sl, dir, h, sq, tok0, nc;
};
__device__ __forceinline__ ChainItem decode_item(int it) {
  ChainItem c;
  c.lng = it < 256;
  int idx = c.lng ? it : it - 256;
  c.sl = idx & 3; c.dir = (idx >> 2) & 1; c.h = (idx >> 3) & 3; c.sq = idx >> 5;
  c.tok0 = c.lng ? NPROMPT + c.sq * 2048 : c.sq * 256;
  c.nc = c.lng ? 32 : 4;
  return c;
}

__device__ __forceinline__ void phase_ret_chain(const Params& p, int l, unsigned char* smem) {
  const int il = l >> 1;
  bf16_t* qs = (bf16_t*)smem;
  bf16_t* ks = qs + 64 * 72;
  bf16_t* kT = ks + 64 * 72;
  bf16_t* vT = kT + 64 * 72;
  bf16_t* intra = vT + 32 * 72;
  bf16_t* ST = intra + 64 * 72;
  const bf16_t* P = (const bf16_t*)(p.ws + OFF_P);
  float* odir = (float*)(p.ws + OFF_ODIR);
  const float2* rope = (const float2*)(p.ws + OFF_ROPE);
  const int tid = opaque_tid(), lane = tid & 63, w = tid >> 6, quad = lane >> 4, l15 = lane & 15;
  for (int it = blockIdx.x; it < 1280; it += gridDim.x) {
    const ChainItem ci = decode_item(it);
    const int sl = ci.sl, dir = ci.dir, h = ci.h;
    const float xg = p.in[13][(il * 2 + dir) * 4 + h];
    const float lg = -log1pf(expf(-xg));
    const float g64 = expf(lg * 64.f);
    f32x4 S[2];
    if (ci.lng) {
      const float* s0 = p.in[2] + ((((size_t)ci.sq * 2 + il) * 2 + dir) * 4 + h) * 8192;
#pragma unroll
      for (int ct = 0; ct < 2; ++ct)
#pragma unroll
        for (int jj = 0; jj < 4; ++jj) S[ct][jj] = s0[(16 * w + quad * 4 + jj) * 128 + sl * 32 + ct * 16 + l15];
    } else {
      S[0] = (f32x4){0.f, 0.f, 0.f, 0.f};
      S[1] = (f32x4){0.f, 0.f, 0.f, 0.f};
    }
    for (int n = 0; n < ci.nc; ++n) {
      const int cn = dir ? ci.nc - 1 - n : n;
      const int tb = ci.tok0 + cn * 64;
      {
        const int i = tid >> 2, mq = tid & 3;
        const int t = tb + (dir ? 63 - i : i);
        const bf16_t* pr = P + (size_t)t * PSTRIDE;
        float qa[8], qb[8], ka[8], kb[8];
        unpack8(*(const uint4*)(pr + h * 64 + mq * 8), qa);
        unpack8(*(const uint4*)(pr + h * 64 + 32 + mq * 8), qb);
        unpack8(*(const uint4*)(pr + 256 + h * 64 + mq * 8), ka);
        unpack8(*(const uint4*)(pr + 256 + h * 64 + 32 + mq * 8), kb);
        if (ci.lng) {
          const int pos = (mq < 2) ? cn : (t - tb);
          const int f0 = (mq & 1) * 8;
#pragma unroll
          for (int e = 0; e < 8; ++e) {
            float2 cs = rope[pos * 16 + f0 + e];
            float a = qa[e], b = qb[e];
            qa[e] = a * cs.x - b * cs.y; qb[e] = b * cs.x + a * cs.y;
            a = ka[e]; b = kb[e];
            ka[e] = a * cs.x - b * cs.y; kb[e] = b * cs.x + a * cs.y;
          }
        }
        const float wend = expf(lg * (float)(63 - i));
        uint4 o;
        o.x = pack2(qa[0], qa[1]); o.y = pack2(qa[2], qa[3]); o.z = pack2(qa[4], qa[5]); o.w = pack2(qa[6], qa[7]);
        *(uint4*)(qs + i * 72 + mq * 8) = o;
        o.x = pack2(qb[0], qb[1]); o.y = pack2(qb[2], qb[3]); o.z = pack2(qb[4], qb[5]); o.w = pack2(qb[6], qb[7]);
        *(uint4*)(qs + i * 72 + 32 + mq * 8) = o;
#pragma unroll
        for (int e = 0; e < 8; ++e) { ka[e] *= 0.125f; kb[e] *= 0.125f; }
        o.x = pack2(ka[0], ka[1]); o.y = pack2(ka[2], ka[3]); o.z = pack2(ka[4], ka[5]); o.w = pack2(ka[6], ka[7]);
        *(uint4*)(ks + i * 72 + mq * 8) = o;
        o.x = pack2(kb[0], kb[1]); o.y = pack2(kb[2], kb[3]); o.z = pack2(kb[4], kb[5]); o.w = pack2(kb[6], kb[7]);
        *(uint4*)(ks + i * 72 + 32 + mq * 8) = o;
#pragma unroll
        for (int e = 0; e < 8; ++e) {
          kT[(mq * 8 + e) * 72 + i] = f2bf(ka[e] * wend);
          kT[(32 + mq * 8 + e) * 72 + i] = f2bf(kb[e] * wend);
        }
        uint4 v8 = *(const uint4*)(pr + 512 + h * 128 + sl * 32 + mq * 8);
        vT[(mq * 8 + 0) * 72 + i] = (bf16_t)(v8.x & 0xffff); vT[(mq * 8 + 1) * 72 + i] = (bf16_t)(v8.x >> 16);
        vT[(mq * 8 + 2) * 72 + i] = (bf16_t)(v8.y & 0xffff); vT[(mq * 8 + 3) * 72 + i] = (bf16_t)(v8.y >> 16);
        vT[(mq * 8 + 4) * 72 + i] = (bf16_t)(v8.z & 0xffff); vT[(mq * 8 + 5) * 72 + i] = (bf16_t)(v8.z >> 16);
        vT[(mq * 8 + 6) * 72 + i] = (bf16_t)(v8.w & 0xffff); vT[(mq * 8 + 7) * 72 + i] = (bf16_t)(v8.w >> 16);
      }
      __syncthreads();
      const bf16x8 a0 = ldfrag(qs + (16 * w + l15) * 72 + quad * 8);
      const bf16x8 a1 = ldfrag(qs + (16 * w + l15) * 72 + 32 + quad * 8);
#pragma unroll
      for (int ct = 0; ct < 4; ++ct) {
        bf16x8 b0 = ldfrag(ks + (ct * 16 + l15) * 72 + quad * 8);
        bf16x8 b1 = ldfrag(ks + (ct * 16 + l15) * 72 + 32 + quad * 8);
        f32x4 c = (f32x4){0.f, 0.f, 0.f, 0.f};
        c = mfma16(a0, b0, c);
        c = mfma16(a1, b1, c);
#pragma unroll
        for (int jj = 0; jj < 4; ++jj) {
          int i = 16 * w + quad * 4 + jj, j = ct * 16 + l15;
          float val = (i >= j) ? c[jj] * expf(lg * (float)(i - j)) : 0.f;
          intra[i * 72 + j] = f2bf(val);
        }
      }
#pragma unroll
      for (int ct = 0; ct < 2; ++ct)
#pragma unroll
        for (int jj = 0; jj < 4; ++jj) ST[(ct * 16 + l15) * 72 + 16 * w + quad * 4 + jj] = f2bf(S[ct][jj]);
      __syncthreads();
      const bf16x8 ai0 = ldfrag(intra + (16 * w + l15) * 72 + quad * 8);
      const bf16x8 ai1 = ldfrag(intra + (16 * w + l15) * 72 + 32 + quad * 8);
      const bf16x8 ak0 = ldfrag(kT + (16 * w + l15) * 72 + quad * 8);
      const bf16x8 ak1 = ldfrag(kT + (16 * w + l15) * 72 + 32 + quad * 8);
#pragma unroll
      for (int ct = 0; ct < 2; ++ct) {
        bf16x8 bv0 = ldfrag(vT + (ct * 16 + l15) * 72 + quad * 8);
        bf16x8 bv1 = ldfrag(vT + (ct * 16 + l15) * 72 + 32 + quad * 8);
        bf16x8 bs0 = ldfrag(ST + (ct * 16 + l15) * 72 + quad * 8);
        bf16x8 bs1 = ldfrag(ST + (ct * 16 + l15) * 72 + 32 + quad * 8);
        f32x4 ci_ = (f32x4){0.f, 0.f, 0.f, 0.f}, cc = (f32x4){0.f, 0.f, 0.f, 0.f};
        ci_ = mfma16(ai0, bv0, ci_);
        ci_ = mfma16(ai1, bv1, ci_);
        cc = mfma16(a0, bs0, cc);
        cc = mfma16(a1, bs1, cc);
#pragma unroll
        for (int jj = 0; jj < 4; ++jj) {
          int i = 16 * w + quad * 4 + jj;
          int t = tb + (dir ? 63 - i : i);
          float o = ci_[jj] + expf(lg * (float)(i + 1)) * cc[jj];
          odir[((size_t)dir * NTOK + t) * 512 + h * 128 + sl * 32 + ct * 16 + l15] = o;
        }
        f32x4 s = S[ct];
        s[0] *= g64; s[1] *= g64; s[2] *= g64; s[3] *= g64;
        s = mfma16(ak0, bv0, s);
        s = mfma16(ak1, bv1, s);
        S[ct] = s;
      }
      __syncthreads();
    }
    if (!ci.lng) {
      float* so = p.out + 25165824 + ((((size_t)ci.sq * 2 + il) * 2 + dir) * 4 + h) * 8192;
#pragma unroll
      for (int ct = 0; ct < 2; ++ct)
#pragma unroll
        for (int jj = 0; jj < 4; ++jj) so[(16 * w + quad * 4 + jj) * 128 + sl * 32 + ct * 16 + l15] = S[ct][jj];
    }
  }
}

__device__ __forceinline__ void gdn_prep_item(const Params& p, int l, int pi, unsigned char* smem) {
  const int il = l >> 1;
  bf16_t* ks = (bf16_t*)smem;
  bf16_t* vs = ks + 64 * 136;
  float* Am = (float*)(vs + 64 * 136);
  float* rq = Am + 4096;
  float* rk = rq + 64;
  float* gcs = rk + 64;
  float* bet = gcs + 64;
  float* fac = bet + 64;
  bf16_t* qs = (bf16_t*)(fac + 128);
  const bf16_t* P = (const bf16_t*)(p.ws + OFF_P);
  unsigned char* gp = p.ws + OFF_GPREP + (size_t)pi * GP_ITEM;
  bf16_t* Wb = (bf16_t*)gp;
  bf16_t* QG = Wb + 8192;
  bf16_t* KDT = QG + 8192;
  bf16_t* Ub = KDT + 8192;
  bf16_t* ATT = Ub + 8192;
  float* EGL = (float*)(p.ws + OFF_EGL);
  const int tid = opaque_tid(), lane = tid & 63, w = tid >> 6, quad = lane >> 4, l15 = lane & 15;
  const int dir = pi & 1, h = (pi >> 1) & 3, c = pi >> 3;
  int tb, seq_lo, seq_hi;
  if (c < 128) { tb = c * 64; seq_lo = (c >> 2) * 256; seq_hi = seq_lo + 256; }
  else { int cc = c - 128; tb = NPROMPT + cc * 64; seq_lo = NPROMPT + (cc >> 5) * 2048; seq_hi = seq_lo + 2048; }
  const float SCALE = 0.08838834764831845f;
  {
    const int cg_ = tid & 127, rh = tid >> 7;
    for (int mat = 0; mat < 3; ++mat) {
      const int col = mat * 512 + h * 128 + cg_;
      const float* cw = p.in[18] + (size_t)il * 3 * 1536 + col;
      const float w0 = cw[0], w1 = cw[1536], w2 = cw[3072];
      bf16_t* dst = mat == 0 ? qs : (mat == 1 ? ks : vs);
      const int t0 = tb + rh * 32;
      bf16_t raw[34];
#pragma unroll
      for (int o = 0; o < 34; ++o) {
        const int t = t0 - 1 + o;
        const int tc = min(max(t, seq_lo), seq_hi - 1);
        const bf16_t rv = P[(size_t)tc * PSTRIDE + col];
        raw[o] = (t == tc) ? rv : (bf16_t)0;
      }
#pragma unroll
      for (int o = 0; o < 32; ++o) {
        float y = w0 * bf2f(raw[o]) + w1 * bf2f(raw[o + 1]) + w2 * bf2f(raw[o + 2]);
        y = siluf(y);
        const int oi = rh * 32 + o;
        const int i = dir ? 63 - oi : oi;
        dst[i * 136 + cg_] = f2bf(y);
      }
    }
  }
  __syncthreads();
  {
    const int r = tid >> 2, part = tid & 3;
    float sq_ = 0.f, sk_ = 0.f;
#pragma unroll 8
    for (int e = 0; e < 32; ++e) {
      float a = bf2f(qs[r * 136 + part * 32 + e]);
      float b = bf2f(ks[r * 136 + part * 32 + e]);
      sq_ += a * a; sk_ += b * b;
    }
    sq_ += __shfl_xor(sq_, 1); sq_ += __shfl_xor(sq_, 2);
    sk_ += __shfl_xor(sk_, 1); sk_ += __shfl_xor(sk_, 2);
    if (part == 0) {
      rq[r] = rsqrtf(sq_ + EPSV);
      rk[r] = rsqrtf(sk_ + EPSV);
      const int t = tb + (dir ? 63 - r : r);
      float a = bf2f(P[(size_t)t * PSTRIDE + 2048 + dir * 4 + h]);
      float bbv = bf2f(P[(size_t)t * PSTRIDE + 2056 + dir * 4 + h]);
      float al = p.in[19][(il * 2 + dir) * 4 + h], dtb = p.in[20][(il * 2 + dir) * 4 + h];
      float z = a + dtb;
      float sp = (z > 20.f) ? z : log1pf(expf(z));
      gcs[r] = -expf(al) * sp;
      bet[r] = 1.f / (1.f + expf(-bbv));
    }
  }
  __syncthreads();
  if (tid < 64) {
    float v = gcs[tid];
#pragma unroll
    for (int o = 1; o < 64; o <<= 1) {
      float u = __shfl_up(v, o);
      if (tid >= o) v += u;
    }
    gcs[tid] = v;
  }
  __syncthreads();
  {
    bf16x8 ak[4], aq[4];
#pragma unroll
    for (int kk = 0; kk < 4; ++kk) {
      ak[kk] = ldfrag(ks + (16 * w + l15) * 136 + kk * 32 + quad * 8);
      aq[kk] = ldfrag(qs + (16 * w + l15) * 136 + kk * 32 + quad * 8);
    }
#pragma unroll
    for (int ct = 0; ct < 4; ++ct) {
      f32x4 ckk = (f32x4){0.f, 0.f, 0.f, 0.f}, cqk = (f32x4){0.f, 0.f, 0.f, 0.f};
#pragma unroll
      for (int kk = 0; kk < 4; ++kk) {
        bf16x8 b = ldfrag(ks + (ct * 16 + l15) * 136 + kk * 32 + quad * 8);
        ckk = mfma16(ak[kk], b, ckk);
        cqk = mfma16(aq[kk], b, cqk);
      }
#pragma unroll
      for (int jj = 0; jj < 4; ++jj) {
        const int i = 16 * w + quad * 4 + jj, j = ct * 16 + l15;
        const float dec = (i >= j) ? expf(gcs[i] - gcs[j]) : 0.f;
        Am[j * 64 + i] = (i > j) ? bet[i] * rk[i] * rk[j] * ckk[jj] * dec : 0.f;
        ATT[i * 64 + j] = f2bf((i >= j) ? SCALE * rq[i] * rk[j] * cqk[jj] * dec : 0.f);
      }
    }
  }
  __syncthreads();
  const float gl = gcs[63];
  for (int e = tid; e < 64 * 128; e += 256) {
    int i = e >> 7, d = e & 127;
    QG[e] = f2bf(bf2f(qs[i * 136 + d]) * rq[i] * SCALE * __expf(gcs[i]));
  }
  for (int e = tid; e < 128 * 64; e += 256) {
    int d = e >> 6, i = e & 63;
    KDT[e] = f2bf(bf2f(ks[i * 136 + d]) * rk[i] * __expf(gl - gcs[i]));
  }
  if (tid < 64) {
    fac[tid] = bet[tid];
    fac[64 + tid] = rk[tid] * bet[tid] * __expf(gcs[tid]);
  }
  __syncthreads();
  {
    const int cidx = tid & 127;
    const bf16_t* srcm = ((tid < 128) ? vs : ks) + cidx;
    const float* fc = fac + ((tid < 128) ? 0 : 64);
    bf16_t* dstm = ((tid < 128) ? Ub : Wb) + cidx;
    bf16_t* XB = qs + tid;
#pragma unroll 1
    for (int b = 0; b < 4; ++b) {
      float x[16];
#pragma unroll
      for (int r = 0; r < 16; ++r) x[r] = bf2f(srcm[(16 * b + r) * 136]) * fc[16 * b + r];
      const float* arow = Am + 16 * b;
#pragma unroll 2
      for (int j = 0; j < 16 * b; ++j) {
        const float xv = bf2f(XB[j * 256]);
        const f32x4 a0 = *(const f32x4*)(arow + j * 64), a1 = *(const f32x4*)(arow + j * 64 + 4);
        const f32x4 a2 = *(const f32x4*)(arow + j * 64 + 8), a3 = *(const f32x4*)(arow + j * 64 + 12);
#pragma unroll
        for (int r = 0; r < 4; ++r) {
          x[r] -= a0[r] * xv; x[4 + r] -= a1[r] * xv; x[8 + r] -= a2[r] * xv; x[12 + r] -= a3[r] * xv;
        }
      }
      const float* ablk = Am + (16 * b) * 64 + 16 * b;
#pragma unroll
      for (int jj = 0; jj < 15; ++jj) {
#pragma unroll
        for (int r = jj + 1; r < 16; ++r) x[r] -= ablk[jj * 64 + r] * x[jj];
      }
#pragma unroll
      for (int r = 0; r < 16; ++r) {
        const bf16_t bb = f2bf(x[r]);
        dstm[(16 * b + r) * 128] = bb;
        if (b < 3) XB[(16 * b + r) * 256] = bb;
      }
    }
  }
  if (tid == 0) EGL[pi] = expf(gl);
  __syncthreads();
}

__device__ __forceinline__ void conf_conv_item(const Params& p, int l, int item, unsigned char* smem) {
  const int il = l >> 1;
  float* hc = (float*)smem;
  const bf16_t* P = (const bf16_t*)(p.ws + OFF_P);
  float* convout = (float*)(p.ws + OFF_CONV);
  const int tid = opaque_tid();
  const int tile = item >> 1, ch = (item & 1) * 256 + tid;
  const int t0 = tile * 32;
  int seq_lo, seq_hi;
  if (t0 < NPROMPT) { seq_lo = (t0 >> 8) << 8; seq_hi = seq_lo + 256; }
  else { seq_lo = NPROMPT + (((t0 - NPROMPT) >> 11) << 11); seq_hi = seq_lo + 2048; }
#pragma unroll 31
  for (int r = 0; r < 62; ++r) {
    const int tt = t0 - 15 + r;
    const int tc = min(max(tt, seq_lo), seq_hi - 1);
    float ca = bf2f(P[(size_t)tc * PSTRIDE + 2064 + ch]);
    float cgv = bf2f(P[(size_t)tc * PSTRIDE + 2576 + ch]);
    float v = ca * __builtin_amdgcn_rcpf(1.f + __expf(-cgv));
    hc[r * 256 + tid] = (tt == tc) ? v : 0.f;
  }
  float wk[31];
#pragma unroll
  for (int k = 0; k < 31; ++k) wk[k] = p.in[22][((size_t)il * 31 + k) * 512 + ch];
  const float bias = p.in[23][il * 512 + ch];
  for (int i = 0; i < 32; ++i) {
    float acc = bias;
#pragma unroll
    for (int k = 0; k < 31; ++k) acc += wk[k] * hc[(i + k) * 256 + tid];
    convout[(size_t)(t0 + i) * 512 + ch] = acc;
  }
}

__device__ __forceinline__ void phase_odd_prep(const Params& p, int l, unsigned char* smem, int rep) {
  for (int u = blockIdx.x; u < 3072 + 1536; u += gridDim.x) {
#if PROBE_ODD == 1
    if (rep && u >= 3072) break;
#elif PROBE_ODD == 2
    if (rep && u < 3072) continue;
#endif
    if (u < 3072) gdn_prep_item(p, l, u, smem);
    else { conf_conv_item(p, l, u - 3072, smem); __syncthreads(); }
  }
}

__device__ __forceinline__ void phase_gdn_chain(const Params& p, int l, unsigned char* smem) {
  const int il = l >> 1;
  bf16_t* ST = (bf16_t*)smem;
  bf16_t* VT = ST + 32 * 136;
  float* odir = (float*)(p.ws + OFF_ODIR);
  const float* EGL = (const float*)(p.ws + OFF_EGL);
  const int tid = opaque_tid(), lane = tid & 63, w = tid >> 6, quad = lane >> 4, l15 = lane & 15;
  for (int it = blockIdx.x; it < 1280; it += gridDim.x) {
    const ChainItem ci = decode_item(it);
    const int sl = ci.sl, dir = ci.dir, h = ci.h;
    f32x4 S[2][2];
    if (ci.lng) {
      const float* s0 = p.in[3] + ((((size_t)ci.sq * 2 + il) * 2 + dir) * 4 + h) * 16384;
#pragma unroll
      for (int rb = 0; rb < 2; ++rb)
#pragma unroll
        for (int ct = 0; ct < 2; ++ct)
#pragma unroll
          for (int jj = 0; jj < 4; ++jj)
            S[rb][ct][jj] = s0[(16 * (2 * w + rb) + quad * 4 + jj) * 128 + sl * 32 + ct * 16 + l15];
    } else {
#pragma unroll
      for (int rb = 0; rb < 2; ++rb)
#pragma unroll
        for (int ct = 0; ct < 2; ++ct) S[rb][ct] = (f32x4){0.f, 0.f, 0.f, 0.f};
    }
    for (int n = 0; n < ci.nc; ++n) {
      const int cn = dir ? ci.nc - 1 - n : n;
      const int tb = ci.tok0 + cn * 64;
      const int cglob = ci.lng ? 128 + ci.sq * 32 + cn : ci.sq * 4 + cn;
      const int pi = (cglob * 4 + h) * 2 + dir;
      const unsigned char* gp = p.ws + OFF_GPREP + (size_t)pi * GP_ITEM;
      const bf16_t* Wb = (const bf16_t*)gp;
      const bf16_t* QG = Wb + 8192;
      const bf16_t* KDT = QG + 8192;
      const bf16_t* Ub = KDT + 8192;
      const bf16_t* ATT = Ub + 8192;
      bf16x8 aw[4], aqg[4], aat[2], akd[2][2];
      float uu[2][4];
#pragma unroll
      for (int kk = 0; kk < 4; ++kk) {
        aw[kk] = ldfrag(Wb + (16 * w + l15) * 128 + kk * 32 + quad * 8);
        aqg[kk] = ldfrag(QG + (16 * w + l15) * 128 + kk * 32 + quad * 8);
      }
#pragma unroll
      for (int kk = 0; kk < 2; ++kk) {
        aat[kk] = ldfrag(ATT + (16 * w + l15) * 64 + kk * 32 + quad * 8);
#pragma unroll
        for (int rb = 0; rb < 2; ++rb) akd[rb][kk] = ldfrag(KDT + (16 * (2 * w + rb) + l15) * 64 + kk * 32 + quad * 8);
      }
#pragma unroll
      for (int ct = 0; ct < 2; ++ct)
#pragma unroll
        for (int jj = 0; jj < 4; ++jj) uu[ct][jj] = bf2f(Ub[(16 * w + quad * 4 + jj) * 128 + sl * 32 + ct * 16 + l15]);
      const float egl = EGL[pi];
#pragma unroll
      for (int rb = 0; rb < 2; ++rb)
#pragma unroll
        for (int ct = 0; ct < 2; ++ct)
#pragma unroll
          for (int jj = 0; jj < 4; ++jj)
            ST[(ct * 16 + l15) * 136 + 16 * (2 * w + rb) + quad * 4 + jj] = f2bf(S[rb][ct][jj]);
      __syncthreads();
      f32x4 co[2];
#pragma unroll
      for (int ct = 0; ct < 2; ++ct) {
        f32x4 cv = (f32x4){0.f, 0.f, 0.f, 0.f};
        co[ct] = (f32x4){0.f, 0.f, 0.f, 0.f};
#pragma unroll
        for (int kk = 0; kk < 4; ++kk) {
          bf16x8 b = ldfrag(ST + (ct * 16 + l15) * 136 + kk * 32 + quad * 8);
          cv = mfma16(aw[kk], b, cv);
          co[ct] = mfma16(aqg[kk], b, co[ct]);
        }
#pragma unroll
        for (int jj = 0; jj < 4; ++jj) {
          float vn = uu[ct][jj] - cv[jj];
          VT[(ct * 16 + l15) * 72 + 16 * w + quad * 4 + jj] = f2bf(vn);
        }
      }
      __syncthreads();
#pragma unroll
      for (int ct = 0; ct < 2; ++ct) {
        bf16x8 bv[2];
#pragma unroll
        for (int kk = 0; kk < 2; ++kk) {
          bv[kk] = ldfrag(VT + (ct * 16 + l15) * 72 + kk * 32 + quad * 8);
          co[ct] = mfma16(aat[kk], bv[kk], co[ct]);
        }
#pragma unroll
        for (int jj = 0; jj < 4; ++jj) {
          int i = 16 * w + quad * 4 + jj;
          int t = tb + (dir ? 63 - i : i);
          odir[((size_t)dir * NTOK + t) * 512 + h * 128 + sl * 32 + ct * 16 + l15] = co[ct][jj];
        }
#pragma unroll
        for (int rb = 0; rb < 2; ++rb) {
          f32x4 s = S[rb][ct];
          s[0] *= egl; s[1] *= egl; s[2] *= egl; s[3] *= egl;
          s = mfma16(akd[rb][0], bv[0], s);
          s = mfma16(akd[rb][1], bv[1], s);
          S[rb][ct] = s;
        }
      }
    }
    __syncthreads();
    if (!ci.lng) {
      float* so = p.out + 29360128 + ((((size_t)ci.sq * 2 + il) * 2 + dir) * 4 + h) * 16384;
#pragma unroll
      for (int rb = 0; rb < 2; ++rb)
#pragma unroll
        for (int ct = 0; ct < 2; ++ct)
#pragma unroll
          for (int jj = 0; jj < 4; ++jj)
            so[(16 * (2 * w + rb) + quad * 4 + jj) * 128 + sl * 32 + ct * 16 + l15] = S[rb][ct][jj];
    }
  }
}

__device__ __forceinline__ void phase_mix_out(const Params& p, int l) {
  const int il = l >> 1;
  const bool odd = l & 1;
  const int tid_ = opaque_tid(); const int lane = tid_ & 63, wv = tid_ >> 6;
  const bf16_t* P = (const bf16_t*)(p.ws + OFF_P);
  const float* od0 = (const float*)(p.ws + OFF_ODIR);
  const float* od1 = od0 + (size_t)NTOK * 512;
  const float* convout = (const float*)(p.ws + OFF_CONV);
  bf16_t* Y = (bf16_t*)(p.ws + OFF_YMIX);
  for (int t = blockIdx.x * 4 + wv; t < NTOK; t += gridDim.x * 4) {
    const bf16_t* pr = P + (size_t)t * PSTRIDE;
    bf16_t* yr = Y + (size_t)t * 1024;
#pragma unroll
    for (int h = 0; h < 4; ++h) {
      const int idx = h * 128 + lane * 2;
      float2 a = *(const float2*)(od0 + (size_t)t * 512 + idx);
      float2 b = *(const float2*)(od1 + (size_t)t * 512 + idx);
      float o0 = a.x + b.x, o1 = a.y + b.y;
      float ss = wave_sum(o0 * o0 + o1 * o1);
      float rs = rsqrtf(ss * (1.f / 128.f) + EPSV);
      float n0, n1;
      unsigned gz;
      if (!odd) {
        n0 = p.in[14][il * 512 + idx]; n1 = p.in[14][il * 512 + idx + 1];
        gz = *(const unsigned*)(pr + 1024 + idx);
      } else {
        n0 = p.in[21][il * 128 + lane * 2]; n1 = p.in[21][il * 128 + lane * 2 + 1];
        gz = *(const unsigned*)(pr + 1536 + idx);
      }
      float y0 = siluf(bflo(gz)) * o0 * rs * n0;
      float y1 = siluf(bfhi(gz)) * o1 * rs * n1;
      *(unsigned*)(yr + idx) = pack2(y0, y1);
    }
    if (!odd) {
      int seq_lo, seq_hi;
      if (t < NPROMPT) { seq_lo = (t >> 8) << 8; seq_hi = seq_lo + 256; }
      else { seq_lo = NPROMPT + (((t - NPROMPT) >> 11) << 11); seq_hi = seq_lo + 2048; }
      const bool hp = (t - 1 >= seq_lo), hn = (t + 1 < seq_hi);
#pragma unroll
      for (int j = 0; j < 4; ++j) {
        const int c = j * 128 + lane * 2;
        unsigned cg0 = *(const unsigned*)(pr + 2048 + c), hb0 = *(const unsigned*)(pr + 2560 + c);
        const bf16_t* prm = hp ? pr - PSTRIDE : pr;
        const bf16_t* prp = hn ? pr + PSTRIDE : pr;
        unsigned cgm = *(const unsigned*)(prm + 2048 + c), hbm = *(const unsigned*)(prm + 2560 + c);
        unsigned cgp = *(const unsigned*)(prp + 2048 + c), hbp = *(const unsigned*)(prp + 2560 + c);
        if (!hp) { cgm = 0; hbm = 0; }
        if (!hn) { cgp = 0; hbp = 0; }
        unsigned bg = *(const unsigned*)(pr + 1536 + c);
        const float* sw = p.in[15] + (size_t)il * 3 * 512 + c;
        float y0 = bflo(bg) * (sw[0] * bflo(cgm) * bflo(hbm) + sw[512] * bflo(cg0) * bflo(hb0) + sw[1024] * bflo(cgp) * bflo(hbp));
        float y1 = bfhi(bg) * (sw[1] * bfhi(cgm) * bfhi(hbm) + sw[513] * bfhi(cg0) * bfhi(hb0) + sw[1025] * bfhi(cgp) * bfhi(hbp));
        *(unsigned*)(yr + 512 + c) = pack2(y0, y1);
      }
    } else {
      float v[8];
      float s = 0.f;
#pragma unroll
      for (int j = 0; j < 4; ++j) {
        float2 a = *(const float2*)(convout + (size_t)t * 512 + j * 128 + lane * 2);
        v[2 * j] = a.x; v[2 * j + 1] = a.y;
        s += a.x + a.y;
      }
      const float mean = wave_sum(s) * (1.f / 512.f);
      float vs = 0.f;
#pragma unroll
      for (int j = 0; j < 8; ++j) { v[j] -= mean; vs += v[j] * v[j]; }
      const float rstd = rsqrtf(wave_sum(vs) * (1.f / 512.f) + EPSV);
#pragma unroll
      for (int j = 0; j < 4; ++j) {
        const int c = j * 128 + lane * 2;
        float y0 = v[2 * j] * rstd * p.in[24][il * 512 + c] + p.in[25][il * 512 + c];
        float y1 = v[2 * j + 1] * rstd * p.in[24][il * 512 + c + 1] + p.in[25][il * 512 + c + 1];
        *(unsigned*)(yr + 512 + c) = pack2(siluf(y0), siluf(y1));
      }
    }
  }
}

#define CE_DESC(a, b) { unsigned _mx = max(a, b), _mn = min(a, b); a = _mx; b = _mn; }
#define CE_ASC(a, b) { unsigned _mx = max(a, b), _mn = min(a, b); a = _mn; b = _mx; }
__device__ __forceinline__ void sort16_desc(unsigned* v) {
#pragma unroll
  for (int k = 2; k <= 16; k <<= 1) {
#pragma unroll
    for (int j = k >> 1; j > 0; j >>= 1) {
#pragma unroll
      for (int i = 0; i < 16; ++i) {
        const int l = i ^ j;
        if (l > i) {
          if ((i & k) == 0) CE_DESC(v[i], v[l]) else CE_ASC(v[i], v[l])
        }
      }
    }
  }
}
__device__ __forceinline__ void merge16_top(unsigned* a, const unsigned* b) {
#pragma unroll
  for (int i = 0; i < 16; ++i) a[i] = max(a[i], b[15 - i]);
#pragma unroll
  for (int j = 8; j > 0; j >>= 1) {
#pragma unroll
    for (int i = 0; i < 16; ++i) {
      const int l = i ^ j;
      if (l > i) CE_DESC(a[i], a[l])
    }
  }
}
__device__ __forceinline__ void phase_peer_score(const Params& p, int l, unsigned char* smem) {
  const int tid = opaque_tid(), lane = tid & 63, w = tid >> 6, quad = lane >> 4, l15 = lane & 15;
  unsigned* scw = (unsigned*)smem + w * (32 * 132 + 512);
  unsigned* sel = scw + 32 * 132;
  const bf16_t* Q = (const bf16_t*)(p.ws + OFF_Q);
  const bf16_t* KB = (const bf16_t*)(p.ws + OFF_KEYS) + (size_t)l * 8 * 2 * 128 * 128;
  int* EI = (int*)(p.ws + OFF_EIDX);
  float* GT = (float*)(p.ws + OFF_GATE);
  for (int u = blockIdx.x; u < 3072; u += gridDim.x) {
    const int tt = u >> 1, h = (u & 1) * 4 + w;
    const int t0 = tt * 16;
#pragma unroll
    for (int pp = 0; pp < 2; ++pp) {
      bf16x8 a[4];
#pragma unroll
      for (int kk = 0; kk < 4; ++kk) a[kk] = ldfrag(Q + (size_t)(t0 + l15) * 2048 + h * 256 + pp * 128 + kk * 32 + quad * 8);
      const bf16_t* kb = KB + (size_t)((h * 2 + pp) * 128) * 128;
#pragma unroll
      for (int ct = 0; ct < 8; ++ct) {
        f32x4 c = (f32x4){0.f, 0.f, 0.f, 0.f};
#pragma unroll
        for (int kk = 0; kk < 4; ++kk) {
          bf16x8 b = ldfrag(kb + (ct * 16 + l15) * 128 + kk * 32 + quad * 8);
          c = mfma16(a[kk], b, c);
        }
#pragma unroll
        for (int jj = 0; jj < 4; ++jj) {
          const int row = pp * 16 + quad * 4 + jj, col = ct * 16 + l15;
          unsigned key = (fkey(c[jj]) & ~127u) | (unsigned)(127 - col);
          scw[row * 132 + col] = key;
        }
      }
    }
    __syncthreads();
    {
      const int row = lane >> 1, hf = lane & 1;
      const u32x4* rp = (const u32x4*)(scw + row * 132 + hf * 64);
      unsigned g0[16], g1[16];
#pragma unroll
      for (int q = 0; q < 4; ++q) { u32x4 t4 = rp[q]; g0[4 * q] = t4[0]; g0[4 * q + 1] = t4[1]; g0[4 * q + 2] = t4[2]; g0[4 * q + 3] = t4[3]; }
#pragma unroll
      for (int q = 0; q < 4; ++q) { u32x4 t4 = rp[4 + q]; g1[4 * q] = t4[0]; g1[4 * q + 1] = t4[1]; g1[4 * q + 2] = t4[2]; g1[4 * q + 3] = t4[3]; }
      sort16_desc(g0);
      sort16_desc(g1);
      merge16_top(g0, g1);
#pragma unroll
      for (int q = 0; q < 4; ++q) { u32x4 t4 = rp[8 + q]; g1[4 * q] = t4[0]; g1[4 * q + 1] = t4[1]; g1[4 * q + 2] = t4[2]; g1[4 * q + 3] = t4[3]; }
      sort16_desc(g1);
      merge16_top(g0, g1);
#pragma unroll
      for (int q = 0; q < 4; ++q) { u32x4 t4 = rp[12 + q]; g1[4 * q] = t4[0]; g1[4 * q + 1] = t4[1]; g1[4 * q + 2] = t4[2]; g1[4 * q + 3] = t4[3]; }
      sort16_desc(g1);
      merge16_top(g0, g1);
#pragma unroll
      for (int i = 0; i < 16; ++i) g1[i] = (unsigned)__shfl_xor((int)g0[i], 1);
      merge16_top(g0, g1);
      if (hf == 0) {
#pragma unroll
        for (int q = 0; q < 4; ++q) {
          u32x4 t4 = {g0[4 * q], g0[4 * q + 1], g0[4 * q + 2], g0[4 * q + 3]};
          *(u32x4*)(sel + row * 16 + 4 * q) = t4;
        }
      }
    }
    __syncthreads();
    {
      const int tok = lane >> 2, sub = lane & 3;
      const unsigned* s1 = sel + tok * 16;
      const unsigned* s2 = sel + (16 + tok) * 16;
      unsigned ck[13];
#pragma unroll
      for (int i = 0; i < 13; ++i) {
        const int cidx = sub + 4 * i;
        const int a = CAND_A[cidx], b = CAND_B[cidx];
        float s = keyf(s1[a] & ~127u) + keyf(s2[b] & ~127u);
        unsigned k = (fkey(s) & ~255u) | (unsigned)(255 - (a * 16 + b));
        ck[i] = (cidx < 50) ? k : 0u;
      }
      unsigned prev = 0xFFFFFFFFu;
      unsigned top[16];
#pragma unroll
      for (int r = 0; r < 16; ++r) {
        unsigned best = 0;
#pragma unroll
        for (int i = 0; i < 13; ++i) {
          unsigned tsel = (ck[i] < prev) ? ck[i] : 0u;
          best = max(best, tsel);
        }
        best = max(best, (unsigned)__shfl_xor((int)best, 1));
        best = max(best, (unsigned)__shfl_xor((int)best, 2));
        prev = best;
        top[r] = best;
      }
      float sv[16];
      int ev[16];
#pragma unroll
      for (int r = 0; r < 16; ++r) {
        const int cidx = 255 - (int)(top[r] & 255u);
        const int a = cidx >> 4, b = cidx & 15;
        const unsigned k1 = s1[a], k2 = s2[b];
        sv[r] = keyf(k1 & ~127u) + keyf(k2 & ~127u);
        ev[r] = (127 - (int)(k1 & 127u)) * 128 + (127 - (int)(k2 & 127u));
      }
      float mx = sv[0];
#pragma unroll
      for (int r = 1; r < 16; ++r) mx = fmaxf(mx, sv[r]);
      float sum = 0.f;
#pragma unroll
      for (int r = 0; r < 16; ++r) { sv[r] = expf(sv[r] - mx); sum += sv[r]; }
      const float inv = 1.f / sum;
      const size_t ob = (size_t)(t0 + tok) * 128 + h * 16;
#pragma unroll
      for (int r = 0; r < 16; ++r) {
        if ((r & 3) == sub) { EI[ob + r] = ev[r]; GT[ob + r] = sv[r] * inv; }
      }
    }
    __syncthreads();
  }
}

__device__ __forceinline__ float gelu_tanh(float x) {
  return 0.5f * x * (1.f + tanhf(0.7978845608028654f * (x + 0.044715f * x * x * x)));
}
__device__ __forceinline__ void phase_peer_gather(const Params& p, int l) {
  const int tid_ = opaque_tid(); const int lane = tid_ & 63, wv = tid_ >> 6;
  const bf16_t* H = (const bf16_t*)(p.ws + OFF_H);
  bf16_t* Hw = (bf16_t*)(p.ws + OFF_H);
  const unsigned char* UB = p.ws + OFF_UB + (size_t)l * 16384 * 1024;
  const unsigned char* VB = p.ws + OFF_VB + (size_t)l * 16384 * 1024;
  const int* EI = (const int*)(p.ws + OFF_EIDX);
  const float* GT = (const float*)(p.ws + OFF_GATE);
  const float* modv = (const float*)(p.ws + OFF_MOD);
  for (int t = blockIdx.x * 4 + wv; t < NTOK; t += gridDim.x * 4) {
    float xf[16];
    unpack8(*(const uint4*)(H + (size_t)t * 1024 + lane * 16), xf);
    unpack8(*(const uint4*)(H + (size_t)t * 1024 + lane * 16 + 8), xf + 8);
    float out[16];
#pragma unroll
    for (int e = 0; e < 16; ++e) out[e] = 0.f;
    float coef[2];
    int eix[2];
#pragma unroll
    for (int hf = 0; hf < 2; ++hf) {
      const int ev = EI[(size_t)t * 128 + hf * 64 + lane];
      const float gv = GT[(size_t)t * 128 + hf * 64 + lane];
      float cacc = 0.f;
      for (int k = 0; k < 64; k += 8) {
        u32x4 rows[8];
#pragma unroll
        for (int j = 0; j < 8; ++j) {
          const int e = __builtin_amdgcn_readlane(ev, k + j);
          rows[j] = *(const u32x4*)(UB + (size_t)e * 1024 + lane * 16);
        }
        float d[8];
#pragma unroll
        for (int j = 0; j < 8; ++j) {
          float uf[16];
          unpack16_fp8(rows[j], uf);
          float sacc = 0.f;
#pragma unroll
          for (int q = 0; q < 16; ++q) sacc += uf[q] * xf[q];
          d[j] = sacc;
        }
        {
          const bool b5 = lane & 32, b4 = lane & 16, b3 = lane & 8;
          float e4[4], e2[2], e1;
#pragma unroll
          for (int j = 0; j < 4; ++j) {
            float snd = b5 ? d[j] : d[j + 4];
            float kep = b5 ? d[j + 4] : d[j];
            e4[j] = kep + __shfl_xor(snd, 32);
          }
#pragma unroll
          for (int j = 0; j < 2; ++j) {
            float snd = b4 ? e4[j] : e4[j + 2];
            float kep = b4 ? e4[j + 2] : e4[j];
            e2[j] = kep + __shfl_xor(snd, 16);
          }
          {
            float snd = b3 ? e2[0] : e2[1];
            float kep = b3 ? e2[1] : e2[0];
            e1 = kep + __shfl_xor(snd, 8);
          }
          e1 += __shfl_xor(e1, 4);
          e1 += __shfl_xor(e1, 2);
          e1 += __shfl_xor(e1, 1);
          const int jj = lane & 7;
          const int srcl = ((jj >> 2) & 1) * 32 + ((jj >> 1) & 1) * 16 + (jj & 1) * 8;
          const float tot = __shfl(e1, srcl);
          if ((lane >> 3) == (k >> 3)) cacc = tot;
        }
      }
      coef[hf] = gelu_tanh(cacc * (1.f / U_SCALE)) * gv * (1.f / V_SCALE);
      eix[hf] = ev;
    }
#pragma unroll
    for (int hf = 0; hf < 2; ++hf) {
      for (int k = 0; k < 64; k += 8) {
        u32x4 rows[8];
#pragma unroll
        for (int j = 0; j < 8; ++j) {
          const int e = __builtin_amdgcn_readlane(eix[hf], k + j);
          rows[j] = *(const u32x4*)(VB + (size_t)e * 1024 + lane * 16);
        }
#pragma unroll
        for (int j = 0; j < 8; ++j) {
          const float cf = __uint_as_float((unsigned)__builtin_amdgcn_readlane((int)__float_as_uint(coef[hf]), k + j));
          float vf[16];
          unpack16_fp8(rows[j], vf);
#pragma unroll
          for (int q = 0; q < 16; ++q) out[q] += cf * vf[q];
        }
      }
    }
    const int m = tok_mod(t);
    const float* ga2 = modv + (size_t)(l * 9 + m) * 6144 + 5120;
    float* xr = p.out + (size_t)t * 1024 + lane * 16;
    float xn[16];
    float ss = 0.f;
#pragma unroll
    for (int q4 = 0; q4 < 4; ++q4) {
      float4 xv = *(const float4*)(xr + q4 * 4);
      float4 gg = *(const float4*)(ga2 + lane * 16 + q4 * 4);
      const int o = q4 * 4;
      xn[o + 0] = xv.x + gg.x * out[o + 0];
      xn[o + 1] = xv.y + gg.y * out[o + 1];
      xn[o + 2] = xv.z + gg.z * out[o + 2];
      xn[o + 3] = xv.w + gg.w * out[o + 3];
      ss += xn[o] * xn[o] + xn[o + 1] * xn[o + 1] + xn[o + 2] * xn[o + 2] + xn[o + 3] * xn[o + 3];
    }
    ss = wave_sum(ss);
    const float rs = rsqrtf(ss * (1.f / 1024.f) + EPSV);
    if (l < 3) {
      const float* md = modv + (size_t)((l + 1) * 9 + m) * 6144 + lane * 16;
      const float* g = p.in[8] + (l + 1) * 1024 + lane * 16;
      float hv[16];
#pragma unroll
      for (int q = 0; q < 16; ++q) hv[q] = xn[q] * rs * g[q] * (1.f + md[1024 + q]) + md[q];
      uint4 o;
      o.x = pack2(hv[0], hv[1]); o.y = pack2(hv[2], hv[3]); o.z = pack2(hv[4], hv[5]); o.w = pack2(hv[6], hv[7]);
      *(uint4*)(Hw + (size_t)t * 1024 + lane * 16) = o;
      o.x = pack2(hv[8], hv[9]); o.y = pack2(hv[10], hv[11]); o.z = pack2(hv[12], hv[13]); o.w = pack2(hv[14], hv[15]);
      *(uint4*)(Hw + (size_t)t * 1024 + lane * 16 + 8) = o;
#pragma unroll
      for (int q4 = 0; q4 < 4; ++q4) *(float4*)(xr + q4 * 4) = make_float4(xn[q4 * 4], xn[q4 * 4 + 1], xn[q4 * 4 + 2], xn[q4 * 4 + 3]);
    } else {
      const float* g = p.in[10] + lane * 16;
#pragma unroll
      for (int q4 = 0; q4 < 4; ++q4)
        *(float4*)(xr + q4 * 4) = make_float4(xn[q4 * 4] * rs * g[q4 * 4], xn[q4 * 4 + 1] * rs * g[q4 * 4 + 1],
                                              xn[q4 * 4 + 2] * rs * g[q4 * 4 + 2], xn[q4 * 4 + 3] * rs * g[q4 * 4 + 3]);
    }
  }
}

#define XB_TMO      128
#define XB_XCNT(j)  (256  + 64 * (j))
#define XB_XSUB(j)  (1280 + 64 * (j))
#define XB_XGEN(j)  (2304 + 64 * (j))
#define XB_TOP      3328
#define XB_TOPGEN   3392
#define XCD_BAR_WORDS 3456
#define XB_SPIN_CAP (1u << 18)
#define LAS __attribute__((address_space(3)))

__device__ __forceinline__ unsigned xb_ld(unsigned* p)              { return __hip_atomic_load(p, __ATOMIC_RELAXED, __HIP_MEMORY_SCOPE_AGENT); }
__device__ __forceinline__ unsigned xb_add(unsigned* p, unsigned v) { return __hip_atomic_fetch_add(p, v, __ATOMIC_RELAXED, __HIP_MEMORY_SCOPE_AGENT); }
__device__ __forceinline__ unsigned xb_xcc_id() { return (unsigned)__builtin_amdgcn_s_getreg((3 << 11) | 20) & 0xFu; }
#define XB_SPIN(cond, bar) do { unsigned _sp = 0; while (cond) { __builtin_amdgcn_s_sleep(1); \
    if ((++_sp & 255u) == 0u) { if (xb_ld(&(bar)[XB_TMO])) break; if (_sp > XB_SPIN_CAP) { atomicAdd(&(bar)[XB_TMO], 1u); break; } } } } while (0)

struct XcdBarrier {
    unsigned* bar; unsigned x;
    volatile LAS unsigned* st;
};

__device__ __forceinline__ XcdBarrier xcd_barrier_post(unsigned* bar, volatile LAS unsigned* st) {
    XcdBarrier b; b.bar = bar; b.x = xb_xcc_id(); b.st = st;
    if (threadIdx.x == 0) (void)xb_add(&bar[XB_XCNT(b.x)], 1u);
    return b;
}
__device__ __forceinline__ void xcd_barrier_complete(unsigned* bar, unsigned x, unsigned& nloc, unsigned& nx) {
    const unsigned G = gridDim.x * gridDim.y * gridDim.z;
    unsigned sum, cnt, mine, sp = 0u;
    for (;;) {
        sum = 0u; cnt = 0u; mine = 0u;
#pragma unroll
        for (unsigned j = 0; j < 16; ++j) { const unsigned c = xb_ld(&bar[XB_XCNT(j)]); sum += c; cnt += (c > 0u) ? 1u : 0u; mine = (j == x) ? c : mine; }
        if (sum == G) break;
        __builtin_amdgcn_s_sleep(1);
        if ((++sp & 255u) == 0u) { if (xb_ld(&bar[XB_TMO])) break; if (sp > XB_SPIN_CAP) { atomicAdd(&bar[XB_TMO], 1u); break; } }
    }
    nloc = mine > 0u ? mine : 1u; nx = cnt > 0u ? cnt : 1u;
}

__device__ __forceinline__ void xcd_barrier(const XcdBarrier& b) {
    asm volatile("s_waitcnt vmcnt(0)" ::: "memory");
    __syncthreads();
    if (threadIdx.x == 0) {
        unsigned* bar = b.bar;
        __builtin_amdgcn_s_waitcnt(0);
        unsigned nloc = b.st[0], nx = b.st[1];
        if (nloc == 0u) { xcd_barrier_complete(bar, b.x, nloc, nx); b.st[0] = nloc; b.st[1] = nx; }
        const unsigned old = xb_add(&bar[XB_XSUB(b.x)], 1u);
        const unsigned gen = old / nloc;
        if (old + 1u == (gen + 1u) * nloc) {
            __builtin_amdgcn_fence(__ATOMIC_RELEASE, "agent");
            asm volatile("s_waitcnt vmcnt(0)" ::: "memory");
            const unsigned og = xb_add(&bar[XB_TOP], 1u);
            const unsigned tg = og / nx;
            if (og + 1u == (tg + 1u) * nx) xb_add(&bar[XB_TOPGEN], 1u);
            else XB_SPIN(xb_ld(&bar[XB_TOPGEN]) == tg, bar);
            __builtin_amdgcn_fence(__ATOMIC_ACQUIRE, "agent");
            xb_add(&bar[XB_XGEN(b.x)], 1u);
            asm volatile("s_waitcnt vmcnt(0)" ::: "memory");
        } else {
            XB_SPIN(xb_ld(&bar[XB_XGEN(b.x)]) == gen, bar);
            __builtin_amdgcn_fence(__ATOMIC_ACQUIRE, "agent");
            asm volatile("s_waitcnt vmcnt(0)" ::: "memory");
        }
    }
    __syncthreads();
}

__global__ void __launch_bounds__(256, 2) mega(Params p, int ph_lo, int ph_hi) {
  __shared__ __attribute__((aligned(16))) unsigned char smem[77312];
  cg::grid_group grid = cg::this_grid();
  __shared__ uint4 xb_words;
  if (threadIdx.x == 0) xb_words = make_uint4(0u, 0u, 0u, 0u);
  __syncthreads();
  XcdBarrier xb = xcd_barrier_post((unsigned*)(p.ws + OFF_BAR), (volatile LAS unsigned*)&xb_words);
  if (ph_hi > 100000) grid.sync();
  for (int ph = ph_lo; ph < ph_hi; ++ph) {
#if PROBE_MASK
    const int pcode = ph < 2 ? ph : 2 + (ph - 2) % 9;
    const int nrep = ((PROBE_MASK >> pcode) & 1) ? 2 : 1;
    for (int rep = 0; rep < nrep; ++rep) {
    if (rep) xcd_barrier(xb);
#endif
    bool did = true;
#if PROBE_MASK
    const int prep_rep = rep;
#else
    const int prep_rep = 0;
#endif
    if (ph == 0) phase_prep_a(p, smem);
    else if (ph == 1) phase_prep_b(p);
    else {
      const int l = (ph - 2) / 9, sub = (ph - 2) % 9;
      const int il = l >> 1;
      const bool odd = l & 1;
      const float* modv = (const float*)(p.ws + OFF_MOD);
      if (sub == 0 || sub == 6) {
        const bf16_t* Bt; int ntn, ldc; bf16_t* C;
        if (sub == 0) {
          Bt = odd ? (const bf16_t*)(p.ws + OFF_WIN_OD) + (size_t)il * 3200 * 1024
                   : (const bf16_t*)(p.ws + OFF_WIN_EV) + (size_t)il * 3072 * 1024;
          ntn = odd ? 25 : 24; ldc = PSTRIDE; C = (bf16_t*)(p.ws + OFF_P);
        } else {
          Bt = (const bf16_t*)(p.ws + OFF_WQ) + (size_t)l * 2048 * 1024;
          ntn = 16; ldc = 2048; C = (bf16_t*)(p.ws + OFF_Q);
        }
        gemm_phase<0>((const bf16_t*)(p.ws + OFF_H), Bt, ntn, C, ldc, nullptr, nullptr, smem);
      } else if (sub == 1) {
        if (odd) phase_odd_prep(p, l, smem, prep_rep); else did = false;
      } else if (sub == 2) {
        if (odd) phase_gdn_chain(p, l, smem); else phase_ret_chain(p, l, smem);
      } else if (sub == 3) {
        phase_mix_out(p, l);
      } else if (sub == 4) {
        gemm_phase<1>((const bf16_t*)(p.ws + OFF_YMIX), (const bf16_t*)(p.ws + OFF_WOUT) + (size_t)l * 1024 * 1024, 8,
                      nullptr, 0, p.out, modv + (size_t)l * 9 * 6144 + 2048, smem);
      } else if (sub == 5) {
        phase_norm2(p, l);
      } else if (sub == 7) {
        phase_peer_score(p, l, smem);
      } else {
        phase_peer_gather(p, l);
      }
    }
#if PROBE_MASK
    if (rep + 1 < nrep) continue;
#endif
    if (did && ph + 1 < ph_hi) xcd_barrier(xb);
#if PROBE_MASK
    }
#endif
  }
}

extern "C" void kernel_launch(void* const* d_in, const int* in_sizes, int n_in, void* d_out, int out_size,
                              void* d_ws, size_t ws_size, hipStream_t stream) {
  static int grid_blocks = 0;
  if (!grid_blocks) {
    int dev = 0, cus = 0, per_cu = 0;
    (void)hipGetDevice(&dev);
    (void)hipDeviceGetAttribute(&cus, hipDeviceAttributeMultiprocessorCount, dev);
    (void)hipOccupancyMaxActiveBlocksPerMultiprocessor(&per_cu, mega, 256, 0);
    if (per_cu < 1) per_cu = 1;
    if (per_cu > 2) per_cu = 2;
    grid_blocks = cus * per_cu;
    if (ws_size < WS_NEED) fprintf(stderr, "kernel_launch: workspace too small: %zu < %zu\n", ws_size, (size_t)WS_NEED);
  }
  Params p{};
  for (int i = 0; i < 30; ++i) p.in[i] = (const float*)d_in[i];
  p.out = (float*)d_out;
  p.ws = (unsigned char*)d_ws;
  (void)hipMemsetAsync((unsigned char*)d_ws + OFF_BAR, 0, XCD_BAR_WORDS * sizeof(unsigned), stream);
#if SINGLE_LAUNCH
  int lo = 0, hi = NPHASE;
  void* args[] = {&p, &lo, &hi};
  hipError_t e = hipLaunchCooperativeKernel((void*)mega, dim3(grid_blocks), dim3(256), args, 0, stream);
  if (e != hipSuccess) fprintf(stderr, "cooperative launch failed: %s (grid %d)\n", hipGetErrorString(e), grid_blocks);
#else
  for (int ph = 0; ph < NPHASE; ++ph) {
    const int l = (ph - 2) / 9, sub = (ph - 2) % 9;
    if (ph >= 2 && sub == 1 && !(l & 1)) continue;
    hipLaunchKernelGGL(mega, dim3(grid_blocks), dim3(256), 0, stream, p, ph, ph + 1);
  }
#endif
}
```

```cpp
#include <hip/hip_runtime.h>
#include <hip/hip_cooperative_groups.h>
#include <cstdio>
namespace cg = cooperative_groups;

#ifndef PROBE_MASK
#define PROBE_MASK 0
#endif
#ifndef PROBE_ODD
#define PROBE_ODD 0
#endif
#ifndef SINGLE_LAUNCH
#define SINGLE_LAUNCH 1
#endif

typedef unsigned short bf16_t;
using bf16x8 = __attribute__((ext_vector_type(8))) short;
using f32x4 = __attribute__((ext_vector_type(4))) float;
using f32x2 = __attribute__((ext_vector_type(2))) float;
using u32x4 = __attribute__((ext_vector_type(4))) unsigned;

#define NTOK 24576
#define NPROMPT 8192
#define PSTRIDE 3200
#define EPSV 1e-6f
#define NPHASE 38

constexpr size_t OFF_MOD = 0;
constexpr size_t OFF_ROPE = 1u << 20;
constexpr size_t OFF_WIN_EV = OFF_ROPE + 65536;
constexpr size_t OFF_WIN_OD = OFF_WIN_EV + 2ull * 3072 * 1024 * 2;
constexpr size_t OFF_WOUT = OFF_WIN_OD + 2ull * 3200 * 1024 * 2;
constexpr size_t OFF_WQ = OFF_WOUT + 4ull * 1024 * 1024 * 2;
constexpr size_t OFF_KEYS = OFF_WQ + 4ull * 2048 * 1024 * 2;
constexpr size_t OFF_UB = OFF_KEYS + 4ull * 8 * 2 * 128 * 128 * 2;
constexpr size_t OFF_VB = OFF_UB + 4ull * 16384 * 1024 * 2;
constexpr size_t OFF_H = OFF_VB + 4ull * 16384 * 1024 * 2;
constexpr size_t OFF_P = OFF_H + (size_t)NTOK * 1024 * 2;
constexpr size_t OFF_YMIX = OFF_P + (size_t)NTOK * PSTRIDE * 2;
constexpr size_t OFF_ODIR = OFF_YMIX + (size_t)NTOK * 1024 * 2;
constexpr size_t OFF_Q = OFF_ODIR;
constexpr size_t OFF_EIDX = OFF_ODIR + 2ull * NTOK * 512 * 4;
constexpr size_t OFF_GATE = OFF_EIDX + (size_t)NTOK * 128 * 4;
constexpr size_t GP_ITEM = 73728;
constexpr size_t OFF_GPREP = OFF_GATE + (size_t)NTOK * 128 * 4;
constexpr size_t OFF_EGL = OFF_GPREP + 3072ull * GP_ITEM;
constexpr size_t OFF_CONV = OFF_EGL + 16384;
constexpr size_t OFF_BAR = OFF_CONV + (size_t)NTOK * 512 * 4;
constexpr size_t WS_NEED = OFF_BAR + 16384;

struct Params {
  const float* in[30];
  float* out;
  unsigned char* ws;
};

__device__ const unsigned char CAND_A[52] = {0,0,0,0,0,0,0,0,0,0,0,0,0,0,0,0,1,1,1,1,1,1,1,1,2,2,2,2,2,3,3,3,3,4,4,4,5,5,6,6,7,7,8,9,10,11,12,13,14,15,0,0};
__device__ const unsigned char CAND_B[52] = {0,1,2,3,4,5,6,7,8,9,10,11,12,13,14,15,0,1,2,3,4,5,6,7,0,1,2,3,4,0,1,2,3,0,1,2,0,1,0,1,0,1,0,0,0,0,0,0,0,0,0,0};

__device__ __forceinline__ int opaque_tid() { int t = threadIdx.x; asm volatile("" : "+v"(t)); return t; }
typedef __bf16 hbf16x2 __attribute__((ext_vector_type(2)));
__device__ __forceinline__ bf16_t f2bf(float f) {
  return __builtin_bit_cast(unsigned short, (__bf16)f);
}
__device__ __forceinline__ float bf2f(bf16_t b) { return __uint_as_float(((unsigned)b) << 16); }
__device__ __forceinline__ float bflo(unsigned u) { return __uint_as_float(u << 16); }
__device__ __forceinline__ float bfhi(unsigned u) { return __uint_as_float(u & 0xffff0000u); }
__device__ __forceinline__ unsigned pack2(float a, float b) {
  f32x2 v = {a, b};
  return __builtin_bit_cast(unsigned, __builtin_convertvector(v, hbf16x2));
}
__device__ __forceinline__ float wave_sum(float v) {
#pragma unroll
  for (int o = 32; o > 0; o >>= 1) v += __shfl_xor(v, o);
  return v;
}
__device__ __forceinline__ f32x4 mfma16(bf16x8 a, bf16x8 b, f32x4 c) {
  return __builtin_amdgcn_mfma_f32_16x16x32_bf16(a, b, c, 0, 0, 0);
}
__device__ __forceinline__ bf16x8 ldfrag(const bf16_t* p) { return *(const bf16x8*)p; }
__device__ __forceinline__ float siluf(float v) { return v * __builtin_amdgcn_rcpf(1.f + __expf(-v)); }
__device__ __forceinline__ int tok_mod(int t) { return t < NPROMPT ? 0 : 1 + ((t - NPROMPT) >> 11); }
__device__ __forceinline__ unsigned fkey(float f) {
  unsigned u = __float_as_uint(f);
  return (u & 0x80000000u) ? ~u : (u | 0x80000000u);
}
__device__ __forceinline__ float keyf(unsigned k) {
  unsigned b = (k & 0x80000000u) ? (k ^ 0x80000000u) : ~k;
  return __uint_as_float(b);
}
__device__ __forceinline__ void unpack8(uint4 v, float* f) {
  f[0] = bflo(v.x); f[1] = bfhi(v.x); f[2] = bflo(v.y); f[3] = bfhi(v.y);
  f[4] = bflo(v.z); f[5] = bfhi(v.z); f[6] = bflo(v.w); f[7] = bfhi(v.w);
}

__device__ __forceinline__ void prep_mod(const Params& p, float* smem) {
  float* sc = smem;
  float* red = smem + 9 * 1024;
  const int tid = opaque_tid();
  const float* c = p.in[4];
  const float* cctx = p.in[5];
  for (int i = tid; i < 9 * 1024; i += 256) {
    int m = i >> 10, k = i & 1023;
    float v = (m == 0) ? cctx[k] : c[(m - 1) * 1024 + k];
    sc[i] = v / (1.f + expf(-v));
  }
  __syncthreads();
  float* modv = (float*)(p.ws + OFF_MOD);
  const int cl = tid & 63, kg = tid >> 6;
  for (int u = blockIdx.x; u < 4 * 96; u += gridDim.x) {
    const int l = u / 96, nb = (u % 96) * 64;
    const float* W = p.in[6] + (size_t)l * 1024 * 6144 + nb + cl;
    float acc[9];
#pragma unroll
    for (int m = 0; m < 9; ++m) acc[m] = 0.f;
#pragma unroll 16
    for (int k = kg * 256; k < kg * 256 + 256; ++k) {
      float w = W[(size_t)k * 6144];
#pragma unroll
      for (int m = 0; m < 9; ++m) acc[m] += sc[m * 1024 + k] * w;
    }
#pragma unroll
    for (int m = 0; m < 9; ++m) red[(kg * 9 + m) * 64 + cl] = acc[m];
    __syncthreads();
    for (int i = tid; i < 9 * 64; i += 256) {
      int m = i >> 6, c2 = i & 63;
      float s = red[(0 * 9 + m) * 64 + c2] + red[(1 * 9 + m) * 64 + c2] + red[(2 * 9 + m) * 64 + c2] + red[(3 * 9 + m) * 64 + c2];
      int nn = nb + c2;
      modv[(size_t)(l * 9 + m) * 6144 + nn] = s + p.in[7][l * 6144 + nn];
    }
    __syncthreads();
  }
}

__device__ __forceinline__ void prep_transpose(const float* src, bf16_t* dst, int N, int Npad, float* tile) {
  const int tid = opaque_tid();
  const int ntn = Npad / 64;
  const int units = ntn * 16;
  for (int u = blockIdx.x; u < units; u += gridDim.x) {
    const int nt = u % ntn, kt = u / ntn;
    const int n0 = nt * 64, k0 = kt * 64;
    {
      const int c = tid & 63;
      const int n = n0 + c;
      const int nc = n < N ? n : N - 1;
      float tv[16];
#pragma unroll
      for (int i = 0; i < 16; ++i) tv[i] = src[(size_t)(k0 + (tid >> 6) + 4 * i) * N + nc];
#pragma unroll
      for (int i = 0; i < 16; ++i) tile[((tid >> 6) + 4 * i) * 65 + c] = (n < N) ? tv[i] : 0.f;
    }
    __syncthreads();
#pragma unroll 4
    for (int i = 0; i < 16; ++i) {
      int rr = (tid >> 6) + 4 * i, cc = tid & 63;
      dst[(size_t)(n0 + rr) * 1024 + k0 + cc] = f2bf(tile[cc * 65 + rr]);
    }
    __syncthreads();
  }
}

__device__ __forceinline__ void prep_convert(const float* src, bf16_t* dst, size_t n4) {
  const size_t stride = (size_t)gridDim.x * 256;
  for (size_t i0 = (size_t)blockIdx.x * 256 + threadIdx.x; i0 < n4; i0 += stride * 8) {
    float4 v[8];
#pragma unroll
    for (int j = 0; j < 8; ++j) { const size_t i = i0 + j * stride; const size_t ic = i < n4 ? i : n4 - 1; v[j] = ((const float4*)src)[ic]; }
#pragma unroll
    for (int j = 0; j < 8; ++j) {
      const size_t i = i0 + j * stride;
      if (i < n4) { uint2 o; o.x = pack2(v[j].x, v[j].y); o.y = pack2(v[j].z, v[j].w); ((uint2*)dst)[i] = o; }
    }
  }
}

__device__ __forceinline__ void prep_convert_fp8(const float* src, unsigned* dst, size_t n4, float scale) {
  const size_t stride = (size_t)gridDim.x * 256;
  for (size_t i0 = (size_t)blockIdx.x * 256 + threadIdx.x; i0 < n4; i0 += stride * 8) {
    float4 v[8];
#pragma unroll
    for (int j = 0; j < 8; ++j) { const size_t i = i0 + j * stride; const size_t ic = i < n4 ? i : n4 - 1; f32x4 t4 = __builtin_nontemporal_load((const f32x4*)src + ic); v[j] = make_float4(t4[0], t4[1], t4[2], t4[3]); }
#pragma unroll
    for (int j = 0; j < 8; ++j) {
      const size_t i = i0 + j * stride;
      if (i < n4) {
        unsigned w = __builtin_amdgcn_cvt_pk_fp8_f32(v[j].x * scale, v[j].y * scale, 0, false);
        w = __builtin_amdgcn_cvt_pk_fp8_f32(v[j].z * scale, v[j].w * scale, w, true);
        dst[i] = w;
      }
    }
  }
}
__device__ __forceinline__ void prep_convert_fp4(const float* src, unsigned* dst, size_t n8, float scale) {
  const size_t stride = (size_t)gridDim.x * 256;
  for (size_t i0 = (size_t)blockIdx.x * 256 + threadIdx.x; i0 < n8; i0 += stride * 4) {
    f32x4 va[4], vb[4];
#pragma unroll
    for (int j = 0; j < 4; ++j) {
      const size_t i = i0 + j * stride; const size_t ic = i < n8 ? i : n8 - 1;
      va[j] = __builtin_nontemporal_load((const f32x4*)src + 2 * ic);
      vb[j] = __builtin_nontemporal_load((const f32x4*)src + 2 * ic + 1);
    }
#pragma unroll
    for (int j = 0; j < 4; ++j) {
      const size_t i = i0 + j * stride;
      if (i < n8) {
        unsigned w = 0;
        w = __builtin_amdgcn_cvt_scalef32_pk_fp4_f32(w, va[j][0] * scale, va[j][1] * scale, 1.0f, 0);
        w = __builtin_amdgcn_cvt_scalef32_pk_fp4_f32(w, va[j][2] * scale, va[j][3] * scale, 1.0f, 1);
        w = __builtin_amdgcn_cvt_scalef32_pk_fp4_f32(w, vb[j][0] * scale, vb[j][1] * scale, 1.0f, 2);
        w = __builtin_amdgcn_cvt_scalef32_pk_fp4_f32(w, vb[j][2] * scale, vb[j][3] * scale, 1.0f, 3);
        dst[i] = w;
      }
    }
  }
}
__device__ __forceinline__ void unpack16_fp4(unsigned w0, unsigned w1, f32x2* f) {
  f[0] = __builtin_amdgcn_cvt_scalef32_pk_f32_fp4(w0, 1.0f, 0);
  f[1] = __builtin_amdgcn_cvt_scalef32_pk_f32_fp4(w0, 1.0f, 1);
  f[2] = __builtin_amdgcn_cvt_scalef32_pk_f32_fp4(w0, 1.0f, 2);
  f[3] = __builtin_amdgcn_cvt_scalef32_pk_f32_fp4(w0, 1.0f, 3);
  f[4] = __builtin_amdgcn_cvt_scalef32_pk_f32_fp4(w1, 1.0f, 0);
  f[5] = __builtin_amdgcn_cvt_scalef32_pk_f32_fp4(w1, 1.0f, 1);
  f[6] = __builtin_amdgcn_cvt_scalef32_pk_f32_fp4(w1, 1.0f, 2);
  f[7] = __builtin_amdgcn_cvt_scalef32_pk_f32_fp4(w1, 1.0f, 3);
}
__device__ __forceinline__ void unpack16_fp8(u32x4 v, float* f) {
#pragma unroll
  for (int i = 0; i < 4; ++i) {
    f32x2 lo = __builtin_amdgcn_cvt_pk_f32_fp8(v[i], false);
    f32x2 hi = __builtin_amdgcn_cvt_pk_f32_fp8(v[i], true);
    f[4 * i + 0] = lo.x; f[4 * i + 1] = lo.y; f[4 * i + 2] = hi.x; f[4 * i + 3] = hi.y;
  }
}
#define U_SCALE 64.f
#define V_SCALE 20.f
__device__ __forceinline__ void phase_prep_a(const Params& p, unsigned char* smem) {
  float* fs = (float*)smem;
  prep_mod(p, fs);
  {
    float2* rope = (float2*)(p.ws + OFF_ROPE);
    int i = blockIdx.x * 256 + threadIdx.x;
    if (i < 64 * 16) {
      int pos = i >> 4, f = i & 15;
      float fr = powf(10000.f, -(float)f / 16.f);
      float ang = (float)pos * fr;
      rope[i] = make_float2(cosf(ang), sinf(ang));
    }
  }
  for (int i = 0; i < 2; ++i) {
    prep_transpose(p.in[11] + (size_t)i * 1024 * 3072, (bf16_t*)(p.ws + OFF_WIN_EV) + (size_t)i * 3072 * 1024, 3072, 3072, fs);
    prep_transpose(p.in[16] + (size_t)i * 1024 * 3088, (bf16_t*)(p.ws + OFF_WIN_OD) + (size_t)i * 3200 * 1024, 3088, 3200, fs);
    prep_transpose(p.in[12] + (size_t)i * 1024 * 1024, (bf16_t*)(p.ws + OFF_WOUT) + (size_t)(2 * i) * 1024 * 1024, 1024, 1024, fs);
    prep_transpose(p.in[17] + (size_t)i * 1024 * 1024, (bf16_t*)(p.ws + OFF_WOUT) + (size_t)(2 * i + 1) * 1024 * 1024, 1024, 1024, fs);
  }
  for (int l = 0; l < 4; ++l)
    prep_transpose(p.in[26] + (size_t)l * 1024 * 2048, (bf16_t*)(p.ws + OFF_WQ) + (size_t)l * 2048 * 1024, 2048, 2048, fs);
  prep_convert(p.in[27], (bf16_t*)(p.ws + OFF_KEYS), (size_t)4 * 8 * 2 * 128 * 128 / 4);
  prep_convert_fp4(p.in[28], (unsigned*)(p.ws + OFF_UB), (size_t)4 * 16384 * 1024 / 8, U_SCALE);
  prep_convert_fp4(p.in[29], (unsigned*)(p.ws + OFF_VB), (size_t)4 * 16384 * 1024 / 8, V_SCALE);
}

__device__ __forceinline__ void norm_token(const float* xrow, const float* g, const float* scale, const float* shift,
                                           bf16_t* hrow, float* copy_dst, int lane) {
  float4 v[4];
  float ss = 0.f;
#pragma unroll
  for (int i = 0; i < 4; ++i) {
    v[i] = *(const float4*)(xrow + i * 256 + lane * 4);
    ss += v[i].x * v[i].x + v[i].y * v[i].y + v[i].z * v[i].z + v[i].w * v[i].w;
  }
  ss = wave_sum(ss);
  const float rs = rsqrtf(ss * (1.f / 1024.f) + EPSV);
#pragma unroll
  for (int i = 0; i < 4; ++i) {
    const int idx = i * 256 + lane * 4;
    if (copy_dst) *(float4*)(copy_dst + idx) = v[i];
    float4 gg = *(const float4*)(g + idx);
    float4 sc = *(const float4*)(scale + idx);
    float4 sh = *(const float4*)(shift + idx);
    float a = v[i].x * rs * gg.x * (1.f + sc.x) + sh.x;
    float b = v[i].y * rs * gg.y * (1.f + sc.y) + sh.y;
    float c = v[i].z * rs * gg.z * (1.f + sc.z) + sh.z;
    float d = v[i].w * rs * gg.w * (1.f + sc.w) + sh.w;
    uint2 o;
    o.x = pack2(a, b);
    o.y = pack2(c, d);
    *(uint2*)(hrow + idx) = o;
  }
}

__device__ __forceinline__ void phase_prep_b(const Params& p) {
  const int tid_ = opaque_tid(); const int lane = tid_ & 63, wv = tid_ >> 6;
  const float* modv = (const float*)(p.ws + OFF_MOD);
  bf16_t* H = (bf16_t*)(p.ws + OFF_H);
  for (int t = blockIdx.x * 4 + wv; t < NTOK; t += gridDim.x * 4) {
    const float* xr = (t < NPROMPT) ? p.in[0] + (size_t)t * 1024 : p.in[1] + (size_t)(t - NPROMPT) * 1024;
    const float* md = modv + (size_t)(0 * 9 + tok_mod(t)) * 6144;
    norm_token(xr, p.in[8], md + 1024, md, H + (size_t)t * 1024, p.out + (size_t)t * 1024, lane);
  }
}

__device__ __forceinline__ void phase_norm2(const Params& p, int l) {
  const int tid_ = opaque_tid(); const int lane = tid_ & 63, wv = tid_ >> 6;
  const float* modv = (const float*)(p.ws + OFF_MOD);
  bf16_t* H = (bf16_t*)(p.ws + OFF_H);
  for (int t = blockIdx.x * 4 + wv; t < NTOK; t += gridDim.x * 4) {
    const float* md = modv + (size_t)(l * 9 + tok_mod(t)) * 6144;
    norm_token(p.out + (size_t)t * 1024, p.in[9] + l * 1024, md + 4096, md + 3072, H + (size_t)t * 1024, nullptr, lane);
  }
}

template <int EPI>
__device__ __forceinline__ void gemm_phase(const bf16_t* __restrict__ A, const bf16_t* __restrict__ Bt, int ntiles_n,
                           bf16_t* __restrict__ C, int ldc, float* __restrict__ X, const float* __restrict__ ga,
                           unsigned char* smem) {
  bf16_t* As = (bf16_t*)smem;
  bf16_t* Bs = As + 128 * 72;
  const int tid = opaque_tid(), lane = tid & 63, w = tid >> 6, quad = lane >> 4, l15 = lane & 15;
  const int wm = w >> 1, wn = w & 1;
  const int lr = tid >> 3, lseg = (tid & 7) * 8;
  const int units = 192 * ntiles_n;
  for (int u = blockIdx.x; u < units; u += gridDim.x) {
    const int mt = u % 192, nt = u / 192;
    const int m0 = mt * 128, n0 = nt * 128;
    f32x4 acc[4][4];
#pragma unroll
    for (int i = 0; i < 4; ++i)
#pragma unroll
      for (int j = 0; j < 4; ++j) acc[i][j] = (f32x4){0.f, 0.f, 0.f, 0.f};
    const bf16_t* Ag = A + (size_t)(m0 + lr) * 1024 + lseg;
    const bf16_t* Bg = Bt + (size_t)(n0 + lr) * 1024 + lseg;
    u32x4 ra0, ra1, ra2, ra3, rb0, rb1, rb2, rb3;
    ra0 = *(const u32x4*)(Ag); ra1 = *(const u32x4*)(Ag + 32 * 1024); ra2 = *(const u32x4*)(Ag + 64 * 1024); ra3 = *(const u32x4*)(Ag + 96 * 1024);
    rb0 = *(const u32x4*)(Bg); rb1 = *(const u32x4*)(Bg + 32 * 1024); rb2 = *(const u32x4*)(Bg + 64 * 1024); rb3 = *(const u32x4*)(Bg + 96 * 1024);
    for (int kt = 0; kt < 16; ++kt) {
      *(u32x4*)(As + (lr) * 72 + lseg) = ra0; *(u32x4*)(As + (lr + 32) * 72 + lseg) = ra1;
      *(u32x4*)(As + (lr + 64) * 72 + lseg) = ra2; *(u32x4*)(As + (lr + 96) * 72 + lseg) = ra3;
      *(u32x4*)(Bs + (lr) * 72 + lseg) = rb0; *(u32x4*)(Bs + (lr + 32) * 72 + lseg) = rb1;
      *(u32x4*)(Bs + (lr + 64) * 72 + lseg) = rb2; *(u32x4*)(Bs + (lr + 96) * 72 + lseg) = rb3;
      __syncthreads();
      if (kt + 1 < 16) {
        const bf16_t* An = Ag + (kt + 1) * 64; const bf16_t* Bn = Bg + (kt + 1) * 64;
        ra0 = *(const u32x4*)(An); ra1 = *(const u32x4*)(An + 32 * 1024); ra2 = *(const u32x4*)(An + 64 * 1024); ra3 = *(const u32x4*)(An + 96 * 1024);
        rb0 = *(const u32x4*)(Bn); rb1 = *(const u32x4*)(Bn + 32 * 1024); rb2 = *(const u32x4*)(Bn + 64 * 1024); rb3 = *(const u32x4*)(Bn + 96 * 1024);
      }
#pragma unroll
      for (int kk = 0; kk < 2; ++kk) {
        bf16x8 af[4], bfr[4];
#pragma unroll
        for (int i = 0; i < 4; ++i) af[i] = ldfrag(As + (wm * 64 + i * 16 + l15) * 72 + kk * 32 + quad * 8);
#pragma unroll
        for (int j = 0; j < 4; ++j) bfr[j] = ldfrag(Bs + (wn * 64 + j * 16 + l15) * 72 + kk * 32 + quad * 8);
#pragma unroll
        for (int i = 0; i < 4; ++i)
#pragma unroll
          for (int j = 0; j < 4; ++j) acc[i][j] = mfma16(af[i], bfr[j], acc[i][j]);
      }
      __syncthreads();
    }
    if (EPI == 0) {
#pragma unroll
      for (int i = 0; i < 4; ++i)
#pragma unroll
        for (int j = 0; j < 4; ++j)
#pragma unroll
          for (int jj = 0; jj < 4; ++jj) {
            int row = m0 + wm * 64 + i * 16 + quad * 4 + jj;
            int col = n0 + wn * 64 + j * 16 + l15;
            C[(size_t)row * ldc + col] = f2bf(acc[i][j][jj]);
          }
    } else {
      const float* gam = ga + (size_t)tok_mod(m0) * 6144;
#pragma unroll
      for (int i = 0; i < 4; ++i)
#pragma unroll
        for (int j = 0; j < 4; ++j)
#pragma unroll
          for (int jj = 0; jj < 4; ++jj) {
            int row = m0 + wm * 64 + i * 16 + quad * 4 + jj;
            int col = n0 + wn * 64 + j * 16 + l15;
            float* xp = X + (size_t)row * 1024 + col;
            *xp = *xp + gam[col] * acc[i][j][jj];
          }
    }
  }
}

struct ChainItem {
  bool lng; int sl, dir, h, sq, tok0, nc;
};
__device__ __forceinline__ ChainItem decode_item(int it) {
  ChainItem c;
  c.lng = it < 256;
  int idx = c.lng ? it : it - 256;
  c.sl = idx & 3; c.dir = (idx >> 2) & 1; c.h = (idx >> 3) & 3; c.sq = idx >> 5;
  c.tok0 = c.lng ? NPROMPT + c.sq * 2048 : c.sq * 256;
  c.nc = c.lng ? 32 : 4;
  return c;
}

__device__ __forceinline__ void phase_ret_chain(const Params& p, int l, unsigned char* smem) {
  const int il = l >> 1;
  bf16_t* qs = (bf16_t*)smem;
  bf16_t* ks = qs + 64 * 72;
  bf16_t* kT = ks + 64 * 72;
  bf16_t* vT = kT + 64 * 72;
  bf16_t* intra = vT + 32 * 72;
  bf16_t* ST = intra + 64 * 72;
  const bf16_t* P = (const bf16_t*)(p.ws + OFF_P);
  float* odir = (float*)(p.ws + OFF_ODIR);
  const float2* rope = (const float2*)(p.ws + OFF_ROPE);
  const int tid = opaque_tid(), lane = tid & 63, w = tid >> 6, quad = lane >> 4, l15 = lane & 15;
  for (int it = blockIdx.x; it < 1280; it += gridDim.x) {
    const ChainItem ci = decode_item(it);
    const int sl = ci.sl, dir = ci.dir, h = ci.h;
    const float xg = p.in[13][(il * 2 + dir) * 4 + h];
    const float lg = -log1pf(expf(-xg));
    const float g64 = expf(lg * 64.f);
    f32x4 S[2];
    if (ci.lng) {
      const float* s0 = p.in[2] + ((((size_t)ci.sq * 2 + il) * 2 + dir) * 4 + h) * 8192;
#pragma unroll
      for (int ct = 0; ct < 2; ++ct)
#pragma unroll
        for (int jj = 0; jj < 4; ++jj) S[ct][jj] = s0[(16 * w + quad * 4 + jj) * 128 + sl * 32 + ct * 16 + l15];
    } else {
      S[0] = (f32x4){0.f, 0.f, 0.f, 0.f};
      S[1] = (f32x4){0.f, 0.f, 0.f, 0.f};
    }
    for (int n = 0; n < ci.nc; ++n) {
      const int cn = dir ? ci.nc - 1 - n : n;
      const int tb = ci.tok0 + cn * 64;
      {
        const int i = tid >> 2, mq = tid & 3;
        const int t = tb + (dir ? 63 - i : i);
        const bf16_t* pr = P + (size_t)t * PSTRIDE;
        float qa[8], qb[8], ka[8], kb[8];
        unpack8(*(const uint4*)(pr + h * 64 + mq * 8), qa);
        unpack8(*(const uint4*)(pr + h * 64 + 32 + mq * 8), qb);
        unpack8(*(const uint4*)(pr + 256 + h * 64 + mq * 8), ka);
        unpack8(*(const uint4*)(pr + 256 + h * 64 + 32 + mq * 8), kb);
        if (ci.lng) {
          const int pos = (mq < 2) ? cn : (t - tb);
          const int f0 = (mq & 1) * 8;
#pragma unroll
          for (int e = 0; e < 8; ++e) {
            float2 cs = rope[pos * 16 + f0 + e];
            float a = qa[e], b = qb[e];
            qa[e] = a * cs.x - b * cs.y; qb[e] = b * cs.x + a * cs.y;
            a = ka[e]; b = kb[e];
            ka[e] = a * cs.x - b * cs.y; kb[e] = b * cs.x + a * cs.y;
          }
        }
        const float wend = expf(lg * (float)(63 - i));
        uint4 o;
        o.x = pack2(qa[0], qa[1]); o.y = pack2(qa[2], qa[3]); o.z = pack2(qa[4], qa[5]); o.w = pack2(qa[6], qa[7]);
        *(uint4*)(qs + i * 72 + mq * 8) = o;
        o.x = pack2(qb[0], qb[1]); o.y = pack2(qb[2], qb[3]); o.z = pack2(qb[4], qb[5]); o.w = pack2(qb[6], qb[7]);
        *(uint4*)(qs + i * 72 + 32 + mq * 8) = o;
#pragma unroll
        for (int e = 0; e < 8; ++e) { ka[e] *= 0.125f; kb[e] *= 0.125f; }
        o.x = pack2(ka[0], ka[1]); o.y = pack2(ka[2], ka[3]); o.z = pack2(ka[4], ka[5]); o.w = pack2(ka[6], ka[7]);
        *(uint4*)(ks + i * 72 + mq * 8) = o;
        o.x = pack2(kb[0], kb[1]); o.y = pack2(kb[2], kb[3]); o.z = pack2(kb[4], kb[5]); o.w = pack2(kb[6], kb[7]);
        *(uint4*)(ks + i * 72 + 32 + mq * 8) = o;
#pragma unroll
        for (int e = 0; e < 8; ++e) {
          kT[(mq * 8 + e) * 72 + i] = f2bf(ka[e] * wend);
          kT[(32 + mq * 8 + e) * 72 + i] = f2bf(kb[e] * wend);
        }
        uint4 v8 = *(const uint4*)(pr + 512 + h * 128 + sl * 32 + mq * 8);
        vT[(mq * 8 + 0) * 72 + i] = (bf16_t)(v8.x & 0xffff); vT[(mq * 8 + 1) * 72 + i] = (bf16_t)(v8.x >> 16);
        vT[(mq * 8 + 2) * 72 + i] = (bf16_t)(v8.y & 0xffff); vT[(mq * 8 + 3) * 72 + i] = (bf16_t)(v8.y >> 16);
        vT[(mq * 8 + 4) * 72 + i] = (bf16_t)(v8.z & 0xffff); vT[(mq * 8 + 5) * 72 + i] = (bf16_t)(v8.z >> 16);
        vT[(mq * 8 + 6) * 72 + i] = (bf16_t)(v8.w & 0xffff); vT[(mq * 8 + 7) * 72 + i] = (bf16_t)(v8.w >> 16);
      }
      __syncthreads();
      const bf16x8 a0 = ldfrag(qs + (16 * w + l15) * 72 + quad * 8);
      const bf16x8 a1 = ldfrag(qs + (16 * w + l15) * 72 + 32 + quad * 8);
#pragma unroll
      for (int ct = 0; ct < 4; ++ct) {
        bf16x8 b0 = ldfrag(ks + (ct * 16 + l15) * 72 + quad * 8);
        bf16x8 b1 = ldfrag(ks + (ct * 16 + l15) * 72 + 32 + quad * 8);
        f32x4 c = (f32x4){0.f, 0.f, 0.f, 0.f};
        c = mfma16(a0, b0, c);
        c = mfma16(a1, b1, c);
#pragma unroll
        for (int jj = 0; jj < 4; ++jj) {
          int i = 16 * w + quad * 4 + jj, j = ct * 16 + l15;
          float val = (i >= j) ? c[jj] * expf(lg * (float)(i - j)) : 0.f;
          intra[i * 72 + j] = f2bf(val);
        }
      }
#pragma unroll
      for (int ct = 0; ct < 2; ++ct)
#pragma unroll
        for (int jj = 0; jj < 4; ++jj) ST[(ct * 16 + l15) * 72 + 16 * w + quad * 4 + jj] = f2bf(S[ct][jj]);
      __syncthreads();
      const bf16x8 ai0 = ldfrag(intra + (16 * w + l15) * 72 + quad * 8);
      const bf16x8 ai1 = ldfrag(intra + (16 * w + l15) * 72 + 32 + quad * 8);
      const bf16x8 ak0 = ldfrag(kT + (16 * w + l15) * 72 + quad * 8);
      const bf16x8 ak1 = ldfrag(kT + (16 * w + l15) * 72 + 32 + quad * 8);
#pragma unroll
      for (int ct = 0; ct < 2; ++ct) {
        bf16x8 bv0 = ldfrag(vT + (ct * 16 + l15) * 72 + quad * 8);
        bf16x8 bv1 = ldfrag(vT + (ct * 16 + l15) * 72 + 32 + quad * 8);
        bf16x8 bs0 = ldfrag(ST + (ct * 16 + l15) * 72 + quad * 8);
        bf16x8 bs1 = ldfrag(ST + (ct * 16 + l15) * 72 + 32 + quad * 8);
        f32x4 ci_ = (f32x4){0.f, 0.f, 0.f, 0.f}, cc = (f32x4){0.f, 0.f, 0.f, 0.f};
        ci_ = mfma16(ai0, bv0, ci_);
        ci_ = mfma16(ai1, bv1, ci_);
        cc = mfma16(a0, bs0, cc);
        cc = mfma16(a1, bs1, cc);
#pragma unroll
        for (int jj = 0; jj < 4; ++jj) {
          int i = 16 * w + quad * 4 + jj;
          int t = tb + (dir ? 63 - i : i);
          float o = ci_[jj] + expf(lg * (float)(i + 1)) * cc[jj];
          odir[((size_t)dir * NTOK + t) * 512 + h * 128 + sl * 32 + ct * 16 + l15] = o;
        }
        f32x4 s = S[ct];
        s[0] *= g64; s[1] *= g64; s[2] *= g64; s[3] *= g64;
        s = mfma16(ak0, bv0, s);
        s = mfma16(ak1, bv1, s);
        S[ct] = s;
      }
      __syncthreads();
    }
    if (!ci.lng) {
      float* so = p.out + 25165824 + ((((size_t)ci.sq * 2 + il) * 2 + dir) * 4 + h) * 8192;
#pragma unroll
      for (int ct = 0; ct < 2; ++ct)
#pragma unroll
        for (int jj = 0; jj < 4; ++jj) so[(16 * w + quad * 4 + jj) * 128 + sl * 32 + ct * 16 + l15] = S[ct][jj];
    }
  }
}

__device__ __forceinline__ void gdn_prep_item(const Params& p, int l, int pi, unsigned char* smem, int plvl) {
  const int il = l >> 1;
  bf16_t* ks = (bf16_t*)smem;
  bf16_t* vs = ks + 64 * 136;
  float* Am = (float*)(vs + 64 * 136);
  float* rq = Am + 4096;
  float* rk = rq + 64;
  float* gcs = rk + 64;
  float* bet = gcs + 64;
  float* fac = bet + 64;
  bf16_t* qs = (bf16_t*)(fac + 128);
  const bf16_t* P = (const bf16_t*)(p.ws + OFF_P);
  unsigned char* gp = p.ws + OFF_GPREP + (size_t)pi * GP_ITEM;
  bf16_t* Wb = (bf16_t*)gp;
  bf16_t* QG = Wb + 8192;
  bf16_t* KDT = QG + 8192;
  bf16_t* Ub = KDT + 8192;
  bf16_t* ATT = Ub + 8192;
  float* EGL = (float*)(p.ws + OFF_EGL);
  const int tid = opaque_tid(), lane = tid & 63, w = tid >> 6, quad = lane >> 4, l15 = lane & 15;
  const int dir = pi & 1, h = (pi >> 1) & 3, c = pi >> 3;
  int tb, seq_lo, seq_hi;
  if (c < 128) { tb = c * 64; seq_lo = (c >> 2) * 256; seq_hi = seq_lo + 256; }
  else { int cc = c - 128; tb = NPROMPT + cc * 64; seq_lo = NPROMPT + (cc >> 5) * 2048; seq_hi = seq_lo + 2048; }
  const float SCALE = 0.08838834764831845f;
  {
    const int cg_ = tid & 127, rh = tid >> 7;
#pragma unroll
    for (int mat = 0; mat < 3; ++mat) {
      const int col = mat * 512 + h * 128 + cg_;
      const float* cw = p.in[18] + (size_t)il * 3 * 1536 + col;
      const float w0 = cw[0], w1 = cw[1536], w2 = cw[3072];
      bf16_t* dst = mat == 0 ? qs : (mat == 1 ? ks : vs);
      const int t0 = tb + rh * 32;
      bf16_t raw[34];
#pragma unroll
      for (int o = 0; o < 34; ++o) {
        const int t = t0 - 1 + o;
        const int tc = min(max(t, seq_lo), seq_hi - 1);
        const bf16_t rv = P[(size_t)tc * PSTRIDE + col];
        raw[o] = (t == tc) ? rv : (bf16_t)0;
      }
#pragma unroll
      for (int o = 0; o < 32; ++o) {
        float y = w0 * bf2f(raw[o]) + w1 * bf2f(raw[o + 1]) + w2 * bf2f(raw[o + 2]);
        y = siluf(y);
        const int oi = rh * 32 + o;
        const int i = dir ? 63 - oi : oi;
        dst[i * 136 + cg_] = f2bf(y);
      }
    }
  }
  __syncthreads();
  if (plvl == 4) return;
  {
    const int r = tid >> 2, part = tid & 3;
    float sq_ = 0.f, sk_ = 0.f;
#pragma unroll 8
    for (int e = 0; e < 32; ++e) {
      float a = bf2f(qs[r * 136 + part * 32 + e]);
      float b = bf2f(ks[r * 136 + part * 32 + e]);
      sq_ += a * a; sk_ += b * b;
    }
    sq_ += __shfl_xor(sq_, 1); sq_ += __shfl_xor(sq_, 2);
    sk_ += __shfl_xor(sk_, 1); sk_ += __shfl_xor(sk_, 2);
    if (part == 0) {
      rq[r] = rsqrtf(sq_ + EPSV);
      rk[r] = rsqrtf(sk_ + EPSV);
      const int t = tb + (dir ? 63 - r : r);
      float a = bf2f(P[(size_t)t * PSTRIDE + 2048 + dir * 4 + h]);
      float bbv = bf2f(P[(size_t)t * PSTRIDE + 2056 + dir * 4 + h]);
      float al = p.in[19][(il * 2 + dir) * 4 + h], dtb = p.in[20][(il * 2 + dir) * 4 + h];
      float z = a + dtb;
      float sp = (z > 20.f) ? z : log1pf(expf(z));
      gcs[r] = -expf(al) * sp;
      bet[r] = 1.f / (1.f + expf(-bbv));
    }
  }
  __syncthreads();
  if (tid < 64) {
    float v = gcs[tid];
#pragma unroll
    for (int o = 1; o < 64; o <<= 1) {
      float u = __shfl_up(v, o);
      if (tid >= o) v += u;
    }
    gcs[tid] = v;
  }
  __syncthreads();
  {
    bf16x8 ak[4], aq[4];
#pragma unroll
    for (int kk = 0; kk < 4; ++kk) {
      ak[kk] = ldfrag(ks + (16 * w + l15) * 136 + kk * 32 + quad * 8);
      aq[kk] = ldfrag(qs + (16 * w + l15) * 136 + kk * 32 + quad * 8);
    }
#pragma unroll
    for (int ct = 0; ct < 4; ++ct) {
      f32x4 ckk = (f32x4){0.f, 0.f, 0.f, 0.f}, cqk = (f32x4){0.f, 0.f, 0.f, 0.f};
#pragma unroll
      for (int kk = 0; kk < 4; ++kk) {
        bf16x8 b = ldfrag(ks + (ct * 16 + l15) * 136 + kk * 32 + quad * 8);
        ckk = mfma16(ak[kk], b, ckk);
        cqk = mfma16(aq[kk], b, cqk);
      }
#pragma unroll
      for (int jj = 0; jj < 4; ++jj) {
        const int i = 16 * w + quad * 4 + jj, j = ct * 16 + l15;
        const float dec = (i >= j) ? __expf(gcs[i] - gcs[j]) : 0.f;
        Am[j * 64 + i] = (i > j) ? bet[i] * rk[i] * rk[j] * ckk[jj] * dec : 0.f;
        ATT[i * 64 + j] = f2bf((i >= j) ? SCALE * rq[i] * rk[j] * cqk[jj] * dec : 0.f);
      }
    }
  }
  __syncthreads();
  const float gl = gcs[63];
#pragma unroll 8
  for (int e = tid; e < 64 * 128; e += 256) {
    int i = e >> 7, d = e & 127;
    QG[e] = f2bf(bf2f(qs[i * 136 + d]) * rq[i] * SCALE * __expf(gcs[i]));
  }
#pragma unroll 8
  for (int e = tid; e < 128 * 64; e += 256) {
    int d = e >> 6, i = e & 63;
    KDT[e] = f2bf(bf2f(ks[i * 136 + d]) * rk[i] * __expf(gl - gcs[i]));
  }
  if (tid < 64) {
    fac[tid] = bet[tid];
    fac[64 + tid] = rk[tid] * bet[tid] * __expf(gcs[tid]);
  }
  __syncthreads();
  if (plvl != 3) {
    const int cidx = tid & 127;
    const bf16_t* srcm = ((tid < 128) ? vs : ks) + cidx;
    const float* fc = fac + ((tid < 128) ? 0 : 64);
    bf16_t* dstm = ((tid < 128) ? Ub : Wb) + cidx;
    bf16_t* XB = qs + tid;
#pragma unroll 1
    for (int b = 0; b < 4; ++b) {
      float x[16];
#pragma unroll
      for (int r = 0; r < 16; ++r) x[r] = bf2f(srcm[(16 * b + r) * 136]) * fc[16 * b + r];
      const float* arow = Am + 16 * b;
#pragma unroll 4
      for (int j = 0; j < 16 * b; ++j) {
        const float xv = bf2f(XB[j * 256]);
        const f32x4 a0 = *(const f32x4*)(arow + j * 64), a1 = *(const f32x4*)(arow + j * 64 + 4);
        const f32x4 a2 = *(const f32x4*)(arow + j * 64 + 8), a3 = *(const f32x4*)(arow + j * 64 + 12);
#pragma unroll
        for (int r = 0; r < 4; ++r) {
          x[r] -= a0[r] * xv; x[4 + r] -= a1[r] * xv; x[8 + r] -= a2[r] * xv; x[12 + r] -= a3[r] * xv;
        }
      }
      const float* ablk = Am + (16 * b) * 64 + 16 * b;
#pragma unroll
      for (int jj = 0; jj < 15; ++jj) {
#pragma unroll
        for (int r = jj + 1; r < 16; ++r) x[r] -= ablk[jj * 64 + r] * x[jj];
      }
#pragma unroll
      for (int r = 0; r < 16; ++r) {
        const bf16_t bb = f2bf(x[r]);
        dstm[(16 * b + r) * 128] = bb;
        if (b < 3) XB[(16 * b + r) * 256] = bb;
      }
    }
  }
  if (tid == 0) EGL[pi] = expf(gl);
  __syncthreads();
}

__device__ __forceinline__ void conf_conv_item(const Params& p, int l, int item, unsigned char* smem) {
  const int il = l >> 1;
  float* hc = (float*)smem;
  const bf16_t* P = (const bf16_t*)(p.ws + OFF_P);
  float* convout = (float*)(p.ws + OFF_CONV);
  const int tid = opaque_tid();
  const int tile = item >> 1, ch = (item & 1) * 256 + tid;
  const int t0 = tile * 32;
  int seq_lo, seq_hi;
  if (t0 < NPROMPT) { seq_lo = (t0 >> 8) << 8; seq_hi = seq_lo + 256; }
  else { seq_lo = NPROMPT + (((t0 - NPROMPT) >> 11) << 11); seq_hi = seq_lo + 2048; }
#pragma unroll 31
  for (int r = 0; r < 62; ++r) {
    const int tt = t0 - 15 + r;
    const int tc = min(max(tt, seq_lo), seq_hi - 1);
    float ca = bf2f(P[(size_t)tc * PSTRIDE + 2064 + ch]);
    float cgv = bf2f(P[(size_t)tc * PSTRIDE + 2576 + ch]);
    float v = ca * __builtin_amdgcn_rcpf(1.f + __expf(-cgv));
    hc[r * 256 + tid] = (tt == tc) ? v : 0.f;
  }
  float wk[31];
#pragma unroll
  for (int k = 0; k < 31; ++k) wk[k] = p.in[22][((size_t)il * 31 + k) * 512 + ch];
  const float bias = p.in[23][il * 512 + ch];
  for (int i = 0; i < 32; ++i) {
    float acc = bias;
#pragma unroll
    for (int k = 0; k < 31; ++k) acc += wk[k] * hc[(i + k) * 256 + tid];
    convout[(size_t)(t0 + i) * 512 + ch] = acc;
  }
}

__device__ __forceinline__ void phase_odd_prep(const Params& p, int l, unsigned char* smem, int rep) {
  for (int u = blockIdx.x; u < 3072 + 1536; u += gridDim.x) {
#if PROBE_ODD == 1 || PROBE_ODD >= 3
    if (rep && u >= 3072) break;
#elif PROBE_ODD == 2
    if (rep && u < 3072) continue;
#endif
    if (u < 3072) gdn_prep_item(p, l, u, smem, (PROBE_ODD >= 3 && rep) ? PROBE_ODD : 0);
    else { conf_conv_item(p, l, u - 3072, smem); __syncthreads(); }
  }
}

__device__ __forceinline__ void phase_gdn_chain(const Params& p, int l, unsigned char* smem) {
  const int il = l >> 1;
  bf16_t* ST = (bf16_t*)smem;
  bf16_t* VT = ST + 32 * 136;
  float* odir = (float*)(p.ws + OFF_ODIR);
  const float* EGL = (const float*)(p.ws + OFF_EGL);
  const int tid = opaque_tid(), lane = tid & 63, w = tid >> 6, quad = lane >> 4, l15 = lane & 15;
  for (int it = blockIdx.x; it < 1280; it += gridDim.x) {
    const ChainItem ci = decode_item(it);
    const int sl = ci.sl, dir = ci.dir, h = ci.h;
    f32x4 S[2][2];
    if (ci.lng) {
      const float* s0 = p.in[3] + ((((size_t)ci.sq * 2 + il) * 2 + dir) * 4 + h) * 16384;
#pragma unroll
      for (int rb = 0; rb < 2; ++rb)
#pragma unroll
        for (int ct = 0; ct < 2; ++ct)
#pragma unroll
          for (int jj = 0; jj < 4; ++jj)
            S[rb][ct][jj] = s0[(16 * (2 * w + rb) + quad * 4 + jj) * 128 + sl * 32 + ct * 16 + l15];
    } else {
#pragma unroll
      for (int rb = 0; rb < 2; ++rb)
#pragma unroll
        for (int ct = 0; ct < 2; ++ct) S[rb][ct] = (f32x4){0.f, 0.f, 0.f, 0.f};
    }
    for (int n = 0; n < ci.nc; ++n) {
      const int cn = dir ? ci.nc - 1 - n : n;
      const int tb = ci.tok0 + cn * 64;
      const int cglob = ci.lng ? 128 + ci.sq * 32 + cn : ci.sq * 4 + cn;
      const int pi = (cglob * 4 + h) * 2 + dir;
      const unsigned char* gp = p.ws + OFF_GPREP + (size_t)pi * GP_ITEM;
      const bf16_t* Wb = (const bf16_t*)gp;
      const bf16_t* QG = Wb + 8192;
      const bf16_t* KDT = QG + 8192;
      const bf16_t* Ub = KDT + 8192;
      const bf16_t* ATT = Ub + 8192;
      bf16x8 aw[4], aqg[4], aat[2], akd[2][2];
      float uu[2][4];
#pragma unroll
      for (int kk = 0; kk < 4; ++kk) {
        aw[kk] = ldfrag(Wb + (16 * w + l15) * 128 + kk * 32 + quad * 8);
        aqg[kk] = ldfrag(QG + (16 * w + l15) * 128 + kk * 32 + quad * 8);
      }
#pragma unroll
      for (int kk = 0; kk < 2; ++kk) {
        aat[kk] = ldfrag(ATT + (16 * w + l15) * 64 + kk * 32 + quad * 8);
#pragma unroll
        for (int rb = 0; rb < 2; ++rb) akd[rb][kk] = ldfrag(KDT + (16 * (2 * w + rb) + l15) * 64 + kk * 32 + quad * 8);
      }
#pragma unroll
      for (int ct = 0; ct < 2; ++ct)
#pragma unroll
        for (int jj = 0; jj < 4; ++jj) uu[ct][jj] = bf2f(Ub[(16 * w + quad * 4 + jj) * 128 + sl * 32 + ct * 16 + l15]);
      const float egl = EGL[pi];
#pragma unroll
      for (int rb = 0; rb < 2; ++rb)
#pragma unroll
        for (int ct = 0; ct < 2; ++ct)
#pragma unroll
          for (int jj = 0; jj < 4; ++jj)
            ST[(ct * 16 + l15) * 136 + 16 * (2 * w + rb) + quad * 4 + jj] = f2bf(S[rb][ct][jj]);
      __syncthreads();
      f32x4 co[2];
#pragma unroll
      for (int ct = 0; ct < 2; ++ct) {
        f32x4 cv = (f32x4){0.f, 0.f, 0.f, 0.f};
        co[ct] = (f32x4){0.f, 0.f, 0.f, 0.f};
#pragma unroll
        for (int kk = 0; kk < 4; ++kk) {
          bf16x8 b = ldfrag(ST + (ct * 16 + l15) * 136 + kk * 32 + quad * 8);
          cv = mfma16(aw[kk], b, cv);
          co[ct] = mfma16(aqg[kk], b, co[ct]);
        }
#pragma unroll
        for (int jj = 0; jj < 4; ++jj) {
          float vn = uu[ct][jj] - cv[jj];
          VT[(ct * 16 + l15) * 72 + 16 * w + quad * 4 + jj] = f2bf(vn);
        }
      }
      __syncthreads();
#pragma unroll
      for (int ct = 0; ct < 2; ++ct) {
        bf16x8 bv[2];
#pragma unroll
        for (int kk = 0; kk < 2; ++kk) {
          bv[kk] = ldfrag(VT + (ct * 16 + l15) * 72 + kk * 32 + quad * 8);
          co[ct] = mfma16(aat[kk], bv[kk], co[ct]);
        }
#pragma unroll
        for (int jj = 0; jj < 4; ++jj) {
          int i = 16 * w + quad * 4 + jj;
          int t = tb + (dir ? 63 - i : i);
          odir[((size_t)dir * NTOK + t) * 512 + h * 128 + sl * 32 + ct * 16 + l15] = co[ct][jj];
        }
#pragma unroll
        for (int rb = 0; rb < 2; ++rb) {
          f32x4 s = S[rb][ct];
          s[0] *= egl; s[1] *= egl; s[2] *= egl; s[3] *= egl;
          s = mfma16(akd[rb][0], bv[0], s);
          s = mfma16(akd[rb][1], bv[1], s);
          S[rb][ct] = s;
        }
      }
    }
    __syncthreads();
    if (!ci.lng) {
      float* so = p.out + 29360128 + ((((size_t)ci.sq * 2 + il) * 2 + dir) * 4 + h) * 16384;
#pragma unroll
      for (int rb = 0; rb < 2; ++rb)
#pragma unroll
        for (int ct = 0; ct < 2; ++ct)
#pragma unroll
          for (int jj = 0; jj < 4; ++jj)
            so[(16 * (2 * w + rb) + quad * 4 + jj) * 128 + sl * 32 + ct * 16 + l15] = S[rb][ct][jj];
    }
  }
}

__device__ __forceinline__ void phase_mix_out(const Params& p, int l) {
  const int il = l >> 1;
  const bool odd = l & 1;
  const int tid_ = opaque_tid(); const int lane = tid_ & 63, wv = tid_ >> 6;
  const bf16_t* P = (const bf16_t*)(p.ws + OFF_P);
  const float* od0 = (const float*)(p.ws + OFF_ODIR);
  const float* od1 = od0 + (size_t)NTOK * 512;
  const float* convout = (const float*)(p.ws + OFF_CONV);
  bf16_t* Y = (bf16_t*)(p.ws + OFF_YMIX);
  for (int t = blockIdx.x * 4 + wv; t < NTOK; t += gridDim.x * 4) {
    const bf16_t* pr = P + (size_t)t * PSTRIDE;
    bf16_t* yr = Y + (size_t)t * 1024;
#pragma unroll
    for (int h = 0; h < 4; ++h) {
      const int idx = h * 128 + lane * 2;
      float2 a = *(const float2*)(od0 + (size_t)t * 512 + idx);
      float2 b = *(const float2*)(od1 + (size_t)t * 512 + idx);
      float o0 = a.x + b.x, o1 = a.y + b.y;
      float ss = wave_sum(o0 * o0 + o1 * o1);
      float rs = rsqrtf(ss * (1.f / 128.f) + EPSV);
      float n0, n1;
      unsigned gz;
      if (!odd) {
        n0 = p.in[14][il * 512 + idx]; n1 = p.in[14][il * 512 + idx + 1];
        gz = *(const unsigned*)(pr + 1024 + idx);
      } else {
        n0 = p.in[21][il * 128 + lane * 2]; n1 = p.in[21][il * 128 + lane * 2 + 1];
        gz = *(const unsigned*)(pr + 1536 + idx);
      }
      float y0 = siluf(bflo(gz)) * o0 * rs * n0;
      float y1 = siluf(bfhi(gz)) * o1 * rs * n1;
      *(unsigned*)(yr + idx) = pack2(y0, y1);
    }
    if (!odd) {
      int seq_lo, seq_hi;
      if (t < NPROMPT) { seq_lo = (t >> 8) << 8; seq_hi = seq_lo + 256; }
      else { seq_lo = NPROMPT + (((t - NPROMPT) >> 11) << 11); seq_hi = seq_lo + 2048; }
      const bool hp = (t - 1 >= seq_lo), hn = (t + 1 < seq_hi);
#pragma unroll
      for (int j = 0; j < 4; ++j) {
        const int c = j * 128 + lane * 2;
        unsigned cg0 = *(const unsigned*)(pr + 2048 + c), hb0 = *(const unsigned*)(pr + 2560 + c);
        const bf16_t* prm = hp ? pr - PSTRIDE : pr;
        const bf16_t* prp = hn ? pr + PSTRIDE : pr;
        unsigned cgm = *(const unsigned*)(prm + 2048 + c), hbm = *(const unsigned*)(prm + 2560 + c);
        unsigned cgp = *(const unsigned*)(prp + 2048 + c), hbp = *(const unsigned*)(prp + 2560 + c);
        if (!hp) { cgm = 0; hbm = 0; }
        if (!hn) { cgp = 0; hbp = 0; }
        unsigned bg = *(const unsigned*)(pr + 1536 + c);
        const float* sw = p.in[15] + (size_t)il * 3 * 512 + c;
        float y0 = bflo(bg) * (sw[0] * bflo(cgm) * bflo(hbm) + sw[512] * bflo(cg0) * bflo(hb0) + sw[1024] * bflo(cgp) * bflo(hbp));
        float y1 = bfhi(bg) * (sw[1] * bfhi(cgm) * bfhi(hbm) + sw[513] * bfhi(cg0) * bfhi(hb0) + sw[1025] * bfhi(cgp) * bfhi(hbp));
        *(unsigned*)(yr + 512 + c) = pack2(y0, y1);
      }
    } else {
      float v[8];
      float s = 0.f;
#pragma unroll
      for (int j = 0; j < 4; ++j) {
        float2 a = *(const float2*)(convout + (size_t)t * 512 + j * 128 + lane * 2);
        v[2 * j] = a.x; v[2 * j + 1] = a.y;
        s += a.x + a.y;
      }
      const float mean = wave_sum(s) * (1.f / 512.f);
      float vs = 0.f;
#pragma unroll
      for (int j = 0; j < 8; ++j) { v[j] -= mean; vs += v[j] * v[j]; }
      const float rstd = rsqrtf(wave_sum(vs) * (1.f / 512.f) + EPSV);
#pragma unroll
      for (int j = 0; j < 4; ++j) {
        const int c = j * 128 + lane * 2;
        float y0 = v[2 * j] * rstd * p.in[24][il * 512 + c] + p.in[25][il * 512 + c];
        float y1 = v[2 * j + 1] * rstd * p.in[24][il * 512 + c + 1] + p.in[25][il * 512 + c + 1];
        *(unsigned*)(yr + 512 + c) = pack2(siluf(y0), siluf(y1));
      }
    }
  }
}

#define CE_DESC(a, b) { unsigned _mx = max(a, b), _mn = min(a, b); a = _mx; b = _mn; }
#define CE_ASC(a, b) { unsigned _mx = max(a, b), _mn = min(a, b); a = _mn; b = _mx; }
__device__ __forceinline__ void sort16_desc(unsigned* v) {
#pragma unroll
  for (int k = 2; k <= 16; k <<= 1) {
#pragma unroll
    for (int j = k >> 1; j > 0; j >>= 1) {
#pragma unroll
      for (int i = 0; i < 16; ++i) {
        const int l = i ^ j;
        if (l > i) {
          if ((i & k) == 0) CE_DESC(v[i], v[l]) else CE_ASC(v[i], v[l])
        }
      }
    }
  }
}
__device__ __forceinline__ void merge16_top(unsigned* a, const unsigned* b) {
#pragma unroll
  for (int i = 0; i < 16; ++i) a[i] = max(a[i], b[15 - i]);
#pragma unroll
  for (int j = 8; j > 0; j >>= 1) {
#pragma unroll
    for (int i = 0; i < 16; ++i) {
      const int l = i ^ j;
      if (l > i) CE_DESC(a[i], a[l])
    }
  }
}
__device__ __forceinline__ void phase_peer_score(const Params& p, int l, unsigned char* smem) {
  const int tid = opaque_tid(), lane = tid & 63, w = tid >> 6, quad = lane >> 4, l15 = lane & 15;
  unsigned* scw = (unsigned*)smem + w * (32 * 132 + 512);
  unsigned* sel = scw + 32 * 132;
  const bf16_t* Q = (const bf16_t*)(p.ws + OFF_Q);
  const bf16_t* KB = (const bf16_t*)(p.ws + OFF_KEYS) + (size_t)l * 8 * 2 * 128 * 128;
  int* EI = (int*)(p.ws + OFF_EIDX);
  float* GT = (float*)(p.ws + OFF_GATE);
  for (int u = blockIdx.x; u < 3072; u += gridDim.x) {
    const int tt = u >> 1, h = (u & 1) * 4 + w;
    const int t0 = tt * 16;
#pragma unroll
    for (int pp = 0; pp < 2; ++pp) {
      bf16x8 a[4];
#pragma unroll
      for (int kk = 0; kk < 4; ++kk) a[kk] = ldfrag(Q + (size_t)(t0 + l15) * 2048 + h * 256 + pp * 128 + kk * 32 + quad * 8);
      const bf16_t* kb = KB + (size_t)((h * 2 + pp) * 128) * 128;
#pragma unroll
      for (int ct = 0; ct < 8; ++ct) {
        f32x4 c = (f32x4){0.f, 0.f, 0.f, 0.f};
#pragma unroll
        for (int kk = 0; kk < 4; ++kk) {
          bf16x8 b = ldfrag(kb + (ct * 16 + l15) * 128 + kk * 32 + quad * 8);
          c = mfma16(a[kk], b, c);
        }
#pragma unroll
        for (int jj = 0; jj < 4; ++jj) {
          const int row = pp * 16 + quad * 4 + jj, col = ct * 16 + l15;
          unsigned key = (fkey(c[jj]) & ~127u) | (unsigned)(127 - col);
          scw[row * 132 + col] = key;
        }
      }
    }
    __syncthreads();
    {
      const int row = lane >> 1, hf = lane & 1;
      const u32x4* rp = (const u32x4*)(scw + row * 132 + hf * 64);
      unsigned g0[16], g1[16];
#pragma unroll
      for (int q = 0; q < 4; ++q) { u32x4 t4 = rp[q]; g0[4 * q] = t4[0]; g0[4 * q + 1] = t4[1]; g0[4 * q + 2] = t4[2]; g0[4 * q + 3] = t4[3]; }
#pragma unroll
      for (int q = 0; q < 4; ++q) { u32x4 t4 = rp[4 + q]; g1[4 * q] = t4[0]; g1[4 * q + 1] = t4[1]; g1[4 * q + 2] = t4[2]; g1[4 * q + 3] = t4[3]; }
      sort16_desc(g0);
      sort16_desc(g1);
      merge16_top(g0, g1);
#pragma unroll
      for (int q = 0; q < 4; ++q) { u32x4 t4 = rp[8 + q]; g1[4 * q] = t4[0]; g1[4 * q + 1] = t4[1]; g1[4 * q + 2] = t4[2]; g1[4 * q + 3] = t4[3]; }
      sort16_desc(g1);
      merge16_top(g0, g1);
#pragma unroll
      for (int q = 0; q < 4; ++q) { u32x4 t4 = rp[12 + q]; g1[4 * q] = t4[0]; g1[4 * q + 1] = t4[1]; g1[4 * q + 2] = t4[2]; g1[4 * q + 3] = t4[3]; }
      sort16_desc(g1);
      merge16_top(g0, g1);
#pragma unroll
      for (int i = 0; i < 16; ++i) g1[i] = (unsigned)__shfl_xor((int)g0[i], 1);
      merge16_top(g0, g1);
      if (hf == 0) {
#pragma unroll
        for (int q = 0; q < 4; ++q) {
          u32x4 t4 = {g0[4 * q], g0[4 * q + 1], g0[4 * q + 2], g0[4 * q + 3]};
          *(u32x4*)(sel + row * 16 + 4 * q) = t4;
        }
      }
    }
    __syncthreads();
    {
      const int tok = lane >> 2, sub = lane & 3;
      const unsigned* s1 = sel + tok * 16;
      const unsigned* s2 = sel + (16 + tok) * 16;
      unsigned ck[13];
#pragma unroll
      for (int i = 0; i < 13; ++i) {
        const int cidx = sub + 4 * i;
        const int a = CAND_A[cidx], b = CAND_B[cidx];
        float s = keyf(s1[a] & ~127u) + keyf(s2[b] & ~127u);
        unsigned k = (fkey(s) & ~255u) | (unsigned)(255 - (a * 16 + b));
        ck[i] = (cidx < 50) ? k : 0u;
      }
      unsigned prev = 0xFFFFFFFFu;
      unsigned top[16];
#pragma unroll
      for (int r = 0; r < 16; ++r) {
        unsigned best = 0;
#pragma unroll
        for (int i = 0; i < 13; ++i) {
          unsigned tsel = (ck[i] < prev) ? ck[i] : 0u;
          best = max(best, tsel);
        }
        best = max(best, (unsigned)__shfl_xor((int)best, 1));
        best = max(best, (unsigned)__shfl_xor((int)best, 2));
        prev = best;
        top[r] = best;
      }
      float sv[16];
      int ev[16];
#pragma unroll
      for (int r = 0; r < 16; ++r) {
        const int cidx = 255 - (int)(top[r] & 255u);
        const int a = cidx >> 4, b = cidx & 15;
        const unsigned k1 = s1[a], k2 = s2[b];
        sv[r] = keyf(k1 & ~127u) + keyf(k2 & ~127u);
        ev[r] = (127 - (int)(k1 & 127u)) * 128 + (127 - (int)(k2 & 127u));
      }
      float mx = sv[0];
#pragma unroll
      for (int r = 1; r < 16; ++r) mx = fmaxf(mx, sv[r]);
      float sum = 0.f;
#pragma unroll
      for (int r = 0; r < 16; ++r) { sv[r] = expf(sv[r] - mx); sum += sv[r]; }
      const float inv = 1.f / sum;
      const size_t ob = (size_t)(t0 + tok) * 128 + h * 16;
#pragma unroll
      for (int r = 0; r < 16; ++r) {
        if ((r & 3) == sub) { EI[ob + r] = ev[r]; GT[ob + r] = sv[r] * inv; }
      }
    }
    __syncthreads();
  }
}

__device__ __forceinline__ float gelu_tanh(float x) {
  return 0.5f * x * (1.f + tanhf(0.7978845608028654f * (x + 0.044715f * x * x * x)));
}
__device__ __forceinline__ float butterfly8(const float* d, int lane) {
  const bool b5 = lane & 32, b4 = lane & 16, b3 = lane & 8;
  float e4[4], e2[2], e1;
#pragma unroll
  for (int j = 0; j < 4; ++j) {
    float snd = b5 ? d[j] : d[j + 4];
    float kep = b5 ? d[j + 4] : d[j];
    e4[j] = kep + __shfl_xor(snd, 32);
  }
#pragma unroll
  for (int j = 0; j < 2; ++j) {
    float snd = b4 ? e4[j] : e4[j + 2];
    float kep = b4 ? e4[j + 2] : e4[j];
    e2[j] = kep + __shfl_xor(snd, 16);
  }
  {
    float snd = b3 ? e2[0] : e2[1];
    float kep = b3 ? e2[1] : e2[0];
    e1 = kep + __shfl_xor(snd, 8);
  }
  e1 += __shfl_xor(e1, 4);
  e1 += __shfl_xor(e1, 2);
  e1 += __shfl_xor(e1, 1);
  const int jj = lane & 7;
  const int srcl = ((jj >> 2) & 1) * 32 + ((jj >> 1) & 1) * 16 + (jj & 1) * 8;
  return __shfl(e1, srcl);
}
__device__ __forceinline__ void phase_peer_gather(const Params& p, int l) {
  const int tid_ = opaque_tid(); const int lane = tid_ & 63, wv = tid_ >> 6;
  const bf16_t* H = (const bf16_t*)(p.ws + OFF_H);
  bf16_t* Hw = (bf16_t*)(p.ws + OFF_H);
  const unsigned char* UB = p.ws + OFF_UB + (size_t)l * 16384 * 512;
  const unsigned char* VB = p.ws + OFF_VB + (size_t)l * 16384 * 512;
  const int* EI = (const int*)(p.ws + OFF_EIDX);
  const float* GT = (const float*)(p.ws + OFF_GATE);
  const float* modv = (const float*)(p.ws + OFF_MOD);
  for (int t = blockIdx.x * 4 + wv; t < NTOK; t += gridDim.x * 4) {
    float xf[16];
    unpack8(*(const uint4*)(H + (size_t)t * 1024 + lane * 16), xf);
    unpack8(*(const uint4*)(H + (size_t)t * 1024 + lane * 16 + 8), xf + 8);
    f32x2 xf2[8], out2[8];
#pragma unroll
    for (int e = 0; e < 8; ++e) { xf2[e] = (f32x2){xf[2 * e], xf[2 * e + 1]}; out2[e] = (f32x2){0.f, 0.f}; }
    const int ev0 = EI[(size_t)t * 128 + lane], ev1 = EI[(size_t)t * 128 + 64 + lane];
    const float gv0 = GT[(size_t)t * 128 + lane], gv1 = GT[(size_t)t * 128 + 64 + lane];
    float cacc0 = 0.f, cacc1 = 0.f, coef0 = 0.f, coef1 = 0.f;
    uint2 bufA[16], bufB[16];
#define GLOAD(buf, bb) { \
      const unsigned char* tb_ = ((bb) < 8) ? UB : VB; \
      const int evv_ = (((bb) & 7) < 4) ? ev0 : ev1; \
      _Pragma("unroll") for (int j = 0; j < 16; ++j) { \
        const int e_ = __builtin_amdgcn_readlane(evv_, ((bb) & 3) * 16 + j); \
        buf[j] = *(const uint2*)(tb_ + (size_t)e_ * 512 + lane * 8); } }
#define GCOMP(buf, bb) { \
      if ((bb) < 8) { \
        float d_[16]; \
        _Pragma("unroll") for (int j = 0; j < 16; ++j) { \
          f32x2 uf_[8]; unpack16_fp4(buf[j].x, buf[j].y, uf_); \
          f32x2 sa_ = uf_[0] * xf2[0]; \
          _Pragma("unroll") for (int q = 1; q < 8; ++q) sa_ = __builtin_elementwise_fma(uf_[q], xf2[q], sa_); \
          d_[j] = sa_.x + sa_.y; } \
        const float t0_ = butterfly8(d_, lane), t1_ = butterfly8(d_ + 8, lane); \
        const int k0_ = ((bb) & 3) * 16; \
        if (((bb) & 7) < 4) { if ((lane >> 3) == (k0_ >> 3)) cacc0 = t0_; if ((lane >> 3) == (k0_ >> 3) + 1) cacc0 = t1_; } \
        else { if ((lane >> 3) == (k0_ >> 3)) cacc1 = t0_; if ((lane >> 3) == (k0_ >> 3) + 1) cacc1 = t1_; } \
        if ((bb) == 7) { coef0 = gelu_tanh(cacc0 * (1.f / U_SCALE)) * gv0 * (1.f / V_SCALE); coef1 = gelu_tanh(cacc1 * (1.f / U_SCALE)) * gv1 * (1.f / V_SCALE); } \
      } else { \
        const float cfv_ = (((bb) & 7) < 4) ? coef0 : coef1; \
        _Pragma("unroll") for (int j = 0; j < 16; ++j) { \
          const float cf_ = __uint_as_float((unsigned)__builtin_amdgcn_readlane((int)__float_as_uint(cfv_), ((bb) & 3) * 16 + j)); \
          f32x2 vf_[8]; unpack16_fp4(buf[j].x, buf[j].y, vf_); \
          const f32x2 c2_ = {cf_, cf_}; \
          _Pragma("unroll") for (int q = 0; q < 8; ++q) out2[q] = __builtin_elementwise_fma(vf_[q], c2_, out2[q]); } \
      } }
    GLOAD(bufA, 0)
#pragma unroll
    for (int b = 0; b < 16; b += 2) {
      GLOAD(bufB, b + 1)
      GCOMP(bufA, b)
      if (b + 2 < 16) GLOAD(bufA, b + 2)
      GCOMP(bufB, b + 1)
    }
#undef GLOAD
#undef GCOMP
    float out[16];
#pragma unroll
    for (int e = 0; e < 8; ++e) { out[2 * e] = out2[e].x; out[2 * e + 1] = out2[e].y; }
    const int m = tok_mod(t);
    const float* ga2 = modv + (size_t)(l * 9 + m) * 6144 + 5120;
    float* xr = p.out + (size_t)t * 1024 + lane * 16;
    float xn[16];
    float ss = 0.f;
#pragma unroll
    for (int q4 = 0; q4 < 4; ++q4) {
      float4 xv = *(const float4*)(xr + q4 * 4);
      float4 gg = *(const float4*)(ga2 + lane * 16 + q4 * 4);
      const int o = q4 * 4;
      xn[o + 0] = xv.x + gg.x * out[o + 0];
      xn[o + 1] = xv.y + gg.y * out[o + 1];
      xn[o + 2] = xv.z + gg.z * out[o + 2];
      xn[o + 3] = xv.w + gg.w * out[o + 3];
      ss += xn[o] * xn[o] + xn[o + 1] * xn[o + 1] + xn[o + 2] * xn[o + 2] + xn[o + 3] * xn[o + 3];
    }
    ss = wave_sum(ss);
    const float rs = rsqrtf(ss * (1.f / 1024.f) + EPSV);
    if (l < 3) {
      const float* md = modv + (size_t)((l + 1) * 9 + m) * 6144 + lane * 16;
      const float* g = p.in[8] + (l + 1) * 1024 + lane * 16;
      float hv[16];
#pragma unroll
      for (int q = 0; q < 16; ++q) hv[q] = xn[q] * rs * g[q] * (1.f + md[1024 + q]) + md[q];
      uint4 o;
      o.x = pack2(hv[0], hv[1]); o.y = pack2(hv[2], hv[3]); o.z = pack2(hv[4], hv[5]); o.w = pack2(hv[6], hv[7]);
      *(uint4*)(Hw + (size_t)t * 1024 + lane * 16) = o;
      o.x = pack2(hv[8], hv[9]); o.y = pack2(hv[10], hv[11]); o.z = pack2(hv[12], hv[13]); o.w = pack2(hv[14], hv[15]);
      *(uint4*)(Hw + (size_t)t * 1024 + lane * 16 + 8) = o;
#pragma unroll
      for (int q4 = 0; q4 < 4; ++q4) *(float4*)(xr + q4 * 4) = make_float4(xn[q4 * 4], xn[q4 * 4 + 1], xn[q4 * 4 + 2], xn[q4 * 4 + 3]);
    } else {
      const float* g = p.in[10] + lane * 16;
#pragma unroll
      for (int q4 = 0; q4 < 4; ++q4)
        *(float4*)(xr + q4 * 4) = make_float4(xn[q4 * 4] * rs * g[q4 * 4], xn[q4 * 4 + 1] * rs * g[q4 * 4 + 1],
                                              xn[q4 * 4 + 2] * rs * g[q4 * 4 + 2], xn[q4 * 4 + 3] * rs * g[q4 * 4 + 3]);
    }
  }
}

#define XB_TMO      128
#define XB_XCNT(j)  (256  + 64 * (j))
#define XB_XSUB(j)  (1280 + 64 * (j))
#define XB_XGEN(j)  (2304 + 64 * (j))
#define XB_TOP      3328
#define XB_TOPGEN   3392
#define XCD_BAR_WORDS 3456
#define XB_SPIN_CAP (1u << 18)
#define LAS __attribute__((address_space(3)))

__device__ __forceinline__ unsigned xb_ld(unsigned* p)              { return __hip_atomic_load(p, __ATOMIC_RELAXED, __HIP_MEMORY_SCOPE_AGENT); }
__device__ __forceinline__ unsigned xb_add(unsigned* p, unsigned v) { return __hip_atomic_fetch_add(p, v, __ATOMIC_RELAXED, __HIP_MEMORY_SCOPE_AGENT); }
__device__ __forceinline__ unsigned xb_xcc_id() { return (unsigned)__builtin_amdgcn_s_getreg((3 << 11) | 20) & 0xFu; }
#define XB_SPIN(cond, bar) do { unsigned _sp = 0; while (cond) { __builtin_amdgcn_s_sleep(1); \
    if ((++_sp & 255u) == 0u) { if (xb_ld(&(bar)[XB_TMO])) break; if (_sp > XB_SPIN_CAP) { atomicAdd(&(bar)[XB_TMO], 1u); break; } } } } while (0)

struct XcdBarrier {
    unsigned* bar; unsigned x;
    volatile LAS unsigned* st;
};

__device__ __forceinline__ XcdBarrier xcd_barrier_post(unsigned* bar, volatile LAS unsigned* st) {
    XcdBarrier b; b.bar = bar; b.x = xb_xcc_id(); b.st = st;
    if (threadIdx.x == 0) (void)xb_add(&bar[XB_XCNT(b.x)], 1u);
    return b;
}
__device__ __forceinline__ void xcd_barrier_complete(unsigned* bar, unsigned x, unsigned& nloc, unsigned& nx) {
    const unsigned G = gridDim.x * gridDim.y * gridDim.z;
    unsigned sum, cnt, mine, sp = 0u;
    for (;;) {
        sum = 0u; cnt = 0u; mine = 0u;
#pragma unroll
        for (unsigned j = 0; j < 16; ++j) { const unsigned c = xb_ld(&bar[XB_XCNT(j)]); sum += c; cnt += (c > 0u) ? 1u : 0u; mine = (j == x) ? c : mine; }
        if (sum == G) break;
        __builtin_amdgcn_s_sleep(1);
        if ((++sp & 255u) == 0u) { if (xb_ld(&bar[XB_TMO])) break; if (sp > XB_SPIN_CAP) { atomicAdd(&bar[XB_TMO], 1u); break; } }
    }
    nloc = mine > 0u ? mine : 1u; nx = cnt > 0u ? cnt : 1u;
}

__device__ __forceinline__ void xcd_barrier(const XcdBarrier& b) {
    asm volatile("s_waitcnt vmcnt(0)" ::: "memory");
    __syncthreads();
    if (threadIdx.x == 0) {
        unsigned* bar = b.bar;
        __builtin_amdgcn_s_waitcnt(0);
        unsigned nloc = b.st[0], nx = b.st[1];
        if (nloc == 0u) { xcd_barrier_complete(bar, b.x, nloc, nx); b.st[0] = nloc; b.st[1] = nx; }
        const unsigned old = xb_add(&bar[XB_XSUB(b.x)], 1u);
        const unsigned gen = old / nloc;
        if (old + 1u == (gen + 1u) * nloc) {
            __builtin_amdgcn_fence(__ATOMIC_RELEASE, "agent");
            asm volatile("s_waitcnt vmcnt(0)" ::: "memory");
            const unsigned og = xb_add(&bar[XB_TOP], 1u);
            const unsigned tg = og / nx;
            if (og + 1u == (tg + 1u) * nx) xb_add(&bar[XB_TOPGEN], 1u);
            else XB_SPIN(xb_ld(&bar[XB_TOPGEN]) == tg, bar);
            __builtin_amdgcn_fence(__ATOMIC_ACQUIRE, "agent");
            xb_add(&bar[XB_XGEN(b.x)], 1u);
            asm volatile("s_waitcnt vmcnt(0)" ::: "memory");
        } else {
            XB_SPIN(xb_ld(&bar[XB_XGEN(b.x)]) == gen, bar);
            __builtin_amdgcn_fence(__ATOMIC_ACQUIRE, "agent");
            asm volatile("s_waitcnt vmcnt(0)" ::: "memory");
        }
    }
    __syncthreads();
}

__global__ void __launch_bounds__(256, 2) mega(Params p, int ph_lo, int ph_hi) {
  __shared__ __attribute__((aligned(16))) unsigned char smem[77312];
  cg::grid_group grid = cg::this_grid();
  __shared__ uint4 xb_words;
  if (threadIdx.x == 0) xb_words = make_uint4(0u, 0u, 0u, 0u);
  __syncthreads();
  XcdBarrier xb = xcd_barrier_post((unsigned*)(p.ws + OFF_BAR), (volatile LAS unsigned*)&xb_words);
  if (ph_hi > 100000) grid.sync();
  for (int ph = ph_lo; ph < ph_hi; ++ph) {
#if PROBE_MASK
    const int pcode = ph < 2 ? ph : 2 + (ph - 2) % 9;
    const int nrep = ((PROBE_MASK >> pcode) & 1) ? 2 : 1;
    for (int rep = 0; rep < nrep; ++rep) {
    if (rep) xcd_barrier(xb);
#endif
    bool did = true;
#if PROBE_MASK
    const int prep_rep = rep;
#else
    const int prep_rep = 0;
#endif
    if (ph == 0) phase_prep_a(p, smem);
    else if (ph == 1) phase_prep_b(p);
    else {
      const int l = (ph - 2) / 9, sub = (ph - 2) % 9;
      const int il = l >> 1;
      const bool odd = l & 1;
      const float* modv = (const float*)(p.ws + OFF_MOD);
      if (sub == 0 || sub == 6) {
        const bf16_t* Bt; int ntn, ldc; bf16_t* C;
        if (sub == 0) {
          Bt = odd ? (const bf16_t*)(p.ws + OFF_WIN_OD) + (size_t)il * 3200 * 1024
                   : (const bf16_t*)(p.ws + OFF_WIN_EV) + (size_t)il * 3072 * 1024;
          ntn = odd ? 25 : 24; ldc = PSTRIDE; C = (bf16_t*)(p.ws + OFF_P);
        } else {
          Bt = (const bf16_t*)(p.ws + OFF_WQ) + (size_t)l * 2048 * 1024;
          ntn = 16; ldc = 2048; C = (bf16_t*)(p.ws + OFF_Q);
        }
        gemm_phase<0>((const bf16_t*)(p.ws + OFF_H), Bt, ntn, C, ldc, nullptr, nullptr, smem);
      } else if (sub == 1) {
        if (odd) phase_odd_prep(p, l, smem, prep_rep); else did = false;
      } else if (sub == 2) {
        if (odd) phase_gdn_chain(p, l, smem); else phase_ret_chain(p, l, smem);
      } else if (sub == 3) {
        phase_mix_out(p, l);
      } else if (sub == 4) {
        gemm_phase<1>((const bf16_t*)(p.ws + OFF_YMIX), (const bf16_t*)(p.ws + OFF_WOUT) + (size_t)l * 1024 * 1024, 8,
                      nullptr, 0, p.out, modv + (size_t)l * 9 * 6144 + 2048, smem);
      } else if (sub == 5) {
        phase_norm2(p, l);
      } else if (sub == 7) {
        phase_peer_score(p, l, smem);
      } else {
        phase_peer_gather(p, l);
      }
    }
#if PROBE_MASK
    if (rep + 1 < nrep) continue;
#endif
    if (did && ph + 1 < ph_hi) xcd_barrier(xb);
#if PROBE_MASK
    }
#endif
  }
}

extern "C" void kernel_launch(void* const* d_in, const int* in_sizes, int n_in, void* d_out, int out_size,
                              void* d_ws, size_t ws_size, hipStream_t stream) {
  static int grid_blocks = 0;
  if (!grid_blocks) {
    int dev = 0, cus = 0, per_cu = 0;
    (void)hipGetDevice(&dev);
    (void)hipDeviceGetAttribute(&cus, hipDeviceAttributeMultiprocessorCount, dev);
    (void)hipOccupancyMaxActiveBlocksPerMultiprocessor(&per_cu, mega, 256, 0);
    if (per_cu < 1) per_cu = 1;
    if (per_cu > 2) per_cu = 2;
    grid_blocks = cus * per_cu;
    if (ws_size < WS_NEED) fprintf(stderr, "kernel_launch: workspace too small: %zu < %zu\n", ws_size, (size_t)WS_NEED);
  }
  Params p{};
  for (int i = 0; i < 30; ++i) p.in[i] = (const float*)d_in[i];
  p.out = (float*)d_out;
  p.ws = (unsigned char*)d_ws;
  (void)hipMemsetAsync((unsigned char*)d_ws + OFF_BAR, 0, XCD_BAR_WORDS * sizeof(unsigned), stream);
#if SINGLE_LAUNCH
  int lo = 0, hi = NPHASE;
  void* args[] = {&p, &lo, &hi};
  hipError_t e = hipLaunchCooperativeKernel((void*)mega, dim3(grid_blocks), dim3(256), args, 0, stream);
  if (e != hipSuccess) fprintf(stderr, "cooperative launch failed: %s (grid %d)\n", hipGetErrorString(e), grid_blocks);
#else
  for (int ph = 0; ph < NPHASE; ++ph) {
    const int l = (ph - 2) / 9, sub = (ph - 2) % 9;
    if (ph >= 2 && sub == 1 && !(l & 1)) continue;
    hipLaunchKernelGGL(mega, dim3(grid_blocks), dim3(256), 0, stream, p, ph, ph + 1);
  }
#endif
}
```

```cpp
#include <hip/hip_runtime.h>
#include <hip/hip_cooperative_groups.h>
#include <cstdio>
namespace cg = cooperative_groups;

#ifndef PROBE_MASK
#define PROBE_MASK 0
#endif
#ifndef GATHER_CHECK
#define GATHER_CHECK 0
#endif
#ifndef PROBE_CVT
#define PROBE_CVT 0
#endif
#ifndef PROBE_ODD
#define PROBE_ODD 0
#endif
#ifndef SINGLE_LAUNCH
#define SINGLE_LAUNCH 1
#endif

typedef unsigned short bf16_t;
using bf16x8 = __attribute__((ext_vector_type(8))) short;
using f32x4 = __attribute__((ext_vector_type(4))) float;
using f32x2 = __attribute__((ext_vector_type(2))) float;
using u32x4 = __attribute__((ext_vector_type(4))) unsigned;
using v8i32 = __attribute__((ext_vector_type(8))) int;

#define NTOK 24576
#define NPROMPT 8192
#define PSTRIDE 3200
#define EPSV 1e-6f
#define NPHASE 38
#define X_SCALE 1.5f

constexpr size_t OFF_MOD = 0;
constexpr size_t OFF_ROPE = 1u << 20;
constexpr size_t OFF_WIN_EV = OFF_ROPE + 65536;
constexpr size_t OFF_WIN_OD = OFF_WIN_EV + 2ull * 3072 * 1024 * 2;
constexpr size_t OFF_WOUT = OFF_WIN_OD + 2ull * 3328 * 1024 * 2;
constexpr size_t OFF_WQ = OFF_WOUT + 4ull * 1024 * 1024 * 2;
constexpr size_t OFF_KEYS = OFF_WQ + 4ull * 2048 * 1024 * 2;
constexpr size_t OFF_UB = OFF_KEYS + 4ull * 8 * 2 * 128 * 128 * 2;
constexpr size_t OFF_VB = OFF_UB + 4ull * 16384 * 1024 * 2;
constexpr size_t OFF_H = OFF_VB + 4ull * 16384 * 1024 * 2;
constexpr size_t OFF_P = OFF_H + (size_t)NTOK * 1024 * 2;
constexpr size_t OFF_YMIX = OFF_P + (size_t)NTOK * PSTRIDE * 2;
constexpr size_t OFF_ODIR = OFF_YMIX + (size_t)NTOK * 1024 * 2;
constexpr size_t OFF_Q = OFF_ODIR;
constexpr size_t OFF_EIDX = OFF_ODIR + 2ull * NTOK * 512 * 4;
constexpr size_t OFF_GATE = OFF_EIDX + (size_t)NTOK * 128 * 4;
constexpr size_t GP_ITEM = 73728;
constexpr size_t OFF_GPREP = OFF_GATE + (size_t)NTOK * 128 * 4;
constexpr size_t OFF_EGL = OFF_GPREP + 3072ull * GP_ITEM;
constexpr size_t OFF_CONV = OFF_EGL + 16384;
constexpr size_t OFF_H8 = OFF_CONV;
constexpr size_t OFF_BAR = OFF_CONV + (size_t)NTOK * 512 * 4;
constexpr size_t WS_NEED = OFF_BAR + 16384;

struct Params {
  const float* in[30];
  float* out;
  unsigned char* ws;
};

__device__ const unsigned char CAND_A[52] = {0,0,0,0,0,0,0,0,0,0,0,0,0,0,0,0,1,1,1,1,1,1,1,1,2,2,2,2,2,3,3,3,3,4,4,4,5,5,6,6,7,7,8,9,10,11,12,13,14,15,0,0};
__device__ const unsigned char CAND_B[52] = {0,1,2,3,4,5,6,7,8,9,10,11,12,13,14,15,0,1,2,3,4,5,6,7,0,1,2,3,4,0,1,2,3,0,1,2,0,1,0,1,0,1,0,0,0,0,0,0,0,0,0,0};

__device__ __forceinline__ int opaque_tid() { int t = threadIdx.x; asm volatile("" : "+v"(t)); return t; }
typedef __bf16 hbf16x2 __attribute__((ext_vector_type(2)));
__device__ __forceinline__ bf16_t f2bf(float f) {
  return __builtin_bit_cast(unsigned short, (__bf16)f);
}
__device__ __forceinline__ float bf2f(bf16_t b) { return __uint_as_float(((unsigned)b) << 16); }
__device__ __forceinline__ float bflo(unsigned u) { return __uint_as_float(u << 16); }
__device__ __forceinline__ float bfhi(unsigned u) { return __uint_as_float(u & 0xffff0000u); }
__device__ __forceinline__ unsigned pack2(float a, float b) {
  f32x2 v = {a, b};
  return __builtin_bit_cast(unsigned, __builtin_convertvector(v, hbf16x2));
}
__device__ __forceinline__ float wave_sum(float v) {
#pragma unroll
  for (int o = 32; o > 0; o >>= 1) v += __shfl_xor(v, o);
  return v;
}
__device__ __forceinline__ f32x4 mfma16(bf16x8 a, bf16x8 b, f32x4 c) {
  return __builtin_amdgcn_mfma_f32_16x16x32_bf16(a, b, c, 0, 0, 0);
}
__device__ __forceinline__ bf16x8 ldfrag(const bf16_t* p) { return *(const bf16x8*)p; }
__device__ __forceinline__ float siluf(float v) { return v * __builtin_amdgcn_rcpf(1.f + __expf(-v)); }
__device__ __forceinline__ int tok_mod(int t) { return t < NPROMPT ? 0 : 1 + ((t - NPROMPT) >> 11); }
__device__ __forceinline__ unsigned fkey(float f) {
  unsigned u = __float_as_uint(f);
  return (u & 0x80000000u) ? ~u : (u | 0x80000000u);
}
__device__ __forceinline__ float keyf(unsigned k) {
  unsigned b = (k & 0x80000000u) ? (k ^ 0x80000000u) : ~k;
  return __uint_as_float(b);
}
__device__ __forceinline__ void unpack8(uint4 v, float* f) {
  f[0] = bflo(v.x); f[1] = bfhi(v.x); f[2] = bflo(v.y); f[3] = bfhi(v.y);
  f[4] = bflo(v.z); f[5] = bfhi(v.z); f[6] = bflo(v.w); f[7] = bfhi(v.w);
}

__device__ __forceinline__ void prep_mod(const Params& p, float* smem) {
  float* sc = smem;
  float* red = smem + 9 * 1024;
  const int tid = opaque_tid();
  const float* c = p.in[4];
  const float* cctx = p.in[5];
  for (int i = tid; i < 9 * 1024; i += 256) {
    int m = i >> 10, k = i & 1023;
    float v = (m == 0) ? cctx[k] : c[(m - 1) * 1024 + k];
    sc[i] = v / (1.f + expf(-v));
  }
  __syncthreads();
  float* modv = (float*)(p.ws + OFF_MOD);
  const int cl = tid & 63, kg = tid >> 6;
  for (int u = blockIdx.x; u < 4 * 96; u += gridDim.x) {
    const int l = u / 96, nb = (u % 96) * 64;
    const float* W = p.in[6] + (size_t)l * 1024 * 6144 + nb + cl;
    float acc[9];
#pragma unroll
    for (int m = 0; m < 9; ++m) acc[m] = 0.f;
#pragma unroll 16
    for (int k = kg * 256; k < kg * 256 + 256; ++k) {
      float w = W[(size_t)k * 6144];
#pragma unroll
      for (int m = 0; m < 9; ++m) acc[m] += sc[m * 1024 + k] * w;
    }
#pragma unroll
    for (int m = 0; m < 9; ++m) red[(kg * 9 + m) * 64 + cl] = acc[m];
    __syncthreads();
    for (int i = tid; i < 9 * 64; i += 256) {
      int m = i >> 6, c2 = i & 63;
      float s = red[(0 * 9 + m) * 64 + c2] + red[(1 * 9 + m) * 64 + c2] + red[(2 * 9 + m) * 64 + c2] + red[(3 * 9 + m) * 64 + c2];
      int nn = nb + c2;
      modv[(size_t)(l * 9 + m) * 6144 + nn] = s + p.in[7][l * 6144 + nn];
    }
    __syncthreads();
  }
}

__device__ __forceinline__ void prep_transpose(const float* src, bf16_t* dst, int N, int Npad, float* tile) {
  const int tid = opaque_tid();
  const int ntn = Npad / 64;
  const int units = ntn * 16;
  for (int u = blockIdx.x; u < units; u += gridDim.x) {
    const int nt = u % ntn, kt = u / ntn;
    const int n0 = nt * 64, k0 = kt * 64;
    {
      const int c = tid & 63;
      const int n = n0 + c;
      const int nc = n < N ? n : N - 1;
      float tv[16];
#pragma unroll
      for (int i = 0; i < 16; ++i) tv[i] = src[(size_t)(k0 + (tid >> 6) + 4 * i) * N + nc];
#pragma unroll
      for (int i = 0; i < 16; ++i) tile[((tid >> 6) + 4 * i) * 65 + c] = (n < N) ? tv[i] : 0.f;
    }
    __syncthreads();
#pragma unroll 4
    for (int i = 0; i < 16; ++i) {
      int rr = (tid >> 6) + 4 * i, cc = tid & 63;
      dst[(size_t)(n0 + rr) * 1024 + k0 + cc] = f2bf(tile[cc * 65 + rr]);
    }
    __syncthreads();
  }
}

__device__ __forceinline__ void prep_convert(const float* src, bf16_t* dst, size_t n4) {
  const size_t stride = (size_t)gridDim.x * 256;
  for (size_t i0 = (size_t)blockIdx.x * 256 + threadIdx.x; i0 < n4; i0 += stride * 8) {
    float4 v[8];
#pragma unroll
    for (int j = 0; j < 8; ++j) { const size_t i = i0 + j * stride; const size_t ic = i < n4 ? i : n4 - 1; v[j] = ((const float4*)src)[ic]; }
#pragma unroll
    for (int j = 0; j < 8; ++j) {
      const size_t i = i0 + j * stride;
      if (i < n4) { uint2 o; o.x = pack2(v[j].x, v[j].y); o.y = pack2(v[j].z, v[j].w); ((uint2*)dst)[i] = o; }
    }
  }
}

__device__ __forceinline__ void prep_convert_fp8(const float* src, unsigned* dst, size_t n4, float scale) {
  const size_t stride = (size_t)gridDim.x * 256;
  for (size_t i0 = (size_t)blockIdx.x * 256 + threadIdx.x; i0 < n4; i0 += stride * 8) {
    float4 v[8];
#pragma unroll
    for (int j = 0; j < 8; ++j) { const size_t i = i0 + j * stride; const size_t ic = i < n4 ? i : n4 - 1; f32x4 t4 = __builtin_nontemporal_load((const f32x4*)src + ic); v[j] = make_float4(t4[0], t4[1], t4[2], t4[3]); }
#pragma unroll
    for (int j = 0; j < 8; ++j) {
      const size_t i = i0 + j * stride;
      if (i < n4) {
        unsigned w = __builtin_amdgcn_cvt_pk_fp8_f32(v[j].x * scale, v[j].y * scale, 0, false);
        w = __builtin_amdgcn_cvt_pk_fp8_f32(v[j].z * scale, v[j].w * scale, w, true);
        dst[i] = w;
      }
    }
  }
}
__device__ __forceinline__ void prep_convert_fp4(const float* src, unsigned* dst, size_t n8, float scale) {
  const size_t stride = (size_t)gridDim.x * 256;
  for (size_t i0 = (size_t)blockIdx.x * 256 + threadIdx.x; i0 < n8; i0 += stride * 4) {
    f32x4 va[4], vb[4];
#pragma unroll
    for (int j = 0; j < 4; ++j) {
      const size_t i = i0 + j * stride; const size_t ic = i < n8 ? i : n8 - 1;
      va[j] = __builtin_nontemporal_load((const f32x4*)src + 2 * ic);
      vb[j] = __builtin_nontemporal_load((const f32x4*)src + 2 * ic + 1);
    }
#pragma unroll
    for (int j = 0; j < 4; ++j) {
      const size_t i = i0 + j * stride;
      if (i < n8) {
        unsigned w = 0;
        w = __builtin_amdgcn_cvt_scalef32_pk_fp4_f32(w, va[j][0] * scale, va[j][1] * scale, 1.0f, 0);
        w = __builtin_amdgcn_cvt_scalef32_pk_fp4_f32(w, va[j][2] * scale, va[j][3] * scale, 1.0f, 1);
        w = __builtin_amdgcn_cvt_scalef32_pk_fp4_f32(w, vb[j][0] * scale, vb[j][1] * scale, 1.0f, 2);
        w = __builtin_amdgcn_cvt_scalef32_pk_fp4_f32(w, vb[j][2] * scale, vb[j][3] * scale, 1.0f, 3);
        dst[i] = w;
      }
    }
  }
}
__device__ __forceinline__ void unpack16_fp4(unsigned w0, unsigned w1, f32x2* f) {
  f[0] = __builtin_amdgcn_cvt_scalef32_pk_f32_fp4(w0, 1.0f, 0);
  f[1] = __builtin_amdgcn_cvt_scalef32_pk_f32_fp4(w0, 1.0f, 1);
  f[2] = __builtin_amdgcn_cvt_scalef32_pk_f32_fp4(w0, 1.0f, 2);
  f[3] = __builtin_amdgcn_cvt_scalef32_pk_f32_fp4(w0, 1.0f, 3);
  f[4] = __builtin_amdgcn_cvt_scalef32_pk_f32_fp4(w1, 1.0f, 0);
  f[5] = __builtin_amdgcn_cvt_scalef32_pk_f32_fp4(w1, 1.0f, 1);
  f[6] = __builtin_amdgcn_cvt_scalef32_pk_f32_fp4(w1, 1.0f, 2);
  f[7] = __builtin_amdgcn_cvt_scalef32_pk_f32_fp4(w1, 1.0f, 3);
}
__device__ __forceinline__ void unpack16_fp8(u32x4 v, float* f) {
#pragma unroll
  for (int i = 0; i < 4; ++i) {
    f32x2 lo = __builtin_amdgcn_cvt_pk_f32_fp8(v[i], false);
    f32x2 hi = __builtin_amdgcn_cvt_pk_f32_fp8(v[i], true);
    f[4 * i + 0] = lo.x; f[4 * i + 1] = lo.y; f[4 * i + 2] = hi.x; f[4 * i + 3] = hi.y;
  }
}
#define U_SCALE 64.f
#define V_SCALE 20.f
__device__ __forceinline__ void phase_prep_a(const Params& p, unsigned char* smem) {
  float* fs = (float*)smem;
  prep_mod(p, fs);
  {
    float2* rope = (float2*)(p.ws + OFF_ROPE);
    int i = blockIdx.x * 256 + threadIdx.x;
    if (i < 64 * 16) {
      int pos = i >> 4, f = i & 15;
      float fr = powf(10000.f, -(float)f / 16.f);
      float ang = (float)pos * fr;
      rope[i] = make_float2(cosf(ang), sinf(ang));
    }
  }
  for (int i = 0; i < 2; ++i) {
    prep_transpose(p.in[11] + (size_t)i * 1024 * 3072, (bf16_t*)(p.ws + OFF_WIN_EV) + (size_t)i * 3072 * 1024, 3072, 3072, fs);
    prep_transpose(p.in[16] + (size_t)i * 1024 * 3088, (bf16_t*)(p.ws + OFF_WIN_OD) + (size_t)i * 3328 * 1024, 3088, 3328, fs);
    prep_transpose(p.in[12] + (size_t)i * 1024 * 1024, (bf16_t*)(p.ws + OFF_WOUT) + (size_t)(2 * i) * 1024 * 1024, 1024, 1024, fs);
    prep_transpose(p.in[17] + (size_t)i * 1024 * 1024, (bf16_t*)(p.ws + OFF_WOUT) + (size_t)(2 * i + 1) * 1024 * 1024, 1024, 1024, fs);
  }
  for (int l = 0; l < 4; ++l)
    prep_transpose(p.in[26] + (size_t)l * 1024 * 2048, (bf16_t*)(p.ws + OFF_WQ) + (size_t)l * 2048 * 1024, 2048, 2048, fs);
  prep_convert(p.in[27], (bf16_t*)(p.ws + OFF_KEYS), (size_t)4 * 8 * 2 * 128 * 128 / 4);
  prep_convert_fp4(p.in[28], (unsigned*)(p.ws + OFF_UB), (size_t)4 * 16384 * 1024 / 8, U_SCALE);
  prep_convert_fp4(p.in[29], (unsigned*)(p.ws + OFF_VB), (size_t)4 * 16384 * 1024 / 8, V_SCALE);
}

__device__ __forceinline__ void norm_token(const float* xrow, const float* g, const float* scale, const float* shift,
                                           bf16_t* hrow, float* copy_dst, int lane, unsigned char* h8row = nullptr) {
  float4 v[4];
  float ss = 0.f;
#pragma unroll
  for (int i = 0; i < 4; ++i) {
    v[i] = *(const float4*)(xrow + i * 256 + lane * 4);
    ss += v[i].x * v[i].x + v[i].y * v[i].y + v[i].z * v[i].z + v[i].w * v[i].w;
  }
  ss = wave_sum(ss);
  const float rs = rsqrtf(ss * (1.f / 1024.f) + EPSV);
#pragma unroll
  for (int i = 0; i < 4; ++i) {
    const int idx = i * 256 + lane * 4;
    if (copy_dst) *(float4*)(copy_dst + idx) = v[i];
    float4 gg = *(const float4*)(g + idx);
    float4 sc = *(const float4*)(scale + idx);
    float4 sh = *(const float4*)(shift + idx);
    float a = v[i].x * rs * gg.x * (1.f + sc.x) + sh.x;
    float b = v[i].y * rs * gg.y * (1.f + sc.y) + sh.y;
    float c = v[i].z * rs * gg.z * (1.f + sc.z) + sh.z;
    float d = v[i].w * rs * gg.w * (1.f + sc.w) + sh.w;
    uint2 o;
    o.x = pack2(a, b);
    o.y = pack2(c, d);
    *(uint2*)(hrow + idx) = o;
    if (h8row) {
      unsigned w4 = 0;
      w4 = __builtin_amdgcn_cvt_scalef32_pk_fp4_f32(w4, a * X_SCALE, b * X_SCALE, 1.0f, 0);
      w4 = __builtin_amdgcn_cvt_scalef32_pk_fp4_f32(w4, c * X_SCALE, d * X_SCALE, 1.0f, 1);
      *(unsigned short*)(h8row + (idx >> 1)) = (unsigned short)w4;
    }
  }
}

__device__ __forceinline__ void phase_prep_b(const Params& p) {
  const int tid_ = opaque_tid(); const int lane = tid_ & 63, wv = tid_ >> 6;
  const float* modv = (const float*)(p.ws + OFF_MOD);
  bf16_t* H = (bf16_t*)(p.ws + OFF_H);
  for (int t = blockIdx.x * 4 + wv; t < NTOK; t += gridDim.x * 4) {
    const float* xr = (t < NPROMPT) ? p.in[0] + (size_t)t * 1024 : p.in[1] + (size_t)(t - NPROMPT) * 1024;
    const float* md = modv + (size_t)(0 * 9 + tok_mod(t)) * 6144;
    norm_token(xr, p.in[8], md + 1024, md, H + (size_t)t * 1024, p.out + (size_t)t * 1024, lane);
  }
}

__device__ __forceinline__ void phase_norm2(const Params& p, int l) {
  const int tid_ = opaque_tid(); const int lane = tid_ & 63, wv = tid_ >> 6;
  const float* modv = (const float*)(p.ws + OFF_MOD);
  bf16_t* H = (bf16_t*)(p.ws + OFF_H);
  for (int t = blockIdx.x * 4 + wv; t < NTOK; t += gridDim.x * 4) {
    const float* md = modv + (size_t)(l * 9 + tok_mod(t)) * 6144;
    norm_token(p.out + (size_t)t * 1024, p.in[9] + l * 1024, md + 4096, md + 3072, H + (size_t)t * 1024, nullptr, lane,
               p.ws + OFF_H8 + (size_t)t * 512);
  }
}

template <int EPI, int NJ, int BK>
__device__ __forceinline__ void gemm_phase(const bf16_t* __restrict__ A, const bf16_t* __restrict__ Bt, int ntiles_n,
                           bf16_t* __restrict__ C, int ldc, float* __restrict__ X, const float* __restrict__ ga,
                           unsigned char* smem, int dry = 0) {
  constexpr int TN = 32 * NJ;
  constexpr int LS = BK + 8;
  constexpr int TPR = BK / 8;
  constexpr int RPP = 256 / TPR;
  constexpr int NA = 128 / RPP, NB = TN / RPP;
  bf16_t* As = (bf16_t*)smem;
  bf16_t* Bs = As + 128 * LS;
  const int tid = opaque_tid(), lane = tid & 63, w = tid >> 6, quad = lane >> 4, l15 = lane & 15;
  const int wm = w >> 1, wn = w & 1;
  const int lr = tid / TPR, lseg = (tid % TPR) * 8;
  const int units = 192 * ntiles_n;
  for (int u = blockIdx.x; u < units; u += gridDim.x) {
    const int mt = u % 192, nt = u / 192;
    const int m0 = mt * 128, n0 = nt * TN;
    f32x4 acc[4][NJ];
#pragma unroll
    for (int i = 0; i < 4; ++i)
#pragma unroll
      for (int j = 0; j < NJ; ++j) acc[i][j] = (f32x4){0.f, 0.f, 0.f, 0.f};
    const bf16_t* Ag = A + (size_t)(m0 + lr) * 1024 + lseg;
    const bf16_t* Bg = Bt + (size_t)(n0 + lr) * 1024 + lseg;
    u32x4 ra[NA], rb[NB];
#pragma unroll
    for (int i = 0; i < NA; ++i) ra[i] = *(const u32x4*)(Ag + (size_t)i * RPP * 1024);
#pragma unroll
    for (int i = 0; i < NB; ++i) rb[i] = *(const u32x4*)(Bg + (size_t)i * RPP * 1024);
    for (int kt = 0; kt < 1024 / BK; ++kt) {
#pragma unroll
      for (int i = 0; i < NA; ++i) *(u32x4*)(As + (lr + RPP * i) * LS + lseg) = ra[i];
#pragma unroll
      for (int i = 0; i < NB; ++i) *(u32x4*)(Bs + (lr + RPP * i) * LS + lseg) = rb[i];
      __syncthreads();
      if (kt + 1 < 1024 / BK) {
        const bf16_t* An = Ag + (kt + 1) * BK;
        const bf16_t* Bn = Bg + (kt + 1) * BK;
#pragma unroll
        for (int i = 0; i < NA; ++i) ra[i] = *(const u32x4*)(An + (size_t)i * RPP * 1024);
#pragma unroll
        for (int i = 0; i < NB; ++i) rb[i] = *(const u32x4*)(Bn + (size_t)i * RPP * 1024);
      }
#pragma unroll
      for (int kk = 0; kk < BK / 32; ++kk) {
        bf16x8 af[4];
#pragma unroll
        for (int i = 0; i < 4; ++i) af[i] = ldfrag(As + (wm * 64 + i * 16 + l15) * LS + kk * 32 + quad * 8);
#pragma unroll
        for (int j = 0; j < NJ; ++j) {
          const bf16x8 bfr = ldfrag(Bs + (wn * (16 * NJ) + j * 16 + l15) * LS + kk * 32 + quad * 8);
#pragma unroll
          for (int i = 0; i < 4; ++i) acc[i][j] = mfma16(af[i], bfr, acc[i][j]);
        }
      }
      __syncthreads();
    }
    if (EPI == 0) {
#pragma unroll
      for (int i = 0; i < 4; ++i)
#pragma unroll
        for (int j = 0; j < NJ; ++j) {
          const int col = n0 + wn * (16 * NJ) + j * 16 + l15;
          if (col < ldc) {
#pragma unroll
            for (int jj = 0; jj < 4; ++jj) {
              int row = m0 + wm * 64 + i * 16 + quad * 4 + jj;
              C[(size_t)row * ldc + col] = f2bf(acc[i][j][jj]);
            }
          }
        }
    } else {
      const float* gam = ga + (size_t)tok_mod(m0) * 6144;
#pragma unroll
      for (int i = 0; i < 4; ++i)
#pragma unroll
        for (int j = 0; j < NJ; ++j)
#pragma unroll
          for (int jj = 0; jj < 4; ++jj) {
            int row = m0 + wm * 64 + i * 16 + quad * 4 + jj;
            int col = n0 + wn * (16 * NJ) + j * 16 + l15;
            float* xp = X + (size_t)row * 1024 + col;
            const float nv = *xp + gam[col] * acc[i][j][jj];
            if (!dry) *xp = nv;
          }
    }
  }
}

struct ChainItem {
  bool lng; int sl, dir, h, sq, tok0, nc;
};
__device__ __forceinline__ ChainItem decode_item(int it) {
  ChainItem c;
  c.lng = it < 256;
  int idx = c.lng ? it : it - 256;
  c.sl = idx & 3; c.dir = (idx >> 2) & 1; c.h = (idx >> 3) & 3; c.sq = idx >> 5;
  c.tok0 = c.lng ? NPROMPT + c.sq * 2048 : c.sq * 256;
  c.nc = c.lng ? 32 : 4;
  return c;
}

__device__ __forceinline__ void phase_ret_chain(const Params& p, int l, unsigned char* smem) {
  const int il = l >> 1;
  bf16_t* qs = (bf16_t*)smem;
  bf16_t* ks = qs + 64 * 72;
  bf16_t* kT = ks + 64 * 72;
  bf16_t* vT = kT + 64 * 72;
  bf16_t* intra = vT + 32 * 72;
  bf16_t* ST = intra + 64 * 72;
  const bf16_t* P = (const bf16_t*)(p.ws + OFF_P);
  float* odir = (float*)(p.ws + OFF_ODIR);
  const float2* rope = (const float2*)(p.ws + OFF_ROPE);
  const int tid = opaque_tid(), lane = tid & 63, w = tid >> 6, quad = lane >> 4, l15 = lane & 15;
  const int nlb = (gridDim.x >= 512) ? 256 : ((gridDim.x >= 2) ? (int)(gridDim.x / 2) : 0);
  const bool longblk = (nlb > 0) ? ((int)blockIdx.x < nlb) : true;
  const int it_lo = (nlb > 0) ? (longblk ? (int)blockIdx.x : 256 + ((int)blockIdx.x - nlb)) : (int)blockIdx.x;
  const int it_hi = (nlb > 0) ? (longblk ? 256 : 1280) : 1280;
  const int it_st = (nlb > 0) ? (longblk ? nlb : ((int)gridDim.x - nlb)) : (int)gridDim.x;
  for (int it = it_lo; it < it_hi; it += it_st) {
    const ChainItem ci = decode_item(it);
    const int sl = ci.sl, dir = ci.dir, h = ci.h;
    const float xg = p.in[13][(il * 2 + dir) * 4 + h];
    const float lg = -log1pf(expf(-xg));
    const float g64 = expf(lg * 64.f);
    f32x4 S[2];
    if (ci.lng) {
      const float* s0 = p.in[2] + ((((size_t)ci.sq * 2 + il) * 2 + dir) * 4 + h) * 8192;
#pragma unroll
      for (int ct = 0; ct < 2; ++ct)
#pragma unroll
        for (int jj = 0; jj < 4; ++jj) S[ct][jj] = s0[(16 * w + quad * 4 + jj) * 128 + sl * 32 + ct * 16 + l15];
    } else {
      S[0] = (f32x4){0.f, 0.f, 0.f, 0.f};
      S[1] = (f32x4){0.f, 0.f, 0.f, 0.f};
    }
    for (int n = 0; n < ci.nc; ++n) {
      const int cn = dir ? ci.nc - 1 - n : n;
      const int tb = ci.tok0 + cn * 64;
      {
        const int i = tid >> 2, mq = tid & 3;
        const int t = tb + (dir ? 63 - i : i);
        const bf16_t* pr = P + (size_t)t * PSTRIDE;
        float qa[8], qb[8], ka[8], kb[8];
        unpack8(*(const uint4*)(pr + h * 64 + mq * 8), qa);
        unpack8(*(const uint4*)(pr + h * 64 + 32 + mq * 8), qb);
        unpack8(*(const uint4*)(pr + 256 + h * 64 + mq * 8), ka);
        unpack8(*(const uint4*)(pr + 256 + h * 64 + 32 + mq * 8), kb);
        if (ci.lng) {
          const int pos = (mq < 2) ? cn : (t - tb);
          const int f0 = (mq & 1) * 8;
#pragma unroll
          for (int e = 0; e < 8; ++e) {
            float2 cs = rope[pos * 16 + f0 + e];
            float a = qa[e], b = qb[e];
            qa[e] = a * cs.x - b * cs.y; qb[e] = b * cs.x + a * cs.y;
            a = ka[e]; b = kb[e];
            ka[e] = a * cs.x - b * cs.y; kb[e] = b * cs.x + a * cs.y;
          }
        }
        const float wend = expf(lg * (float)(63 - i));
        uint4 o;
        o.x = pack2(qa[0], qa[1]); o.y = pack2(qa[2], qa[3]); o.z = pack2(qa[4], qa[5]); o.w = pack2(qa[6], qa[7]);
        *(uint4*)(qs + i * 72 + mq * 8) = o;
        o.x = pack2(qb[0], qb[1]); o.y = pack2(qb[2], qb[3]); o.z = pack2(qb[4], qb[5]); o.w = pack2(qb[6], qb[7]);
        *(uint4*)(qs + i * 72 + 32 + mq * 8) = o;
#pragma unroll
        for (int e = 0; e < 8; ++e) { ka[e] *= 0.125f; kb[e] *= 0.125f; }
        o.x = pack2(ka[0], ka[1]); o.y = pack2(ka[2], ka[3]); o.z = pack2(ka[4], ka[5]); o.w = pack2(ka[6], ka[7]);
        *(uint4*)(ks + i * 72 + mq * 8) = o;
        o.x = pack2(kb[0], kb[1]); o.y = pack2(kb[2], kb[3]); o.z = pack2(kb[4], kb[5]); o.w = pack2(kb[6], kb[7]);
        *(uint4*)(ks + i * 72 + 32 + mq * 8) = o;
#pragma unroll
        for (int e = 0; e < 8; ++e) {
          kT[(mq * 8 + e) * 72 + i] = f2bf(ka[e] * wend);
          kT[(32 + mq * 8 + e) * 72 + i] = f2bf(kb[e] * wend);
        }
        uint4 v8 = *(const uint4*)(pr + 512 + h * 128 + sl * 32 + mq * 8);
        vT[(mq * 8 + 0) * 72 + i] = (bf16_t)(v8.x & 0xffff); vT[(mq * 8 + 1) * 72 + i] = (bf16_t)(v8.x >> 16);
        vT[(mq * 8 + 2) * 72 + i] = (bf16_t)(v8.y & 0xffff); vT[(mq * 8 + 3) * 72 + i] = (bf16_t)(v8.y >> 16);
        vT[(mq * 8 + 4) * 72 + i] = (bf16_t)(v8.z & 0xffff); vT[(mq * 8 + 5) * 72 + i] = (bf16_t)(v8.z >> 16);
        vT[(mq * 8 + 6) * 72 + i] = (bf16_t)(v8.w & 0xffff); vT[(mq * 8 + 7) * 72 + i] = (bf16_t)(v8.w >> 16);
      }
      __syncthreads();
      const bf16x8 a0 = ldfrag(qs + (16 * w + l15) * 72 + quad * 8);
      const bf16x8 a1 = ldfrag(qs + (16 * w + l15) * 72 + 32 + quad * 8);
#pragma unroll
      for (int ct = 0; ct < 4; ++ct) {
        bf16x8 b0 = ldfrag(ks + (ct * 16 + l15) * 72 + quad * 8);
        bf16x8 b1 = ldfrag(ks + (ct * 16 + l15) * 72 + 32 + quad * 8);
        f32x4 c = (f32x4){0.f, 0.f, 0.f, 0.f};
        c = mfma16(a0, b0, c);
        c = mfma16(a1, b1, c);
#pragma unroll
        for (int jj = 0; jj < 4; ++jj) {
          int i = 16 * w + quad * 4 + jj, j = ct * 16 + l15;
          float val = (i >= j) ? c[jj] * expf(lg * (float)(i - j)) : 0.f;
          intra[i * 72 + j] = f2bf(val);
        }
      }
#pragma unroll
      for (int ct = 0; ct < 2; ++ct)
#pragma unroll
        for (int jj = 0; jj < 4; ++jj) ST[(ct * 16 + l15) * 72 + 16 * w + quad * 4 + jj] = f2bf(S[ct][jj]);
      __syncthreads();
      const bf16x8 ai0 = ldfrag(intra + (16 * w + l15) * 72 + quad * 8);
      const bf16x8 ai1 = ldfrag(intra + (16 * w + l15) * 72 + 32 + quad * 8);
      const bf16x8 ak0 = ldfrag(kT + (16 * w + l15) * 72 + quad * 8);
      const bf16x8 ak1 = ldfrag(kT + (16 * w + l15) * 72 + 32 + quad * 8);
#pragma unroll
      for (int ct = 0; ct < 2; ++ct) {
        bf16x8 bv0 = ldfrag(vT + (ct * 16 + l15) * 72 + quad * 8);
        bf16x8 bv1 = ldfrag(vT + (ct * 16 + l15) * 72 + 32 + quad * 8);
        bf16x8 bs0 = ldfrag(ST + (ct * 16 + l15) * 72 + quad * 8);
        bf16x8 bs1 = ldfrag(ST + (ct * 16 + l15) * 72 + 32 + quad * 8);
        f32x4 ci_ = (f32x4){0.f, 0.f, 0.f, 0.f}, cc = (f32x4){0.f, 0.f, 0.f, 0.f};
        ci_ = mfma16(ai0, bv0, ci_);
        ci_ = mfma16(ai1, bv1, ci_);
        cc = mfma16(a0, bs0, cc);
        cc = mfma16(a1, bs1, cc);
#pragma unroll
        for (int jj = 0; jj < 4; ++jj) {
          int i = 16 * w + quad * 4 + jj;
          int t = tb + (dir ? 63 - i : i);
          float o = ci_[jj] + expf(lg * (float)(i + 1)) * cc[jj];
          odir[((size_t)dir * NTOK + t) * 512 + h * 128 + sl * 32 + ct * 16 + l15] = o;
        }
        f32x4 s = S[ct];
        s[0] *= g64; s[1] *= g64; s[2] *= g64; s[3] *= g64;
        s = mfma16(ak0, bv0, s);
        s = mfma16(ak1, bv1, s);
        S[ct] = s;
      }
      __syncthreads();
    }
    if (!ci.lng) {
      float* so = p.out + 25165824 + ((((size_t)ci.sq * 2 + il) * 2 + dir) * 4 + h) * 8192;
#pragma unroll
      for (int ct = 0; ct < 2; ++ct)
#pragma unroll
        for (int jj = 0; jj < 4; ++jj) so[(16 * w + quad * 4 + jj) * 128 + sl * 32 + ct * 16 + l15] = S[ct][jj];
    }
  }
}

__device__ __forceinline__ void gdn_prep_item(const Params& p, int l, int pi, unsigned char* smem, int plvl) {
  const int il = l >> 1;
  bf16_t* ks = (bf16_t*)smem;
  bf16_t* vs = ks + 64 * 136;
  float* Am = (float*)(vs + 64 * 136);
  float* rq = Am + 4096;
  float* rk = rq + 64;
  float* gcs = rk + 64;
  float* bet = gcs + 64;
  float* fac = bet + 64;
  bf16_t* qs = (bf16_t*)(fac + 128);
  const bf16_t* P = (const bf16_t*)(p.ws + OFF_P);
  unsigned char* gp = p.ws + OFF_GPREP + (size_t)pi * GP_ITEM;
  bf16_t* Wb = (bf16_t*)gp;
  bf16_t* QG = Wb + 8192;
  bf16_t* KDT = QG + 8192;
  bf16_t* Ub = KDT + 8192;
  bf16_t* ATT = Ub + 8192;
  float* EGL = (float*)(p.ws + OFF_EGL);
  const int tid = opaque_tid(), lane = tid & 63, w = tid >> 6, quad = lane >> 4, l15 = lane & 15;
  const int dir = pi & 1, h = (pi >> 1) & 3, c = pi >> 3;
  int tb, seq_lo, seq_hi;
  if (c < 128) { tb = c * 64; seq_lo = (c >> 2) * 256; seq_hi = seq_lo + 256; }
  else { int cc = c - 128; tb = NPROMPT + cc * 64; seq_lo = NPROMPT + (cc >> 5) * 2048; seq_hi = seq_lo + 2048; }
  const float SCALE = 0.08838834764831845f;
  {
    const int cg_ = tid & 127, rh = tid >> 7;
#pragma unroll
    for (int mat = 0; mat < 3; ++mat) {
      const int col = mat * 512 + h * 128 + cg_;
      const float* cw = p.in[18] + (size_t)il * 3 * 1536 + col;
      const float w0 = cw[0], w1 = cw[1536], w2 = cw[3072];
      bf16_t* dst = mat == 0 ? qs : (mat == 1 ? ks : vs);
      const int t0 = tb + rh * 32;
      bf16_t raw[34];
#pragma unroll
      for (int o = 0; o < 34; ++o) {
        const int t = t0 - 1 + o;
        const int tc = min(max(t, seq_lo), seq_hi - 1);
        const bf16_t rv = P[(size_t)tc * PSTRIDE + col];
        raw[o] = (t == tc) ? rv : (bf16_t)0;
      }
#pragma unroll
      for (int o = 0; o < 32; ++o) {
        float y = w0 * bf2f(raw[o]) + w1 * bf2f(raw[o + 1]) + w2 * bf2f(raw[o + 2]);
        y = siluf(y);
        const int oi = rh * 32 + o;
        const int i = dir ? 63 - oi : oi;
        dst[i * 136 + cg_] = f2bf(y);
      }
    }
  }
  __syncthreads();
  if (plvl == 4) return;
  {
    const int r = tid >> 2, part = tid & 3;
    float sq_ = 0.f, sk_ = 0.f;
#pragma unroll 8
    for (int e = 0; e < 32; ++e) {
      float a = bf2f(qs[r * 136 + part * 32 + e]);
      float b = bf2f(ks[r * 136 + part * 32 + e]);
      sq_ += a * a; sk_ += b * b;
    }
    sq_ += __shfl_xor(sq_, 1); sq_ += __shfl_xor(sq_, 2);
    sk_ += __shfl_xor(sk_, 1); sk_ += __shfl_xor(sk_, 2);
    if (part == 0) {
      rq[r] = rsqrtf(sq_ + EPSV);
      rk[r] = rsqrtf(sk_ + EPSV);
      const int t = tb + (dir ? 63 - r : r);
      float a = bf2f(P[(size_t)t * PSTRIDE + 2048 + dir * 4 + h]);
      float bbv = bf2f(P[(size_t)t * PSTRIDE + 2056 + dir * 4 + h]);
      float al = p.in[19][(il * 2 + dir) * 4 + h], dtb = p.in[20][(il * 2 + dir) * 4 + h];
      float z = a + dtb;
      float sp = (z > 20.f) ? z : log1pf(expf(z));
      gcs[r] = -expf(al) * sp;
      bet[r] = 1.f / (1.f + expf(-bbv));
    }
  }
  __syncthreads();
  if (tid < 64) {
    float v = gcs[tid];
#pragma unroll
    for (int o = 1; o < 64; o <<= 1) {
      float u = __shfl_up(v, o);
      if (tid >= o) v += u;
    }
    gcs[tid] = v;
  }
  __syncthreads();
  {
    bf16x8 ak[4], aq[4];
#pragma unroll
    for (int kk = 0; kk < 4; ++kk) {
      ak[kk] = ldfrag(ks + (16 * w + l15) * 136 + kk * 32 + quad * 8);
      aq[kk] = ldfrag(qs + (16 * w + l15) * 136 + kk * 32 + quad * 8);
    }
#pragma unroll
    for (int ct = 0; ct < 4; ++ct) {
      f32x4 ckk = (f32x4){0.f, 0.f, 0.f, 0.f}, cqk = (f32x4){0.f, 0.f, 0.f, 0.f};
#pragma unroll
      for (int kk = 0; kk < 4; ++kk) {
        bf16x8 b = ldfrag(ks + (ct * 16 + l15) * 136 + kk * 32 + quad * 8);
        ckk = mfma16(ak[kk], b, ckk);
        cqk = mfma16(aq[kk], b, cqk);
      }
#pragma unroll
      for (int jj = 0; jj < 4; ++jj) {
        const int i = 16 * w + quad * 4 + jj, j = ct * 16 + l15;
        const float dec = (i >= j) ? __expf(gcs[i] - gcs[j]) : 0.f;
        Am[j * 64 + i] = (i > j) ? bet[i] * rk[i] * rk[j] * ckk[jj] * dec : 0.f;
        ATT[i * 64 + j] = f2bf((i >= j) ? SCALE * rq[i] * rk[j] * cqk[jj] * dec : 0.f);
      }
    }
  }
  __syncthreads();
  const float gl = gcs[63];
#pragma unroll 8
  for (int e = tid; e < 64 * 128; e += 256) {
    int i = e >> 7, d = e & 127;
    QG[e] = f2bf(bf2f(qs[i * 136 + d]) * rq[i] * SCALE * __expf(gcs[i]));
  }
#pragma unroll 8
  for (int e = tid; e < 128 * 64; e += 256) {
    int d = e >> 6, i = e & 63;
    KDT[e] = f2bf(bf2f(ks[i * 136 + d]) * rk[i] * __expf(gl - gcs[i]));
  }
  if (tid < 64) {
    fac[tid] = bet[tid];
    fac[64 + tid] = rk[tid] * bet[tid] * __expf(gcs[tid]);
  }
  __syncthreads();
  if (plvl != 3) {
    const int cidx = tid & 127;
    const bf16_t* srcm = ((tid < 128) ? vs : ks) + cidx;
    const float* fc = fac + ((tid < 128) ? 0 : 64);
    bf16_t* dstm = ((tid < 128) ? Ub : Wb) + cidx;
    bf16_t* XB = qs + tid;
#pragma unroll 1
    for (int b = 0; b < 4; ++b) {
      float x[16];
#pragma unroll
      for (int r = 0; r < 16; ++r) x[r] = bf2f(srcm[(16 * b + r) * 136]) * fc[16 * b + r];
      const float* arow = Am + 16 * b;
#pragma unroll 4
      for (int j = 0; j < 16 * b; ++j) {
        const float xv = bf2f(XB[j * 256]);
        const f32x4 a0 = *(const f32x4*)(arow + j * 64), a1 = *(const f32x4*)(arow + j * 64 + 4);
        const f32x4 a2 = *(const f32x4*)(arow + j * 64 + 8), a3 = *(const f32x4*)(arow + j * 64 + 12);
#pragma unroll
        for (int r = 0; r < 4; ++r) {
          x[r] -= a0[r] * xv; x[4 + r] -= a1[r] * xv; x[8 + r] -= a2[r] * xv; x[12 + r] -= a3[r] * xv;
        }
      }
      const float* ablk = Am + (16 * b) * 64 + 16 * b;
#pragma unroll
      for (int jj = 0; jj < 15; ++jj) {
#pragma unroll
        for (int r = jj + 1; r < 16; ++r) x[r] -= ablk[jj * 64 + r] * x[jj];
      }
#pragma unroll
      for (int r = 0; r < 16; ++r) {
        const bf16_t bb = f2bf(x[r]);
        dstm[(16 * b + r) * 128] = bb;
        if (b < 3) XB[(16 * b + r) * 256] = bb;
      }
    }
  }
  if (tid == 0) EGL[pi] = expf(gl);
  __syncthreads();
}

__device__ __forceinline__ void conf_conv_item(const Params& p, int l, int item, unsigned char* smem) {
  const int il = l >> 1;
  float* hc = (float*)smem;
  const bf16_t* P = (const bf16_t*)(p.ws + OFF_P);
  float* convout = (float*)(p.ws + OFF_CONV);
  const int tid = opaque_tid();
  const int tile = item >> 1, ch = (item & 1) * 256 + tid;
  const int t0 = tile * 32;
  int seq_lo, seq_hi;
  if (t0 < NPROMPT) { seq_lo = (t0 >> 8) << 8; seq_hi = seq_lo + 256; }
  else { seq_lo = NPROMPT + (((t0 - NPROMPT) >> 11) << 11); seq_hi = seq_lo + 2048; }
#pragma unroll 31
  for (int r = 0; r < 62; ++r) {
    const int tt = t0 - 15 + r;
    const int tc = min(max(tt, seq_lo), seq_hi - 1);
    float ca = bf2f(P[(size_t)tc * PSTRIDE + 2064 + ch]);
    float cgv = bf2f(P[(size_t)tc * PSTRIDE + 2576 + ch]);
    float v = ca * __builtin_amdgcn_rcpf(1.f + __expf(-cgv));
    hc[r * 256 + tid] = (tt == tc) ? v : 0.f;
  }
  float wk[31];
#pragma unroll
  for (int k = 0; k < 31; ++k) wk[k] = p.in[22][((size_t)il * 31 + k) * 512 + ch];
  const float bias = p.in[23][il * 512 + ch];
  for (int i = 0; i < 32; ++i) {
    float acc = bias;
#pragma unroll
    for (int k = 0; k < 31; ++k) acc += wk[k] * hc[(i + k) * 256 + tid];
    convout[(size_t)(t0 + i) * 512 + ch] = acc;
  }
}

__device__ __forceinline__ void phase_odd_prep(const Params& p, int l, unsigned char* smem, int rep) {
  for (int u = blockIdx.x; u < 3072 + 1536; u += gridDim.x) {
#if PROBE_ODD == 1 || PROBE_ODD >= 3
    if (rep && u >= 3072) break;
#elif PROBE_ODD == 2
    if (rep && u < 3072) continue;
#endif
    if (u < 3072) gdn_prep_item(p, l, u, smem, (PROBE_ODD >= 3 && rep) ? PROBE_ODD : 0);
    else { conf_conv_item(p, l, u - 3072, smem); __syncthreads(); }
  }
}

__device__ __forceinline__ void phase_gdn_chain(const Params& p, int l, unsigned char* smem) {
  const int il = l >> 1;
  bf16_t* ST = (bf16_t*)smem;
  bf16_t* VT = ST + 32 * 136;
  float* odir = (float*)(p.ws + OFF_ODIR);
  const float* EGL = (const float*)(p.ws + OFF_EGL);
  const int tid = opaque_tid(), lane = tid & 63, w = tid >> 6, quad = lane >> 4, l15 = lane & 15;
  const int nlb = (gridDim.x >= 512) ? 256 : ((gridDim.x >= 2) ? (int)(gridDim.x / 2) : 0);
  const bool longblk = (nlb > 0) ? ((int)blockIdx.x < nlb) : true;
  const int it_lo = (nlb > 0) ? (longblk ? (int)blockIdx.x : 256 + ((int)blockIdx.x - nlb)) : (int)blockIdx.x;
  const int it_hi = (nlb > 0) ? (longblk ? 256 : 1280) : 1280;
  const int it_st = (nlb > 0) ? (longblk ? nlb : ((int)gridDim.x - nlb)) : (int)gridDim.x;
  for (int it = it_lo; it < it_hi; it += it_st) {
    const ChainItem ci = decode_item(it);
    const int sl = ci.sl, dir = ci.dir, h = ci.h;
    f32x4 S[2][2];
    if (ci.lng) {
      const float* s0 = p.in[3] + ((((size_t)ci.sq * 2 + il) * 2 + dir) * 4 + h) * 16384;
#pragma unroll
      for (int rb = 0; rb < 2; ++rb)
#pragma unroll
        for (int ct = 0; ct < 2; ++ct)
#pragma unroll
          for (int jj = 0; jj < 4; ++jj)
            S[rb][ct][jj] = s0[(16 * (2 * w + rb) + quad * 4 + jj) * 128 + sl * 32 + ct * 16 + l15];
    } else {
#pragma unroll
      for (int rb = 0; rb < 2; ++rb)
#pragma unroll
        for (int ct = 0; ct < 2; ++ct) S[rb][ct] = (f32x4){0.f, 0.f, 0.f, 0.f};
    }
    bf16x8 naw[4], naqg[4];
    bf16_t nuu[2][4];
    float negl = 0.f;
    for (int n = 0; n < ci.nc; ++n) {
      const int cn = dir ? ci.nc - 1 - n : n;
      const int tb = ci.tok0 + cn * 64;
      const int cglob = ci.lng ? 128 + ci.sq * 32 + cn : ci.sq * 4 + cn;
      const int pi = (cglob * 4 + h) * 2 + dir;
      const unsigned char* gp = p.ws + OFF_GPREP + (size_t)pi * GP_ITEM;
      const bf16_t* Wb = (const bf16_t*)gp;
      const bf16_t* QG = Wb + 8192;
      const bf16_t* KDT = QG + 8192;
      const bf16_t* Ub = KDT + 8192;
      const bf16_t* ATT = Ub + 8192;
      bf16x8 aw[4], aqg[4], aat[2], akd[2][2];
      float uu[2][4];
      float egl;
      if (n == 0) {
#pragma unroll
        for (int kk = 0; kk < 4; ++kk) {
          aw[kk] = ldfrag(Wb + (16 * w + l15) * 128 + kk * 32 + quad * 8);
          aqg[kk] = ldfrag(QG + (16 * w + l15) * 128 + kk * 32 + quad * 8);
        }
#pragma unroll
        for (int kk = 0; kk < 2; ++kk) {
          aat[kk] = ldfrag(ATT + (16 * w + l15) * 64 + kk * 32 + quad * 8);
#pragma unroll
          for (int rb = 0; rb < 2; ++rb) akd[rb][kk] = ldfrag(KDT + (16 * (2 * w + rb) + l15) * 64 + kk * 32 + quad * 8);
        }
#pragma unroll
        for (int ct = 0; ct < 2; ++ct)
#pragma unroll
          for (int jj = 0; jj < 4; ++jj) uu[ct][jj] = bf2f(Ub[(16 * w + quad * 4 + jj) * 128 + sl * 32 + ct * 16 + l15]);
        egl = EGL[pi];
      } else {
#pragma unroll
        for (int kk = 0; kk < 4; ++kk) { aw[kk] = naw[kk]; aqg[kk] = naqg[kk]; }
#pragma unroll
        for (int kk = 0; kk < 2; ++kk) {
          aat[kk] = ldfrag(ATT + (16 * w + l15) * 64 + kk * 32 + quad * 8);
#pragma unroll
          for (int rb = 0; rb < 2; ++rb) akd[rb][kk] = ldfrag(KDT + (16 * (2 * w + rb) + l15) * 64 + kk * 32 + quad * 8);
        }
#pragma unroll
        for (int ct = 0; ct < 2; ++ct)
#pragma unroll
          for (int jj = 0; jj < 4; ++jj) uu[ct][jj] = bf2f(nuu[ct][jj]);
        egl = negl;
      }
      if (n + 1 < ci.nc) {
        const int cn2 = dir ? ci.nc - 2 - n : n + 1;
        const int cglob2 = ci.lng ? 128 + ci.sq * 32 + cn2 : ci.sq * 4 + cn2;
        const int pi2 = (cglob2 * 4 + h) * 2 + dir;
        const bf16_t* Wb2 = (const bf16_t*)(p.ws + OFF_GPREP + (size_t)pi2 * GP_ITEM);
        const bf16_t* QG2 = Wb2 + 8192; const bf16_t* Ub2 = QG2 + 16384;
#pragma unroll
        for (int kk = 0; kk < 4; ++kk) {
          naw[kk] = ldfrag(Wb2 + (16 * w + l15) * 128 + kk * 32 + quad * 8);
          naqg[kk] = ldfrag(QG2 + (16 * w + l15) * 128 + kk * 32 + quad * 8);
        }
#pragma unroll
        for (int ct = 0; ct < 2; ++ct)
#pragma unroll
          for (int jj = 0; jj < 4; ++jj) nuu[ct][jj] = Ub2[(16 * w + quad * 4 + jj) * 128 + sl * 32 + ct * 16 + l15];
        negl = EGL[pi2];
      }
#pragma unroll
      for (int rb = 0; rb < 2; ++rb)
#pragma unroll
        for (int ct = 0; ct < 2; ++ct)
#pragma unroll
          for (int jj = 0; jj < 4; ++jj)
            ST[(ct * 16 + l15) * 136 + 16 * (2 * w + rb) + quad * 4 + jj] = f2bf(S[rb][ct][jj]);
      __syncthreads();
      f32x4 co[2];
#pragma unroll
      for (int ct = 0; ct < 2; ++ct) {
        f32x4 cv = (f32x4){0.f, 0.f, 0.f, 0.f};
        co[ct] = (f32x4){0.f, 0.f, 0.f, 0.f};
#pragma unroll
        for (int kk = 0; kk < 4; ++kk) {
          bf16x8 b = ldfrag(ST + (ct * 16 + l15) * 136 + kk * 32 + quad * 8);
          cv = mfma16(aw[kk], b, cv);
          co[ct] = mfma16(aqg[kk], b, co[ct]);
        }
#pragma unroll
        for (int jj = 0; jj < 4; ++jj) {
          float vn = uu[ct][jj] - cv[jj];
          VT[(ct * 16 + l15) * 72 + 16 * w + quad * 4 + jj] = f2bf(vn);
        }
      }
      __syncthreads();
#pragma unroll
      for (int ct = 0; ct < 2; ++ct) {
        bf16x8 bv[2];
#pragma unroll
        for (int kk = 0; kk < 2; ++kk) {
          bv[kk] = ldfrag(VT + (ct * 16 + l15) * 72 + kk * 32 + quad * 8);
          co[ct] = mfma16(aat[kk], bv[kk], co[ct]);
        }
#pragma unroll
        for (int jj = 0; jj < 4; ++jj) {
          int i = 16 * w + quad * 4 + jj;
          int t = tb + (dir ? 63 - i : i);
          odir[((size_t)dir * NTOK + t) * 512 + h * 128 + sl * 32 + ct * 16 + l15] = co[ct][jj];
        }
#pragma unroll
        for (int rb = 0; rb < 2; ++rb) {
          f32x4 s = S[rb][ct];
          s[0] *= egl; s[1] *= egl; s[2] *= egl; s[3] *= egl;
          s = mfma16(akd[rb][0], bv[0], s);
          s = mfma16(akd[rb][1], bv[1], s);
          S[rb][ct] = s;
        }
      }
    }
    __syncthreads();
    if (!ci.lng) {
      float* so = p.out + 29360128 + ((((size_t)ci.sq * 2 + il) * 2 + dir) * 4 + h) * 16384;
#pragma unroll
      for (int rb = 0; rb < 2; ++rb)
#pragma unroll
        for (int ct = 0; ct < 2; ++ct)
#pragma unroll
          for (int jj = 0; jj < 4; ++jj)
            so[(16 * (2 * w + rb) + quad * 4 + jj) * 128 + sl * 32 + ct * 16 + l15] = S[rb][ct][jj];
    }
  }
}

__device__ __forceinline__ void phase_mix_out(const Params& p, int l) {
  const int il = l >> 1;
  const bool odd = l & 1;
  const int tid_ = opaque_tid(); const int lane = tid_ & 63, wv = tid_ >> 6;
  const bf16_t* P = (const bf16_t*)(p.ws + OFF_P);
  const float* od0 = (const float*)(p.ws + OFF_ODIR);
  const float* od1 = od0 + (size_t)NTOK * 512;
  const float* convout = (const float*)(p.ws + OFF_CONV);
  bf16_t* Y = (bf16_t*)(p.ws + OFF_YMIX);
  for (int t = blockIdx.x * 4 + wv; t < NTOK; t += gridDim.x * 4) {
    const bf16_t* pr = P + (size_t)t * PSTRIDE;
    bf16_t* yr = Y + (size_t)t * 1024;
#pragma unroll
    for (int h = 0; h < 4; ++h) {
      const int idx = h * 128 + lane * 2;
      float2 a = *(const float2*)(od0 + (size_t)t * 512 + idx);
      float2 b = *(const float2*)(od1 + (size_t)t * 512 + idx);
      float o0 = a.x + b.x, o1 = a.y + b.y;
      float ss = wave_sum(o0 * o0 + o1 * o1);
      float rs = rsqrtf(ss * (1.f / 128.f) + EPSV);
      float n0, n1;
      unsigned gz;
      if (!odd) {
        n0 = p.in[14][il * 512 + idx]; n1 = p.in[14][il * 512 + idx + 1];
        gz = *(const unsigned*)(pr + 1024 + idx);
      } else {
        n0 = p.in[21][il * 128 + lane * 2]; n1 = p.in[21][il * 128 + lane * 2 + 1];
        gz = *(const unsigned*)(pr + 1536 + idx);
      }
      float y0 = siluf(bflo(gz)) * o0 * rs * n0;
      float y1 = siluf(bfhi(gz)) * o1 * rs * n1;
      *(unsigned*)(yr + idx) = pack2(y0, y1);
    }
    if (!odd) {
      int seq_lo, seq_hi;
      if (t < NPROMPT) { seq_lo = (t >> 8) << 8; seq_hi = seq_lo + 256; }
      else { seq_lo = NPROMPT + (((t - NPROMPT) >> 11) << 11); seq_hi = seq_lo + 2048; }
      const bool hp = (t - 1 >= seq_lo), hn = (t + 1 < seq_hi);
#pragma unroll
      for (int j = 0; j < 4; ++j) {
        const int c = j * 128 + lane * 2;
        unsigned cg0 = *(const unsigned*)(pr + 2048 + c), hb0 = *(const unsigned*)(pr + 2560 + c);
        const bf16_t* prm = hp ? pr - PSTRIDE : pr;
        const bf16_t* prp = hn ? pr + PSTRIDE : pr;
        unsigned cgm = *(const unsigned*)(prm + 2048 + c), hbm = *(const unsigned*)(prm + 2560 + c);
        unsigned cgp = *(const unsigned*)(prp + 2048 + c), hbp = *(const unsigned*)(prp + 2560 + c);
        if (!hp) { cgm = 0; hbm = 0; }
        if (!hn) { cgp = 0; hbp = 0; }
        unsigned bg = *(const unsigned*)(pr + 1536 + c);
        const float* sw = p.in[15] + (size_t)il * 3 * 512 + c;
        float y0 = bflo(bg) * (sw[0] * bflo(cgm) * bflo(hbm) + sw[512] * bflo(cg0) * bflo(hb0) + sw[1024] * bflo(cgp) * bflo(hbp));
        float y1 = bfhi(bg) * (sw[1] * bfhi(cgm) * bfhi(hbm) + sw[513] * bfhi(cg0) * bfhi(hb0) + sw[1025] * bfhi(cgp) * bfhi(hbp));
        *(unsigned*)(yr + 512 + c) = pack2(y0, y1);
      }
    } else {
      float v[8];
      float s = 0.f;
#pragma unroll
      for (int j = 0; j < 4; ++j) {
        float2 a = *(const float2*)(convout + (size_t)t * 512 + j * 128 + lane * 2);
        v[2 * j] = a.x; v[2 * j + 1] = a.y;
        s += a.x + a.y;
      }
      const float mean = wave_sum(s) * (1.f / 512.f);
      float vs = 0.f;
#pragma unroll
      for (int j = 0; j < 8; ++j) { v[j] -= mean; vs += v[j] * v[j]; }
      const float rstd = rsqrtf(wave_sum(vs) * (1.f / 512.f) + EPSV);
#pragma unroll
      for (int j = 0; j < 4; ++j) {
        const int c = j * 128 + lane * 2;
        float y0 = v[2 * j] * rstd * p.in[24][il * 512 + c] + p.in[25][il * 512 + c];
        float y1 = v[2 * j + 1] * rstd * p.in[24][il * 512 + c + 1] + p.in[25][il * 512 + c + 1];
        *(unsigned*)(yr + 512 + c) = pack2(siluf(y0), siluf(y1));
      }
    }
  }
}

#define WAVE_LDS_SYNC() { asm volatile("s_waitcnt lgkmcnt(0)" ::: "memory"); __builtin_amdgcn_wave_barrier(); }
#define CE_DESC(a, b) { unsigned _mx = max(a, b), _mn = min(a, b); a = _mx; b = _mn; }
#define CE_ASC(a, b) { unsigned _mx = max(a, b), _mn = min(a, b); a = _mn; b = _mx; }
__device__ __forceinline__ void sort16_desc(unsigned* v) {
#pragma unroll
  for (int k = 2; k <= 16; k <<= 1) {
#pragma unroll
    for (int j = k >> 1; j > 0; j >>= 1) {
#pragma unroll
      for (int i = 0; i < 16; ++i) {
        const int l = i ^ j;
        if (l > i) {
          if ((i & k) == 0) CE_DESC(v[i], v[l]) else CE_ASC(v[i], v[l])
        }
      }
    }
  }
}
__device__ __forceinline__ void merge16_top(unsigned* a, const unsigned* b) {
#pragma unroll
  for (int i = 0; i < 16; ++i) a[i] = max(a[i], b[15 - i]);
#pragma unroll
  for (int j = 8; j > 0; j >>= 1) {
#pragma unroll
    for (int i = 0; i < 16; ++i) {
      const int l = i ^ j;
      if (l > i) CE_DESC(a[i], a[l])
    }
  }
}
__device__ __forceinline__ void phase_peer_score(const Params& p, int l, unsigned char* smem) {
  const int tid = opaque_tid(), lane = tid & 63, w = tid >> 6, quad = lane >> 4, l15 = lane & 15;
  unsigned* scw = (unsigned*)smem + w * (32 * 132 + 512);
  unsigned* sel = scw + 32 * 132;
  const bf16_t* Q = (const bf16_t*)(p.ws + OFF_Q);
  const bf16_t* KB = (const bf16_t*)(p.ws + OFF_KEYS) + (size_t)l * 8 * 2 * 128 * 128;
  int* EI = (int*)(p.ws + OFF_EIDX);
  float* GT = (float*)(p.ws + OFF_GATE);
  unsigned cab[13];
  {
    const int sub = lane & 3;
#pragma unroll
    for (int i = 0; i < 13; ++i) { const int cidx = sub + 4 * i; cab[i] = (unsigned)CAND_A[cidx] | ((unsigned)CAND_B[cidx] << 4); }
  }
  bf16x8 qa[2][4];
  if (blockIdx.x < 3072) {
    const int t0f = (blockIdx.x >> 1) * 16, hf_ = (blockIdx.x & 1) * 4 + w;
#pragma unroll
    for (int pp = 0; pp < 2; ++pp)
#pragma unroll
      for (int kk = 0; kk < 4; ++kk) qa[pp][kk] = ldfrag(Q + (size_t)(t0f + l15) * 2048 + hf_ * 256 + pp * 128 + kk * 32 + quad * 8);
  }
  for (int u = blockIdx.x; u < 3072; u += gridDim.x) {
    const int tt = u >> 1, h = (u & 1) * 4 + w;
    const int t0 = tt * 16;
#pragma unroll
    for (int pp = 0; pp < 2; ++pp) {
      bf16x8 a[4];
#pragma unroll
      for (int kk = 0; kk < 4; ++kk) a[kk] = qa[pp][kk];
      const bf16_t* kb = KB + (size_t)((h * 2 + pp) * 128) * 128;
#pragma unroll
      for (int ct = 0; ct < 8; ++ct) {
        f32x4 c = (f32x4){0.f, 0.f, 0.f, 0.f};
#pragma unroll
        for (int kk = 0; kk < 4; ++kk) {
          bf16x8 b = ldfrag(kb + (ct * 16 + l15) * 128 + kk * 32 + quad * 8);
          c = mfma16(a[kk], b, c);
        }
#pragma unroll
        for (int jj = 0; jj < 4; ++jj) {
          const int row = pp * 16 + quad * 4 + jj, col = ct * 16 + l15;
          unsigned key = (fkey(c[jj]) & ~127u) | (unsigned)(127 - col);
          scw[row * 132 + col] = key;
        }
      }
    }
    {
      const int un = u + gridDim.x;
      if (un < 3072) {
        const int t0n = (un >> 1) * 16, hn = (un & 1) * 4 + w;
#pragma unroll
        for (int pp = 0; pp < 2; ++pp)
#pragma unroll
          for (int kk = 0; kk < 4; ++kk) qa[pp][kk] = ldfrag(Q + (size_t)(t0n + l15) * 2048 + hn * 256 + pp * 128 + kk * 32 + quad * 8);
      }
    }
    WAVE_LDS_SYNC();
    {
      const int row = lane >> 1, hf = lane & 1;
      const u32x4* rp = (const u32x4*)(scw + row * 132 + hf * 64);
      unsigned g0[16], g1[16];
#pragma unroll
      for (int q = 0; q < 4; ++q) { u32x4 t4 = rp[q]; g0[4 * q] = t4[0]; g0[4 * q + 1] = t4[1]; g0[4 * q + 2] = t4[2]; g0[4 * q + 3] = t4[3]; }
#pragma unroll
      for (int q = 0; q < 4; ++q) { u32x4 t4 = rp[4 + q]; g1[4 * q] = t4[0]; g1[4 * q + 1] = t4[1]; g1[4 * q + 2] = t4[2]; g1[4 * q + 3] = t4[3]; }
      sort16_desc(g0);
      sort16_desc(g1);
      merge16_top(g0, g1);
#pragma unroll
      for (int q = 0; q < 4; ++q) { u32x4 t4 = rp[8 + q]; g1[4 * q] = t4[0]; g1[4 * q + 1] = t4[1]; g1[4 * q + 2] = t4[2]; g1[4 * q + 3] = t4[3]; }
      sort16_desc(g1);
      merge16_top(g0, g1);
#pragma unroll
      for (int q = 0; q < 4; ++q) { u32x4 t4 = rp[12 + q]; g1[4 * q] = t4[0]; g1[4 * q + 1] = t4[1]; g1[4 * q + 2] = t4[2]; g1[4 * q + 3] = t4[3]; }
      sort16_desc(g1);
      merge16_top(g0, g1);
#pragma unroll
      for (int i = 0; i < 16; ++i) g1[i] = (unsigned)__shfl_xor((int)g0[i], 1);
      merge16_top(g0, g1);
      if (hf == 0) {
#pragma unroll
        for (int q = 0; q < 4; ++q) {
          u32x4 t4 = {g0[4 * q], g0[4 * q + 1], g0[4 * q + 2], g0[4 * q + 3]};
          *(u32x4*)(sel + row * 16 + 4 * q) = t4;
        }
      }
    }
    WAVE_LDS_SYNC();
    {
      const int tok = lane >> 2, sub = lane & 3;
      const unsigned* s1 = sel + tok * 16;
      const unsigned* s2 = sel + (16 + tok) * 16;
      unsigned ck[13];
#pragma unroll
      for (int i = 0; i < 13; ++i) {
        const int cidx = sub + 4 * i;
        const int a = cab[i] & 15, b = cab[i] >> 4;
        float s = keyf(s1[a] & ~127u) + keyf(s2[b] & ~127u);
        unsigned k = (fkey(s) & ~255u) | (unsigned)(255 - (a * 16 + b));
        ck[i] = (cidx < 50) ? k : 0u;
      }
      unsigned prev = 0xFFFFFFFFu;
      unsigned top[16];
#pragma unroll
      for (int r = 0; r < 16; ++r) {
        unsigned best = 0;
#pragma unroll
        for (int i = 0; i < 13; ++i) {
          unsigned tsel = (ck[i] < prev) ? ck[i] : 0u;
          best = max(best, tsel);
        }
        best = max(best, (unsigned)__shfl_xor((int)best, 1));
        best = max(best, (unsigned)__shfl_xor((int)best, 2));
        prev = best;
        top[r] = best;
      }
      float sv[16];
      int ev[16];
#pragma unroll
      for (int r = 0; r < 16; ++r) {
        const int cidx = 255 - (int)(top[r] & 255u);
        const int a = cidx >> 4, b = cidx & 15;
        const unsigned k1 = s1[a], k2 = s2[b];
        sv[r] = keyf(k1 & ~127u) + keyf(k2 & ~127u);
        ev[r] = (127 - (int)(k1 & 127u)) * 128 + (127 - (int)(k2 & 127u));
      }
      float mx = sv[0];
#pragma unroll
      for (int r = 1; r < 16; ++r) mx = fmaxf(mx, sv[r]);
      float sum = 0.f;
#pragma unroll
      for (int r = 0; r < 16; ++r) { sv[r] = expf(sv[r] - mx); sum += sv[r]; }
      const float inv = 1.f / sum;
      const size_t ob = (size_t)(t0 + tok) * 128 + h * 16;
#pragma unroll
      for (int r = 0; r < 16; ++r) {
        if ((r & 3) == sub) { EI[ob + r] = ev[r]; GT[ob + r] = sv[r] * inv; }
      }
    }
    WAVE_LDS_SYNC();
  }
}

__device__ __forceinline__ float gelu_tanh(float x) {
  return 0.5f * x * (1.f + tanhf(0.7978845608028654f * (x + 0.044715f * x * x * x)));
}
__device__ __forceinline__ float butterfly8(const float* d, int lane) {
  const bool b5 = lane & 32, b4 = lane & 16, b3 = lane & 8;
  float e4[4], e2[2], e1;
#pragma unroll
  for (int j = 0; j < 4; ++j) {
    float snd = b5 ? d[j] : d[j + 4];
    float kep = b5 ? d[j + 4] : d[j];
    e4[j] = kep + __shfl_xor(snd, 32);
  }
#pragma unroll
  for (int j = 0; j < 2; ++j) {
    float snd = b4 ? e4[j] : e4[j + 2];
    float kep = b4 ? e4[j + 2] : e4[j];
    e2[j] = kep + __shfl_xor(snd, 16);
  }
  {
    float snd = b3 ? e2[0] : e2[1];
    float kep = b3 ? e2[1] : e2[0];
    e1 = kep + __shfl_xor(snd, 8);
  }
  e1 += __shfl_xor(e1, 4);
  e1 += __shfl_xor(e1, 2);
  e1 += __shfl_xor(e1, 1);
  const int jj = lane & 7;
  const int srcl = ((jj >> 2) & 1) * 32 + ((jj >> 1) & 1) * 16 + (jj & 1) * 8;
  return __shfl(e1, srcl);
}
__device__ __forceinline__ void phase_peer_gather(const Params& p, int l, int dry) {
  const int tid_ = opaque_tid(); const int lane = tid_ & 63, wv = tid_ >> 6;
  const bf16_t* H = (const bf16_t*)(p.ws + OFF_H);
  bf16_t* Hw = (bf16_t*)(p.ws + OFF_H);
  const unsigned char* UB = p.ws + OFF_UB + (size_t)l * 16384 * 512;
  const unsigned char* VB = p.ws + OFF_VB + (size_t)l * 16384 * 512;
  const int* EI = (const int*)(p.ws + OFF_EIDX);
  const float* GT = (const float*)(p.ws + OFF_GATE);
  const float* modv = (const float*)(p.ws + OFF_MOD);
  uint4 nx0 = make_uint4(0, 0, 0, 0), nx1 = nx0; int nev0 = 0, nev1 = 0; float ngv0 = 0.f, ngv1 = 0.f;
  {
    const int tf = blockIdx.x * 4 + wv;
    if (tf < NTOK) {
      nx0 = *(const uint4*)(H + (size_t)tf * 1024 + lane * 16); nx1 = *(const uint4*)(H + (size_t)tf * 1024 + lane * 16 + 8);
      nev0 = EI[(size_t)tf * 128 + lane]; nev1 = EI[(size_t)tf * 128 + 64 + lane];
      ngv0 = GT[(size_t)tf * 128 + lane]; ngv1 = GT[(size_t)tf * 128 + 64 + lane];
    }
  }
  for (int t = blockIdx.x * 4 + wv; t < NTOK; t += gridDim.x * 4) {
    float xf[16];
    unpack8(nx0, xf);
    unpack8(nx1, xf + 8);
    f32x2 xf2[8], out2[8];
#pragma unroll
    for (int e = 0; e < 8; ++e) { xf2[e] = (f32x2){xf[2 * e], xf[2 * e + 1]}; out2[e] = (f32x2){0.f, 0.f}; }
    const int ev0 = nev0, ev1 = nev1;
    const float gv0 = ngv0, gv1 = ngv1;
    {
      const int tn = t + gridDim.x * 4;
      if (tn < NTOK) {
        nx0 = *(const uint4*)(H + (size_t)tn * 1024 + lane * 16); nx1 = *(const uint4*)(H + (size_t)tn * 1024 + lane * 16 + 8);
        nev0 = EI[(size_t)tn * 128 + lane]; nev1 = EI[(size_t)tn * 128 + 64 + lane];
        ngv0 = GT[(size_t)tn * 128 + lane]; ngv1 = GT[(size_t)tn * 128 + 64 + lane];
      }
    }
    float cacc0 = 0.f, cacc1 = 0.f, coef0 = 0.f, coef1 = 0.f;
    uint2 bufA[16], bufB[16], bufC[16];
    const f32x2 zero2_ = {(float)dry, (float)dry};
#define GLOAD(buf, bb) { \
      const unsigned char* tb_ = ((bb) < 8) ? UB : VB; \
      const int evv_ = (((bb) & 7) < 4) ? ev0 : ev1; \
      _Pragma("unroll") for (int j = 0; j < 16; ++j) { \
        const int e_ = __builtin_amdgcn_readlane(evv_, ((bb) & 3) * 16 + j); \
        buf[j] = *(const uint2*)(tb_ + (size_t)e_ * 512 + lane * 8); } }
#define GCOMP(buf, bb) { \
      if ((bb) < 8) { \
        float d_[16]; \
        _Pragma("unroll") for (int j = 0; j < 16; ++j) { \
          f32x2 uf_[8]; unpack16_fp4(buf[j].x, buf[j].y, uf_); \
          f32x2 sa_ = uf_[0] * xf2[0]; \
          if (PROBE_CVT) { f32x2 ug_[8]; \
            ug_[0] = __builtin_amdgcn_cvt_scalef32_pk_f32_fp4(buf[j].x, 2.0f, 0); ug_[1] = __builtin_amdgcn_cvt_scalef32_pk_f32_fp4(buf[j].x, 2.0f, 1); \
            ug_[2] = __builtin_amdgcn_cvt_scalef32_pk_f32_fp4(buf[j].x, 2.0f, 2); ug_[3] = __builtin_amdgcn_cvt_scalef32_pk_f32_fp4(buf[j].x, 2.0f, 3); \
            ug_[4] = __builtin_amdgcn_cvt_scalef32_pk_f32_fp4(buf[j].y, 2.0f, 0); ug_[5] = __builtin_amdgcn_cvt_scalef32_pk_f32_fp4(buf[j].y, 2.0f, 1); \
            ug_[6] = __builtin_amdgcn_cvt_scalef32_pk_f32_fp4(buf[j].y, 2.0f, 2); ug_[7] = __builtin_amdgcn_cvt_scalef32_pk_f32_fp4(buf[j].y, 2.0f, 3); \
            _Pragma("unroll") for (int q = 0; q < 8; ++q) sa_ = __builtin_elementwise_fma(ug_[q], zero2_, sa_); } \
          _Pragma("unroll") for (int q = 1; q < 8; ++q) sa_ = __builtin_elementwise_fma(uf_[q], xf2[q], sa_); \
          d_[j] = sa_.x + sa_.y; } \
        const float t0_ = butterfly8(d_, lane), t1_ = butterfly8(d_ + 8, lane); \
        const int k0_ = ((bb) & 3) * 16; \
        if (((bb) & 7) < 4) { if ((lane >> 3) == (k0_ >> 3)) cacc0 = t0_; if ((lane >> 3) == (k0_ >> 3) + 1) cacc0 = t1_; } \
        else { if ((lane >> 3) == (k0_ >> 3)) cacc1 = t0_; if ((lane >> 3) == (k0_ >> 3) + 1) cacc1 = t1_; } \
        if ((bb) == 7) { coef0 = gelu_tanh(cacc0 * (1.f / U_SCALE)) * gv0 * (1.f / V_SCALE); coef1 = gelu_tanh(cacc1 * (1.f / U_SCALE)) * gv1 * (1.f / V_SCALE); } \
      } else { \
        const float cfv_ = (((bb) & 7) < 4) ? coef0 : coef1; \
        _Pragma("unroll") for (int j = 0; j < 16; ++j) { \
          const float cf_ = __uint_as_float((unsigned)__builtin_amdgcn_readlane((int)__float_as_uint(cfv_), ((bb) & 3) * 16 + j)); \
          f32x2 vf_[8]; unpack16_fp4(buf[j].x, buf[j].y, vf_); \
          const f32x2 c2_ = {cf_, cf_}; \
          _Pragma("unroll") for (int q = 0; q < 8; ++q) out2[q] = __builtin_elementwise_fma(vf_[q], c2_, out2[q]); } \
      } }
#if GATHER_CHECK
    GLOAD(bufA, 0)
#pragma unroll
    for (int b = 0; b < 8; b += 2) {
      GLOAD(bufB, b + 1)
      GCOMP(bufA, b)
      if (b + 2 < 8) GLOAD(bufA, b + 2)
      GCOMP(bufB, b + 1)
    }
    const float vacc0 = cacc0, vacc1 = cacc1;
#endif
#if !GATHER_CHECK
    GLOAD(bufA, 8)
#endif
    {
      const int q_ = lane >> 4, n_ = lane & 15;
      u32x4 xa[8];
      const unsigned char* xrow4 = p.ws + OFF_H8 + (size_t)t * 512 + q_ * 16;
#pragma unroll
      for (int kk = 0; kk < 8; ++kk) xa[kk] = *(const u32x4*)(xrow4 + kk * 64);
      u32x4 bq[2][8];
#define ULOAD(g, slot) { \
        const int e_ = __shfl(((g) < 4) ? ev0 : ev1, ((g) & 3) * 16 + n_); \
        const unsigned char* rp_ = UB + (size_t)e_ * 512 + q_ * 16; \
        _Pragma("unroll") for (int kk = 0; kk < 8; ++kk) bq[slot][kk] = *(const u32x4*)(rp_ + kk * 64); }
      ULOAD(0, 0)
#pragma unroll
      for (int g = 0; g < 8; ++g) {
        if (g + 1 < 8) ULOAD(g + 1, (g + 1) & 1)
        f32x4 ac = (f32x4){0.f, 0.f, 0.f, 0.f};
#pragma unroll
        for (int kk = 0; kk < 8; ++kk) {
          const u32x4 b4 = bq[g & 1][kk];
          const v8i32 bb = {(int)b4[0], (int)b4[1], (int)b4[2], (int)b4[3], 0, 0, 0, 0};
          const v8i32 aa = {(int)xa[kk][0], (int)xa[kk][1], (int)xa[kk][2], (int)xa[kk][3], 0, 0, 0, 0};
          ac = __builtin_amdgcn_mfma_scale_f32_16x16x128_f8f6f4(aa, bb, ac, 4, 4, 0, 0, 0, 0);
        }
        if ((lane >> 4) == (g & 3)) { if (g < 4) cacc0 = ac[0] * (1.f / X_SCALE); else cacc1 = ac[0] * (1.f / X_SCALE); }
      }
#undef ULOAD
    }
#if GATHER_CHECK
    {
      const bool bad0 = fabsf(cacc0 - vacc0) > 0.15f * fabsf(vacc0) + 45.f;
      const bool bad1 = fabsf(cacc1 - vacc1) > 0.15f * fabsf(vacc1) + 45.f;
      const unsigned long long m0 = __ballot(bad0), m1 = __ballot(bad1);
      if (__popcll(m0) + __popcll(m1) > 32) out2[0] = (f32x2){__builtin_nanf(""), __builtin_nanf("")};
    }
#endif
    coef0 = gelu_tanh(cacc0 * (1.f / U_SCALE)) * gv0 * (1.f / V_SCALE);
    coef1 = gelu_tanh(cacc1 * (1.f / U_SCALE)) * gv1 * (1.f / V_SCALE);
#if GATHER_CHECK
    GLOAD(bufA, 8)
#endif
    GLOAD(bufB, 9)
#pragma unroll
    for (int b = 8; b < 14; b += 3) {
      GLOAD(bufC, b + 2)
      GCOMP(bufA, b)
      GLOAD(bufA, b + 3)
      GCOMP(bufB, b + 1)
      GLOAD(bufB, b + 4)
      GCOMP(bufC, b + 2)
    }
    GCOMP(bufA, 14)
    GCOMP(bufB, 15)
#undef GLOAD
#undef GCOMP
    float out[16];
#pragma unroll
    for (int e = 0; e < 8; ++e) { out[2 * e] = out2[e].x; out[2 * e + 1] = out2[e].y; }
    const int m = tok_mod(t);
    const float* ga2 = modv + (size_t)(l * 9 + m) * 6144 + 5120;
    float* xr = p.out + (size_t)t * 1024 + lane * 16;
    float xn[16];
    float ss = 0.f;
#pragma unroll
    for (int q4 = 0; q4 < 4; ++q4) {
      float4 xv = *(const float4*)(xr + q4 * 4);
      float4 gg = *(const float4*)(ga2 + lane * 16 + q4 * 4);
      const int o = q4 * 4;
      xn[o + 0] = xv.x + gg.x * out[o + 0];
      xn[o + 1] = xv.y + gg.y * out[o + 1];
      xn[o + 2] = xv.z + gg.z * out[o + 2];
      xn[o + 3] = xv.w + gg.w * out[o + 3];
      ss += xn[o] * xn[o] + xn[o + 1] * xn[o + 1] + xn[o + 2] * xn[o + 2] + xn[o + 3] * xn[o + 3];
    }
    ss = wave_sum(ss);
    const float rs = rsqrtf(ss * (1.f / 1024.f) + EPSV);
    if (dry) continue;
    if (l < 3) {
      const float* md = modv + (size_t)((l + 1) * 9 + m) * 6144 + lane * 16;
      const float* g = p.in[8] + (l + 1) * 1024 + lane * 16;
      float hv[16];
#pragma unroll
      for (int q = 0; q < 16; ++q) hv[q] = xn[q] * rs * g[q] * (1.f + md[1024 + q]) + md[q];
      uint4 o;
      o.x = pack2(hv[0], hv[1]); o.y = pack2(hv[2], hv[3]); o.z = pack2(hv[4], hv[5]); o.w = pack2(hv[6], hv[7]);
      *(uint4*)(Hw + (size_t)t * 1024 + lane * 16) = o;
      o.x = pack2(hv[8], hv[9]); o.y = pack2(hv[10], hv[11]); o.z = pack2(hv[12], hv[13]); o.w = pack2(hv[14], hv[15]);
      *(uint4*)(Hw + (size_t)t * 1024 + lane * 16 + 8) = o;
#pragma unroll
      for (int q4 = 0; q4 < 4; ++q4) *(float4*)(xr + q4 * 4) = make_float4(xn[q4 * 4], xn[q4 * 4 + 1], xn[q4 * 4 + 2], xn[q4 * 4 + 3]);
    } else {
      const float* g = p.in[10] + lane * 16;
#pragma unroll
      for (int q4 = 0; q4 < 4; ++q4)
        *(float4*)(xr + q4 * 4) = make_float4(xn[q4 * 4] * rs * g[q4 * 4], xn[q4 * 4 + 1] * rs * g[q4 * 4 + 1],
                                              xn[q4 * 4 + 2] * rs * g[q4 * 4 + 2], xn[q4 * 4 + 3] * rs * g[q4 * 4 + 3]);
    }
  }
}

#define XB_TMO      128
#define XB_XCNT(j)  (256  + 64 * (j))
#define XB_XSUB(j)  (1280 + 64 * (j))
#define XB_XGEN(j)  (2304 + 64 * (j))
#define XB_TOP      3328
#define XB_TOPGEN   3392
#define XCD_BAR_WORDS 3456
#define XB_SPIN_CAP (1u << 18)
#define LAS __attribute__((address_space(3)))

__device__ __forceinline__ unsigned xb_ld(unsigned* p)              { return __hip_atomic_load(p, __ATOMIC_RELAXED, __HIP_MEMORY_SCOPE_AGENT); }
__device__ __forceinline__ unsigned xb_add(unsigned* p, unsigned v) { return __hip_atomic_fetch_add(p, v, __ATOMIC_RELAXED, __HIP_MEMORY_SCOPE_AGENT); }
__device__ __forceinline__ unsigned xb_xcc_id() { return (unsigned)__builtin_amdgcn_s_getreg((3 << 11) | 20) & 0xFu; }
#define XB_SPIN(cond, bar) do { unsigned _sp = 0; while (cond) { __builtin_amdgcn_s_sleep(1); \
    if ((++_sp & 255u) == 0u) { if (xb_ld(&(bar)[XB_TMO])) break; if (_sp > XB_SPIN_CAP) { atomicAdd(&(bar)[XB_TMO], 1u); break; } } } } while (0)

struct XcdBarrier {
    unsigned* bar; unsigned x;
    volatile LAS unsigned* st;
};

__device__ __forceinline__ XcdBarrier xcd_barrier_post(unsigned* bar, volatile LAS unsigned* st) {
    XcdBarrier b; b.bar = bar; b.x = xb_xcc_id(); b.st = st;
    if (threadIdx.x == 0) (void)xb_add(&bar[XB_XCNT(b.x)], 1u);
    return b;
}
__device__ __forceinline__ void xcd_barrier_complete(unsigned* bar, unsigned x, unsigned& nloc, unsigned& nx) {
    const unsigned G = gridDim.x * gridDim.y * gridDim.z;
    unsigned sum, cnt, mine, sp = 0u;
    for (;;) {
        sum = 0u; cnt = 0u; mine = 0u;
#pragma unroll
        for (unsigned j = 0; j < 16; ++j) { const unsigned c = xb_ld(&bar[XB_XCNT(j)]); sum += c; cnt += (c > 0u) ? 1u : 0u; mine = (j == x) ? c : mine; }
        if (sum == G) break;
        __builtin_amdgcn_s_sleep(1);
        if ((++sp & 255u) == 0u) { if (xb_ld(&bar[XB_TMO])) break; if (sp > XB_SPIN_CAP) { atomicAdd(&bar[XB_TMO], 1u); break; } }
    }
    nloc = mine > 0u ? mine : 1u; nx = cnt > 0u ? cnt : 1u;
}

__device__ __forceinline__ void xcd_barrier(const XcdBarrier& b) {
    asm volatile("s_waitcnt vmcnt(0)" ::: "memory");
    __syncthreads();
    if (threadIdx.x == 0) {
        unsigned* bar = b.bar;
        __builtin_amdgcn_s_waitcnt(0);
        unsigned nloc = b.st[0], nx = b.st[1];
        if (nloc == 0u) { xcd_barrier_complete(bar, b.x, nloc, nx); b.st[0] = nloc; b.st[1] = nx; }
        const unsigned old = xb_add(&bar[XB_XSUB(b.x)], 1u);
        const unsigned gen = old / nloc;
        if (old + 1u == (gen + 1u) * nloc) {
            __builtin_amdgcn_fence(__ATOMIC_RELEASE, "agent");
            asm volatile("s_waitcnt vmcnt(0)" ::: "memory");
            const unsigned og = xb_add(&bar[XB_TOP], 1u);
            const unsigned tg = og / nx;
            if (og + 1u == (tg + 1u) * nx) xb_add(&bar[XB_TOPGEN], 1u);
            else XB_SPIN(xb_ld(&bar[XB_TOPGEN]) == tg, bar);
            __builtin_amdgcn_fence(__ATOMIC_ACQUIRE, "agent");
            xb_add(&bar[XB_XGEN(b.x)], 1u);
            asm volatile("s_waitcnt vmcnt(0)" ::: "memory");
        } else {
            XB_SPIN(xb_ld(&bar[XB_XGEN(b.x)]) == gen, bar);
            __builtin_amdgcn_fence(__ATOMIC_ACQUIRE, "agent");
            asm volatile("s_waitcnt vmcnt(0)" ::: "memory");
        }
    }
    __syncthreads();
}

__global__ void __launch_bounds__(256, 2) mega(Params p, int ph_lo, int ph_hi) {
  __shared__ __attribute__((aligned(16))) unsigned char smem[77312];
  cg::grid_group grid = cg::this_grid();
  __shared__ uint4 xb_words;
  if (threadIdx.x == 0) xb_words = make_uint4(0u, 0u, 0u, 0u);
  __syncthreads();
  XcdBarrier xb = xcd_barrier_post((unsigned*)(p.ws + OFF_BAR), (volatile LAS unsigned*)&xb_words);
  if (ph_hi > 100000) grid.sync();
  for (int ph = ph_lo; ph < ph_hi; ++ph) {
#if PROBE_MASK
    const int pcode = ph < 2 ? ph : 2 + (ph - 2) % 9;
    const int nrep = ((PROBE_MASK >> pcode) & 1) ? 2 : 1;
    for (int rep = 0; rep < nrep; ++rep) {
    if (rep) xcd_barrier(xb);
#endif
    bool did = true;
#if PROBE_MASK
    const int prep_rep = rep; const int nrep_ = nrep;
#else
    const int prep_rep = 0; const int nrep_ = 1;
#endif
    if (ph == 0) phase_prep_a(p, smem);
    else if (ph == 1) phase_prep_b(p);
    else {
      const int l = (ph - 2) / 9, sub = (ph - 2) % 9;
      const int il = l >> 1;
      const bool odd = l & 1;
      const float* modv = (const float*)(p.ws + OFF_MOD);
      if (sub == 0 || sub == 6) {
        const bf16_t* Bt; int ntn, ldc; bf16_t* C;
        if (sub == 0) {
          Bt = odd ? (const bf16_t*)(p.ws + OFF_WIN_OD) + (size_t)il * 3328 * 1024
                   : (const bf16_t*)(p.ws + OFF_WIN_EV) + (size_t)il * 3072 * 1024;
          ntn = odd ? 13 : 12; ldc = PSTRIDE; C = (bf16_t*)(p.ws + OFF_P);
        } else {
          Bt = (const bf16_t*)(p.ws + OFF_WQ) + (size_t)l * 2048 * 1024;
          ntn = 8; ldc = 2048; C = (bf16_t*)(p.ws + OFF_Q);
        }
        gemm_phase<0, 8, 32>((const bf16_t*)(p.ws + OFF_H), Bt, ntn, C, ldc, nullptr, nullptr, smem);
      } else if (sub == 1) {
        if (odd) phase_odd_prep(p, l, smem, prep_rep); else did = false;
      } else if (sub == 2) {
        if (odd) phase_gdn_chain(p, l, smem); else phase_ret_chain(p, l, smem);
      } else if (sub == 3) {
        phase_mix_out(p, l);
      } else if (sub == 4) {
        gemm_phase<1, 4, 64>((const bf16_t*)(p.ws + OFF_YMIX), (const bf16_t*)(p.ws + OFF_WOUT) + (size_t)l * 1024 * 1024, 8,
                      nullptr, 0, p.out, modv + (size_t)l * 9 * 6144 + 2048, smem, (nrep_ > 1 && prep_rep == 0) ? 1 : 0);
      } else if (sub == 5) {
        phase_norm2(p, l);
      } else if (sub == 7) {
        phase_peer_score(p, l, smem);
      } else {
        phase_peer_gather(p, l, (nrep_ > 1 && prep_rep == 0) ? 1 : 0);
      }
    }
#if PROBE_MASK
    if (rep + 1 < nrep) continue;
#endif
    if (did && ph + 1 < ph_hi) xcd_barrier(xb);
#if PROBE_MASK
    }
#endif
  }
}

extern "C" void kernel_launch(void* const* d_in, const int* in_sizes, int n_in, void* d_out, int out_size,
                              void* d_ws, size_t ws_size, hipStream_t stream) {
  static int grid_blocks = 0;
  if (!grid_blocks) {
    int dev = 0, cus = 0, per_cu = 0;
    (void)hipGetDevice(&dev);
    (void)hipDeviceGetAttribute(&cus, hipDeviceAttributeMultiprocessorCount, dev);
    (void)hipOccupancyMaxActiveBlocksPerMultiprocessor(&per_cu, mega, 256, 0);
    if (per_cu < 1) per_cu = 1;
    if (per_cu > 2) per_cu = 2;
    grid_blocks = cus * per_cu;
    if (ws_size < WS_NEED) fprintf(stderr, "kernel_launch: workspace too small: %zu < %zu\n", ws_size, (size_t)WS_NEED);
  }
  Params p{};
  for (int i = 0; i < 30; ++i) p.in[i] = (const float*)d_in[i];
  p.out = (float*)d_out;
  p.ws = (unsigned char*)d_ws;
  (void)hipMemsetAsync((unsigned char*)d_ws + OFF_BAR, 0, XCD_BAR_WORDS * sizeof(unsigned), stream);
#if SINGLE_LAUNCH
  int lo = 0, hi = NPHASE;
  void* args[] = {&p, &lo, &hi};
  hipError_t e = hipLaunchCooperativeKernel((void*)mega, dim3(grid_blocks), dim3(256), args, 0, stream);
  if (e != hipSuccess) fprintf(stderr, "cooperative launch failed: %s (grid %d)\n", hipGetErrorString(e), grid_blocks);
#else
  for (int ph = 0; ph < NPHASE; ++ph) {
    const int l = (ph - 2) / 9, sub = (ph - 2) % 9;
    if (ph >= 2 && sub == 1 && !(l & 1)) continue;
    hipLaunchKernelGGL(mega, dim3(grid_blocks), dim3(256), 0, stream, p, ph, ph + 1);
  }
#endif
}
```

```cpp
#include <hip/hip_runtime.h>
#include <hip/hip_cooperative_groups.h>
#include <cstdio>
namespace cg = cooperative_groups;

#ifndef PROBE_MASK
#define PROBE_MASK 0
#endif
#ifndef GATHER_CHECK
#define GATHER_CHECK 0
#endif
#ifndef PROBE_CVT
#define PROBE_CVT 0
#endif
#ifndef PROBE_ODD
#define PROBE_ODD 0
#endif
#ifndef SINGLE_LAUNCH
#define SINGLE_LAUNCH 1
#endif

typedef unsigned short bf16_t;
using bf16x8 = __attribute__((ext_vector_type(8))) short;
using f32x4 = __attribute__((ext_vector_type(4))) float;
using f32x2 = __attribute__((ext_vector_type(2))) float;
using u32x4 = __attribute__((ext_vector_type(4))) unsigned;
using v8i32 = __attribute__((ext_vector_type(8))) int;

#define NTOK 24576
#define NPROMPT 8192
#define PSTRIDE 3200
#define EPSV 1e-6f
#define NPHASE 38
#define X_SCALE 1.5f

constexpr size_t OFF_MOD = 0;
constexpr size_t OFF_ROPE = 1u << 20;
constexpr size_t OFF_WIN_EV = OFF_ROPE + 65536;
constexpr size_t OFF_WIN_OD = OFF_WIN_EV + 2ull * 3072 * 1024 * 2;
constexpr size_t OFF_WOUT = OFF_WIN_OD + 2ull * 3328 * 1024 * 2;
constexpr size_t OFF_WQ = OFF_WOUT + 4ull * 1024 * 1024 * 2;
constexpr size_t OFF_KEYS = OFF_WQ + 4ull * 2048 * 1024 * 2;
constexpr size_t OFF_UB = OFF_KEYS + 4ull * 8 * 2 * 128 * 128 * 2;
constexpr size_t OFF_VB = OFF_UB + 4ull * 16384 * 1024 * 2;
constexpr size_t OFF_H = OFF_VB + 4ull * 16384 * 1024 * 2;
constexpr size_t OFF_P = OFF_H + (size_t)NTOK * 1024 * 2;
constexpr size_t OFF_YMIX = OFF_P + (size_t)NTOK * PSTRIDE * 2;
constexpr size_t OFF_ODIR = OFF_YMIX + (size_t)NTOK * 1024 * 2;
constexpr size_t OFF_Q = OFF_ODIR;
constexpr size_t OFF_EIDX = OFF_ODIR + 2ull * NTOK * 512 * 4;
constexpr size_t OFF_GATE = OFF_EIDX + (size_t)NTOK * 128 * 4;
constexpr size_t GP_ITEM = 73728;
constexpr size_t OFF_GPREP = OFF_GATE + (size_t)NTOK * 128 * 4;
constexpr size_t OFF_EGL = OFF_GPREP + 3072ull * GP_ITEM;
constexpr size_t OFF_CONV = OFF_EGL + 16384;
constexpr size_t OFF_H8 = OFF_CONV;
constexpr size_t OFF_BAR = OFF_CONV + (size_t)NTOK * 512 * 4;
constexpr size_t WS_NEED = OFF_BAR + 16384;

struct Params {
  const float* in[30];
  float* out;
  unsigned char* ws;
};

__device__ const unsigned char CAND_A[52] = {0,0,0,0,0,0,0,0,0,0,0,0,0,0,0,0,1,1,1,1,1,1,1,1,2,2,2,2,2,3,3,3,3,4,4,4,5,5,6,6,7,7,8,9,10,11,12,13,14,15,0,0};
__device__ const unsigned char CAND_B[52] = {0,1,2,3,4,5,6,7,8,9,10,11,12,13,14,15,0,1,2,3,4,5,6,7,0,1,2,3,4,0,1,2,3,0,1,2,0,1,0,1,0,1,0,0,0,0,0,0,0,0,0,0};

__device__ __forceinline__ int opaque_tid() { int t = threadIdx.x; asm volatile("" : "+v"(t)); return t; }
typedef __bf16 hbf16x2 __attribute__((ext_vector_type(2)));
__device__ __forceinline__ bf16_t f2bf(float f) {
  return __builtin_bit_cast(unsigned short, (__bf16)f);
}
__device__ __forceinline__ float bf2f(bf16_t b) { return __uint_as_float(((unsigned)b) << 16); }
__device__ __forceinline__ float bflo(unsigned u) { return __uint_as_float(u << 16); }
__device__ __forceinline__ float bfhi(unsigned u) { return __uint_as_float(u & 0xffff0000u); }
__device__ __forceinline__ unsigned pack2(float a, float b) {
  f32x2 v = {a, b};
  return __builtin_bit_cast(unsigned, __builtin_convertvector(v, hbf16x2));
}
__device__ __forceinline__ float wave_sum(float v) {
#pragma unroll
  for (int o = 32; o > 0; o >>= 1) v += __shfl_xor(v, o);
  return v;
}
__device__ __forceinline__ f32x4 mfma16(bf16x8 a, bf16x8 b, f32x4 c) {
  return __builtin_amdgcn_mfma_f32_16x16x32_bf16(a, b, c, 0, 0, 0);
}
__device__ __forceinline__ bf16x8 ldfrag(const bf16_t* p) { return *(const bf16x8*)p; }
__device__ __forceinline__ float siluf(float v) { return v * __builtin_amdgcn_rcpf(1.f + __expf(-v)); }
__device__ __forceinline__ int tok_mod(int t) { return t < NPROMPT ? 0 : 1 + ((t - NPROMPT) >> 11); }
__device__ __forceinline__ unsigned fkey(float f) {
  unsigned u = __float_as_uint(f);
  return (u & 0x80000000u) ? ~u : (u | 0x80000000u);
}
__device__ __forceinline__ float keyf(unsigned k) {
  unsigned b = (k & 0x80000000u) ? (k ^ 0x80000000u) : ~k;
  return __uint_as_float(b);
}
__device__ __forceinline__ void unpack8(uint4 v, float* f) {
  f[0] = bflo(v.x); f[1] = bfhi(v.x); f[2] = bflo(v.y); f[3] = bfhi(v.y);
  f[4] = bflo(v.z); f[5] = bfhi(v.z); f[6] = bflo(v.w); f[7] = bfhi(v.w);
}

__device__ __forceinline__ void prep_mod(const Params& p, float* smem) {
  float* sc = smem;
  float* red = smem + 9 * 1024;
  const int tid = opaque_tid();
  const float* c = p.in[4];
  const float* cctx = p.in[5];
  for (int i = tid; i < 9 * 1024; i += 256) {
    int m = i >> 10, k = i & 1023;
    float v = (m == 0) ? cctx[k] : c[(m - 1) * 1024 + k];
    sc[i] = v / (1.f + expf(-v));
  }
  __syncthreads();
  float* modv = (float*)(p.ws + OFF_MOD);
  const int cl = tid & 63, kg = tid >> 6;
  for (int u = blockIdx.x; u < 4 * 96; u += gridDim.x) {
    const int l = u / 96, nb = (u % 96) * 64;
    const float* W = p.in[6] + (size_t)l * 1024 * 6144 + nb + cl;
    float acc[9];
#pragma unroll
    for (int m = 0; m < 9; ++m) acc[m] = 0.f;
#pragma unroll 16
    for (int k = kg * 256; k < kg * 256 + 256; ++k) {
      float w = W[(size_t)k * 6144];
#pragma unroll
      for (int m = 0; m < 9; ++m) acc[m] += sc[m * 1024 + k] * w;
    }
#pragma unroll
    for (int m = 0; m < 9; ++m) red[(kg * 9 + m) * 64 + cl] = acc[m];
    __syncthreads();
    for (int i = tid; i < 9 * 64; i += 256) {
      int m = i >> 6, c2 = i & 63;
      float s = red[(0 * 9 + m) * 64 + c2] + red[(1 * 9 + m) * 64 + c2] + red[(2 * 9 + m) * 64 + c2] + red[(3 * 9 + m) * 64 + c2];
      int nn = nb + c2;
      modv[(size_t)(l * 9 + m) * 6144 + nn] = s + p.in[7][l * 6144 + nn];
    }
    __syncthreads();
  }
}

__device__ __forceinline__ void prep_transpose(const float* src, bf16_t* dst, int N, int Npad, float* tile) {
  const int tid = opaque_tid();
  const int ntn = Npad / 64;
  const int units = ntn * 16;
  for (int u = blockIdx.x; u < units; u += gridDim.x) {
    const int nt = u % ntn, kt = u / ntn;
    const int n0 = nt * 64, k0 = kt * 64;
    {
      const int c = tid & 63;
      const int n = n0 + c;
      const int nc = n < N ? n : N - 1;
      float tv[16];
#pragma unroll
      for (int i = 0; i < 16; ++i) tv[i] = src[(size_t)(k0 + (tid >> 6) + 4 * i) * N + nc];
#pragma unroll
      for (int i = 0; i < 16; ++i) tile[((tid >> 6) + 4 * i) * 65 + c] = (n < N) ? tv[i] : 0.f;
    }
    __syncthreads();
#pragma unroll 4
    for (int i = 0; i < 16; ++i) {
      int rr = (tid >> 6) + 4 * i, cc = tid & 63;
      dst[(size_t)(n0 + rr) * 1024 + k0 + cc] = f2bf(tile[cc * 65 + rr]);
    }
    __syncthreads();
  }
}

__device__ __forceinline__ void prep_convert(const float* src, bf16_t* dst, size_t n4) {
  const size_t stride = (size_t)gridDim.x * 256;
  for (size_t i0 = (size_t)blockIdx.x * 256 + threadIdx.x; i0 < n4; i0 += stride * 8) {
    float4 v[8];
#pragma unroll
    for (int j = 0; j < 8; ++j) { const size_t i = i0 + j * stride; const size_t ic = i < n4 ? i : n4 - 1; v[j] = ((const float4*)src)[ic]; }
#pragma unroll
    for (int j = 0; j < 8; ++j) {
      const size_t i = i0 + j * stride;
      if (i < n4) { uint2 o; o.x = pack2(v[j].x, v[j].y); o.y = pack2(v[j].z, v[j].w); ((uint2*)dst)[i] = o; }
    }
  }
}

__device__ __forceinline__ void prep_convert_fp8(const float* src, unsigned* dst, size_t n4, float scale) {
  const size_t stride = (size_t)gridDim.x * 256;
  for (size_t i0 = (size_t)blockIdx.x * 256 + threadIdx.x; i0 < n4; i0 += stride * 8) {
    float4 v[8];
#pragma unroll
    for (int j = 0; j < 8; ++j) { const size_t i = i0 + j * stride; const size_t ic = i < n4 ? i : n4 - 1; f32x4 t4 = __builtin_nontemporal_load((const f32x4*)src + ic); v[j] = make_float4(t4[0], t4[1], t4[2], t4[3]); }
#pragma unroll
    for (int j = 0; j < 8; ++j) {
      const size_t i = i0 + j * stride;
      if (i < n4) {
        unsigned w = __builtin_amdgcn_cvt_pk_fp8_f32(v[j].x * scale, v[j].y * scale, 0, false);
        w = __builtin_amdgcn_cvt_pk_fp8_f32(v[j].z * scale, v[j].w * scale, w, true);
        dst[i] = w;
      }
    }
  }
}
__device__ __forceinline__ void prep_convert_fp4(const float* src, unsigned* dst, size_t n8, float scale, int W) {
  const size_t stride = (size_t)gridDim.x * 256;
  for (size_t i0 = (size_t)blockIdx.x * 256 + threadIdx.x; i0 < n8; i0 += stride * 4) {
    f32x4 va[4], vb[4];
#pragma unroll
    for (int j = 0; j < 4; ++j) {
      const size_t i = i0 + j * stride; const size_t ic = i < n8 ? i : n8 - 1;
      va[j] = __builtin_nontemporal_load((const f32x4*)src + 2 * ic);
      vb[j] = __builtin_nontemporal_load((const f32x4*)src + 2 * ic + 1);
    }
#pragma unroll
    for (int j = 0; j < 4; ++j) {
      const size_t i = i0 + j * stride;
      if (i < n8) {
        unsigned w = 0;
        w = __builtin_amdgcn_cvt_scalef32_pk_fp4_f32(w, va[j][0] * scale, va[j][1] * scale, 1.0f, 0);
        w = __builtin_amdgcn_cvt_scalef32_pk_fp4_f32(w, va[j][2] * scale, va[j][3] * scale, 1.0f, 1);
        w = __builtin_amdgcn_cvt_scalef32_pk_fp4_f32(w, vb[j][0] * scale, vb[j][1] * scale, 1.0f, 2);
        w = __builtin_amdgcn_cvt_scalef32_pk_fp4_f32(w, vb[j][2] * scale, vb[j][3] * scale, 1.0f, 3);
        const size_t el = i * 8;
        const size_t lay = el >> 24, e = (el >> 10) & 16383, d0 = el & 1023;
        const size_t off = lay * (16384ull * 512) + (d0 / W) * (16384ull * (W / 2)) + e * (W / 2) + ((d0 % W) >> 1);
        *(unsigned*)((unsigned char*)dst + off) = w;
      }
    }
  }
}
__device__ __forceinline__ void unpack16_fp4(unsigned w0, unsigned w1, f32x2* f) {
  f[0] = __builtin_amdgcn_cvt_scalef32_pk_f32_fp4(w0, 1.0f, 0);
  f[1] = __builtin_amdgcn_cvt_scalef32_pk_f32_fp4(w0, 1.0f, 1);
  f[2] = __builtin_amdgcn_cvt_scalef32_pk_f32_fp4(w0, 1.0f, 2);
  f[3] = __builtin_amdgcn_cvt_scalef32_pk_f32_fp4(w0, 1.0f, 3);
  f[4] = __builtin_amdgcn_cvt_scalef32_pk_f32_fp4(w1, 1.0f, 0);
  f[5] = __builtin_amdgcn_cvt_scalef32_pk_f32_fp4(w1, 1.0f, 1);
  f[6] = __builtin_amdgcn_cvt_scalef32_pk_f32_fp4(w1, 1.0f, 2);
  f[7] = __builtin_amdgcn_cvt_scalef32_pk_f32_fp4(w1, 1.0f, 3);
}
__device__ __forceinline__ void unpack16_fp8(u32x4 v, float* f) {
#pragma unroll
  for (int i = 0; i < 4; ++i) {
    f32x2 lo = __builtin_amdgcn_cvt_pk_f32_fp8(v[i], false);
    f32x2 hi = __builtin_amdgcn_cvt_pk_f32_fp8(v[i], true);
    f[4 * i + 0] = lo.x; f[4 * i + 1] = lo.y; f[4 * i + 2] = hi.x; f[4 * i + 3] = hi.y;
  }
}
#define U_SCALE 64.f
#define V_SCALE 20.f
__device__ __forceinline__ void phase_prep_a(const Params& p, unsigned char* smem) {
  float* fs = (float*)smem;
  prep_mod(p, fs);
  {
    float2* rope = (float2*)(p.ws + OFF_ROPE);
    int i = blockIdx.x * 256 + threadIdx.x;
    if (i < 64 * 16) {
      int pos = i >> 4, f = i & 15;
      float fr = powf(10000.f, -(float)f / 16.f);
      float ang = (float)pos * fr;
      rope[i] = make_float2(cosf(ang), sinf(ang));
    }
  }
  for (int i = 0; i < 2; ++i) {
    prep_transpose(p.in[11] + (size_t)i * 1024 * 3072, (bf16_t*)(p.ws + OFF_WIN_EV) + (size_t)i * 3072 * 1024, 3072, 3072, fs);
    prep_transpose(p.in[16] + (size_t)i * 1024 * 3088, (bf16_t*)(p.ws + OFF_WIN_OD) + (size_t)i * 3328 * 1024, 3088, 3328, fs);
    prep_transpose(p.in[12] + (size_t)i * 1024 * 1024, (bf16_t*)(p.ws + OFF_WOUT) + (size_t)(2 * i) * 1024 * 1024, 1024, 1024, fs);
    prep_transpose(p.in[17] + (size_t)i * 1024 * 1024, (bf16_t*)(p.ws + OFF_WOUT) + (size_t)(2 * i + 1) * 1024 * 1024, 1024, 1024, fs);
  }
  for (int l = 0; l < 4; ++l)
    prep_transpose(p.in[26] + (size_t)l * 1024 * 2048, (bf16_t*)(p.ws + OFF_WQ) + (size_t)l * 2048 * 1024, 2048, 2048, fs);
  prep_convert(p.in[27], (bf16_t*)(p.ws + OFF_KEYS), (size_t)4 * 8 * 2 * 128 * 128 / 4);
  prep_convert_fp4(p.in[28], (unsigned*)(p.ws + OFF_UB), (size_t)4 * 16384 * 1024 / 8, U_SCALE, 128);
  prep_convert_fp4(p.in[29], (unsigned*)(p.ws + OFF_VB), (size_t)4 * 16384 * 1024 / 8, V_SCALE, 1024);
}

__device__ __forceinline__ void norm_token(const float* xrow, const float* g, const float* scale, const float* shift,
                                           bf16_t* hrow, float* copy_dst, int lane, unsigned char* h8row = nullptr) {
  float4 v[4];
  float ss = 0.f;
#pragma unroll
  for (int i = 0; i < 4; ++i) {
    v[i] = *(const float4*)(xrow + i * 256 + lane * 4);
    ss += v[i].x * v[i].x + v[i].y * v[i].y + v[i].z * v[i].z + v[i].w * v[i].w;
  }
  ss = wave_sum(ss);
  const float rs = rsqrtf(ss * (1.f / 1024.f) + EPSV);
#pragma unroll
  for (int i = 0; i < 4; ++i) {
    const int idx = i * 256 + lane * 4;
    if (copy_dst) *(float4*)(copy_dst + idx) = v[i];
    float4 gg = *(const float4*)(g + idx);
    float4 sc = *(const float4*)(scale + idx);
    float4 sh = *(const float4*)(shift + idx);
    float a = v[i].x * rs * gg.x * (1.f + sc.x) + sh.x;
    float b = v[i].y * rs * gg.y * (1.f + sc.y) + sh.y;
    float c = v[i].z * rs * gg.z * (1.f + sc.z) + sh.z;
    float d = v[i].w * rs * gg.w * (1.f + sc.w) + sh.w;
    uint2 o;
    o.x = pack2(a, b);
    o.y = pack2(c, d);
    *(uint2*)(hrow + idx) = o;
    if (h8row) {
      unsigned w4 = 0;
      w4 = __builtin_amdgcn_cvt_scalef32_pk_fp4_f32(w4, a * X_SCALE, b * X_SCALE, 1.0f, 0);
      w4 = __builtin_amdgcn_cvt_scalef32_pk_fp4_f32(w4, c * X_SCALE, d * X_SCALE, 1.0f, 1);
      *(unsigned short*)(h8row + (idx >> 1)) = (unsigned short)w4;
    }
  }
}

__device__ __forceinline__ void phase_prep_b(const Params& p) {
  const int tid_ = opaque_tid(); const int lane = tid_ & 63, wv = tid_ >> 6;
  const float* modv = (const float*)(p.ws + OFF_MOD);
  bf16_t* H = (bf16_t*)(p.ws + OFF_H);
  for (int t = blockIdx.x * 4 + wv; t < NTOK; t += gridDim.x * 4) {
    const float* xr = (t < NPROMPT) ? p.in[0] + (size_t)t * 1024 : p.in[1] + (size_t)(t - NPROMPT) * 1024;
    const float* md = modv + (size_t)(0 * 9 + tok_mod(t)) * 6144;
    norm_token(xr, p.in[8], md + 1024, md, H + (size_t)t * 1024, p.out + (size_t)t * 1024, lane);
  }
}

__device__ __forceinline__ void phase_norm2(const Params& p, int l) {
  const int tid_ = opaque_tid(); const int lane = tid_ & 63, wv = tid_ >> 6;
  const float* modv = (const float*)(p.ws + OFF_MOD);
  bf16_t* H = (bf16_t*)(p.ws + OFF_H);
  for (int t = blockIdx.x * 4 + wv; t < NTOK; t += gridDim.x * 4) {
    const float* md = modv + (size_t)(l * 9 + tok_mod(t)) * 6144;
    norm_token(p.out + (size_t)t * 1024, p.in[9] + l * 1024, md + 4096, md + 3072, H + (size_t)t * 1024, nullptr, lane,
               p.ws + OFF_H8 + (size_t)t * 512);
  }
}

template <int EPI, int NJ, int BK>
__device__ __forceinline__ void gemm_phase(const bf16_t* __restrict__ A, const bf16_t* __restrict__ Bt, int ntiles_n,
                           bf16_t* __restrict__ C, int ldc, float* __restrict__ X, const float* __restrict__ ga,
                           unsigned char* smem, int dry = 0) {
  constexpr int TN = 32 * NJ;
  constexpr int LS = BK + 8;
  constexpr int TPR = BK / 8;
  constexpr int RPP = 256 / TPR;
  constexpr int NA = 128 / RPP, NB = TN / RPP;
  bf16_t* As = (bf16_t*)smem;
  bf16_t* Bs = As + 128 * LS;
  const int tid = opaque_tid(), lane = tid & 63, w = tid >> 6, quad = lane >> 4, l15 = lane & 15;
  const int wm = w >> 1, wn = w & 1;
  const int lr = tid / TPR, lseg = (tid % TPR) * 8;
  const int units = 192 * ntiles_n;
  for (int u = blockIdx.x; u < units; u += gridDim.x) {
    const int mt = u % 192, nt = u / 192;
    const int m0 = mt * 128, n0 = nt * TN;
    f32x4 acc[4][NJ];
#pragma unroll
    for (int i = 0; i < 4; ++i)
#pragma unroll
      for (int j = 0; j < NJ; ++j) acc[i][j] = (f32x4){0.f, 0.f, 0.f, 0.f};
    const bf16_t* Ag = A + (size_t)(m0 + lr) * 1024 + lseg;
    const bf16_t* Bg = Bt + (size_t)(n0 + lr) * 1024 + lseg;
    u32x4 ra[NA], rb[NB];
#pragma unroll
    for (int i = 0; i < NA; ++i) ra[i] = *(const u32x4*)(Ag + (size_t)i * RPP * 1024);
#pragma unroll
    for (int i = 0; i < NB; ++i) rb[i] = *(const u32x4*)(Bg + (size_t)i * RPP * 1024);
    for (int kt = 0; kt < 1024 / BK; ++kt) {
#pragma unroll
      for (int i = 0; i < NA; ++i) *(u32x4*)(As + (lr + RPP * i) * LS + lseg) = ra[i];
#pragma unroll
      for (int i = 0; i < NB; ++i) *(u32x4*)(Bs + (lr + RPP * i) * LS + lseg) = rb[i];
      __syncthreads();
      if (kt + 1 < 1024 / BK) {
        const bf16_t* An = Ag + (kt + 1) * BK;
        const bf16_t* Bn = Bg + (kt + 1) * BK;
#pragma unroll
        for (int i = 0; i < NA; ++i) ra[i] = *(const u32x4*)(An + (size_t)i * RPP * 1024);
#pragma unroll
        for (int i = 0; i < NB; ++i) rb[i] = *(const u32x4*)(Bn + (size_t)i * RPP * 1024);
      }
#pragma unroll
      for (int kk = 0; kk < BK / 32; ++kk) {
        bf16x8 af[4];
#pragma unroll
        for (int i = 0; i < 4; ++i) af[i] = ldfrag(As + (wm * 64 + i * 16 + l15) * LS + kk * 32 + quad * 8);
#pragma unroll
        for (int j = 0; j < NJ; ++j) {
          const bf16x8 bfr = ldfrag(Bs + (wn * (16 * NJ) + j * 16 + l15) * LS + kk * 32 + quad * 8);
#pragma unroll
          for (int i = 0; i < 4; ++i) acc[i][j] = mfma16(af[i], bfr, acc[i][j]);
        }
      }
      __syncthreads();
    }
    if (EPI == 0) {
#pragma unroll
      for (int i = 0; i < 4; ++i)
#pragma unroll
        for (int j = 0; j < NJ; ++j) {
          const int col = n0 + wn * (16 * NJ) + j * 16 + l15;
          if (col < ldc) {
#pragma unroll
            for (int jj = 0; jj < 4; ++jj) {
              int row = m0 + wm * 64 + i * 16 + quad * 4 + jj;
              C[(size_t)row * ldc + col] = f2bf(acc[i][j][jj]);
            }
          }
        }
    } else {
      const float* gam = ga + (size_t)tok_mod(m0) * 6144;
#pragma unroll
      for (int i = 0; i < 4; ++i)
#pragma unroll
        for (int j = 0; j < NJ; ++j)
#pragma unroll
          for (int jj = 0; jj < 4; ++jj) {
            int row = m0 + wm * 64 + i * 16 + quad * 4 + jj;
            int col = n0 + wn * (16 * NJ) + j * 16 + l15;
            float* xp = X + (size_t)row * 1024 + col;
            const float nv = *xp + gam[col] * acc[i][j][jj];
            if (!dry) *xp = nv;
          }
    }
  }
}

struct ChainItem {
  bool lng; int sl, dir, h, sq, tok0, nc;
};
__device__ __forceinline__ ChainItem decode_item(int it) {
  ChainItem c;
  c.lng = it < 256;
  int idx = c.lng ? it : it - 256;
  c.sl = idx & 3; c.dir = (idx >> 2) & 1; c.h = (idx >> 3) & 3; c.sq = idx >> 5;
  c.tok0 = c.lng ? NPROMPT + c.sq * 2048 : c.sq * 256;
  c.nc = c.lng ? 32 : 4;
  return c;
}

__device__ __forceinline__ void phase_ret_chain(const Params& p, int l, unsigned char* smem) {
  const int il = l >> 1;
  bf16_t* qs = (bf16_t*)smem;
  bf16_t* ks = qs + 64 * 72;
  bf16_t* kT = ks + 64 * 72;
  bf16_t* vT = kT + 64 * 72;
  bf16_t* intra = vT + 32 * 72;
  bf16_t* ST = intra + 64 * 72;
  const bf16_t* P = (const bf16_t*)(p.ws + OFF_P);
  float* odir = (float*)(p.ws + OFF_ODIR);
  const float2* rope = (const float2*)(p.ws + OFF_ROPE);
  const int tid = opaque_tid(), lane = tid & 63, w = tid >> 6, quad = lane >> 4, l15 = lane & 15;
  const int nlb = (gridDim.x >= 512) ? 256 : ((gridDim.x >= 2) ? (int)(gridDim.x / 2) : 0);
  const bool longblk = (nlb > 0) ? ((int)blockIdx.x < nlb) : true;
  const int it_lo = (nlb > 0) ? (longblk ? (int)blockIdx.x : 256 + ((int)blockIdx.x - nlb)) : (int)blockIdx.x;
  const int it_hi = (nlb > 0) ? (longblk ? 256 : 1280) : 1280;
  const int it_st = (nlb > 0) ? (longblk ? nlb : ((int)gridDim.x - nlb)) : (int)gridDim.x;
  for (int it = it_lo; it < it_hi; it += it_st) {
    const ChainItem ci = decode_item(it);
    const int sl = ci.sl, dir = ci.dir, h = ci.h;
    const float xg = p.in[13][(il * 2 + dir) * 4 + h];
    const float lg = -log1pf(expf(-xg));
    const float g64 = expf(lg * 64.f);
    f32x4 S[2];
    if (ci.lng) {
      const float* s0 = p.in[2] + ((((size_t)ci.sq * 2 + il) * 2 + dir) * 4 + h) * 8192;
#pragma unroll
      for (int ct = 0; ct < 2; ++ct)
#pragma unroll
        for (int jj = 0; jj < 4; ++jj) S[ct][jj] = s0[(16 * w + quad * 4 + jj) * 128 + sl * 32 + ct * 16 + l15];
    } else {
      S[0] = (f32x4){0.f, 0.f, 0.f, 0.f};
      S[1] = (f32x4){0.f, 0.f, 0.f, 0.f};
    }
    for (int n = 0; n < ci.nc; ++n) {
      const int cn = dir ? ci.nc - 1 - n : n;
      const int tb = ci.tok0 + cn * 64;
      {
        const int i = tid >> 2, mq = tid & 3;
        const int t = tb + (dir ? 63 - i : i);
        const bf16_t* pr = P + (size_t)t * PSTRIDE;
        float qa[8], qb[8], ka[8], kb[8];
        unpack8(*(const uint4*)(pr + h * 64 + mq * 8), qa);
        unpack8(*(const uint4*)(pr + h * 64 + 32 + mq * 8), qb);
        unpack8(*(const uint4*)(pr + 256 + h * 64 + mq * 8), ka);
        unpack8(*(const uint4*)(pr + 256 + h * 64 + 32 + mq * 8), kb);
        if (ci.lng) {
          const int pos = (mq < 2) ? cn : (t - tb);
          const int f0 = (mq & 1) * 8;
#pragma unroll
          for (int e = 0; e < 8; ++e) {
            float2 cs = rope[pos * 16 + f0 + e];
            float a = qa[e], b = qb[e];
            qa[e] = a * cs.x - b * cs.y; qb[e] = b * cs.x + a * cs.y;
            a = ka[e]; b = kb[e];
            ka[e] = a * cs.x - b * cs.y; kb[e] = b * cs.x + a * cs.y;
          }
        }
        const float wend = expf(lg * (float)(63 - i));
        uint4 o;
        o.x = pack2(qa[0], qa[1]); o.y = pack2(qa[2], qa[3]); o.z = pack2(qa[4], qa[5]); o.w = pack2(qa[6], qa[7]);
        *(uint4*)(qs + i * 72 + mq * 8) = o;
        o.x = pack2(qb[0], qb[1]); o.y = pack2(qb[2], qb[3]); o.z = pack2(qb[4], qb[5]); o.w = pack2(qb[6], qb[7]);
        *(uint4*)(qs + i * 72 + 32 + mq * 8) = o;
#pragma unroll
        for (int e = 0; e < 8; ++e) { ka[e] *= 0.125f; kb[e] *= 0.125f; }
        o.x = pack2(ka[0], ka[1]); o.y = pack2(ka[2], ka[3]); o.z = pack2(ka[4], ka[5]); o.w = pack2(ka[6], ka[7]);
        *(uint4*)(ks + i * 72 + mq * 8) = o;
        o.x = pack2(kb[0], kb[1]); o.y = pack2(kb[2], kb[3]); o.z = pack2(kb[4], kb[5]); o.w = pack2(kb[6], kb[7]);
        *(uint4*)(ks + i * 72 + 32 + mq * 8) = o;
#pragma unroll
        for (int e = 0; e < 8; ++e) {
          kT[(mq * 8 + e) * 72 + i] = f2bf(ka[e] * wend);
          kT[(32 + mq * 8 + e) * 72 + i] = f2bf(kb[e] * wend);
        }
        uint4 v8 = *(const uint4*)(pr + 512 + h * 128 + sl * 32 + mq * 8);
        vT[(mq * 8 + 0) * 72 + i] = (bf16_t)(v8.x & 0xffff); vT[(mq * 8 + 1) * 72 + i] = (bf16_t)(v8.x >> 16);
        vT[(mq * 8 + 2) * 72 + i] = (bf16_t)(v8.y & 0xffff); vT[(mq * 8 + 3) * 72 + i] = (bf16_t)(v8.y >> 16);
        vT[(mq * 8 + 4) * 72 + i] = (bf16_t)(v8.z & 0xffff); vT[(mq * 8 + 5) * 72 + i] = (bf16_t)(v8.z >> 16);
        vT[(mq * 8 + 6) * 72 + i] = (bf16_t)(v8.w & 0xffff); vT[(mq * 8 + 7) * 72 + i] = (bf16_t)(v8.w >> 16);
      }
      __syncthreads();
      const bf16x8 a0 = ldfrag(qs + (16 * w + l15) * 72 + quad * 8);
      const bf16x8 a1 = ldfrag(qs + (16 * w + l15) * 72 + 32 + quad * 8);
#pragma unroll
      for (int ct = 0; ct < 4; ++ct) {
        bf16x8 b0 = ldfrag(ks + (ct * 16 + l15) * 72 + quad * 8);
        bf16x8 b1 = ldfrag(ks + (ct * 16 + l15) * 72 + 32 + quad * 8);
        f32x4 c = (f32x4){0.f, 0.f, 0.f, 0.f};
        c = mfma16(a0, b0, c);
        c = mfma16(a1, b1, c);
#pragma unroll
        for (int jj = 0; jj < 4; ++jj) {
          int i = 16 * w + quad * 4 + jj, j = ct * 16 + l15;
          float val = (i >= j) ? c[jj] * expf(lg * (float)(i - j)) : 0.f;
          intra[i * 72 + j] = f2bf(val);
        }
      }
#pragma unroll
      for (int ct = 0; ct < 2; ++ct)
#pragma unroll
        for (int jj = 0; jj < 4; ++jj) ST[(ct * 16 + l15) * 72 + 16 * w + quad * 4 + jj] = f2bf(S[ct][jj]);
      __syncthreads();
      const bf16x8 ai0 = ldfrag(intra + (16 * w + l15) * 72 + quad * 8);
      const bf16x8 ai1 = ldfrag(intra + (16 * w + l15) * 72 + 32 + quad * 8);
      const bf16x8 ak0 = ldfrag(kT + (16 * w + l15) * 72 + quad * 8);
      const bf16x8 ak1 = ldfrag(kT + (16 * w + l15) * 72 + 32 + quad * 8);
#pragma unroll
      for (int ct = 0; ct < 2; ++ct) {
        bf16x8 bv0 = ldfrag(vT + (ct * 16 + l15) * 72 + quad * 8);
        bf16x8 bv1 = ldfrag(vT + (ct * 16 + l15) * 72 + 32 + quad * 8);
        bf16x8 bs0 = ldfrag(ST + (ct * 16 + l15) * 72 + quad * 8);
        bf16x8 bs1 = ldfrag(ST + (ct * 16 + l15) * 72 + 32 + quad * 8);
        f32x4 ci_ = (f32x4){0.f, 0.f, 0.f, 0.f}, cc = (f32x4){0.f, 0.f, 0.f, 0.f};
        ci_ = mfma16(ai0, bv0, ci_);
        ci_ = mfma16(ai1, bv1, ci_);
        cc = mfma16(a0, bs0, cc);
        cc = mfma16(a1, bs1, cc);
#pragma unroll
        for (int jj = 0; jj < 4; ++jj) {
          int i = 16 * w + quad * 4 + jj;
          int t = tb + (dir ? 63 - i : i);
          float o = ci_[jj] + expf(lg * (float)(i + 1)) * cc[jj];
          odir[((size_t)dir * NTOK + t) * 512 + h * 128 + sl * 32 + ct * 16 + l15] = o;
        }
        f32x4 s = S[ct];
        s[0] *= g64; s[1] *= g64; s[2] *= g64; s[3] *= g64;
        s = mfma16(ak0, bv0, s);
        s = mfma16(ak1, bv1, s);
        S[ct] = s;
      }
      __syncthreads();
    }
    if (!ci.lng) {
      float* so = p.out + 25165824 + ((((size_t)ci.sq * 2 + il) * 2 + dir) * 4 + h) * 8192;
#pragma unroll
      for (int ct = 0; ct < 2; ++ct)
#pragma unroll
        for (int jj = 0; jj < 4; ++jj) so[(16 * w + quad * 4 + jj) * 128 + sl * 32 + ct * 16 + l15] = S[ct][jj];
    }
  }
}

__device__ __forceinline__ void gdn_prep_item(const Params& p, int l, int pi, unsigned char* smem, int plvl) {
  const int il = l >> 1;
  bf16_t* ks = (bf16_t*)smem;
  bf16_t* vs = ks + 64 * 136;
  float* Am = (float*)(vs + 64 * 136);
  float* rq = Am + 4096;
  float* rk = rq + 64;
  float* gcs = rk + 64;
  float* bet = gcs + 64;
  float* fac = bet + 64;
  bf16_t* qs = (bf16_t*)(fac + 128);
  const bf16_t* P = (const bf16_t*)(p.ws + OFF_P);
  unsigned char* gp = p.ws + OFF_GPREP + (size_t)pi * GP_ITEM;
  bf16_t* Wb = (bf16_t*)gp;
  bf16_t* QG = Wb + 8192;
  bf16_t* KDT = QG + 8192;
  bf16_t* Ub = KDT + 8192;
  bf16_t* ATT = Ub + 8192;
  float* EGL = (float*)(p.ws + OFF_EGL);
  const int tid = opaque_tid(), lane = tid & 63, w = tid >> 6, quad = lane >> 4, l15 = lane & 15;
  const int dir = pi & 1, h = (pi >> 1) & 3, c = pi >> 3;
  int tb, seq_lo, seq_hi;
  if (c < 128) { tb = c * 64; seq_lo = (c >> 2) * 256; seq_hi = seq_lo + 256; }
  else { int cc = c - 128; tb = NPROMPT + cc * 64; seq_lo = NPROMPT + (cc >> 5) * 2048; seq_hi = seq_lo + 2048; }
  const float SCALE = 0.08838834764831845f;
  {
    const int cg_ = tid & 127, rh = tid >> 7;
#pragma unroll
    for (int mat = 0; mat < 3; ++mat) {
      const int col = mat * 512 + h * 128 + cg_;
      const float* cw = p.in[18] + (size_t)il * 3 * 1536 + col;
      const float w0 = cw[0], w1 = cw[1536], w2 = cw[3072];
      bf16_t* dst = mat == 0 ? qs : (mat == 1 ? ks : vs);
      const int t0 = tb + rh * 32;
      bf16_t raw[34];
#pragma unroll
      for (int o = 0; o < 34; ++o) {
        const int t = t0 - 1 + o;
        const int tc = min(max(t, seq_lo), seq_hi - 1);
        const bf16_t rv = P[(size_t)tc * PSTRIDE + col];
        raw[o] = (t == tc) ? rv : (bf16_t)0;
      }
#pragma unroll
      for (int o = 0; o < 32; ++o) {
        float y = w0 * bf2f(raw[o]) + w1 * bf2f(raw[o + 1]) + w2 * bf2f(raw[o + 2]);
        y = siluf(y);
        const int oi = rh * 32 + o;
        const int i = dir ? 63 - oi : oi;
        dst[i * 136 + cg_] = f2bf(y);
      }
    }
  }
  __syncthreads();
  if (plvl == 4) return;
  {
    const int r = tid >> 2, part = tid & 3;
    float sq_ = 0.f, sk_ = 0.f;
#pragma unroll 8
    for (int e = 0; e < 32; ++e) {
      float a = bf2f(qs[r * 136 + part * 32 + e]);
      float b = bf2f(ks[r * 136 + part * 32 + e]);
      sq_ += a * a; sk_ += b * b;
    }
    sq_ += __shfl_xor(sq_, 1); sq_ += __shfl_xor(sq_, 2);
    sk_ += __shfl_xor(sk_, 1); sk_ += __shfl_xor(sk_, 2);
    if (part == 0) {
      rq[r] = rsqrtf(sq_ + EPSV);
      rk[r] = rsqrtf(sk_ + EPSV);
      const int t = tb + (dir ? 63 - r : r);
      float a = bf2f(P[(size_t)t * PSTRIDE + 2048 + dir * 4 + h]);
      float bbv = bf2f(P[(size_t)t * PSTRIDE + 2056 + dir * 4 + h]);
      float al = p.in[19][(il * 2 + dir) * 4 + h], dtb = p.in[20][(il * 2 + dir) * 4 + h];
      float z = a + dtb;
      float sp = (z > 20.f) ? z : log1pf(expf(z));
      gcs[r] = -expf(al) * sp;
      bet[r] = 1.f / (1.f + expf(-bbv));
    }
  }
  __syncthreads();
  if (tid < 64) {
    float v = gcs[tid];
#pragma unroll
    for (int o = 1; o < 64; o <<= 1) {
      float u = __shfl_up(v, o);
      if (tid >= o) v += u;
    }
    gcs[tid] = v;
  }
  __syncthreads();
  {
    bf16x8 ak[4], aq[4];
#pragma unroll
    for (int kk = 0; kk < 4; ++kk) {
      ak[kk] = ldfrag(ks + (16 * w + l15) * 136 + kk * 32 + quad * 8);
      aq[kk] = ldfrag(qs + (16 * w + l15) * 136 + kk * 32 + quad * 8);
    }
#pragma unroll
    for (int ct = 0; ct < 4; ++ct) {
      f32x4 ckk = (f32x4){0.f, 0.f, 0.f, 0.f}, cqk = (f32x4){0.f, 0.f, 0.f, 0.f};
#pragma unroll
      for (int kk = 0; kk < 4; ++kk) {
        bf16x8 b = ldfrag(ks + (ct * 16 + l15) * 136 + kk * 32 + quad * 8);
        ckk = mfma16(ak[kk], b, ckk);
        cqk = mfma16(aq[kk], b, cqk);
      }
#pragma unroll
      for (int jj = 0; jj < 4; ++jj) {
        const int i = 16 * w + quad * 4 + jj, j = ct * 16 + l15;
        const float dec = (i >= j) ? __expf(gcs[i] - gcs[j]) : 0.f;
        Am[j * 64 + i] = (i > j) ? bet[i] * rk[i] * rk[j] * ckk[jj] * dec : 0.f;
        ATT[i * 64 + j] = f2bf((i >= j) ? SCALE * rq[i] * rk[j] * cqk[jj] * dec : 0.f);
      }
    }
  }
  __syncthreads();
  const float gl = gcs[63];
#pragma unroll 8
  for (int e = tid; e < 64 * 128; e += 256) {
    int i = e >> 7, d = e & 127;
    QG[e] = f2bf(bf2f(qs[i * 136 + d]) * rq[i] * SCALE * __expf(gcs[i]));
  }
#pragma unroll 8
  for (int e = tid; e < 128 * 64; e += 256) {
    int d = e >> 6, i = e & 63;
    KDT[e] = f2bf(bf2f(ks[i * 136 + d]) * rk[i] * __expf(gl - gcs[i]));
  }
  if (tid < 64) {
    fac[tid] = bet[tid];
    fac[64 + tid] = rk[tid] * bet[tid] * __expf(gcs[tid]);
  }
  __syncthreads();
  if (plvl != 3) {
    const int cidx = tid & 127;
    const bf16_t* srcm = ((tid < 128) ? vs : ks) + cidx;
    const float* fc = fac + ((tid < 128) ? 0 : 64);
    bf16_t* dstm = ((tid < 128) ? Ub : Wb) + cidx;
    bf16_t* XB = qs + tid;
#pragma unroll 1
    for (int b = 0; b < 4; ++b) {
      float x[16];
#pragma unroll
      for (int r = 0; r < 16; ++r) x[r] = bf2f(srcm[(16 * b + r) * 136]) * fc[16 * b + r];
      const float* arow = Am + 16 * b;
#pragma unroll 4
      for (int j = 0; j < 16 * b; ++j) {
        const float xv = bf2f(XB[j * 256]);
        const f32x4 a0 = *(const f32x4*)(arow + j * 64), a1 = *(const f32x4*)(arow + j * 64 + 4);
        const f32x4 a2 = *(const f32x4*)(arow + j * 64 + 8), a3 = *(const f32x4*)(arow + j * 64 + 12);
#pragma unroll
        for (int r = 0; r < 4; ++r) {
          x[r] -= a0[r] * xv; x[4 + r] -= a1[r] * xv; x[8 + r] -= a2[r] * xv; x[12 + r] -= a3[r] * xv;
        }
      }
      const float* ablk = Am + (16 * b) * 64 + 16 * b;
#pragma unroll
      for (int jj = 0; jj < 15; ++jj) {
#pragma unroll
        for (int r = jj + 1; r < 16; ++r) x[r] -= ablk[jj * 64 + r] * x[jj];
      }
#pragma unroll
      for (int r = 0; r < 16; ++r) {
        const bf16_t bb = f2bf(x[r]);
        dstm[(16 * b + r) * 128] = bb;
        if (b < 3) XB[(16 * b + r) * 256] = bb;
      }
    }
  }
  if (tid == 0) EGL[pi] = expf(gl);
  __syncthreads();
}

__device__ __forceinline__ void conf_conv_item(const Params& p, int l, int item, unsigned char* smem) {
  const int il = l >> 1;
  float* hc = (float*)smem;
  const bf16_t* P = (const bf16_t*)(p.ws + OFF_P);
  float* convout = (float*)(p.ws + OFF_CONV);
  const int tid = opaque_tid();
  const int tile = item >> 1, ch = (item & 1) * 256 + tid;
  const int t0 = tile * 32;
  int seq_lo, seq_hi;
  if (t0 < NPROMPT) { seq_lo = (t0 >> 8) << 8; seq_hi = seq_lo + 256; }
  else { seq_lo = NPROMPT + (((t0 - NPROMPT) >> 11) << 11); seq_hi = seq_lo + 2048; }
#pragma unroll 31
  for (int r = 0; r < 62; ++r) {
    const int tt = t0 - 15 + r;
    const int tc = min(max(tt, seq_lo), seq_hi - 1);
    float ca = bf2f(P[(size_t)tc * PSTRIDE + 2064 + ch]);
    float cgv = bf2f(P[(size_t)tc * PSTRIDE + 2576 + ch]);
    float v = ca * __builtin_amdgcn_rcpf(1.f + __expf(-cgv));
    hc[r * 256 + tid] = (tt == tc) ? v : 0.f;
  }
  float wk[31];
#pragma unroll
  for (int k = 0; k < 31; ++k) wk[k] = p.in[22][((size_t)il * 31 + k) * 512 + ch];
  const float bias = p.in[23][il * 512 + ch];
  for (int i = 0; i < 32; ++i) {
    float acc = bias;
#pragma unroll
    for (int k = 0; k < 31; ++k) acc += wk[k] * hc[(i + k) * 256 + tid];
    convout[(size_t)(t0 + i) * 512 + ch] = acc;
  }
}

__device__ __forceinline__ void phase_odd_prep(const Params& p, int l, unsigned char* smem, int rep) {
  for (int u = blockIdx.x; u < 3072 + 1536; u += gridDim.x) {
#if PROBE_ODD == 1 || PROBE_ODD >= 3
    if (rep && u >= 3072) break;
#elif PROBE_ODD == 2
    if (rep && u < 3072) continue;
#endif
    if (u < 3072) gdn_prep_item(p, l, u, smem, (PROBE_ODD >= 3 && rep) ? PROBE_ODD : 0);
    else { conf_conv_item(p, l, u - 3072, smem); __syncthreads(); }
  }
}

__device__ __forceinline__ void phase_gdn_chain(const Params& p, int l, unsigned char* smem) {
  const int il = l >> 1;
  bf16_t* ST = (bf16_t*)smem;
  bf16_t* VT = ST + 32 * 136;
  float* odir = (float*)(p.ws + OFF_ODIR);
  const float* EGL = (const float*)(p.ws + OFF_EGL);
  const int tid = opaque_tid(), lane = tid & 63, w = tid >> 6, quad = lane >> 4, l15 = lane & 15;
  const int nlb = (gridDim.x >= 512) ? 256 : ((gridDim.x >= 2) ? (int)(gridDim.x / 2) : 0);
  const bool longblk = (nlb > 0) ? ((int)blockIdx.x < nlb) : true;
  const int it_lo = (nlb > 0) ? (longblk ? (int)blockIdx.x : 256 + ((int)blockIdx.x - nlb)) : (int)blockIdx.x;
  const int it_hi = (nlb > 0) ? (longblk ? 256 : 1280) : 1280;
  const int it_st = (nlb > 0) ? (longblk ? nlb : ((int)gridDim.x - nlb)) : (int)gridDim.x;
  for (int it = it_lo; it < it_hi; it += it_st) {
    const ChainItem ci = decode_item(it);
    const int sl = ci.sl, dir = ci.dir, h = ci.h;
    f32x4 S[2][2];
    if (ci.lng) {
      const float* s0 = p.in[3] + ((((size_t)ci.sq * 2 + il) * 2 + dir) * 4 + h) * 16384;
#pragma unroll
      for (int rb = 0; rb < 2; ++rb)
#pragma unroll
        for (int ct = 0; ct < 2; ++ct)
#pragma unroll
          for (int jj = 0; jj < 4; ++jj)
            S[rb][ct][jj] = s0[(16 * (2 * w + rb) + quad * 4 + jj) * 128 + sl * 32 + ct * 16 + l15];
    } else {
#pragma unroll
      for (int rb = 0; rb < 2; ++rb)
#pragma unroll
        for (int ct = 0; ct < 2; ++ct) S[rb][ct] = (f32x4){0.f, 0.f, 0.f, 0.f};
    }
    bf16x8 naw[4], naqg[4];
    bf16_t nuu[2][4];
    float negl = 0.f;
    for (int n = 0; n < ci.nc; ++n) {
      const int cn = dir ? ci.nc - 1 - n : n;
      const int tb = ci.tok0 + cn * 64;
      const int cglob = ci.lng ? 128 + ci.sq * 32 + cn : ci.sq * 4 + cn;
      const int pi = (cglob * 4 + h) * 2 + dir;
      const unsigned char* gp = p.ws + OFF_GPREP + (size_t)pi * GP_ITEM;
      const bf16_t* Wb = (const bf16_t*)gp;
      const bf16_t* QG = Wb + 8192;
      const bf16_t* KDT = QG + 8192;
      const bf16_t* Ub = KDT + 8192;
      const bf16_t* ATT = Ub + 8192;
      bf16x8 aw[4], aqg[4], aat[2], akd[2][2];
      float uu[2][4];
      float egl;
      if (n == 0) {
#pragma unroll
        for (int kk = 0; kk < 4; ++kk) {
          aw[kk] = ldfrag(Wb + (16 * w + l15) * 128 + kk * 32 + quad * 8);
          aqg[kk] = ldfrag(QG + (16 * w + l15) * 128 + kk * 32 + quad * 8);
        }
#pragma unroll
        for (int kk = 0; kk < 2; ++kk) {
          aat[kk] = ldfrag(ATT + (16 * w + l15) * 64 + kk * 32 + quad * 8);
#pragma unroll
          for (int rb = 0; rb < 2; ++rb) akd[rb][kk] = ldfrag(KDT + (16 * (2 * w + rb) + l15) * 64 + kk * 32 + quad * 8);
        }
#pragma unroll
        for (int ct = 0; ct < 2; ++ct)
#pragma unroll
          for (int jj = 0; jj < 4; ++jj) uu[ct][jj] = bf2f(Ub[(16 * w + quad * 4 + jj) * 128 + sl * 32 + ct * 16 + l15]);
        egl = EGL[pi];
      } else {
#pragma unroll
        for (int kk = 0; kk < 4; ++kk) { aw[kk] = naw[kk]; aqg[kk] = naqg[kk]; }
#pragma unroll
        for (int kk = 0; kk < 2; ++kk) {
          aat[kk] = ldfrag(ATT + (16 * w + l15) * 64 + kk * 32 + quad * 8);
#pragma unroll
          for (int rb = 0; rb < 2; ++rb) akd[rb][kk] = ldfrag(KDT + (16 * (2 * w + rb) + l15) * 64 + kk * 32 + quad * 8);
        }
#pragma unroll
        for (int ct = 0; ct < 2; ++ct)
#pragma unroll
          for (int jj = 0; jj < 4; ++jj) uu[ct][jj] = bf2f(nuu[ct][jj]);
        egl = negl;
      }
      if (n + 1 < ci.nc) {
        const int cn2 = dir ? ci.nc - 2 - n : n + 1;
        const int cglob2 = ci.lng ? 128 + ci.sq * 32 + cn2 : ci.sq * 4 + cn2;
        const int pi2 = (cglob2 * 4 + h) * 2 + dir;
        const bf16_t* Wb2 = (const bf16_t*)(p.ws + OFF_GPREP + (size_t)pi2 * GP_ITEM);
        const bf16_t* QG2 = Wb2 + 8192; const bf16_t* Ub2 = QG2 + 16384;
#pragma unroll
        for (int kk = 0; kk < 4; ++kk) {
          naw[kk] = ldfrag(Wb2 + (16 * w + l15) * 128 + kk * 32 + quad * 8);
          naqg[kk] = ldfrag(QG2 + (16 * w + l15) * 128 + kk * 32 + quad * 8);
        }
#pragma unroll
        for (int ct = 0; ct < 2; ++ct)
#pragma unroll
          for (int jj = 0; jj < 4; ++jj) nuu[ct][jj] = Ub2[(16 * w + quad * 4 + jj) * 128 + sl * 32 + ct * 16 + l15];
        negl = EGL[pi2];
      }
#pragma unroll
      for (int rb = 0; rb < 2; ++rb)
#pragma unroll
        for (int ct = 0; ct < 2; ++ct)
#pragma unroll
          for (int jj = 0; jj < 4; ++jj)
            ST[(ct * 16 + l15) * 136 + 16 * (2 * w + rb) + quad * 4 + jj] = f2bf(S[rb][ct][jj]);
      __syncthreads();
      f32x4 co[2];
#pragma unroll
      for (int ct = 0; ct < 2; ++ct) {
        f32x4 cv = (f32x4){0.f, 0.f, 0.f, 0.f};
        co[ct] = (f32x4){0.f, 0.f, 0.f, 0.f};
#pragma unroll
        for (int kk = 0; kk < 4; ++kk) {
          bf16x8 b = ldfrag(ST + (ct * 16 + l15) * 136 + kk * 32 + quad * 8);
          cv = mfma16(aw[kk], b, cv);
          co[ct] = mfma16(aqg[kk], b, co[ct]);
        }
#pragma unroll
        for (int jj = 0; jj < 4; ++jj) {
          float vn = uu[ct][jj] - cv[jj];
          VT[(ct * 16 + l15) * 72 + 16 * w + quad * 4 + jj] = f2bf(vn);
        }
      }
      __syncthreads();
#pragma unroll
      for (int ct = 0; ct < 2; ++ct) {
        bf16x8 bv[2];
#pragma unroll
        for (int kk = 0; kk < 2; ++kk) {
          bv[kk] = ldfrag(VT + (ct * 16 + l15) * 72 + kk * 32 + quad * 8);
          co[ct] = mfma16(aat[kk], bv[kk], co[ct]);
        }
#pragma unroll
        for (int jj = 0; jj < 4; ++jj) {
          int i = 16 * w + quad * 4 + jj;
          int t = tb + (dir ? 63 - i : i);
          odir[((size_t)dir * NTOK + t) * 512 + h * 128 + sl * 32 + ct * 16 + l15] = co[ct][jj];
        }
#pragma unroll
        for (int rb = 0; rb < 2; ++rb) {
          f32x4 s = S[rb][ct];
          s[0] *= egl; s[1] *= egl; s[2] *= egl; s[3] *= egl;
          s = mfma16(akd[rb][0], bv[0], s);
          s = mfma16(akd[rb][1], bv[1], s);
          S[rb][ct] = s;
        }
      }
    }
    __syncthreads();
    if (!ci.lng) {
      float* so = p.out + 29360128 + ((((size_t)ci.sq * 2 + il) * 2 + dir) * 4 + h) * 16384;
#pragma unroll
      for (int rb = 0; rb < 2; ++rb)
#pragma unroll
        for (int ct = 0; ct < 2; ++ct)
#pragma unroll
          for (int jj = 0; jj < 4; ++jj)
            so[(16 * (2 * w + rb) + quad * 4 + jj) * 128 + sl * 32 + ct * 16 + l15] = S[rb][ct][jj];
    }
  }
}

__device__ __forceinline__ void phase_mix_out(const Params& p, int l) {
  const int il = l >> 1;
  const bool odd = l & 1;
  const int tid_ = opaque_tid(); const int lane = tid_ & 63, wv = tid_ >> 6;
  const bf16_t* P = (const bf16_t*)(p.ws + OFF_P);
  const float* od0 = (const float*)(p.ws + OFF_ODIR);
  const float* od1 = od0 + (size_t)NTOK * 512;
  const float* convout = (const float*)(p.ws + OFF_CONV);
  bf16_t* Y = (bf16_t*)(p.ws + OFF_YMIX);
  for (int t = blockIdx.x * 4 + wv; t < NTOK; t += gridDim.x * 4) {
    const bf16_t* pr = P + (size_t)t * PSTRIDE;
    bf16_t* yr = Y + (size_t)t * 1024;
#pragma unroll
    for (int h = 0; h < 4; ++h) {
      const int idx = h * 128 + lane * 2;
      float2 a = *(const float2*)(od0 + (size_t)t * 512 + idx);
      float2 b = *(const float2*)(od1 + (size_t)t * 512 + idx);
      float o0 = a.x + b.x, o1 = a.y + b.y;
      float ss = wave_sum(o0 * o0 + o1 * o1);
      float rs = rsqrtf(ss * (1.f / 128.f) + EPSV);
      float n0, n1;
      unsigned gz;
      if (!odd) {
        n0 = p.in[14][il * 512 + idx]; n1 = p.in[14][il * 512 + idx + 1];
        gz = *(const unsigned*)(pr + 1024 + idx);
      } else {
        n0 = p.in[21][il * 128 + lane * 2]; n1 = p.in[21][il * 128 + lane * 2 + 1];
        gz = *(const unsigned*)(pr + 1536 + idx);
      }
      float y0 = siluf(bflo(gz)) * o0 * rs * n0;
      float y1 = siluf(bfhi(gz)) * o1 * rs * n1;
      *(unsigned*)(yr + idx) = pack2(y0, y1);
    }
    if (!odd) {
      int seq_lo, seq_hi;
      if (t < NPROMPT) { seq_lo = (t >> 8) << 8; seq_hi = seq_lo + 256; }
      else { seq_lo = NPROMPT + (((t - NPROMPT) >> 11) << 11); seq_hi = seq_lo + 2048; }
      const bool hp = (t - 1 >= seq_lo), hn = (t + 1 < seq_hi);
#pragma unroll
      for (int j = 0; j < 4; ++j) {
        const int c = j * 128 + lane * 2;
        unsigned cg0 = *(const unsigned*)(pr + 2048 + c), hb0 = *(const unsigned*)(pr + 2560 + c);
        const bf16_t* prm = hp ? pr - PSTRIDE : pr;
        const bf16_t* prp = hn ? pr + PSTRIDE : pr;
        unsigned cgm = *(const unsigned*)(prm + 2048 + c), hbm = *(const unsigned*)(prm + 2560 + c);
        unsigned cgp = *(const unsigned*)(prp + 2048 + c), hbp = *(const unsigned*)(prp + 2560 + c);
        if (!hp) { cgm = 0; hbm = 0; }
        if (!hn) { cgp = 0; hbp = 0; }
        unsigned bg = *(const unsigned*)(pr + 1536 + c);
        const float* sw = p.in[15] + (size_t)il * 3 * 512 + c;
        float y0 = bflo(bg) * (sw[0] * bflo(cgm) * bflo(hbm) + sw[512] * bflo(cg0) * bflo(hb0) + sw[1024] * bflo(cgp) * bflo(hbp));
        float y1 = bfhi(bg) * (sw[1] * bfhi(cgm) * bfhi(hbm) + sw[513] * bfhi(cg0) * bfhi(hb0) + sw[1025] * bfhi(cgp) * bfhi(hbp));
        *(unsigned*)(yr + 512 + c) = pack2(y0, y1);
      }
    } else {
      float v[8];
      float s = 0.f;
#pragma unroll
      for (int j = 0; j < 4; ++j) {
        float2 a = *(const float2*)(convout + (size_t)t * 512 + j * 128 + lane * 2);
        v[2 * j] = a.x; v[2 * j + 1] = a.y;
        s += a.x + a.y;
      }
      const float mean = wave_sum(s) * (1.f / 512.f);
      float vs = 0.f;
#pragma unroll
      for (int j = 0; j < 8; ++j) { v[j] -= mean; vs += v[j] * v[j]; }
      const float rstd = rsqrtf(wave_sum(vs) * (1.f / 512.f) + EPSV);
#pragma unroll
      for (int j = 0; j < 4; ++j) {
        const int c = j * 128 + lane * 2;
        float y0 = v[2 * j] * rstd * p.in[24][il * 512 + c] + p.in[25][il * 512 + c];
        float y1 = v[2 * j + 1] * rstd * p.in[24][il * 512 + c + 1] + p.in[25][il * 512 + c + 1];
        *(unsigned*)(yr + 512 + c) = pack2(siluf(y0), siluf(y1));
      }
    }
  }
}

#define WAVE_LDS_SYNC() { asm volatile("s_waitcnt lgkmcnt(0)" ::: "memory"); __builtin_amdgcn_wave_barrier(); }
#define CE_DESC(a, b) { unsigned _mx = max(a, b), _mn = min(a, b); a = _mx; b = _mn; }
#define CE_ASC(a, b) { unsigned _mx = max(a, b), _mn = min(a, b); a = _mn; b = _mx; }
__device__ __forceinline__ void sort16_desc(unsigned* v) {
#pragma unroll
  for (int k = 2; k <= 16; k <<= 1) {
#pragma unroll
    for (int j = k >> 1; j > 0; j >>= 1) {
#pragma unroll
      for (int i = 0; i < 16; ++i) {
        const int l = i ^ j;
        if (l > i) {
          if ((i & k) == 0) CE_DESC(v[i], v[l]) else CE_ASC(v[i], v[l])
        }
      }
    }
  }
}
__device__ __forceinline__ void merge16_top(unsigned* a, const unsigned* b) {
#pragma unroll
  for (int i = 0; i < 16; ++i) a[i] = max(a[i], b[15 - i]);
#pragma unroll
  for (int j = 8; j > 0; j >>= 1) {
#pragma unroll
    for (int i = 0; i < 16; ++i) {
      const int l = i ^ j;
      if (l > i) CE_DESC(a[i], a[l])
    }
  }
}
__device__ __forceinline__ void phase_peer_score(const Params& p, int l, unsigned char* smem) {
  const int tid = opaque_tid(), lane = tid & 63, w = tid >> 6, quad = lane >> 4, l15 = lane & 15;
  unsigned* scw = (unsigned*)smem + w * (32 * 132 + 512);
  unsigned* sel = scw + 32 * 132;
  const bf16_t* Q = (const bf16_t*)(p.ws + OFF_Q);
  const bf16_t* KB = (const bf16_t*)(p.ws + OFF_KEYS) + (size_t)l * 8 * 2 * 128 * 128;
  int* EI = (int*)(p.ws + OFF_EIDX);
  float* GT = (float*)(p.ws + OFF_GATE);
  unsigned cab[13];
  {
    const int sub = lane & 3;
#pragma unroll
    for (int i = 0; i < 13; ++i) { const int cidx = sub + 4 * i; cab[i] = (unsigned)CAND_A[cidx] | ((unsigned)CAND_B[cidx] << 4); }
  }
  bf16x8 qa[2][4];
  if (blockIdx.x < 3072) {
    const int t0f = (blockIdx.x >> 1) * 16, hf_ = (blockIdx.x & 1) * 4 + w;
#pragma unroll
    for (int pp = 0; pp < 2; ++pp)
#pragma unroll
      for (int kk = 0; kk < 4; ++kk) qa[pp][kk] = ldfrag(Q + (size_t)(t0f + l15) * 2048 + hf_ * 256 + pp * 128 + kk * 32 + quad * 8);
  }
  for (int u = blockIdx.x; u < 3072; u += gridDim.x) {
    const int tt = u >> 1, h = (u & 1) * 4 + w;
    const int t0 = tt * 16;
#pragma unroll
    for (int pp = 0; pp < 2; ++pp) {
      bf16x8 a[4];
#pragma unroll
      for (int kk = 0; kk < 4; ++kk) a[kk] = qa[pp][kk];
      const bf16_t* kb = KB + (size_t)((h * 2 + pp) * 128) * 128;
#pragma unroll
      for (int ct = 0; ct < 8; ++ct) {
        f32x4 c = (f32x4){0.f, 0.f, 0.f, 0.f};
#pragma unroll
        for (int kk = 0; kk < 4; ++kk) {
          bf16x8 b = ldfrag(kb + (ct * 16 + l15) * 128 + kk * 32 + quad * 8);
          c = mfma16(a[kk], b, c);
        }
#pragma unroll
        for (int jj = 0; jj < 4; ++jj) {
          const int row = pp * 16 + quad * 4 + jj, col = ct * 16 + l15;
          unsigned key = (fkey(c[jj]) & ~127u) | (unsigned)(127 - col);
          scw[row * 132 + col] = key;
        }
      }
    }
    {
      const int un = u + gridDim.x;
      if (un < 3072) {
        const int t0n = (un >> 1) * 16, hn = (un & 1) * 4 + w;
#pragma unroll
        for (int pp = 0; pp < 2; ++pp)
#pragma unroll
          for (int kk = 0; kk < 4; ++kk) qa[pp][kk] = ldfrag(Q + (size_t)(t0n + l15) * 2048 + hn * 256 + pp * 128 + kk * 32 + quad * 8);
      }
    }
    WAVE_LDS_SYNC();
    {
      const int row = lane >> 1, hf = lane & 1;
      const u32x4* rp = (const u32x4*)(scw + row * 132 + hf * 64);
      unsigned g0[16], g1[16];
#pragma unroll
      for (int q = 0; q < 4; ++q) { u32x4 t4 = rp[q]; g0[4 * q] = t4[0]; g0[4 * q + 1] = t4[1]; g0[4 * q + 2] = t4[2]; g0[4 * q + 3] = t4[3]; }
#pragma unroll
      for (int q = 0; q < 4; ++q) { u32x4 t4 = rp[4 + q]; g1[4 * q] = t4[0]; g1[4 * q + 1] = t4[1]; g1[4 * q + 2] = t4[2]; g1[4 * q + 3] = t4[3]; }
      sort16_desc(g0);
      sort16_desc(g1);
      merge16_top(g0, g1);
#pragma unroll
      for (int q = 0; q < 4; ++q) { u32x4 t4 = rp[8 + q]; g1[4 * q] = t4[0]; g1[4 * q + 1] = t4[1]; g1[4 * q + 2] = t4[2]; g1[4 * q + 3] = t4[3]; }
      sort16_desc(g1);
      merge16_top(g0, g1);
#pragma unroll
      for (int q = 0; q < 4; ++q) { u32x4 t4 = rp[12 + q]; g1[4 * q] = t4[0]; g1[4 * q + 1] = t4[1]; g1[4 * q + 2] = t4[2]; g1[4 * q + 3] = t4[3]; }
      sort16_desc(g1);
      merge16_top(g0, g1);
#pragma unroll
      for (int i = 0; i < 16; ++i) g1[i] = (unsigned)__shfl_xor((int)g0[i], 1);
      merge16_top(g0, g1);
      if (hf == 0) {
#pragma unroll
        for (int q = 0; q < 4; ++q) {
          u32x4 t4 = {g0[4 * q], g0[4 * q + 1], g0[4 * q + 2], g0[4 * q + 3]};
          *(u32x4*)(sel + row * 16 + 4 * q) = t4;
        }
      }
    }
    WAVE_LDS_SYNC();
    {
      const int tok = lane >> 2, sub = lane & 3;
      const unsigned* s1 = sel + tok * 16;
      const unsigned* s2 = sel + (16 + tok) * 16;
      unsigned ck[13];
#pragma unroll
      for (int i = 0; i < 13; ++i) {
        const int cidx = sub + 4 * i;
        const int a = cab[i] & 15, b = cab[i] >> 4;
        float s = keyf(s1[a] & ~127u) + keyf(s2[b] & ~127u);
        unsigned k = (fkey(s) & ~255u) | (unsigned)(255 - (a * 16 + b));
        ck[i] = (cidx < 50) ? k : 0u;
      }
      unsigned prev = 0xFFFFFFFFu;
      unsigned top[16];
#pragma unroll
      for (int r = 0; r < 16; ++r) {
        unsigned best = 0;
#pragma unroll
        for (int i = 0; i < 13; ++i) {
          unsigned tsel = (ck[i] < prev) ? ck[i] : 0u;
          best = max(best, tsel);
        }
        best = max(best, (unsigned)__shfl_xor((int)best, 1));
        best = max(best, (unsigned)__shfl_xor((int)best, 2));
        prev = best;
        top[r] = best;
      }
      float sv[16];
      int ev[16];
#pragma unroll
      for (int r = 0; r < 16; ++r) {
        const int cidx = 255 - (int)(top[r] & 255u);
        const int a = cidx >> 4, b = cidx & 15;
        const unsigned k1 = s1[a], k2 = s2[b];
        sv[r] = keyf(k1 & ~127u) + keyf(k2 & ~127u);
        ev[r] = (127 - (int)(k1 & 127u)) * 128 + (127 - (int)(k2 & 127u));
      }
      float mx = sv[0];
#pragma unroll
      for (int r = 1; r < 16; ++r) mx = fmaxf(mx, sv[r]);
      float sum = 0.f;
#pragma unroll
      for (int r = 0; r < 16; ++r) { sv[r] = expf(sv[r] - mx); sum += sv[r]; }
      const float inv = 1.f / sum;
      const size_t ob = (size_t)(t0 + tok) * 128 + h * 16;
#pragma unroll
      for (int r = 0; r < 16; ++r) {
        if ((r & 3) == sub) { EI[ob + r] = ev[r]; GT[ob + r] = sv[r] * inv; }
      }
    }
    WAVE_LDS_SYNC();
  }
}

__device__ __forceinline__ float gelu_tanh(float x) {
  return 0.5f * x * (1.f + tanhf(0.7978845608028654f * (x + 0.044715f * x * x * x)));
}
__device__ __forceinline__ float butterfly8(const float* d, int lane) {
  const bool b5 = lane & 32, b4 = lane & 16, b3 = lane & 8;
  float e4[4], e2[2], e1;
#pragma unroll
  for (int j = 0; j < 4; ++j) {
    float snd = b5 ? d[j] : d[j + 4];
    float kep = b5 ? d[j + 4] : d[j];
    e4[j] = kep + __shfl_xor(snd, 32);
  }
#pragma unroll
  for (int j = 0; j < 2; ++j) {
    float snd = b4 ? e4[j] : e4[j + 2];
    float kep = b4 ? e4[j + 2] : e4[j];
    e2[j] = kep + __shfl_xor(snd, 16);
  }
  {
    float snd = b3 ? e2[0] : e2[1];
    float kep = b3 ? e2[1] : e2[0];
    e1 = kep + __shfl_xor(snd, 8);
  }
  e1 += __shfl_xor(e1, 4);
  e1 += __shfl_xor(e1, 2);
  e1 += __shfl_xor(e1, 1);
  const int jj = lane & 7;
  const int srcl = ((jj >> 2) & 1) * 32 + ((jj >> 1) & 1) * 16 + (jj & 1) * 8;
  return __shfl(e1, srcl);
}
__device__ __forceinline__ void phase_peer_gather(const Params& p, int l, int dry, unsigned char* smem) {
  const int tid_ = opaque_tid(); const int lane = tid_ & 63, wv = tid_ >> 6;
  const bf16_t* H = (const bf16_t*)(p.ws + OFF_H);
  bf16_t* Hw = (bf16_t*)(p.ws + OFF_H);
  const unsigned char* UB = p.ws + OFF_UB + (size_t)l * 16384 * 512;
  const unsigned char* VB = p.ws + OFF_VB + (size_t)l * 16384 * 512;
  const int* EI = (const int*)(p.ws + OFF_EIDX);
  const float* GT = (const float*)(p.ws + OFF_GATE);
  const float* modv = (const float*)(p.ws + OFF_MOD);
  float* actw = (float*)smem + wv * (24 * 128);
  const int tstride = gridDim.x * 4, tfirst = blockIdx.x * 4 + wv;
  int ntok = (tfirst < NTOK) ? (NTOK - 1 - tfirst) / tstride + 1 : 0;
  if (ntok > 24) ntok = 24;
  for (int i = lane; i < ntok * 128; i += 64) actw[i] = 0.f;
  WAVE_LDS_SYNC();
  {
    const int q_ = lane >> 4, n_ = lane & 15;
    for (int kk = 0; kk < 8; ++kk) {
      const unsigned char* ubs = UB + (size_t)kk * (16384 * 64) + q_ * 16;
      int pe0 = 0, pe1 = 0; u32x4 pxa = {0u, 0u, 0u, 0u};
      if (ntok > 0) {
        pe0 = EI[(size_t)tfirst * 128 + lane]; pe1 = EI[(size_t)tfirst * 128 + 64 + lane];
        pxa = *(const u32x4*)(p.ws + OFF_H8 + (size_t)tfirst * 512 + kk * 64 + q_ * 16);
      }
      for (int ti = 0; ti < ntok; ++ti) {
        const int ev0 = pe0, ev1 = pe1;
        const u32x4 xa4 = pxa;
        if (ti + 1 < ntok) {
          const size_t tn = (size_t)(tfirst + (ti + 1) * tstride);
          pe0 = EI[tn * 128 + lane]; pe1 = EI[tn * 128 + 64 + lane];
          pxa = *(const u32x4*)(p.ws + OFF_H8 + tn * 512 + kk * 64 + q_ * 16);
        }
        u32x4 bq[8];
#pragma unroll
        for (int g = 0; g < 8; ++g) {
          const int e_ = __shfl((g < 4) ? ev0 : ev1, (g & 3) * 16 + n_);
          bq[g] = *(const u32x4*)(ubs + (size_t)e_ * 64);
        }
        const v8i32 aa = {(int)xa4[0], (int)xa4[1], (int)xa4[2], (int)xa4[3], 0, 0, 0, 0};
#pragma unroll
        for (int g = 0; g < 8; ++g) {
          const v8i32 bb = {(int)bq[g][0], (int)bq[g][1], (int)bq[g][2], (int)bq[g][3], 0, 0, 0, 0};
          f32x4 ac = (f32x4){0.f, 0.f, 0.f, 0.f};
          ac = __builtin_amdgcn_mfma_scale_f32_16x16x128_f8f6f4(aa, bb, ac, 4, 4, 0, 0, 0, 0);
          if (q_ == (g & 3)) actw[ti * 128 + g * 16 + n_] += ac[0];
        }
      }
    }
  }
  WAVE_LDS_SYNC();
  int ti_ = 0;
  uint4 nx0 = make_uint4(0, 0, 0, 0), nx1 = nx0; int nev0 = 0, nev1 = 0; float ngv0 = 0.f, ngv1 = 0.f;
  {
    const int tf = blockIdx.x * 4 + wv;
    if (tf < NTOK) {
      nx0 = *(const uint4*)(H + (size_t)tf * 1024 + lane * 16); nx1 = *(const uint4*)(H + (size_t)tf * 1024 + lane * 16 + 8);
      nev0 = EI[(size_t)tf * 128 + lane]; nev1 = EI[(size_t)tf * 128 + 64 + lane];
      ngv0 = GT[(size_t)tf * 128 + lane]; ngv1 = GT[(size_t)tf * 128 + 64 + lane];
    }
  }
  for (int t = blockIdx.x * 4 + wv; t < NTOK; t += gridDim.x * 4) {
    float xf[16];
    unpack8(nx0, xf);
    unpack8(nx1, xf + 8);
    f32x2 xf2[8], out2[8];
#pragma unroll
    for (int e = 0; e < 8; ++e) { xf2[e] = (f32x2){xf[2 * e], xf[2 * e + 1]}; out2[e] = (f32x2){0.f, 0.f}; }
    const int ev0 = nev0, ev1 = nev1;
    const float gv0 = ngv0, gv1 = ngv1;
    {
      const int tn = t + gridDim.x * 4;
      if (tn < NTOK) {
        nx0 = *(const uint4*)(H + (size_t)tn * 1024 + lane * 16); nx1 = *(const uint4*)(H + (size_t)tn * 1024 + lane * 16 + 8);
        nev0 = EI[(size_t)tn * 128 + lane]; nev1 = EI[(size_t)tn * 128 + 64 + lane];
        ngv0 = GT[(size_t)tn * 128 + lane]; ngv1 = GT[(size_t)tn * 128 + 64 + lane];
      }
    }
    float cacc0 = 0.f, cacc1 = 0.f, coef0 = 0.f, coef1 = 0.f;
    uint2 bufA[16], bufB[16], bufC[16];
    const f32x2 zero2_ = {(float)dry, (float)dry};
#define GLOAD(buf, bb) { \
      const unsigned char* tb_ = ((bb) < 8) ? UB : VB; \
      const int evv_ = (((bb) & 7) < 4) ? ev0 : ev1; \
      _Pragma("unroll") for (int j = 0; j < 16; ++j) { \
        const int e_ = __builtin_amdgcn_readlane(evv_, ((bb) & 3) * 16 + j); \
        buf[j] = *(const uint2*)(tb_ + (size_t)e_ * 512 + lane * 8); } }
#define GCOMP(buf, bb) { \
      if ((bb) < 8) { \
        float d_[16]; \
        _Pragma("unroll") for (int j = 0; j < 16; ++j) { \
          f32x2 uf_[8]; unpack16_fp4(buf[j].x, buf[j].y, uf_); \
          f32x2 sa_ = uf_[0] * xf2[0]; \
          if (PROBE_CVT) { f32x2 ug_[8]; \
            ug_[0] = __builtin_amdgcn_cvt_scalef32_pk_f32_fp4(buf[j].x, 2.0f, 0); ug_[1] = __builtin_amdgcn_cvt_scalef32_pk_f32_fp4(buf[j].x, 2.0f, 1); \
            ug_[2] = __builtin_amdgcn_cvt_scalef32_pk_f32_fp4(buf[j].x, 2.0f, 2); ug_[3] = __builtin_amdgcn_cvt_scalef32_pk_f32_fp4(buf[j].x, 2.0f, 3); \
            ug_[4] = __builtin_amdgcn_cvt_scalef32_pk_f32_fp4(buf[j].y, 2.0f, 0); ug_[5] = __builtin_amdgcn_cvt_scalef32_pk_f32_fp4(buf[j].y, 2.0f, 1); \
            ug_[6] = __builtin_amdgcn_cvt_scalef32_pk_f32_fp4(buf[j].y, 2.0f, 2); ug_[7] = __builtin_amdgcn_cvt_scalef32_pk_f32_fp4(buf[j].y, 2.0f, 3); \
            _Pragma("unroll") for (int q = 0; q < 8; ++q) sa_ = __builtin_elementwise_fma(ug_[q], zero2_, sa_); } \
          _Pragma("unroll") for (int q = 1; q < 8; ++q) sa_ = __builtin_elementwise_fma(uf_[q], xf2[q], sa_); \
          d_[j] = sa_.x + sa_.y; } \
        const float t0_ = butterfly8(d_, lane), t1_ = butterfly8(d_ + 8, lane); \
        const int k0_ = ((bb) & 3) * 16; \
        if (((bb) & 7) < 4) { if ((lane >> 3) == (k0_ >> 3)) cacc0 = t0_; if ((lane >> 3) == (k0_ >> 3) + 1) cacc0 = t1_; } \
        else { if ((lane >> 3) == (k0_ >> 3)) cacc1 = t0_; if ((lane >> 3) == (k0_ >> 3) + 1) cacc1 = t1_; } \
        if ((bb) == 7) { coef0 = gelu_tanh(cacc0 * (1.f / U_SCALE)) * gv0 * (1.f / V_SCALE); coef1 = gelu_tanh(cacc1 * (1.f / U_SCALE)) * gv1 * (1.f / V_SCALE); } \
      } else { \
        const float cfv_ = (((bb) & 7) < 4) ? coef0 : coef1; \
        _Pragma("unroll") for (int j = 0; j < 16; ++j) { \
          const float cf_ = __uint_as_float((unsigned)__builtin_amdgcn_readlane((int)__float_as_uint(cfv_), ((bb) & 3) * 16 + j)); \
          f32x2 vf_[8]; unpack16_fp4(buf[j].x, buf[j].y, vf_); \
          const f32x2 c2_ = {cf_, cf_}; \
          _Pragma("unroll") for (int q = 0; q < 8; ++q) out2[q] = __builtin_elementwise_fma(vf_[q], c2_, out2[q]); } \
      } }
#if GATHER_CHECK
    GLOAD(bufA, 0)
#pragma unroll
    for (int b = 0; b < 8; b += 2) {
      GLOAD(bufB, b + 1)
      GCOMP(bufA, b)
      if (b + 2 < 8) GLOAD(bufA, b + 2)
      GCOMP(bufB, b + 1)
    }
    const float vacc0 = cacc0, vacc1 = cacc1;
#endif
#if !GATHER_CHECK
    GLOAD(bufA, 8)
#endif
    cacc0 = actw[ti_ * 128 + lane] * (1.f / X_SCALE);
    cacc1 = actw[ti_ * 128 + 64 + lane] * (1.f / X_SCALE);
    ++ti_;
#if GATHER_CHECK
    {
      const bool bad0 = fabsf(cacc0 - vacc0) > 0.15f * fabsf(vacc0) + 45.f;
      const bool bad1 = fabsf(cacc1 - vacc1) > 0.15f * fabsf(vacc1) + 45.f;
      const unsigned long long m0 = __ballot(bad0), m1 = __ballot(bad1);
      if (__popcll(m0) + __popcll(m1) > 32) out2[0] = (f32x2){__builtin_nanf(""), __builtin_nanf("")};
    }
#endif
    coef0 = gelu_tanh(cacc0 * (1.f / U_SCALE)) * gv0 * (1.f / V_SCALE);
    coef1 = gelu_tanh(cacc1 * (1.f / U_SCALE)) * gv1 * (1.f / V_SCALE);
#if GATHER_CHECK
    GLOAD(bufA, 8)
#endif
    GLOAD(bufB, 9)
#pragma unroll
    for (int b = 8; b < 14; b += 3) {
      GLOAD(bufC, b + 2)
      GCOMP(bufA, b)
      GLOAD(bufA, b + 3)
      GCOMP(bufB, b + 1)
      GLOAD(bufB, b + 4)
      GCOMP(bufC, b + 2)
    }
    GCOMP(bufA, 14)
    GCOMP(bufB, 15)
#undef GLOAD
#undef GCOMP
    float out[16];
#pragma unroll
    for (int e = 0; e < 8; ++e) { out[2 * e] = out2[e].x; out[2 * e + 1] = out2[e].y; }
    const int m = tok_mod(t);
    const float* ga2 = modv + (size_t)(l * 9 + m) * 6144 + 5120;
    float* xr = p.out + (size_t)t * 1024 + lane * 16;
    float xn[16];
    float ss = 0.f;
#pragma unroll
    for (int q4 = 0; q4 < 4; ++q4) {
      float4 xv = *(const float4*)(xr + q4 * 4);
      float4 gg = *(const float4*)(ga2 + lane * 16 + q4 * 4);
      const int o = q4 * 4;
      xn[o + 0] = xv.x + gg.x * out[o + 0];
      xn[o + 1] = xv.y + gg.y * out[o + 1];
      xn[o + 2] = xv.z + gg.z * out[o + 2];
      xn[o + 3] = xv.w + gg.w * out[o + 3];
      ss += xn[o] * xn[o] + xn[o + 1] * xn[o + 1] + xn[o + 2] * xn[o + 2] + xn[o + 3] * xn[o + 3];
    }
    ss = wave_sum(ss);
    const float rs = rsqrtf(ss * (1.f / 1024.f) + EPSV);
    if (dry) continue;
    if (l < 3) {
      const float* md = modv + (size_t)((l + 1) * 9 + m) * 6144 + lane * 16;
      const float* g = p.in[8] + (l + 1) * 1024 + lane * 16;
      float hv[16];
#pragma unroll
      for (int q = 0; q < 16; ++q) hv[q] = xn[q] * rs * g[q] * (1.f + md[1024 + q]) + md[q];
      uint4 o;
      o.x = pack2(hv[0], hv[1]); o.y = pack2(hv[2], hv[3]); o.z = pack2(hv[4], hv[5]); o.w = pack2(hv[6], hv[7]);
      *(uint4*)(Hw + (size_t)t * 1024 + lane * 16) = o;
      o.x = pack2(hv[8], hv[9]); o.y = pack2(hv[10], hv[11]); o.z = pack2(hv[12], hv[13]); o.w = pack2(hv[14], hv[15]);
      *(uint4*)(Hw + (size_t)t * 1024 + lane * 16 + 8) = o;
#pragma unroll
      for (int q4 = 0; q4 < 4; ++q4) *(float4*)(xr + q4 * 4) = make_float4(xn[q4 * 4], xn[q4 * 4 + 1], xn[q4 * 4 + 2], xn[q4 * 4 + 3]);
    } else {
      const float* g = p.in[10] + lane * 16;
#pragma unroll
      for (int q4 = 0; q4 < 4; ++q4)
        *(float4*)(xr + q4 * 4) = make_float4(xn[q4 * 4] * rs * g[q4 * 4], xn[q4 * 4 + 1] * rs * g[q4 * 4 + 1],
                                              xn[q4 * 4 + 2] * rs * g[q4 * 4 + 2], xn[q4 * 4 + 3] * rs * g[q4 * 4 + 3]);
    }
  }
}

#define XB_TMO      128
#define XB_XCNT(j)  (256  + 64 * (j))
#define XB_XSUB(j)  (1280 + 64 * (j))
#define XB_XGEN(j)  (2304 + 64 * (j))
#define XB_TOP      3328
#define XB_TOPGEN   3392
#define XCD_BAR_WORDS 3456
#define XB_SPIN_CAP (1u << 18)
#define LAS __attribute__((address_space(3)))

__device__ __forceinline__ unsigned xb_ld(unsigned* p)              { return __hip_atomic_load(p, __ATOMIC_RELAXED, __HIP_MEMORY_SCOPE_AGENT); }
__device__ __forceinline__ unsigned xb_add(unsigned* p, unsigned v) { return __hip_atomic_fetch_add(p, v, __ATOMIC_RELAXED, __HIP_MEMORY_SCOPE_AGENT); }
__device__ __forceinline__ unsigned xb_xcc_id() { return (unsigned)__builtin_amdgcn_s_getreg((3 << 11) | 20) & 0xFu; }
#define XB_SPIN(cond, bar) do { unsigned _sp = 0; while (cond) { __builtin_amdgcn_s_sleep(1); \
    if ((++_sp & 255u) == 0u) { if (xb_ld(&(bar)[XB_TMO])) break; if (_sp > XB_SPIN_CAP) { atomicAdd(&(bar)[XB_TMO], 1u); break; } } } } while (0)

struct XcdBarrier {
    unsigned* bar; unsigned x;
    volatile LAS unsigned* st;
};

__device__ __forceinline__ XcdBarrier xcd_barrier_post(unsigned* bar, volatile LAS unsigned* st) {
    XcdBarrier b; b.bar = bar; b.x = xb_xcc_id(); b.st = st;
    if (threadIdx.x == 0) (void)xb_add(&bar[XB_XCNT(b.x)], 1u);
    return b;
}
__device__ __forceinline__ void xcd_barrier_complete(unsigned* bar, unsigned x, unsigned& nloc, unsigned& nx) {
    const unsigned G = gridDim.x * gridDim.y * gridDim.z;
    unsigned sum, cnt, mine, sp = 0u;
    for (;;) {
        sum = 0u; cnt = 0u; mine = 0u;
#pragma unroll
        for (unsigned j = 0; j < 16; ++j) { const unsigned c = xb_ld(&bar[XB_XCNT(j)]); sum += c; cnt += (c > 0u) ? 1u : 0u; mine = (j == x) ? c : mine; }
        if (sum == G) break;
        __builtin_amdgcn_s_sleep(1);
        if ((++sp & 255u) == 0u) { if (xb_ld(&bar[XB_TMO])) break; if (sp > XB_SPIN_CAP) { atomicAdd(&bar[XB_TMO], 1u); break; } }
    }
    nloc = mine > 0u ? mine : 1u; nx = cnt > 0u ? cnt : 1u;
}

__device__ __forceinline__ void xcd_barrier(const XcdBarrier& b) {
    asm volatile("s_waitcnt vmcnt(0)" ::: "memory");
    __syncthreads();
    if (threadIdx.x == 0) {
        unsigned* bar = b.bar;
        __builtin_amdgcn_s_waitcnt(0);
        unsigned nloc = b.st[0], nx = b.st[1];
        if (nloc == 0u) { xcd_barrier_complete(bar, b.x, nloc, nx); b.st[0] = nloc; b.st[1] = nx; }
        const unsigned old = xb_add(&bar[XB_XSUB(b.x)], 1u);
        const unsigned gen = old / nloc;
        if (old + 1u == (gen + 1u) * nloc) {
            __builtin_amdgcn_fence(__ATOMIC_RELEASE, "agent");
            asm volatile("s_waitcnt vmcnt(0)" ::: "memory");
            const unsigned og = xb_add(&bar[XB_TOP], 1u);
            const unsigned tg = og / nx;
            if (og + 1u == (tg + 1u) * nx) xb_add(&bar[XB_TOPGEN], 1u);
            else XB_SPIN(xb_ld(&bar[XB_TOPGEN]) == tg, bar);
            __builtin_amdgcn_fence(__ATOMIC_ACQUIRE, "agent");
            xb_add(&bar[XB_XGEN(b.x)], 1u);
            asm volatile("s_waitcnt vmcnt(0)" ::: "memory");
        } else {
            XB_SPIN(xb_ld(&bar[XB_XGEN(b.x)]) == gen, bar);
            __builtin_amdgcn_fence(__ATOMIC_ACQUIRE, "agent");
            asm volatile("s_waitcnt vmcnt(0)" ::: "memory");
        }
    }
    __syncthreads();
}

__global__ void __launch_bounds__(256, 2) mega(Params p, int ph_lo, int ph_hi) {
  __shared__ __attribute__((aligned(16))) unsigned char smem[77312];
  cg::grid_group grid = cg::this_grid();
  __shared__ uint4 xb_words;
  if (threadIdx.x == 0) xb_words = make_uint4(0u, 0u, 0u, 0u);
  __syncthreads();
  XcdBarrier xb = xcd_barrier_post((unsigned*)(p.ws + OFF_BAR), (volatile LAS unsigned*)&xb_words);
  if (ph_hi > 100000) grid.sync();
  for (int ph = ph_lo; ph < ph_hi; ++ph) {
#if PROBE_MASK
    const int pcode = ph < 2 ? ph : 2 + (ph - 2) % 9;
    const int nrep = ((PROBE_MASK >> pcode) & 1) ? 2 : 1;
    for (int rep = 0; rep < nrep; ++rep) {
    if (rep) xcd_barrier(xb);
#endif
    bool did = true;
#if PROBE_MASK
    const int prep_rep = rep; const int nrep_ = nrep;
#else
    const int prep_rep = 0; const int nrep_ = 1;
#endif
    if (ph == 0) phase_prep_a(p, smem);
    else if (ph == 1) phase_prep_b(p);
    else {
      const int l = (ph - 2) / 9, sub = (ph - 2) % 9;
      const int il = l >> 1;
      const bool odd = l & 1;
      const float* modv = (const float*)(p.ws + OFF_MOD);
      if (sub == 0 || sub == 6) {
        const bf16_t* Bt; int ntn, ldc; bf16_t* C;
        if (sub == 0) {
          Bt = odd ? (const bf16_t*)(p.ws + OFF_WIN_OD) + (size_t)il * 3328 * 1024
                   : (const bf16_t*)(p.ws + OFF_WIN_EV) + (size_t)il * 3072 * 1024;
          ntn = odd ? 13 : 12; ldc = PSTRIDE; C = (bf16_t*)(p.ws + OFF_P);
        } else {
          Bt = (const bf16_t*)(p.ws + OFF_WQ) + (size_t)l * 2048 * 1024;
          ntn = 8; ldc = 2048; C = (bf16_t*)(p.ws + OFF_Q);
        }
        gemm_phase<0, 8, 32>((const bf16_t*)(p.ws + OFF_H), Bt, ntn, C, ldc, nullptr, nullptr, smem);
      } else if (sub == 1) {
        if (odd) phase_odd_prep(p, l, smem, prep_rep); else did = false;
      } else if (sub == 2) {
        if (odd) phase_gdn_chain(p, l, smem); else phase_ret_chain(p, l, smem);
      } else if (sub == 3) {
        phase_mix_out(p, l);
      } else if (sub == 4) {
        gemm_phase<1, 4, 64>((const bf16_t*)(p.ws + OFF_YMIX), (const bf16_t*)(p.ws + OFF_WOUT) + (size_t)l * 1024 * 1024, 8,
                      nullptr, 0, p.out, modv + (size_t)l * 9 * 6144 + 2048, smem, (nrep_ > 1 && prep_rep == 0) ? 1 : 0);
      } else if (sub == 5) {
        phase_norm2(p, l);
      } else if (sub == 7) {
        phase_peer_score(p, l, smem);
      } else {
        phase_peer_gather(p, l, (nrep_ > 1 && prep_rep == 0) ? 1 : 0, smem);
      }
    }
#if PROBE_MASK
    if (rep + 1 < nrep) continue;
#endif
    if (did && ph + 1 < ph_hi) xcd_barrier(xb);
#if PROBE_MASK
    }
#endif
  }
}

extern "C" void kernel_launch(void* const* d_in, const int* in_sizes, int n_in, void* d_out, int out_size,
                              void* d_ws, size_t ws_size, hipStream_t stream) {
  static int grid_blocks = 0;
  if (!grid_blocks) {
    int dev = 0, cus = 0, per_cu = 0;
    (void)hipGetDevice(&dev);
    (void)hipDeviceGetAttribute(&cus, hipDeviceAttributeMultiprocessorCount, dev);
    (void)hipOccupancyMaxActiveBlocksPerMultiprocessor(&per_cu, mega, 256, 0);
    if (per_cu < 1) per_cu = 1;
    if (per_cu > 2) per_cu = 2;
    grid_blocks = cus * per_cu;
    if (ws_size < WS_NEED) fprintf(stderr, "kernel_launch: workspace too small: %zu < %zu\n", ws_size, (size_t)WS_NEED);
  }
  Params p{};
  for (int i = 0; i < 30; ++i) p.in[i] = (const float*)d_in[i];
  p.out = (float*)d_out;
  p.ws = (unsigned char*)d_ws;
  (void)hipMemsetAsync((unsigned char*)d_ws + OFF_BAR, 0, XCD_BAR_WORDS * sizeof(unsigned), stream);
#if SINGLE_LAUNCH
  int lo = 0, hi = NPHASE;
  void* args[] = {&p, &lo, &hi};
  hipError_t e = hipLaunchCooperativeKernel((void*)mega, dim3(grid_blocks), dim3(256), args, 0, stream);
  if (e != hipSuccess) fprintf(stderr, "cooperative launch failed: %s (grid %d)\n", hipGetErrorString(e), grid_blocks);
#else
  for (int ph = 0; ph < NPHASE; ++ph) {
    const int l = (ph - 2) / 9, sub = (ph - 2) % 9;
    if (ph >= 2 && sub == 1 && !(l & 1)) continue;
    hipLaunchKernelGGL(mega, dim3(grid_blocks), dim3(256), 0, stream, p, ph, ph + 1);
  }
#endif
}
```

```cpp
#include <hip/hip_runtime.h>
#include <hip/hip_cooperative_groups.h>
#include <cstdio>
namespace cg = cooperative_groups;

#ifndef PROBE_MASK
#define PROBE_MASK 0
#endif
#ifndef GATHER_CHECK
#define GATHER_CHECK 0
#endif
#ifndef PROBE_CVT
#define PROBE_CVT 0
#endif
#ifndef PROBE_ODD
#define PROBE_ODD 0
#endif
#ifndef SINGLE_LAUNCH
#define SINGLE_LAUNCH 1
#endif

typedef unsigned short bf16_t;
using bf16x8 = __attribute__((ext_vector_type(8))) short;
using f32x4 = __attribute__((ext_vector_type(4))) float;
using f32x2 = __attribute__((ext_vector_type(2))) float;
using u32x4 = __attribute__((ext_vector_type(4))) unsigned;
using v8i32 = __attribute__((ext_vector_type(8))) int;

#define NTOK 24576
#define NPROMPT 8192
#define PSTRIDE 3200
#define EPSV 1e-6f
#define NPHASE 38
#define X_SCALE 1.5f

constexpr size_t OFF_MOD = 0;
constexpr size_t OFF_ROPE = 1u << 20;
constexpr size_t OFF_WIN_EV = OFF_ROPE + 65536;
constexpr size_t OFF_WIN_OD = OFF_WIN_EV + 2ull * 3072 * 1024 * 2;
constexpr size_t OFF_WOUT = OFF_WIN_OD + 2ull * 3328 * 1024 * 2;
constexpr size_t OFF_WQ = OFF_WOUT + 4ull * 1024 * 1024 * 2;
constexpr size_t OFF_KEYS = OFF_WQ + 4ull * 2048 * 1024 * 2;
constexpr size_t OFF_UB = OFF_KEYS + 4ull * 8 * 2 * 128 * 128 * 2;
constexpr size_t OFF_VB = OFF_UB + 4ull * 16384 * 1024 * 2;
constexpr size_t OFF_H = OFF_VB + 4ull * 16384 * 1024 * 2;
constexpr size_t OFF_P = OFF_H + (size_t)NTOK * 1024 * 2;
constexpr size_t OFF_YMIX = OFF_P + (size_t)NTOK * PSTRIDE * 2;
constexpr size_t OFF_ODIR = OFF_YMIX + (size_t)NTOK * 1024 * 2;
constexpr size_t OFF_Q = OFF_ODIR;
constexpr size_t OFF_EIDX = OFF_ODIR + 2ull * NTOK * 512 * 4;
constexpr size_t OFF_GATE = OFF_EIDX + (size_t)NTOK * 128 * 4;
constexpr size_t GP_ITEM = 73728;
constexpr size_t OFF_GPREP = OFF_GATE + (size_t)NTOK * 128 * 4;
constexpr size_t OFF_EGL = OFF_GPREP + 3072ull * GP_ITEM;
constexpr size_t OFF_CONV = OFF_EGL + 16384;
constexpr size_t OFF_H8 = OFF_CONV;
constexpr size_t OFF_BAR = OFF_CONV + (size_t)NTOK * 512 * 4;
constexpr size_t WS_NEED = OFF_BAR + 16384;

struct Params {
  const float* in[30];
  float* out;
  unsigned char* ws;
};

__device__ const unsigned char CAND_A[52] = {0,0,0,0,0,0,0,0,0,0,0,0,0,0,0,0,1,1,1,1,1,1,1,1,2,2,2,2,2,3,3,3,3,4,4,4,5,5,6,6,7,7,8,9,10,11,12,13,14,15,0,0};
__device__ const unsigned char CAND_B[52] = {0,1,2,3,4,5,6,7,8,9,10,11,12,13,14,15,0,1,2,3,4,5,6,7,0,1,2,3,4,0,1,2,3,0,1,2,0,1,0,1,0,1,0,0,0,0,0,0,0,0,0,0};

__device__ __forceinline__ int opaque_tid() { int t = threadIdx.x; asm volatile("" : "+v"(t)); return t; }
typedef __bf16 hbf16x2 __attribute__((ext_vector_type(2)));
__device__ __forceinline__ bf16_t f2bf(float f) {
  return __builtin_bit_cast(unsigned short, (__bf16)f);
}
__device__ __forceinline__ float bf2f(bf16_t b) { return __uint_as_float(((unsigned)b) << 16); }
__device__ __forceinline__ float bflo(unsigned u) { return __uint_as_float(u << 16); }
__device__ __forceinline__ float bfhi(unsigned u) { return __uint_as_float(u & 0xffff0000u); }
__device__ __forceinline__ unsigned pack2(float a, float b) {
  f32x2 v = {a, b};
  return __builtin_bit_cast(unsigned, __builtin_convertvector(v, hbf16x2));
}
__device__ __forceinline__ float wave_sum(float v) {
#pragma unroll
  for (int o = 32; o > 0; o >>= 1) v += __shfl_xor(v, o);
  return v;
}
__device__ __forceinline__ f32x4 mfma16(bf16x8 a, bf16x8 b, f32x4 c) {
  return __builtin_amdgcn_mfma_f32_16x16x32_bf16(a, b, c, 0, 0, 0);
}
__device__ __forceinline__ bf16x8 ldfrag(const bf16_t* p) { return *(const bf16x8*)p; }
__device__ __forceinline__ float siluf(float v) { return v * __builtin_amdgcn_rcpf(1.f + __expf(-v)); }
__device__ __forceinline__ int tok_mod(int t) { return t < NPROMPT ? 0 : 1 + ((t - NPROMPT) >> 11); }
__device__ __forceinline__ unsigned fkey(float f) {
  unsigned u = __float_as_uint(f);
  return (u & 0x80000000u) ? ~u : (u | 0x80000000u);
}
__device__ __forceinline__ float keyf(unsigned k) {
  unsigned b = (k & 0x80000000u) ? (k ^ 0x80000000u) : ~k;
  return __uint_as_float(b);
}
__device__ __forceinline__ void unpack8(uint4 v, float* f) {
  f[0] = bflo(v.x); f[1] = bfhi(v.x); f[2] = bflo(v.y); f[3] = bfhi(v.y);
  f[4] = bflo(v.z); f[5] = bfhi(v.z); f[6] = bflo(v.w); f[7] = bfhi(v.w);
}

__device__ __forceinline__ void prep_mod(const Params& p, float* smem) {
  float* sc = smem;
  float* red = smem + 9 * 1024;
  const int tid = opaque_tid();
  const float* c = p.in[4];
  const float* cctx = p.in[5];
  for (int i = tid; i < 9 * 1024; i += 256) {
    int m = i >> 10, k = i & 1023;
    float v = (m == 0) ? cctx[k] : c[(m - 1) * 1024 + k];
    sc[i] = v / (1.f + expf(-v));
  }
  __syncthreads();
  float* modv = (float*)(p.ws + OFF_MOD);
  const int cl = tid & 63, kg = tid >> 6;
  for (int u = blockIdx.x; u < 4 * 96; u += gridDim.x) {
    const int l = u / 96, nb = (u % 96) * 64;
    const float* W = p.in[6] + (size_t)l * 1024 * 6144 + nb + cl;
    float acc[9];
#pragma unroll
    for (int m = 0; m < 9; ++m) acc[m] = 0.f;
#pragma unroll 16
    for (int k = kg * 256; k < kg * 256 + 256; ++k) {
      float w = W[(size_t)k * 6144];
#pragma unroll
      for (int m = 0; m < 9; ++m) acc[m] += sc[m * 1024 + k] * w;
    }
#pragma unroll
    for (int m = 0; m < 9; ++m) red[(kg * 9 + m) * 64 + cl] = acc[m];
    __syncthreads();
    for (int i = tid; i < 9 * 64; i += 256) {
      int m = i >> 6, c2 = i & 63;
      float s = red[(0 * 9 + m) * 64 + c2] + red[(1 * 9 + m) * 64 + c2] + red[(2 * 9 + m) * 64 + c2] + red[(3 * 9 + m) * 64 + c2];
      int nn = nb + c2;
      modv[(size_t)(l * 9 + m) * 6144 + nn] = s + p.in[7][l * 6144 + nn];
    }
    __syncthreads();
  }
}

__device__ __forceinline__ void prep_transpose(const float* src, bf16_t* dst, int N, int Npad, float* tile) {
  const int tid = opaque_tid();
  const int ntn = Npad / 64;
  const int units = ntn * 16;
  for (int u = blockIdx.x; u < units; u += gridDim.x) {
    const int nt = u % ntn, kt = u / ntn;
    const int n0 = nt * 64, k0 = kt * 64;
    {
      const int c = tid & 63;
      const int n = n0 + c;
      const int nc = n < N ? n : N - 1;
      float tv[16];
#pragma unroll
      for (int i = 0; i < 16; ++i) tv[i] = src[(size_t)(k0 + (tid >> 6) + 4 * i) * N + nc];
#pragma unroll
      for (int i = 0; i < 16; ++i) tile[((tid >> 6) + 4 * i) * 65 + c] = (n < N) ? tv[i] : 0.f;
    }
    __syncthreads();
#pragma unroll 4
    for (int i = 0; i < 16; ++i) {
      int rr = (tid >> 6) + 4 * i, cc = tid & 63;
      dst[(size_t)(n0 + rr) * 1024 + k0 + cc] = f2bf(tile[cc * 65 + rr]);
    }
    __syncthreads();
  }
}

__device__ __forceinline__ void prep_convert(const float* src, bf16_t* dst, size_t n4) {
  const size_t stride = (size_t)gridDim.x * 256;
  for (size_t i0 = (size_t)blockIdx.x * 256 + threadIdx.x; i0 < n4; i0 += stride * 8) {
    float4 v[8];
#pragma unroll
    for (int j = 0; j < 8; ++j) { const size_t i = i0 + j * stride; const size_t ic = i < n4 ? i : n4 - 1; v[j] = ((const float4*)src)[ic]; }
#pragma unroll
    for (int j = 0; j < 8; ++j) {
      const size_t i = i0 + j * stride;
      if (i < n4) { uint2 o; o.x = pack2(v[j].x, v[j].y); o.y = pack2(v[j].z, v[j].w); ((uint2*)dst)[i] = o; }
    }
  }
}

__device__ __forceinline__ void prep_convert_fp8(const float* src, unsigned* dst, size_t n4, float scale) {
  const size_t stride = (size_t)gridDim.x * 256;
  for (size_t i0 = (size_t)blockIdx.x * 256 + threadIdx.x; i0 < n4; i0 += stride * 8) {
    float4 v[8];
#pragma unroll
    for (int j = 0; j < 8; ++j) { const size_t i = i0 + j * stride; const size_t ic = i < n4 ? i : n4 - 1; f32x4 t4 = __builtin_nontemporal_load((const f32x4*)src + ic); v[j] = make_float4(t4[0], t4[1], t4[2], t4[3]); }
#pragma unroll
    for (int j = 0; j < 8; ++j) {
      const size_t i = i0 + j * stride;
      if (i < n4) {
        unsigned w = __builtin_amdgcn_cvt_pk_fp8_f32(v[j].x * scale, v[j].y * scale, 0, false);
        w = __builtin_amdgcn_cvt_pk_fp8_f32(v[j].z * scale, v[j].w * scale, w, true);
        dst[i] = w;
      }
    }
  }
}
__device__ __forceinline__ void prep_convert_fp4(const float* src, unsigned* dst, size_t n8, float scale, int W) {
  const size_t stride = (size_t)gridDim.x * 256;
  for (size_t i0 = (size_t)blockIdx.x * 256 + threadIdx.x; i0 < n8; i0 += stride * 4) {
    f32x4 va[4], vb[4];
#pragma unroll
    for (int j = 0; j < 4; ++j) {
      const size_t i = i0 + j * stride; const size_t ic = i < n8 ? i : n8 - 1;
      va[j] = __builtin_nontemporal_load((const f32x4*)src + 2 * ic);
      vb[j] = __builtin_nontemporal_load((const f32x4*)src + 2 * ic + 1);
    }
#pragma unroll
    for (int j = 0; j < 4; ++j) {
      const size_t i = i0 + j * stride;
      if (i < n8) {
        unsigned w = 0;
        w = __builtin_amdgcn_cvt_scalef32_pk_fp4_f32(w, va[j][0] * scale, va[j][1] * scale, 1.0f, 0);
        w = __builtin_amdgcn_cvt_scalef32_pk_fp4_f32(w, va[j][2] * scale, va[j][3] * scale, 1.0f, 1);
        w = __builtin_amdgcn_cvt_scalef32_pk_fp4_f32(w, vb[j][0] * scale, vb[j][1] * scale, 1.0f, 2);
        w = __builtin_amdgcn_cvt_scalef32_pk_fp4_f32(w, vb[j][2] * scale, vb[j][3] * scale, 1.0f, 3);
        const size_t el = i * 8;
        const size_t lay = el >> 24, e = (el >> 10) & 16383, d0 = el & 1023;
        const size_t off = lay * (16384ull * 512) + (d0 / W) * (16384ull * (W / 2)) + e * (W / 2) + ((d0 % W) >> 1);
        *(unsigned*)((unsigned char*)dst + off) = w;
      }
    }
  }
}
__device__ __forceinline__ void unpack16_fp4(unsigned w0, unsigned w1, f32x2* f) {
  f[0] = __builtin_amdgcn_cvt_scalef32_pk_f32_fp4(w0, 1.0f, 0);
  f[1] = __builtin_amdgcn_cvt_scalef32_pk_f32_fp4(w0, 1.0f, 1);
  f[2] = __builtin_amdgcn_cvt_scalef32_pk_f32_fp4(w0, 1.0f, 2);
  f[3] = __builtin_amdgcn_cvt_scalef32_pk_f32_fp4(w0, 1.0f, 3);
  f[4] = __builtin_amdgcn_cvt_scalef32_pk_f32_fp4(w1, 1.0f, 0);
  f[5] = __builtin_amdgcn_cvt_scalef32_pk_f32_fp4(w1, 1.0f, 1);
  f[6] = __builtin_amdgcn_cvt_scalef32_pk_f32_fp4(w1, 1.0f, 2);
  f[7] = __builtin_amdgcn_cvt_scalef32_pk_f32_fp4(w1, 1.0f, 3);
}
__device__ __forceinline__ void unpack16_fp8(u32x4 v, float* f) {
#pragma unroll
  for (int i = 0; i < 4; ++i) {
    f32x2 lo = __builtin_amdgcn_cvt_pk_f32_fp8(v[i], false);
    f32x2 hi = __builtin_amdgcn_cvt_pk_f32_fp8(v[i], true);
    f[4 * i + 0] = lo.x; f[4 * i + 1] = lo.y; f[4 * i + 2] = hi.x; f[4 * i + 3] = hi.y;
  }
}
#define U_SCALE 64.f
#define V_SCALE 20.f
__device__ __forceinline__ void phase_prep_a(const Params& p, unsigned char* smem) {
  float* fs = (float*)smem;
  prep_mod(p, fs);
  {
    float2* rope = (float2*)(p.ws + OFF_ROPE);
    int i = blockIdx.x * 256 + threadIdx.x;
    if (i < 64 * 16) {
      int pos = i >> 4, f = i & 15;
      float fr = powf(10000.f, -(float)f / 16.f);
      float ang = (float)pos * fr;
      rope[i] = make_float2(cosf(ang), sinf(ang));
    }
  }
  for (int i = 0; i < 2; ++i) {
    prep_transpose(p.in[11] + (size_t)i * 1024 * 3072, (bf16_t*)(p.ws + OFF_WIN_EV) + (size_t)i * 3072 * 1024, 3072, 3072, fs);
    prep_transpose(p.in[16] + (size_t)i * 1024 * 3088, (bf16_t*)(p.ws + OFF_WIN_OD) + (size_t)i * 3328 * 1024, 3088, 3328, fs);
    prep_transpose(p.in[12] + (size_t)i * 1024 * 1024, (bf16_t*)(p.ws + OFF_WOUT) + (size_t)(2 * i) * 1024 * 1024, 1024, 1024, fs);
    prep_transpose(p.in[17] + (size_t)i * 1024 * 1024, (bf16_t*)(p.ws + OFF_WOUT) + (size_t)(2 * i + 1) * 1024 * 1024, 1024, 1024, fs);
  }
  for (int l = 0; l < 4; ++l)
    prep_transpose(p.in[26] + (size_t)l * 1024 * 2048, (bf16_t*)(p.ws + OFF_WQ) + (size_t)l * 2048 * 1024, 2048, 2048, fs);
  prep_convert(p.in[27], (bf16_t*)(p.ws + OFF_KEYS), (size_t)4 * 8 * 2 * 128 * 128 / 4);
  prep_convert_fp4(p.in[28], (unsigned*)(p.ws + OFF_UB), (size_t)4 * 16384 * 1024 / 8, U_SCALE, 128);
  prep_convert_fp4(p.in[29], (unsigned*)(p.ws + OFF_VB), (size_t)4 * 16384 * 1024 / 8, V_SCALE, 1024);
}

__device__ __forceinline__ void norm_token(const float* xrow, const float* g, const float* scale, const float* shift,
                                           bf16_t* hrow, float* copy_dst, int lane, unsigned char* h8row = nullptr) {
  float4 v[4];
  float ss = 0.f;
#pragma unroll
  for (int i = 0; i < 4; ++i) {
    v[i] = *(const float4*)(xrow + i * 256 + lane * 4);
    ss += v[i].x * v[i].x + v[i].y * v[i].y + v[i].z * v[i].z + v[i].w * v[i].w;
  }
  ss = wave_sum(ss);
  const float rs = rsqrtf(ss * (1.f / 1024.f) + EPSV);
#pragma unroll
  for (int i = 0; i < 4; ++i) {
    const int idx = i * 256 + lane * 4;
    if (copy_dst) *(float4*)(copy_dst + idx) = v[i];
    float4 gg = *(const float4*)(g + idx);
    float4 sc = *(const float4*)(scale + idx);
    float4 sh = *(const float4*)(shift + idx);
    float a = v[i].x * rs * gg.x * (1.f + sc.x) + sh.x;
    float b = v[i].y * rs * gg.y * (1.f + sc.y) + sh.y;
    float c = v[i].z * rs * gg.z * (1.f + sc.z) + sh.z;
    float d = v[i].w * rs * gg.w * (1.f + sc.w) + sh.w;
    uint2 o;
    o.x = pack2(a, b);
    o.y = pack2(c, d);
    *(uint2*)(hrow + idx) = o;
    if (h8row) {
      unsigned w4 = 0;
      w4 = __builtin_amdgcn_cvt_scalef32_pk_fp4_f32(w4, a * X_SCALE, b * X_SCALE, 1.0f, 0);
      w4 = __builtin_amdgcn_cvt_scalef32_pk_fp4_f32(w4, c * X_SCALE, d * X_SCALE, 1.0f, 1);
      *(unsigned short*)(h8row + (idx >> 1)) = (unsigned short)w4;
    }
  }
}

__device__ __forceinline__ void phase_prep_b(const Params& p) {
  const int tid_ = opaque_tid(); const int lane = tid_ & 63, wv = tid_ >> 6;
  const float* modv = (const float*)(p.ws + OFF_MOD);
  bf16_t* H = (bf16_t*)(p.ws + OFF_H);
  for (int t = blockIdx.x * 4 + wv; t < NTOK; t += gridDim.x * 4) {
    const float* xr = (t < NPROMPT) ? p.in[0] + (size_t)t * 1024 : p.in[1] + (size_t)(t - NPROMPT) * 1024;
    const float* md = modv + (size_t)(0 * 9 + tok_mod(t)) * 6144;
    norm_token(xr, p.in[8], md + 1024, md, H + (size_t)t * 1024, p.out + (size_t)t * 1024, lane);
  }
}

__device__ __forceinline__ void phase_norm2(const Params& p, int l) {
  const int tid_ = opaque_tid(); const int lane = tid_ & 63, wv = tid_ >> 6;
  const float* modv = (const float*)(p.ws + OFF_MOD);
  bf16_t* H = (bf16_t*)(p.ws + OFF_H);
  for (int t = blockIdx.x * 4 + wv; t < NTOK; t += gridDim.x * 4) {
    const float* md = modv + (size_t)(l * 9 + tok_mod(t)) * 6144;
    norm_token(p.out + (size_t)t * 1024, p.in[9] + l * 1024, md + 4096, md + 3072, H + (size_t)t * 1024, nullptr, lane,
               p.ws + OFF_H8 + (size_t)t * 512);
  }
}

template <int EPI, int NJ, int BK>
__device__ __forceinline__ void gemm_phase(const bf16_t* __restrict__ A, const bf16_t* __restrict__ Bt, int ntiles_n,
                           bf16_t* __restrict__ C, int ldc, float* __restrict__ X, const float* __restrict__ ga,
                           unsigned char* smem, int dry = 0) {
  constexpr int TN = 32 * NJ;
  constexpr int LS = BK + 8;
  constexpr int TPR = BK / 8;
  constexpr int RPP = 256 / TPR;
  constexpr int NA = 128 / RPP, NB = TN / RPP;
  bf16_t* As = (bf16_t*)smem;
  bf16_t* Bs = As + 128 * LS;
  const int tid = opaque_tid(), lane = tid & 63, w = tid >> 6, quad = lane >> 4, l15 = lane & 15;
  const int wm = w >> 1, wn = w & 1;
  const int lr = tid / TPR, lseg = (tid % TPR) * 8;
  const int units = 192 * ntiles_n;
  for (int u = blockIdx.x; u < units; u += gridDim.x) {
    const int mt = u % 192, nt = u / 192;
    const int m0 = mt * 128, n0 = nt * TN;
    f32x4 acc[4][NJ];
#pragma unroll
    for (int i = 0; i < 4; ++i)
#pragma unroll
      for (int j = 0; j < NJ; ++j) acc[i][j] = (f32x4){0.f, 0.f, 0.f, 0.f};
    const bf16_t* Ag = A + (size_t)(m0 + lr) * 1024 + lseg;
    const bf16_t* Bg = Bt + (size_t)(n0 + lr) * 1024 + lseg;
    u32x4 ra[NA], rb[NB];
#pragma unroll
    for (int i = 0; i < NA; ++i) ra[i] = *(const u32x4*)(Ag + (size_t)i * RPP * 1024);
#pragma unroll
    for (int i = 0; i < NB; ++i) rb[i] = *(const u32x4*)(Bg + (size_t)i * RPP * 1024);
    for (int kt = 0; kt < 1024 / BK; ++kt) {
#pragma unroll
      for (int i = 0; i < NA; ++i) *(u32x4*)(As + (lr + RPP * i) * LS + lseg) = ra[i];
#pragma unroll
      for (int i = 0; i < NB; ++i) *(u32x4*)(Bs + (lr + RPP * i) * LS + lseg) = rb[i];
      __syncthreads();
      if (kt + 1 < 1024 / BK) {
        const bf16_t* An = Ag + (kt + 1) * BK;
        const bf16_t* Bn = Bg + (kt + 1) * BK;
#pragma unroll
        for (int i = 0; i < NA; ++i) ra[i] = *(const u32x4*)(An + (size_t)i * RPP * 1024);
#pragma unroll
        for (int i = 0; i < NB; ++i) rb[i] = *(const u32x4*)(Bn + (size_t)i * RPP * 1024);
      }
#pragma unroll
      for (int kk = 0; kk < BK / 32; ++kk) {
        bf16x8 af[4];
#pragma unroll
        for (int i = 0; i < 4; ++i) af[i] = ldfrag(As + (wm * 64 + i * 16 + l15) * LS + kk * 32 + quad * 8);
#pragma unroll
        for (int j = 0; j < NJ; ++j) {
          const bf16x8 bfr = ldfrag(Bs + (wn * (16 * NJ) + j * 16 + l15) * LS + kk * 32 + quad * 8);
#pragma unroll
          for (int i = 0; i < 4; ++i) acc[i][j] = mfma16(af[i], bfr, acc[i][j]);
        }
      }
      __syncthreads();
    }
    if (EPI == 0) {
#pragma unroll
      for (int i = 0; i < 4; ++i)
#pragma unroll
        for (int j = 0; j < NJ; ++j) {
          const int col = n0 + wn * (16 * NJ) + j * 16 + l15;
          if (col < ldc) {
#pragma unroll
            for (int jj = 0; jj < 4; ++jj) {
              int row = m0 + wm * 64 + i * 16 + quad * 4 + jj;
              C[(size_t)row * ldc + col] = f2bf(acc[i][j][jj]);
            }
          }
        }
    } else {
      const float* gam = ga + (size_t)tok_mod(m0) * 6144;
#pragma unroll
      for (int i = 0; i < 4; ++i)
#pragma unroll
        for (int j = 0; j < NJ; ++j)
#pragma unroll
          for (int jj = 0; jj < 4; ++jj) {
            int row = m0 + wm * 64 + i * 16 + quad * 4 + jj;
            int col = n0 + wn * (16 * NJ) + j * 16 + l15;
            float* xp = X + (size_t)row * 1024 + col;
            const float nv = *xp + gam[col] * acc[i][j][jj];
            if (!dry) *xp = nv;
          }
    }
  }
}

struct ChainItem {
  bool lng; int sl, dir, h, sq, tok0, nc;
};
__device__ __forceinline__ ChainItem decode_item(int it) {
  ChainItem c;
  c.lng = it < 256;
  int idx = c.lng ? it : it - 256;
  c.sl = idx & 3; c.dir = (idx >> 2) & 1; c.h = (idx >> 3) & 3; c.sq = idx >> 5;
  c.tok0 = c.lng ? NPROMPT + c.sq * 2048 : c.sq * 256;
  c.nc = c.lng ? 32 : 4;
  return c;
}

__device__ __forceinline__ void phase_ret_chain(const Params& p, int l, unsigned char* smem) {
  const int il = l >> 1;
  bf16_t* qs = (bf16_t*)smem;
  bf16_t* ks = qs + 64 * 72;
  bf16_t* kT = ks + 64 * 72;
  bf16_t* vT = kT + 64 * 72;
  bf16_t* intra = vT + 32 * 72;
  bf16_t* ST = intra + 64 * 72;
  const bf16_t* P = (const bf16_t*)(p.ws + OFF_P);
  float* odir = (float*)(p.ws + OFF_ODIR);
  const float2* rope = (const float2*)(p.ws + OFF_ROPE);
  const int tid = opaque_tid(), lane = tid & 63, w = tid >> 6, quad = lane >> 4, l15 = lane & 15;
  const int nlb = (gridDim.x >= 512) ? 256 : ((gridDim.x >= 2) ? (int)(gridDim.x / 2) : 0);
  const bool longblk = (nlb > 0) ? ((int)blockIdx.x < nlb) : true;
  const int it_lo = (nlb > 0) ? (longblk ? (int)blockIdx.x : 256 + ((int)blockIdx.x - nlb)) : (int)blockIdx.x;
  const int it_hi = (nlb > 0) ? (longblk ? 256 : 1280) : 1280;
  const int it_st = (nlb > 0) ? (longblk ? nlb : ((int)gridDim.x - nlb)) : (int)gridDim.x;
  for (int it = it_lo; it < it_hi; it += it_st) {
    const ChainItem ci = decode_item(it);
    const int sl = ci.sl, dir = ci.dir, h = ci.h;
    const float xg = p.in[13][(il * 2 + dir) * 4 + h];
    const float lg = -log1pf(expf(-xg));
    const float g64 = expf(lg * 64.f);
    f32x4 S[2];
    if (ci.lng) {
      const float* s0 = p.in[2] + ((((size_t)ci.sq * 2 + il) * 2 + dir) * 4 + h) * 8192;
#pragma unroll
      for (int ct = 0; ct < 2; ++ct)
#pragma unroll
        for (int jj = 0; jj < 4; ++jj) S[ct][jj] = s0[(16 * w + quad * 4 + jj) * 128 + sl * 32 + ct * 16 + l15];
    } else {
      S[0] = (f32x4){0.f, 0.f, 0.f, 0.f};
      S[1] = (f32x4){0.f, 0.f, 0.f, 0.f};
    }
    for (int n = 0; n < ci.nc; ++n) {
      const int cn = dir ? ci.nc - 1 - n : n;
      const int tb = ci.tok0 + cn * 64;
      {
        const int i = tid >> 2, mq = tid & 3;
        const int t = tb + (dir ? 63 - i : i);
        const bf16_t* pr = P + (size_t)t * PSTRIDE;
        float qa[8], qb[8], ka[8], kb[8];
        unpack8(*(const uint4*)(pr + h * 64 + mq * 8), qa);
        unpack8(*(const uint4*)(pr + h * 64 + 32 + mq * 8), qb);
        unpack8(*(const uint4*)(pr + 256 + h * 64 + mq * 8), ka);
        unpack8(*(const uint4*)(pr + 256 + h * 64 + 32 + mq * 8), kb);
        if (ci.lng) {
          const int pos = (mq < 2) ? cn : (t - tb);
          const int f0 = (mq & 1) * 8;
#pragma unroll
          for (int e = 0; e < 8; ++e) {
            float2 cs = rope[pos * 16 + f0 + e];
            float a = qa[e], b = qb[e];
            qa[e] = a * cs.x - b * cs.y; qb[e] = b * cs.x + a * cs.y;
            a = ka[e]; b = kb[e];
            ka[e] = a * cs.x - b * cs.y; kb[e] = b * cs.x + a * cs.y;
          }
        }
        const float wend = expf(lg * (float)(63 - i));
        uint4 o;
        o.x = pack2(qa[0], qa[1]); o.y = pack2(qa[2], qa[3]); o.z = pack2(qa[4], qa[5]); o.w = pack2(qa[6], qa[7]);
        *(uint4*)(qs + i * 72 + mq * 8) = o;
        o.x = pack2(qb[0], qb[1]); o.y = pack2(qb[2], qb[3]); o.z = pack2(qb[4], qb[5]); o.w = pack2(qb[6], qb[7]);
        *(uint4*)(qs + i * 72 + 32 + mq * 8) = o;
#pragma unroll
        for (int e = 0; e < 8; ++e) { ka[e] *= 0.125f; kb[e] *= 0.125f; }
        o.x = pack2(ka[0], ka[1]); o.y = pack2(ka[2], ka[3]); o.z = pack2(ka[4], ka[5]); o.w = pack2(ka[6], ka[7]);
        *(uint4*)(ks + i * 72 + mq * 8) = o;
        o.x = pack2(kb[0], kb[1]); o.y = pack2(kb[2], kb[3]); o.z = pack2(kb[4], kb[5]); o.w = pack2(kb[6], kb[7]);
        *(uint4*)(ks + i * 72 + 32 + mq * 8) = o;
#pragma unroll
        for (int e = 0; e < 8; ++e) {
          kT[(mq * 8 + e) * 72 + i] = f2bf(ka[e] * wend);
          kT[(32 + mq * 8 + e) * 72 + i] = f2bf(kb[e] * wend);
        }
        uint4 v8 = *(const uint4*)(pr + 512 + h * 128 + sl * 32 + mq * 8);
        vT[(mq * 8 + 0) * 72 + i] = (bf16_t)(v8.x & 0xffff); vT[(mq * 8 + 1) * 72 + i] = (bf16_t)(v8.x >> 16);
        vT[(mq * 8 + 2) * 72 + i] = (bf16_t)(v8.y & 0xffff); vT[(mq * 8 + 3) * 72 + i] = (bf16_t)(v8.y >> 16);
        vT[(mq * 8 + 4) * 72 + i] = (bf16_t)(v8.z & 0xffff); vT[(mq * 8 + 5) * 72 + i] = (bf16_t)(v8.z >> 16);
        vT[(mq * 8 + 6) * 72 + i] = (bf16_t)(v8.w & 0xffff); vT[(mq * 8 + 7) * 72 + i] = (bf16_t)(v8.w >> 16);
      }
      __syncthreads();
      const bf16x8 a0 = ldfrag(qs + (16 * w + l15) * 72 + quad * 8);
      const bf16x8 a1 = ldfrag(qs + (16 * w + l15) * 72 + 32 + quad * 8);
#pragma unroll
      for (int ct = 0; ct < 4; ++ct) {
        bf16x8 b0 = ldfrag(ks + (ct * 16 + l15) * 72 + quad * 8);
        bf16x8 b1 = ldfrag(ks + (ct * 16 + l15) * 72 + 32 + quad * 8);
        f32x4 c = (f32x4){0.f, 0.f, 0.f, 0.f};
        c = mfma16(a0, b0, c);
        c = mfma16(a1, b1, c);
#pragma unroll
        for (int jj = 0; jj < 4; ++jj) {
          int i = 16 * w + quad * 4 + jj, j = ct * 16 + l15;
          float val = (i >= j) ? c[jj] * expf(lg * (float)(i - j)) : 0.f;
          intra[i * 72 + j] = f2bf(val);
        }
      }
#pragma unroll
      for (int ct = 0; ct < 2; ++ct)
#pragma unroll
        for (int jj = 0; jj < 4; ++jj) ST[(ct * 16 + l15) * 72 + 16 * w + quad * 4 + jj] = f2bf(S[ct][jj]);
      __syncthreads();
      const bf16x8 ai0 = ldfrag(intra + (16 * w + l15) * 72 + quad * 8);
      const bf16x8 ai1 = ldfrag(intra + (16 * w + l15) * 72 + 32 + quad * 8);
      const bf16x8 ak0 = ldfrag(kT + (16 * w + l15) * 72 + quad * 8);
      const bf16x8 ak1 = ldfrag(kT + (16 * w + l15) * 72 + 32 + quad * 8);
#pragma unroll
      for (int ct = 0; ct < 2; ++ct) {
        bf16x8 bv0 = ldfrag(vT + (ct * 16 + l15) * 72 + quad * 8);
        bf16x8 bv1 = ldfrag(vT + (ct * 16 + l15) * 72 + 32 + quad * 8);
        bf16x8 bs0 = ldfrag(ST + (ct * 16 + l15) * 72 + quad * 8);
        bf16x8 bs1 = ldfrag(ST + (ct * 16 + l15) * 72 + 32 + quad * 8);
        f32x4 ci_ = (f32x4){0.f, 0.f, 0.f, 0.f}, cc = (f32x4){0.f, 0.f, 0.f, 0.f};
        ci_ = mfma16(ai0, bv0, ci_);
        ci_ = mfma16(ai1, bv1, ci_);
        cc = mfma16(a0, bs0, cc);
        cc = mfma16(a1, bs1, cc);
#pragma unroll
        for (int jj = 0; jj < 4; ++jj) {
          int i = 16 * w + quad * 4 + jj;
          int t = tb + (dir ? 63 - i : i);
          float o = ci_[jj] + expf(lg * (float)(i + 1)) * cc[jj];
          odir[((size_t)dir * NTOK + t) * 512 + h * 128 + sl * 32 + ct * 16 + l15] = o;
        }
        f32x4 s = S[ct];
        s[0] *= g64; s[1] *= g64; s[2] *= g64; s[3] *= g64;
        s = mfma16(ak0, bv0, s);
        s = mfma16(ak1, bv1, s);
        S[ct] = s;
      }
      __syncthreads();
    }
    if (!ci.lng) {
      float* so = p.out + 25165824 + ((((size_t)ci.sq * 2 + il) * 2 + dir) * 4 + h) * 8192;
#pragma unroll
      for (int ct = 0; ct < 2; ++ct)
#pragma unroll
        for (int jj = 0; jj < 4; ++jj) so[(16 * w + quad * 4 + jj) * 128 + sl * 32 + ct * 16 + l15] = S[ct][jj];
    }
  }
}

__device__ __forceinline__ void gdn_prep_item(const Params& p, int l, int pi, unsigned char* smem, int plvl) {
  const int il = l >> 1;
  bf16_t* ks = (bf16_t*)smem;
  bf16_t* vs = ks + 64 * 136;
  float* Am = (float*)(vs + 64 * 136);
  float* rq = Am + 4096;
  float* rk = rq + 64;
  float* gcs = rk + 64;
  float* bet = gcs + 64;
  float* fac = bet + 64;
  bf16_t* qs = (bf16_t*)(fac + 128);
  const bf16_t* P = (const bf16_t*)(p.ws + OFF_P);
  unsigned char* gp = p.ws + OFF_GPREP + (size_t)pi * GP_ITEM;
  bf16_t* Wb = (bf16_t*)gp;
  bf16_t* QG = Wb + 8192;
  bf16_t* KDT = QG + 8192;
  bf16_t* Ub = KDT + 8192;
  bf16_t* ATT = Ub + 8192;
  float* EGL = (float*)(p.ws + OFF_EGL);
  const int tid = opaque_tid(), lane = tid & 63, w = tid >> 6, quad = lane >> 4, l15 = lane & 15;
  const int dir = pi & 1, h = (pi >> 1) & 3, c = pi >> 3;
  int tb, seq_lo, seq_hi;
  if (c < 128) { tb = c * 64; seq_lo = (c >> 2) * 256; seq_hi = seq_lo + 256; }
  else { int cc = c - 128; tb = NPROMPT + cc * 64; seq_lo = NPROMPT + (cc >> 5) * 2048; seq_hi = seq_lo + 2048; }
  const float SCALE = 0.08838834764831845f;
  {
    const int cg_ = tid & 127, rh = tid >> 7;
#pragma unroll
    for (int mat = 0; mat < 3; ++mat) {
      const int col = mat * 512 + h * 128 + cg_;
      const float* cw = p.in[18] + (size_t)il * 3 * 1536 + col;
      const float w0 = cw[0], w1 = cw[1536], w2 = cw[3072];
      bf16_t* dst = mat == 0 ? qs : (mat == 1 ? ks : vs);
      const int t0 = tb + rh * 32;
      bf16_t raw[34];
#pragma unroll
      for (int o = 0; o < 34; ++o) {
        const int t = t0 - 1 + o;
        const int tc = min(max(t, seq_lo), seq_hi - 1);
        const bf16_t rv = P[(size_t)tc * PSTRIDE + col];
        raw[o] = (t == tc) ? rv : (bf16_t)0;
      }
#pragma unroll
      for (int o = 0; o < 32; ++o) {
        float y = w0 * bf2f(raw[o]) + w1 * bf2f(raw[o + 1]) + w2 * bf2f(raw[o + 2]);
        y = siluf(y);
        const int oi = rh * 32 + o;
        const int i = dir ? 63 - oi : oi;
        dst[i * 136 + cg_] = f2bf(y);
      }
    }
  }
  __syncthreads();
  if (plvl == 4) return;
  {
    const int r = tid >> 2, part = tid & 3;
    float sq_ = 0.f, sk_ = 0.f;
#pragma unroll 8
    for (int e = 0; e < 32; ++e) {
      float a = bf2f(qs[r * 136 + part * 32 + e]);
      float b = bf2f(ks[r * 136 + part * 32 + e]);
      sq_ += a * a; sk_ += b * b;
    }
    sq_ += __shfl_xor(sq_, 1); sq_ += __shfl_xor(sq_, 2);
    sk_ += __shfl_xor(sk_, 1); sk_ += __shfl_xor(sk_, 2);
    if (part == 0) {
      rq[r] = rsqrtf(sq_ + EPSV);
      rk[r] = rsqrtf(sk_ + EPSV);
      const int t = tb + (dir ? 63 - r : r);
      float a = bf2f(P[(size_t)t * PSTRIDE + 2048 + dir * 4 + h]);
      float bbv = bf2f(P[(size_t)t * PSTRIDE + 2056 + dir * 4 + h]);
      float al = p.in[19][(il * 2 + dir) * 4 + h], dtb = p.in[20][(il * 2 + dir) * 4 + h];
      float z = a + dtb;
      float sp = (z > 20.f) ? z : log1pf(expf(z));
      gcs[r] = -expf(al) * sp;
      bet[r] = 1.f / (1.f + expf(-bbv));
    }
  }
  __syncthreads();
  if (tid < 64) {
    float v = gcs[tid];
#pragma unroll
    for (int o = 1; o < 64; o <<= 1) {
      float u = __shfl_up(v, o);
      if (tid >= o) v += u;
    }
    gcs[tid] = v;
  }
  __syncthreads();
  {
    bf16x8 ak[4], aq[4];
#pragma unroll
    for (int kk = 0; kk < 4; ++kk) {
      ak[kk] = ldfrag(ks + (16 * w + l15) * 136 + kk * 32 + quad * 8);
      aq[kk] = ldfrag(qs + (16 * w + l15) * 136 + kk * 32 + quad * 8);
    }
#pragma unroll
    for (int ct = 0; ct < 4; ++ct) {
      f32x4 ckk = (f32x4){0.f, 0.f, 0.f, 0.f}, cqk = (f32x4){0.f, 0.f, 0.f, 0.f};
#pragma unroll
      for (int kk = 0; kk < 4; ++kk) {
        bf16x8 b = ldfrag(ks + (ct * 16 + l15) * 136 + kk * 32 + quad * 8);
        ckk = mfma16(ak[kk], b, ckk);
        cqk = mfma16(aq[kk], b, cqk);
      }
#pragma unroll
      for (int jj = 0; jj < 4; ++jj) {
        const int i = 16 * w + quad * 4 + jj, j = ct * 16 + l15;
        const float dec = (i >= j) ? __expf(gcs[i] - gcs[j]) : 0.f;
        Am[j * 64 + i] = (i > j) ? bet[i] * rk[i] * rk[j] * ckk[jj] * dec : 0.f;
        ATT[i * 64 + j] = f2bf((i >= j) ? SCALE * rq[i] * rk[j] * cqk[jj] * dec : 0.f);
      }
    }
  }
  __syncthreads();
  const float gl = gcs[63];
#pragma unroll 8
  for (int e = tid; e < 64 * 128; e += 256) {
    int i = e >> 7, d = e & 127;
    QG[e] = f2bf(bf2f(qs[i * 136 + d]) * rq[i] * SCALE * __expf(gcs[i]));
  }
#pragma unroll 8
  for (int e = tid; e < 128 * 64; e += 256) {
    int d = e >> 6, i = e & 63;
    KDT[e] = f2bf(bf2f(ks[i * 136 + d]) * rk[i] * __expf(gl - gcs[i]));
  }
  if (tid < 64) {
    fac[tid] = bet[tid];
    fac[64 + tid] = rk[tid] * bet[tid] * __expf(gcs[tid]);
  }
  __syncthreads();
  if (plvl != 3) {
    const int cidx = tid & 127;
    const bf16_t* srcm = ((tid < 128) ? vs : ks) + cidx;
    const float* fc = fac + ((tid < 128) ? 0 : 64);
    bf16_t* dstm = ((tid < 128) ? Ub : Wb) + cidx;
    bf16_t* XB = qs + tid;
#pragma unroll 1
    for (int b = 0; b < 4; ++b) {
      float x[16];
#pragma unroll
      for (int r = 0; r < 16; ++r) x[r] = bf2f(srcm[(16 * b + r) * 136]) * fc[16 * b + r];
      const float* arow = Am + 16 * b;
#pragma unroll 4
      for (int j = 0; j < 16 * b; ++j) {
        const float xv = bf2f(XB[j * 256]);
        const f32x4 a0 = *(const f32x4*)(arow + j * 64), a1 = *(const f32x4*)(arow + j * 64 + 4);
        const f32x4 a2 = *(const f32x4*)(arow + j * 64 + 8), a3 = *(const f32x4*)(arow + j * 64 + 12);
#pragma unroll
        for (int r = 0; r < 4; ++r) {
          x[r] -= a0[r] * xv; x[4 + r] -= a1[r] * xv; x[8 + r] -= a2[r] * xv; x[12 + r] -= a3[r] * xv;
        }
      }
      const float* ablk = Am + (16 * b) * 64 + 16 * b;
#pragma unroll
      for (int jj = 0; jj < 15; ++jj) {
#pragma unroll
        for (int r = jj + 1; r < 16; ++r) x[r] -= ablk[jj * 64 + r] * x[jj];
      }
#pragma unroll
      for (int r = 0; r < 16; ++r) {
        const bf16_t bb = f2bf(x[r]);
        dstm[(16 * b + r) * 128] = bb;
        if (b < 3) XB[(16 * b + r) * 256] = bb;
      }
    }
  }
  if (tid == 0) EGL[pi] = expf(gl);
  __syncthreads();
}

__device__ __forceinline__ void conf_conv_item(const Params& p, int l, int item, unsigned char* smem) {
  const int il = l >> 1;
  float* hc = (float*)smem;
  const bf16_t* P = (const bf16_t*)(p.ws + OFF_P);
  float* convout = (float*)(p.ws + OFF_CONV);
  const int tid = opaque_tid();
  const int tile = item >> 1, ch = (item & 1) * 256 + tid;
  const int t0 = tile * 32;
  int seq_lo, seq_hi;
  if (t0 < NPROMPT) { seq_lo = (t0 >> 8) << 8; seq_hi = seq_lo + 256; }
  else { seq_lo = NPROMPT + (((t0 - NPROMPT) >> 11) << 11); seq_hi = seq_lo + 2048; }
#pragma unroll 31
  for (int r = 0; r < 62; ++r) {
    const int tt = t0 - 15 + r;
    const int tc = min(max(tt, seq_lo), seq_hi - 1);
    float ca = bf2f(P[(size_t)tc * PSTRIDE + 2064 + ch]);
    float cgv = bf2f(P[(size_t)tc * PSTRIDE + 2576 + ch]);
    float v = ca * __builtin_amdgcn_rcpf(1.f + __expf(-cgv));
    hc[r * 256 + tid] = (tt == tc) ? v : 0.f;
  }
  float wk[31];
#pragma unroll
  for (int k = 0; k < 31; ++k) wk[k] = p.in[22][((size_t)il * 31 + k) * 512 + ch];
  const float bias = p.in[23][il * 512 + ch];
  for (int i = 0; i < 32; ++i) {
    float acc = bias;
#pragma unroll
    for (int k = 0; k < 31; ++k) acc += wk[k] * hc[(i + k) * 256 + tid];
    convout[(size_t)(t0 + i) * 512 + ch] = acc;
  }
}

__device__ __forceinline__ void phase_odd_prep(const Params& p, int l, unsigned char* smem, int rep) {
  for (int u = blockIdx.x; u < 3072 + 1536; u += gridDim.x) {
#if PROBE_ODD == 1 || PROBE_ODD >= 3
    if (rep && u >= 3072) break;
#elif PROBE_ODD == 2
    if (rep && u < 3072) continue;
#endif
    if (u < 3072) gdn_prep_item(p, l, u, smem, (PROBE_ODD >= 3 && rep) ? PROBE_ODD : 0);
    else { conf_conv_item(p, l, u - 3072, smem); __syncthreads(); }
  }
}

__device__ __forceinline__ void phase_gdn_chain(const Params& p, int l, unsigned char* smem) {
  const int il = l >> 1;
  bf16_t* ST = (bf16_t*)smem;
  bf16_t* VT = ST + 32 * 136;
  float* odir = (float*)(p.ws + OFF_ODIR);
  const float* EGL = (const float*)(p.ws + OFF_EGL);
  const int tid = opaque_tid(), lane = tid & 63, w = tid >> 6, quad = lane >> 4, l15 = lane & 15;
  const int nlb = (gridDim.x >= 512) ? 256 : ((gridDim.x >= 2) ? (int)(gridDim.x / 2) : 0);
  const bool longblk = (nlb > 0) ? ((int)blockIdx.x < nlb) : true;
  const int it_lo = (nlb > 0) ? (longblk ? (int)blockIdx.x : 256 + ((int)blockIdx.x - nlb)) : (int)blockIdx.x;
  const int it_hi = (nlb > 0) ? (longblk ? 256 : 1280) : 1280;
  const int it_st = (nlb > 0) ? (longblk ? nlb : ((int)gridDim.x - nlb)) : (int)gridDim.x;
  for (int it = it_lo; it < it_hi; it += it_st) {
    const ChainItem ci = decode_item(it);
    const int sl = ci.sl, dir = ci.dir, h = ci.h;
    f32x4 S[2][2];
    if (ci.lng) {
      const float* s0 = p.in[3] + ((((size_t)ci.sq * 2 + il) * 2 + dir) * 4 + h) * 16384;
#pragma unroll
      for (int rb = 0; rb < 2; ++rb)
#pragma unroll
        for (int ct = 0; ct < 2; ++ct)
#pragma unroll
          for (int jj = 0; jj < 4; ++jj)
            S[rb][ct][jj] = s0[(16 * (2 * w + rb) + quad * 4 + jj) * 128 + sl * 32 + ct * 16 + l15];
    } else {
#pragma unroll
      for (int rb = 0; rb < 2; ++rb)
#pragma unroll
        for (int ct = 0; ct < 2; ++ct) S[rb][ct] = (f32x4){0.f, 0.f, 0.f, 0.f};
    }
    bf16x8 naw[4], naqg[4];
    bf16_t nuu[2][4];
    float negl = 0.f;
    for (int n = 0; n < ci.nc; ++n) {
      const int cn = dir ? ci.nc - 1 - n : n;
      const int tb = ci.tok0 + cn * 64;
      const int cglob = ci.lng ? 128 + ci.sq * 32 + cn : ci.sq * 4 + cn;
      const int pi = (cglob * 4 + h) * 2 + dir;
      const unsigned char* gp = p.ws + OFF_GPREP + (size_t)pi * GP_ITEM;
      const bf16_t* Wb = (const bf16_t*)gp;
      const bf16_t* QG = Wb + 8192;
      const bf16_t* KDT = QG + 8192;
      const bf16_t* Ub = KDT + 8192;
      const bf16_t* ATT = Ub + 8192;
      bf16x8 aw[4], aqg[4], aat[2], akd[2][2];
      float uu[2][4];
      float egl;
      if (n == 0) {
#pragma unroll
        for (int kk = 0; kk < 4; ++kk) {
          aw[kk] = ldfrag(Wb + (16 * w + l15) * 128 + kk * 32 + quad * 8);
          aqg[kk] = ldfrag(QG + (16 * w + l15) * 128 + kk * 32 + quad * 8);
        }
#pragma unroll
        for (int kk = 0; kk < 2; ++kk) {
          aat[kk] = ldfrag(ATT + (16 * w + l15) * 64 + kk * 32 + quad * 8);
#pragma unroll
          for (int rb = 0; rb < 2; ++rb) akd[rb][kk] = ldfrag(KDT + (16 * (2 * w + rb) + l15) * 64 + kk * 32 + quad * 8);
        }
#pragma unroll
        for (int ct = 0; ct < 2; ++ct)
#pragma unroll
          for (int jj = 0; jj < 4; ++jj) uu[ct][jj] = bf2f(Ub[(16 * w + quad * 4 + jj) * 128 + sl * 32 + ct * 16 + l15]);
        egl = EGL[pi];
      } else {
#pragma unroll
        for (int kk = 0; kk < 4; ++kk) { aw[kk] = naw[kk]; aqg[kk] = naqg[kk]; }
#pragma unroll
        for (int kk = 0; kk < 2; ++kk) {
          aat[kk] = ldfrag(ATT + (16 * w + l15) * 64 + kk * 32 + quad * 8);
#pragma unroll
          for (int rb = 0; rb < 2; ++rb) akd[rb][kk] = ldfrag(KDT + (16 * (2 * w + rb) + l15) * 64 + kk * 32 + quad * 8);
        }
#pragma unroll
        for (int ct = 0; ct < 2; ++ct)
#pragma unroll
          for (int jj = 0; jj < 4; ++jj) uu[ct][jj] = bf2f(nuu[ct][jj]);
        egl = negl;
      }
      if (n + 1 < ci.nc) {
        const int cn2 = dir ? ci.nc - 2 - n : n + 1;
        const int cglob2 = ci.lng ? 128 + ci.sq * 32 + cn2 : ci.sq * 4 + cn2;
        const int pi2 = (cglob2 * 4 + h) * 2 + dir;
        const bf16_t* Wb2 = (const bf16_t*)(p.ws + OFF_GPREP + (size_t)pi2 * GP_ITEM);
        const bf16_t* QG2 = Wb2 + 8192; const bf16_t* Ub2 = QG2 + 16384;
#pragma unroll
        for (int kk = 0; kk < 4; ++kk) {
          naw[kk] = ldfrag(Wb2 + (16 * w + l15) * 128 + kk * 32 + quad * 8);
          naqg[kk] = ldfrag(QG2 + (16 * w + l15) * 128 + kk * 32 + quad * 8);
        }
#pragma unroll
        for (int ct = 0; ct < 2; ++ct)
#pragma unroll
          for (int jj = 0; jj < 4; ++jj) nuu[ct][jj] = Ub2[(16 * w + quad * 4 + jj) * 128 + sl * 32 + ct * 16 + l15];
        negl = EGL[pi2];
      }
#pragma unroll
      for (int rb = 0; rb < 2; ++rb)
#pragma unroll
        for (int ct = 0; ct < 2; ++ct)
#pragma unroll
          for (int jj = 0; jj < 4; ++jj)
            ST[(ct * 16 + l15) * 136 + 16 * (2 * w + rb) + quad * 4 + jj] = f2bf(S[rb][ct][jj]);
      __syncthreads();
      f32x4 co[2];
#pragma unroll
      for (int ct = 0; ct < 2; ++ct) {
        f32x4 cv = (f32x4){0.f, 0.f, 0.f, 0.f};
        co[ct] = (f32x4){0.f, 0.f, 0.f, 0.f};
#pragma unroll
        for (int kk = 0; kk < 4; ++kk) {
          bf16x8 b = ldfrag(ST + (ct * 16 + l15) * 136 + kk * 32 + quad * 8);
          cv = mfma16(aw[kk], b, cv);
          co[ct] = mfma16(aqg[kk], b, co[ct]);
        }
#pragma unroll
        for (int jj = 0; jj < 4; ++jj) {
          float vn = uu[ct][jj] - cv[jj];
          VT[(ct * 16 + l15) * 72 + 16 * w + quad * 4 + jj] = f2bf(vn);
        }
      }
      __syncthreads();
#pragma unroll
      for (int ct = 0; ct < 2; ++ct) {
        bf16x8 bv[2];
#pragma unroll
        for (int kk = 0; kk < 2; ++kk) {
          bv[kk] = ldfrag(VT + (ct * 16 + l15) * 72 + kk * 32 + quad * 8);
          co[ct] = mfma16(aat[kk], bv[kk], co[ct]);
        }
#pragma unroll
        for (int jj = 0; jj < 4; ++jj) {
          int i = 16 * w + quad * 4 + jj;
          int t = tb + (dir ? 63 - i : i);
          odir[((size_t)dir * NTOK + t) * 512 + h * 128 + sl * 32 + ct * 16 + l15] = co[ct][jj];
        }
#pragma unroll
        for (int rb = 0; rb < 2; ++rb) {
          f32x4 s = S[rb][ct];
          s[0] *= egl; s[1] *= egl; s[2] *= egl; s[3] *= egl;
          s = mfma16(akd[rb][0], bv[0], s);
          s = mfma16(akd[rb][1], bv[1], s);
          S[rb][ct] = s;
        }
      }
    }
    __syncthreads();
    if (!ci.lng) {
      float* so = p.out + 29360128 + ((((size_t)ci.sq * 2 + il) * 2 + dir) * 4 + h) * 16384;
#pragma unroll
      for (int rb = 0; rb < 2; ++rb)
#pragma unroll
        for (int ct = 0; ct < 2; ++ct)
#pragma unroll
          for (int jj = 0; jj < 4; ++jj)
            so[(16 * (2 * w + rb) + quad * 4 + jj) * 128 + sl * 32 + ct * 16 + l15] = S[rb][ct][jj];
    }
  }
}

__device__ __forceinline__ void phase_mix_out(const Params& p, int l) {
  const int il = l >> 1;
  const bool odd = l & 1;
  const int tid_ = opaque_tid(); const int lane = tid_ & 63, wv = tid_ >> 6;
  const bf16_t* P = (const bf16_t*)(p.ws + OFF_P);
  const float* od0 = (const float*)(p.ws + OFF_ODIR);
  const float* od1 = od0 + (size_t)NTOK * 512;
  const float* convout = (const float*)(p.ws + OFF_CONV);
  bf16_t* Y = (bf16_t*)(p.ws + OFF_YMIX);
  for (int t = blockIdx.x * 4 + wv; t < NTOK; t += gridDim.x * 4) {
    const bf16_t* pr = P + (size_t)t * PSTRIDE;
    bf16_t* yr = Y + (size_t)t * 1024;
#pragma unroll
    for (int h = 0; h < 4; ++h) {
      const int idx = h * 128 + lane * 2;
      float2 a = *(const float2*)(od0 + (size_t)t * 512 + idx);
      float2 b = *(const float2*)(od1 + (size_t)t * 512 + idx);
      float o0 = a.x + b.x, o1 = a.y + b.y;
      float ss = wave_sum(o0 * o0 + o1 * o1);
      float rs = rsqrtf(ss * (1.f / 128.f) + EPSV);
      float n0, n1;
      unsigned gz;
      if (!odd) {
        n0 = p.in[14][il * 512 + idx]; n1 = p.in[14][il * 512 + idx + 1];
        gz = *(const unsigned*)(pr + 1024 + idx);
      } else {
        n0 = p.in[21][il * 128 + lane * 2]; n1 = p.in[21][il * 128 + lane * 2 + 1];
        gz = *(const unsigned*)(pr + 1536 + idx);
      }
      float y0 = siluf(bflo(gz)) * o0 * rs * n0;
      float y1 = siluf(bfhi(gz)) * o1 * rs * n1;
      *(unsigned*)(yr + idx) = pack2(y0, y1);
    }
    if (!odd) {
      int seq_lo, seq_hi;
      if (t < NPROMPT) { seq_lo = (t >> 8) << 8; seq_hi = seq_lo + 256; }
      else { seq_lo = NPROMPT + (((t - NPROMPT) >> 11) << 11); seq_hi = seq_lo + 2048; }
      const bool hp = (t - 1 >= seq_lo), hn = (t + 1 < seq_hi);
#pragma unroll
      for (int j = 0; j < 4; ++j) {
        const int c = j * 128 + lane * 2;
        unsigned cg0 = *(const unsigned*)(pr + 2048 + c), hb0 = *(const unsigned*)(pr + 2560 + c);
        const bf16_t* prm = hp ? pr - PSTRIDE : pr;
        const bf16_t* prp = hn ? pr + PSTRIDE : pr;
        unsigned cgm = *(const unsigned*)(prm + 2048 + c), hbm = *(const unsigned*)(prm + 2560 + c);
        unsigned cgp = *(const unsigned*)(prp + 2048 + c), hbp = *(const unsigned*)(prp + 2560 + c);
        if (!hp) { cgm = 0; hbm = 0; }
        if (!hn) { cgp = 0; hbp = 0; }
        unsigned bg = *(const unsigned*)(pr + 1536 + c);
        const float* sw = p.in[15] + (size_t)il * 3 * 512 + c;
        float y0 = bflo(bg) * (sw[0] * bflo(cgm) * bflo(hbm) + sw[512] * bflo(cg0) * bflo(hb0) + sw[1024] * bflo(cgp) * bflo(hbp));
        float y1 = bfhi(bg) * (sw[1] * bfhi(cgm) * bfhi(hbm) + sw[513] * bfhi(cg0) * bfhi(hb0) + sw[1025] * bfhi(cgp) * bfhi(hbp));
        *(unsigned*)(yr + 512 + c) = pack2(y0, y1);
      }
    } else {
      float v[8];
      float s = 0.f;
#pragma unroll
      for (int j = 0; j < 4; ++j) {
        float2 a = *(const float2*)(convout + (size_t)t * 512 + j * 128 + lane * 2);
        v[2 * j] = a.x; v[2 * j + 1] = a.y;
        s += a.x + a.y;
      }
      const float mean = wave_sum(s) * (1.f / 512.f);
      float vs = 0.f;
#pragma unroll
      for (int j = 0; j < 8; ++j) { v[j] -= mean; vs += v[j] * v[j]; }
      const float rstd = rsqrtf(wave_sum(vs) * (1.f / 512.f) + EPSV);
#pragma unroll
      for (int j = 0; j < 4; ++j) {
        const int c = j * 128 + lane * 2;
        float y0 = v[2 * j] * rstd * p.in[24][il * 512 + c] + p.in[25][il * 512 + c];
        float y1 = v[2 * j + 1] * rstd * p.in[24][il * 512 + c + 1] + p.in[25][il * 512 + c + 1];
        *(unsigned*)(yr + 512 + c) = pack2(siluf(y0), siluf(y1));
      }
    }
  }
}

#define WAVE_LDS_SYNC() { asm volatile("s_waitcnt lgkmcnt(0)" ::: "memory"); __builtin_amdgcn_wave_barrier(); }
#define CE_DESC(a, b) { unsigned _mx = max(a, b), _mn = min(a, b); a = _mx; b = _mn; }
#define CE_ASC(a, b) { unsigned _mx = max(a, b), _mn = min(a, b); a = _mn; b = _mx; }
__device__ __forceinline__ void sort16_desc(unsigned* v) {
#pragma unroll
  for (int k = 2; k <= 16; k <<= 1) {
#pragma unroll
    for (int j = k >> 1; j > 0; j >>= 1) {
#pragma unroll
      for (int i = 0; i < 16; ++i) {
        const int l = i ^ j;
        if (l > i) {
          if ((i & k) == 0) CE_DESC(v[i], v[l]) else CE_ASC(v[i], v[l])
        }
      }
    }
  }
}
__device__ __forceinline__ void merge16_top(unsigned* a, const unsigned* b) {
#pragma unroll
  for (int i = 0; i < 16; ++i) a[i] = max(a[i], b[15 - i]);
#pragma unroll
  for (int j = 8; j > 0; j >>= 1) {
#pragma unroll
    for (int i = 0; i < 16; ++i) {
      const int l = i ^ j;
      if (l > i) CE_DESC(a[i], a[l])
    }
  }
}
__device__ __forceinline__ void phase_peer_score(const Params& p, int l, unsigned char* smem) {
  const int tid = opaque_tid(), lane = tid & 63, w = tid >> 6, quad = lane >> 4, l15 = lane & 15;
  unsigned* scw = (unsigned*)smem + w * (32 * 132 + 512);
  unsigned* sel = scw + 32 * 132;
  const bf16_t* Q = (const bf16_t*)(p.ws + OFF_Q);
  const bf16_t* KB = (const bf16_t*)(p.ws + OFF_KEYS) + (size_t)l * 8 * 2 * 128 * 128;
  int* EI = (int*)(p.ws + OFF_EIDX);
  float* GT = (float*)(p.ws + OFF_GATE);
  unsigned cab[13];
  {
    const int sub = lane & 3;
#pragma unroll
    for (int i = 0; i < 13; ++i) { const int cidx = sub + 4 * i; cab[i] = (unsigned)CAND_A[cidx] | ((unsigned)CAND_B[cidx] << 4); }
  }
  bf16x8 qa[2][4];
  if (blockIdx.x < 3072) {
    const int t0f = (blockIdx.x >> 1) * 16, hf_ = (blockIdx.x & 1) * 4 + w;
#pragma unroll
    for (int pp = 0; pp < 2; ++pp)
#pragma unroll
      for (int kk = 0; kk < 4; ++kk) qa[pp][kk] = ldfrag(Q + (size_t)(t0f + l15) * 2048 + hf_ * 256 + pp * 128 + kk * 32 + quad * 8);
  }
  for (int u = blockIdx.x; u < 3072; u += gridDim.x) {
    const int tt = u >> 1, h = (u & 1) * 4 + w;
    const int t0 = tt * 16;
#pragma unroll
    for (int pp = 0; pp < 2; ++pp) {
      bf16x8 a[4];
#pragma unroll
      for (int kk = 0; kk < 4; ++kk) a[kk] = qa[pp][kk];
      const bf16_t* kb = KB + (size_t)((h * 2 + pp) * 128) * 128;
#pragma unroll
      for (int ct = 0; ct < 8; ++ct) {
        f32x4 c = (f32x4){0.f, 0.f, 0.f, 0.f};
#pragma unroll
        for (int kk = 0; kk < 4; ++kk) {
          bf16x8 b = ldfrag(kb + (ct * 16 + l15) * 128 + kk * 32 + quad * 8);
          c = mfma16(a[kk], b, c);
        }
#pragma unroll
        for (int jj = 0; jj < 4; ++jj) {
          const int row = pp * 16 + quad * 4 + jj, col = ct * 16 + l15;
          unsigned key = (fkey(c[jj]) & ~127u) | (unsigned)(127 - col);
          scw[row * 132 + col] = key;
        }
      }
    }
    {
      const int un = u + gridDim.x;
      if (un < 3072) {
        const int t0n = (un >> 1) * 16, hn = (un & 1) * 4 + w;
#pragma unroll
        for (int pp = 0; pp < 2; ++pp)
#pragma unroll
          for (int kk = 0; kk < 4; ++kk) qa[pp][kk] = ldfrag(Q + (size_t)(t0n + l15) * 2048 + hn * 256 + pp * 128 + kk * 32 + quad * 8);
      }
    }
    WAVE_LDS_SYNC();
    {
      const int row = lane >> 1, hf = lane & 1;
      const u32x4* rp = (const u32x4*)(scw + row * 132 + hf * 64);
      unsigned g0[16], g1[16];
#pragma unroll
      for (int q = 0; q < 4; ++q) { u32x4 t4 = rp[q]; g0[4 * q] = t4[0]; g0[4 * q + 1] = t4[1]; g0[4 * q + 2] = t4[2]; g0[4 * q + 3] = t4[3]; }
#pragma unroll
      for (int q = 0; q < 4; ++q) { u32x4 t4 = rp[4 + q]; g1[4 * q] = t4[0]; g1[4 * q + 1] = t4[1]; g1[4 * q + 2] = t4[2]; g1[4 * q + 3] = t4[3]; }
      sort16_desc(g0);
      sort16_desc(g1);
      merge16_top(g0, g1);
#pragma unroll
      for (int q = 0; q < 4; ++q) { u32x4 t4 = rp[8 + q]; g1[4 * q] = t4[0]; g1[4 * q + 1] = t4[1]; g1[4 * q + 2] = t4[2]; g1[4 * q + 3] = t4[3]; }
      sort16_desc(g1);
      merge16_top(g0, g1);
#pragma unroll
      for (int q = 0; q < 4; ++q) { u32x4 t4 = rp[12 + q]; g1[4 * q] = t4[0]; g1[4 * q + 1] = t4[1]; g1[4 * q + 2] = t4[2]; g1[4 * q + 3] = t4[3]; }
      sort16_desc(g1);
      merge16_top(g0, g1);
#pragma unroll
      for (int i = 0; i < 16; ++i) g1[i] = (unsigned)__shfl_xor((int)g0[i], 1);
      merge16_top(g0, g1);
      if (hf == 0) {
#pragma unroll
        for (int q = 0; q < 4; ++q) {
          u32x4 t4 = {g0[4 * q], g0[4 * q + 1], g0[4 * q + 2], g0[4 * q + 3]};
          *(u32x4*)(sel + row * 16 + 4 * q) = t4;
        }
      }
    }
    WAVE_LDS_SYNC();
    {
      const int tok = lane >> 2, sub = lane & 3;
      const unsigned* s1 = sel + tok * 16;
      const unsigned* s2 = sel + (16 + tok) * 16;
      unsigned ck[16];
#pragma unroll
      for (int i = 0; i < 13; ++i) {
        const int cidx = sub + 4 * i;
        const int a = cab[i] & 15, b = cab[i] >> 4;
        float s = keyf(s1[a] & ~127u) + keyf(s2[b] & ~127u);
        unsigned k = (fkey(s) & ~255u) | (unsigned)(255 - (a * 16 + b));
        ck[i] = (cidx < 50) ? k : 0u;
      }
      ck[13] = 0u; ck[14] = 0u; ck[15] = 0u;
      sort16_desc(ck);
      {
        unsigned g1[16];
#pragma unroll
        for (int i = 0; i < 16; ++i) g1[i] = (unsigned)__builtin_amdgcn_update_dpp(0, (int)ck[i], 0xB1, 0xF, 0xF, true);
        merge16_top(ck, g1);
#pragma unroll
        for (int i = 0; i < 16; ++i) g1[i] = (unsigned)__builtin_amdgcn_update_dpp(0, (int)ck[i], 0x4E, 0xF, 0xF, true);
        merge16_top(ck, g1);
      }
      const float mx = keyf(ck[0] & ~255u);
      float sv[4];
      int ev[4];
#pragma unroll
      for (int j = 0; j < 4; ++j) {
        const unsigned k0_ = ck[j], k1_ = ck[4 + j], k2_ = ck[8 + j], k3_ = ck[12 + j];
        const unsigned ka_ = (sub & 1) ? k1_ : k0_;
        const unsigned kb_ = (sub & 1) ? k3_ : k2_;
        const unsigned key = (sub & 2) ? kb_ : ka_;
        const int cidx = 255 - (int)(key & 255u);
        const int a = cidx >> 4, b = cidx & 15;
        const unsigned k1 = s1[a], k2 = s2[b];
        sv[j] = __expf(keyf(k1 & ~127u) + keyf(k2 & ~127u) - mx);
        ev[j] = (127 - (int)(k1 & 127u)) * 128 + (127 - (int)(k2 & 127u));
      }
      float sum = (sv[0] + sv[1]) + (sv[2] + sv[3]);
      sum += __uint_as_float((unsigned)__builtin_amdgcn_update_dpp(0, (int)__float_as_uint(sum), 0xB1, 0xF, 0xF, true));
      sum += __uint_as_float((unsigned)__builtin_amdgcn_update_dpp(0, (int)__float_as_uint(sum), 0x4E, 0xF, 0xF, true));
      const float inv = 1.f / sum;
      const size_t ob = (size_t)(t0 + tok) * 128 + h * 16 + sub * 4;
      *(int4*)(EI + ob) = make_int4(ev[0], ev[1], ev[2], ev[3]);
      *(float4*)(GT + ob) = make_float4(sv[0] * inv, sv[1] * inv, sv[2] * inv, sv[3] * inv);
    }
    WAVE_LDS_SYNC();
  }
}

__device__ __forceinline__ float gelu_tanh(float x) {
  return 0.5f * x * (1.f + tanhf(0.7978845608028654f * (x + 0.044715f * x * x * x)));
}
__device__ __forceinline__ float butterfly8(const float* d, int lane) {
  const bool b5 = lane & 32, b4 = lane & 16, b3 = lane & 8;
  float e4[4], e2[2], e1;
#pragma unroll
  for (int j = 0; j < 4; ++j) {
    float snd = b5 ? d[j] : d[j + 4];
    float kep = b5 ? d[j + 4] : d[j];
    e4[j] = kep + __shfl_xor(snd, 32);
  }
#pragma unroll
  for (int j = 0; j < 2; ++j) {
    float snd = b4 ? e4[j] : e4[j + 2];
    float kep = b4 ? e4[j + 2] : e4[j];
    e2[j] = kep + __shfl_xor(snd, 16);
  }
  {
    float snd = b3 ? e2[0] : e2[1];
    float kep = b3 ? e2[1] : e2[0];
    e1 = kep + __shfl_xor(snd, 8);
  }
  e1 += __shfl_xor(e1, 4);
  e1 += __shfl_xor(e1, 2);
  e1 += __shfl_xor(e1, 1);
  const int jj = lane & 7;
  const int srcl = ((jj >> 2) & 1) * 32 + ((jj >> 1) & 1) * 16 + (jj & 1) * 8;
  return __shfl(e1, srcl);
}
__device__ __forceinline__ void phase_peer_gather(const Params& p, int l, int dry, unsigned char* smem) {
  const int tid_ = opaque_tid(); const int lane = tid_ & 63, wv = tid_ >> 6;
  const bf16_t* H = (const bf16_t*)(p.ws + OFF_H);
  bf16_t* Hw = (bf16_t*)(p.ws + OFF_H);
  const unsigned char* UB = p.ws + OFF_UB + (size_t)l * 16384 * 512;
  const unsigned char* VB = p.ws + OFF_VB + (size_t)l * 16384 * 512;
  const int* EI = (const int*)(p.ws + OFF_EIDX);
  const float* GT = (const float*)(p.ws + OFF_GATE);
  const float* modv = (const float*)(p.ws + OFF_MOD);
  float* actw = (float*)smem + wv * (24 * 128);
  const int tstride = gridDim.x * 4, tfirst = blockIdx.x * 4 + wv;
  int ntok = (tfirst < NTOK) ? (NTOK - 1 - tfirst) / tstride + 1 : 0;
  if (ntok > 24) ntok = 24;
  for (int i = lane; i < ntok * 128; i += 64) actw[i] = 0.f;
  WAVE_LDS_SYNC();
  {
    const int q_ = lane >> 4, n_ = lane & 15;
    for (int kk = 0; kk < 8; ++kk) {
      const unsigned char* ubs = UB + (size_t)kk * (16384 * 64) + q_ * 16;
      int pe0 = 0, pe1 = 0; u32x4 pxa = {0u, 0u, 0u, 0u};
      if (ntok > 0) {
        pe0 = EI[(size_t)tfirst * 128 + lane]; pe1 = EI[(size_t)tfirst * 128 + 64 + lane];
        pxa = *(const u32x4*)(p.ws + OFF_H8 + (size_t)tfirst * 512 + kk * 64 + q_ * 16);
      }
      for (int ti = 0; ti < ntok; ++ti) {
        const int ev0 = pe0, ev1 = pe1;
        const u32x4 xa4 = pxa;
        if (ti + 1 < ntok) {
          const size_t tn = (size_t)(tfirst + (ti + 1) * tstride);
          pe0 = EI[tn * 128 + lane]; pe1 = EI[tn * 128 + 64 + lane];
          pxa = *(const u32x4*)(p.ws + OFF_H8 + tn * 512 + kk * 64 + q_ * 16);
        }
        u32x4 bq[8];
#pragma unroll
        for (int g = 0; g < 8; ++g) {
          const int e_ = __shfl((g < 4) ? ev0 : ev1, (g & 3) * 16 + n_);
          bq[g] = *(const u32x4*)(ubs + (size_t)e_ * 64);
        }
        const v8i32 aa = {(int)xa4[0], (int)xa4[1], (int)xa4[2], (int)xa4[3], 0, 0, 0, 0};
#pragma unroll
        for (int g = 0; g < 8; ++g) {
          const v8i32 bb = {(int)bq[g][0], (int)bq[g][1], (int)bq[g][2], (int)bq[g][3], 0, 0, 0, 0};
          f32x4 ac = (f32x4){0.f, 0.f, 0.f, 0.f};
          ac = __builtin_amdgcn_mfma_scale_f32_16x16x128_f8f6f4(aa, bb, ac, 4, 4, 0, 0, 0, 0);
          if (q_ == (g & 3)) actw[ti * 128 + g * 16 + n_] += ac[0];
        }
      }
    }
  }
  WAVE_LDS_SYNC();
  int ti_ = 0;
  uint4 nx0 = make_uint4(0, 0, 0, 0), nx1 = nx0; int nev0 = 0, nev1 = 0; float ngv0 = 0.f, ngv1 = 0.f;
  {
    const int tf = blockIdx.x * 4 + wv;
    if (tf < NTOK) {
      nx0 = *(const uint4*)(H + (size_t)tf * 1024 + lane * 16); nx1 = *(const uint4*)(H + (size_t)tf * 1024 + lane * 16 + 8);
      nev0 = EI[(size_t)tf * 128 + lane]; nev1 = EI[(size_t)tf * 128 + 64 + lane];
      ngv0 = GT[(size_t)tf * 128 + lane]; ngv1 = GT[(size_t)tf * 128 + 64 + lane];
    }
  }
  for (int t = blockIdx.x * 4 + wv; t < NTOK; t += gridDim.x * 4) {
    float xf[16];
    unpack8(nx0, xf);
    unpack8(nx1, xf + 8);
    f32x2 xf2[8], out2[8];
#pragma unroll
    for (int e = 0; e < 8; ++e) { xf2[e] = (f32x2){xf[2 * e], xf[2 * e + 1]}; out2[e] = (f32x2){0.f, 0.f}; }
    const int ev0 = nev0, ev1 = nev1;
    const float gv0 = ngv0, gv1 = ngv1;
    {
      const int tn = t + gridDim.x * 4;
      if (tn < NTOK) {
        nx0 = *(const uint4*)(H + (size_t)tn * 1024 + lane * 16); nx1 = *(const uint4*)(H + (size_t)tn * 1024 + lane * 16 + 8);
        nev0 = EI[(size_t)tn * 128 + lane]; nev1 = EI[(size_t)tn * 128 + 64 + lane];
        ngv0 = GT[(size_t)tn * 128 + lane]; ngv1 = GT[(size_t)tn * 128 + 64 + lane];
      }
    }
    float cacc0 = 0.f, cacc1 = 0.f, coef0 = 0.f, coef1 = 0.f;
    uint2 bufA[16], bufB[16], bufC[16];
    const f32x2 zero2_ = {(float)dry, (float)dry};
#define GLOAD(buf, bb) { \
      const unsigned char* tb_ = ((bb) < 8) ? UB : VB; \
      const int evv_ = (((bb) & 7) < 4) ? ev0 : ev1; \
      _Pragma("unroll") for (int j = 0; j < 16; ++j) { \
        const int e_ = __builtin_amdgcn_readlane(evv_, ((bb) & 3) * 16 + j); \
        buf[j] = *(const uint2*)(tb_ + (size_t)e_ * 512 + lane * 8); } }
#define GCOMP(buf, bb) { \
      if ((bb) < 8) { \
        float d_[16]; \
        _Pragma("unroll") for (int j = 0; j < 16; ++j) { \
          f32x2 uf_[8]; unpack16_fp4(buf[j].x, buf[j].y, uf_); \
          f32x2 sa_ = uf_[0] * xf2[0]; \
          if (PROBE_CVT) { f32x2 ug_[8]; \
            ug_[0] = __builtin_amdgcn_cvt_scalef32_pk_f32_fp4(buf[j].x, 2.0f, 0); ug_[1] = __builtin_amdgcn_cvt_scalef32_pk_f32_fp4(buf[j].x, 2.0f, 1); \
            ug_[2] = __builtin_amdgcn_cvt_scalef32_pk_f32_fp4(buf[j].x, 2.0f, 2); ug_[3] = __builtin_amdgcn_cvt_scalef32_pk_f32_fp4(buf[j].x, 2.0f, 3); \
            ug_[4] = __builtin_amdgcn_cvt_scalef32_pk_f32_fp4(buf[j].y, 2.0f, 0); ug_[5] = __builtin_amdgcn_cvt_scalef32_pk_f32_fp4(buf[j].y, 2.0f, 1); \
            ug_[6] = __builtin_amdgcn_cvt_scalef32_pk_f32_fp4(buf[j].y, 2.0f, 2); ug_[7] = __builtin_amdgcn_cvt_scalef32_pk_f32_fp4(buf[j].y, 2.0f, 3); \
            _Pragma("unroll") for (int q = 0; q < 8; ++q) sa_ = __builtin_elementwise_fma(ug_[q], zero2_, sa_); } \
          _Pragma("unroll") for (int q = 1; q < 8; ++q) sa_ = __builtin_elementwise_fma(uf_[q], xf2[q], sa_); \
          d_[j] = sa_.x + sa_.y; } \
        const float t0_ = butterfly8(d_, lane), t1_ = butterfly8(d_ + 8, lane); \
        const int k0_ = ((bb) & 3) * 16; \
        if (((bb) & 7) < 4) { if ((lane >> 3) == (k0_ >> 3)) cacc0 = t0_; if ((lane >> 3) == (k0_ >> 3) + 1) cacc0 = t1_; } \
        else { if ((lane >> 3) == (k0_ >> 3)) cacc1 = t0_; if ((lane >> 3) == (k0_ >> 3) + 1) cacc1 = t1_; } \
        if ((bb) == 7) { coef0 = gelu_tanh(cacc0 * (1.f / U_SCALE)) * gv0 * (1.f / V_SCALE); coef1 = gelu_tanh(cacc1 * (1.f / U_SCALE)) * gv1 * (1.f / V_SCALE); } \
      } else { \
        const float cfv_ = (((bb) & 7) < 4) ? coef0 : coef1; \
        _Pragma("unroll") for (int j = 0; j < 16; ++j) { \
          const float cf_ = __uint_as_float((unsigned)__builtin_amdgcn_readlane((int)__float_as_uint(cfv_), ((bb) & 3) * 16 + j)); \
          f32x2 vf_[8]; unpack16_fp4(buf[j].x, buf[j].y, vf_); \
          const f32x2 c2_ = {cf_, cf_}; \
          _Pragma("unroll") for (int q = 0; q < 8; ++q) out2[q] = __builtin_elementwise_fma(vf_[q], c2_, out2[q]); } \
      } }
#if GATHER_CHECK
    GLOAD(bufA, 0)
#pragma unroll
    for (int b = 0; b < 8; b += 2) {
      GLOAD(bufB, b + 1)
      GCOMP(bufA, b)
      if (b + 2 < 8) GLOAD(bufA, b + 2)
      GCOMP(bufB, b + 1)
    }
    const float vacc0 = cacc0, vacc1 = cacc1;
#endif
#if !GATHER_CHECK
    GLOAD(bufA, 8)
#endif
    cacc0 = actw[ti_ * 128 + lane] * (1.f / X_SCALE);
    cacc1 = actw[ti_ * 128 + 64 + lane] * (1.f / X_SCALE);
    ++ti_;
#if GATHER_CHECK
    {
      const bool bad0 = fabsf(cacc0 - vacc0) > 0.15f * fabsf(vacc0) + 45.f;
      const bool bad1 = fabsf(cacc1 - vacc1) > 0.15f * fabsf(vacc1) + 45.f;
      const unsigned long long m0 = __ballot(bad0), m1 = __ballot(bad1);
      if (__popcll(m0) + __popcll(m1) > 32) out2[0] = (f32x2){__builtin_nanf(""), __builtin_nanf("")};
    }
#endif
    coef0 = gelu_tanh(cacc0 * (1.f / U_SCALE)) * gv0 * (1.f / V_SCALE);
    coef1 = gelu_tanh(cacc1 * (1.f / U_SCALE)) * gv1 * (1.f / V_SCALE);
#if GATHER_CHECK
    GLOAD(bufA, 8)
#endif
    GLOAD(bufB, 9)
#pragma unroll
    for (int b = 8; b < 14; b += 3) {
      GLOAD(bufC, b + 2)
      GCOMP(bufA, b)
      GLOAD(bufA, b + 3)
      GCOMP(bufB, b + 1)
      GLOAD(bufB, b + 4)
      GCOMP(bufC, b + 2)
    }
    GCOMP(bufA, 14)
    GCOMP(bufB, 15)
#undef GLOAD
#undef GCOMP
    float out[16];
#pragma unroll
    for (int e = 0; e < 8; ++e) { out[2 * e] = out2[e].x; out[2 * e + 1] = out2[e].y; }
    const int m = tok_mod(t);
    const float* ga2 = modv + (size_t)(l * 9 + m) * 6144 + 5120;
    float* xr = p.out + (size_t)t * 1024 + lane * 16;
    float xn[16];
    float ss = 0.f;
#pragma unroll
    for (int q4 = 0; q4 < 4; ++q4) {
      float4 xv = *(const float4*)(xr + q4 * 4);
      float4 gg = *(const float4*)(ga2 + lane * 16 + q4 * 4);
      const int o = q4 * 4;
      xn[o + 0] = xv.x + gg.x * out[o + 0];
      xn[o + 1] = xv.y + gg.y * out[o + 1];
      xn[o + 2] = xv.z + gg.z * out[o + 2];
      xn[o + 3] = xv.w + gg.w * out[o + 3];
      ss += xn[o] * xn[o] + xn[o + 1] * xn[o + 1] + xn[o + 2] * xn[o + 2] + xn[o + 3] * xn[o + 3];
    }
    ss = wave_sum(ss);
    const float rs = rsqrtf(ss * (1.f / 1024.f) + EPSV);
    if (dry) continue;
    if (l < 3) {
      const float* md = modv + (size_t)((l + 1) * 9 + m) * 6144 + lane * 16;
      const float* g = p.in[8] + (l + 1) * 1024 + lane * 16;
      float hv[16];
#pragma unroll
      for (int q = 0; q < 16; ++q) hv[q] = xn[q] * rs * g[q] * (1.f + md[1024 + q]) + md[q];
      uint4 o;
      o.x = pack2(hv[0], hv[1]); o.y = pack2(hv[2], hv[3]); o.z = pack2(hv[4], hv[5]); o.w = pack2(hv[6], hv[7]);
      *(uint4*)(Hw + (size_t)t * 1024 + lane * 16) = o;
      o.x = pack2(hv[8], hv[9]); o.y = pack2(hv[10], hv[11]); o.z = pack2(hv[12], hv[13]); o.w = pack2(hv[14], hv[15]);
      *(uint4*)(Hw + (size_t)t * 1024 + lane * 16 + 8) = o;
#pragma unroll
      for (int q4 = 0; q4 < 4; ++q4) *(float4*)(xr + q4 * 4) = make_float4(xn[q4 * 4], xn[q4 * 4 + 1], xn[q4 * 4 + 2], xn[q4 * 4 + 3]);
    } else {
      const float* g = p.in[10] + lane * 16;
#pragma unroll
      for (int q4 = 0; q4 < 4; ++q4)
        *(float4*)(xr + q4 * 4) = make_float4(xn[q4 * 4] * rs * g[q4 * 4], xn[q4 * 4 + 1] * rs * g[q4 * 4 + 1],
                                              xn[q4 * 4 + 2] * rs * g[q4 * 4 + 2], xn[q4 * 4 + 3] * rs * g[q4 * 4 + 3]);
    }
  }
}

#define XB_TMO      128
#define XB_XCNT(j)  (256  + 64 * (j))
#define XB_XSUB(j)  (1280 + 64 * (j))
#define XB_XGEN(j)  (2304 + 64 * (j))
#define XB_TOP      3328
#define XB_TOPGEN   3392
#define XCD_BAR_WORDS 3456
#define XB_SPIN_CAP (1u << 18)
#define LAS __attribute__((address_space(3)))

__device__ __forceinline__ unsigned xb_ld(unsigned* p)              { return __hip_atomic_load(p, __ATOMIC_RELAXED, __HIP_MEMORY_SCOPE_AGENT); }
__device__ __forceinline__ unsigned xb_add(unsigned* p, unsigned v) { return __hip_atomic_fetch_add(p, v, __ATOMIC_RELAXED, __HIP_MEMORY_SCOPE_AGENT); }
__device__ __forceinline__ unsigned xb_xcc_id() { return (unsigned)__builtin_amdgcn_s_getreg((3 << 11) | 20) & 0xFu; }
#define XB_SPIN(cond, bar) do { unsigned _sp = 0; while (cond) { __builtin_amdgcn_s_sleep(1); \
    if ((++_sp & 255u) == 0u) { if (xb_ld(&(bar)[XB_TMO])) break; if (_sp > XB_SPIN_CAP) { atomicAdd(&(bar)[XB_TMO], 1u); break; } } } } while (0)

struct XcdBarrier {
    unsigned* bar; unsigned x;
    volatile LAS unsigned* st;
};

__device__ __forceinline__ XcdBarrier xcd_barrier_post(unsigned* bar, volatile LAS unsigned* st) {
    XcdBarrier b; b.bar = bar; b.x = xb_xcc_id(); b.st = st;
    if (threadIdx.x == 0) (void)xb_add(&bar[XB_XCNT(b.x)], 1u);
    return b;
}
__device__ __forceinline__ void xcd_barrier_complete(unsigned* bar, unsigned x, unsigned& nloc, unsigned& nx) {
    const unsigned G = gridDim.x * gridDim.y * gridDim.z;
    unsigned sum, cnt, mine, sp = 0u;
    for (;;) {
        sum = 0u; cnt = 0u; mine = 0u;
#pragma unroll
        for (unsigned j = 0; j < 16; ++j) { const unsigned c = xb_ld(&bar[XB_XCNT(j)]); sum += c; cnt += (c > 0u) ? 1u : 0u; mine = (j == x) ? c : mine; }
        if (sum == G) break;
        __builtin_amdgcn_s_sleep(1);
        if ((++sp & 255u) == 0u) { if (xb_ld(&bar[XB_TMO])) break; if (sp > XB_SPIN_CAP) { atomicAdd(&bar[XB_TMO], 1u); break; } }
    }
    nloc = mine > 0u ? mine : 1u; nx = cnt > 0u ? cnt : 1u;
}

__device__ __forceinline__ void xcd_barrier(const XcdBarrier& b) {
    asm volatile("s_waitcnt vmcnt(0)" ::: "memory");
    __syncthreads();
    if (threadIdx.x == 0) {
        unsigned* bar = b.bar;
        __builtin_amdgcn_s_waitcnt(0);
        unsigned nloc = b.st[0], nx = b.st[1];
        if (nloc == 0u) { xcd_barrier_complete(bar, b.x, nloc, nx); b.st[0] = nloc; b.st[1] = nx; }
        const unsigned old = xb_add(&bar[XB_XSUB(b.x)], 1u);
        const unsigned gen = old / nloc;
        if (old + 1u == (gen + 1u) * nloc) {
            __builtin_amdgcn_fence(__ATOMIC_RELEASE, "agent");
            asm volatile("s_waitcnt vmcnt(0)" ::: "memory");
            const unsigned og = xb_add(&bar[XB_TOP], 1u);
            const unsigned tg = og / nx;
            if (og + 1u == (tg + 1u) * nx) xb_add(&bar[XB_TOPGEN], 1u);
            else XB_SPIN(xb_ld(&bar[XB_TOPGEN]) == tg, bar);
            __builtin_amdgcn_fence(__ATOMIC_ACQUIRE, "agent");
            xb_add(&bar[XB_XGEN(b.x)], 1u);
            asm volatile("s_waitcnt vmcnt(0)" ::: "memory");
        } else {
            XB_SPIN(xb_ld(&bar[XB_XGEN(b.x)]) == gen, bar);
            __builtin_amdgcn_fence(__ATOMIC_ACQUIRE, "agent");
            asm volatile("s_waitcnt vmcnt(0)" ::: "memory");
        }
    }
    __syncthreads();
}

__global__ void __launch_bounds__(256, 2) mega(Params p, int ph_lo, int ph_hi) {
  __shared__ __attribute__((aligned(16))) unsigned char smem[77312];
  cg::grid_group grid = cg::this_grid();
  __shared__ uint4 xb_words;
  if (threadIdx.x == 0) xb_words = make_uint4(0u, 0u, 0u, 0u);
  __syncthreads();
  XcdBarrier xb = xcd_barrier_post((unsigned*)(p.ws + OFF_BAR), (volatile LAS unsigned*)&xb_words);
  if (ph_hi > 100000) grid.sync();
  for (int ph = ph_lo; ph < ph_hi; ++ph) {
#if PROBE_MASK
    const int pcode = ph < 2 ? ph : 2 + (ph - 2) % 9;
    const int nrep = ((PROBE_MASK >> pcode) & 1) ? 2 : 1;
    for (int rep = 0; rep < nrep; ++rep) {
    if (rep) xcd_barrier(xb);
#endif
    bool did = true;
#if PROBE_MASK
    const int prep_rep = rep; const int nrep_ = nrep;
#else
    const int prep_rep = 0; const int nrep_ = 1;
#endif
    if (ph == 0) phase_prep_a(p, smem);
    else if (ph == 1) phase_prep_b(p);
    else {
      const int l = (ph - 2) / 9, sub = (ph - 2) % 9;
      const int il = l >> 1;
      const bool odd = l & 1;
      const float* modv = (const float*)(p.ws + OFF_MOD);
      if (sub == 0 || sub == 6) {
        const bf16_t* Bt; int ntn, ldc; bf16_t* C;
        if (sub == 0) {
          Bt = odd ? (const bf16_t*)(p.ws + OFF_WIN_OD) + (size_t)il * 3328 * 1024
                   : (const bf16_t*)(p.ws + OFF_WIN_EV) + (size_t)il * 3072 * 1024;
          ntn = odd ? 13 : 12; ldc = PSTRIDE; C = (bf16_t*)(p.ws + OFF_P);
        } else {
          Bt = (const bf16_t*)(p.ws + OFF_WQ) + (size_t)l * 2048 * 1024;
          ntn = 8; ldc = 2048; C = (bf16_t*)(p.ws + OFF_Q);
        }
        gemm_phase<0, 8, 32>((const bf16_t*)(p.ws + OFF_H), Bt, ntn, C, ldc, nullptr, nullptr, smem);
      } else if (sub == 1) {
        if (odd) phase_odd_prep(p, l, smem, prep_rep); else did = false;
      } else if (sub == 2) {
        if (odd) phase_gdn_chain(p, l, smem); else phase_ret_chain(p, l, smem);
      } else if (sub == 3) {
        phase_mix_out(p, l);
      } else if (sub == 4) {
        gemm_phase<1, 4, 64>((const bf16_t*)(p.ws + OFF_YMIX), (const bf16_t*)(p.ws + OFF_WOUT) + (size_t)l * 1024 * 1024, 8,
                      nullptr, 0, p.out, modv + (size_t)l * 9 * 6144 + 2048, smem, (nrep_ > 1 && prep_rep == 0) ? 1 : 0);
      } else if (sub == 5) {
        phase_norm2(p, l);
      } else if (sub == 7) {
        phase_peer_score(p, l, smem);
      } else {
        phase_peer_gather(p, l, (nrep_ > 1 && prep_rep == 0) ? 1 : 0, smem);
      }
    }
#if PROBE_MASK
    if (rep + 1 < nrep) continue;
#endif
    if (did && ph + 1 < ph_hi) xcd_barrier(xb);
#if PROBE_MASK
    }
#endif
  }
}

extern "C" void kernel_launch(void* const* d_in, const int* in_sizes, int n_in, void* d_out, int out_size,
                              void* d_ws, size_t ws_size, hipStream_t stream) {
  static int grid_blocks = 0;
  if (!grid_blocks) {
    int dev = 0, cus = 0, per_cu = 0;
    (void)hipGetDevice(&dev);
    (void)hipDeviceGetAttribute(&cus, hipDeviceAttributeMultiprocessorCount, dev);
    (void)hipOccupancyMaxActiveBlocksPerMultiprocessor(&per_cu, mega, 256, 0);
    if (per_cu < 1) per_cu = 1;
    if (per_cu > 2) per_cu = 2;
    grid_blocks = cus * per_cu;
    if (ws_size < WS_NEED) fprintf(stderr, "kernel_launch: workspace too small: %zu < %zu\n", ws_size, (size_t)WS_NEED);
  }
  Params p{};
  for (int i = 0; i < 30; ++i) p.in[i] = (const float*)d_in[i];
  p.out = (float*)d_out;
  p.ws = (unsigned char*)d_ws;
  (void)hipMemsetAsync((unsigned char*)d_ws + OFF_BAR, 0, XCD_BAR_WORDS * sizeof(unsigned), stream);
#if SINGLE_LAUNCH
  int lo = 0, hi = NPHASE;
  void* args[] = {&p, &lo, &hi};
  hipError_t e = hipLaunchCooperativeKernel((void*)mega, dim3(grid_blocks), dim3(256), args, 0, stream);
  if (e != hipSuccess) fprintf(stderr, "cooperative launch failed: %s (grid %d)\n", hipGetErrorString(e), grid_blocks);
#else
  for (int ph = 0; ph < NPHASE; ++ph) {
    const int l = (ph - 2) / 9, sub = (ph - 2) % 9;
    if (ph >= 2 && sub == 1 && !(l & 1)) continue;
    hipLaunchKernelGGL(mega, dim3(grid_blocks), dim3(256), 0, stream, p, ph, ph + 1);
  }
#endif
}
```

```cpp
#include <hip/hip_runtime.h>
#include <hip/hip_cooperative_groups.h>
#include <cstdio>
namespace cg = cooperative_groups;

#ifndef PROBE_MASK
#define PROBE_MASK 0
#endif
#ifndef GATHER_CHECK
#define GATHER_CHECK 0
#endif
#ifndef PROBE_CVT
#define PROBE_CVT 0
#endif
#ifndef PROBE_ODD
#define PROBE_ODD 0
#endif
#ifndef SINGLE_LAUNCH
#define SINGLE_LAUNCH 1
#endif

typedef unsigned short bf16_t;
using bf16x8 = __attribute__((ext_vector_type(8))) short;
using f32x4 = __attribute__((ext_vector_type(4))) float;
using f32x2 = __attribute__((ext_vector_type(2))) float;
using u32x4 = __attribute__((ext_vector_type(4))) unsigned;
using v8i32 = __attribute__((ext_vector_type(8))) int;

#define NTOK 24576
#define NPROMPT 8192
#define PSTRIDE 3200
#define EPSV 1e-6f
#define NPHASE 38
#define X_SCALE 1.5f

constexpr size_t OFF_MOD = 0;
constexpr size_t OFF_ROPE = 1u << 20;
constexpr size_t OFF_WIN_EV = OFF_ROPE + 65536;
constexpr size_t OFF_WIN_OD = OFF_WIN_EV + 2ull * 3072 * 1024 * 2;
constexpr size_t OFF_WOUT = OFF_WIN_OD + 2ull * 3328 * 1024 * 2;
constexpr size_t OFF_WQ = OFF_WOUT + 4ull * 1024 * 1024 * 2;
constexpr size_t OFF_KEYS = OFF_WQ + 4ull * 2048 * 1024 * 2;
constexpr size_t OFF_UB = OFF_KEYS + 4ull * 8 * 2 * 128 * 128 * 2;
constexpr size_t OFF_VB = OFF_UB + 4ull * 16384 * 1024 * 2;
constexpr size_t OFF_H = OFF_VB + 4ull * 16384 * 1024 * 2;
constexpr size_t OFF_P = OFF_H + (size_t)NTOK * 1024 * 2;
constexpr size_t OFF_YMIX = OFF_P + (size_t)NTOK * PSTRIDE * 2;
constexpr size_t OFF_ODIR = OFF_YMIX + (size_t)NTOK * 1024 * 2;
constexpr size_t OFF_Q = OFF_ODIR;
constexpr size_t OFF_EIDX = OFF_ODIR + 2ull * NTOK * 512 * 4;
constexpr size_t OFF_GATE = OFF_EIDX + (size_t)NTOK * 128 * 4;
constexpr size_t GP_ITEM = 73728;
constexpr size_t OFF_GPREP = OFF_GATE + (size_t)NTOK * 128 * 4;
constexpr size_t OFF_EGL = OFF_GPREP + 3072ull * GP_ITEM;
constexpr size_t OFF_CONV = OFF_EGL + 16384;
constexpr size_t OFF_H8 = OFF_CONV;
constexpr size_t OFF_BAR = OFF_CONV + (size_t)NTOK * 512 * 4;
constexpr size_t WS_NEED = OFF_BAR + 16384;

struct Params {
  const float* in[30];
  float* out;
  unsigned char* ws;
};

__device__ const unsigned char CAND_A[52] = {0,0,0,0,0,0,0,0,0,0,0,0,0,0,0,0,1,1,1,1,1,1,1,1,2,2,2,2,2,3,3,3,3,4,4,4,5,5,6,6,7,7,8,9,10,11,12,13,14,15,0,0};
__device__ const unsigned char CAND_B[52] = {0,1,2,3,4,5,6,7,8,9,10,11,12,13,14,15,0,1,2,3,4,5,6,7,0,1,2,3,4,0,1,2,3,0,1,2,0,1,0,1,0,1,0,0,0,0,0,0,0,0,0,0};

__device__ __forceinline__ int opaque_tid() { int t = threadIdx.x; asm volatile("" : "+v"(t)); return t; }
typedef __bf16 hbf16x2 __attribute__((ext_vector_type(2)));
__device__ __forceinline__ bf16_t f2bf(float f) {
  return __builtin_bit_cast(unsigned short, (__bf16)f);
}
__device__ __forceinline__ float bf2f(bf16_t b) { return __uint_as_float(((unsigned)b) << 16); }
__device__ __forceinline__ float bflo(unsigned u) { return __uint_as_float(u << 16); }
__device__ __forceinline__ float bfhi(unsigned u) { return __uint_as_float(u & 0xffff0000u); }
__device__ __forceinline__ unsigned pack2(float a, float b) {
  f32x2 v = {a, b};
  return __builtin_bit_cast(unsigned, __builtin_convertvector(v, hbf16x2));
}
__device__ __forceinline__ float wave_sum(float v) {
#pragma unroll
  for (int o = 32; o > 0; o >>= 1) v += __shfl_xor(v, o);
  return v;
}
__device__ __forceinline__ f32x4 mfma16(bf16x8 a, bf16x8 b, f32x4 c) {
  return __builtin_amdgcn_mfma_f32_16x16x32_bf16(a, b, c, 0, 0, 0);
}
__device__ __forceinline__ bf16x8 ldfrag(const bf16_t* p) { return *(const bf16x8*)p; }
__device__ __forceinline__ float siluf(float v) { return v * __builtin_amdgcn_rcpf(1.f + __expf(-v)); }
__device__ __forceinline__ int tok_mod(int t) { return t < NPROMPT ? 0 : 1 + ((t - NPROMPT) >> 11); }
__device__ __forceinline__ unsigned fkey(float f) {
  const unsigned u = __float_as_uint(f);
  return u ^ ((unsigned)((int)u >> 31) | 0x80000000u);
}
__device__ __forceinline__ float keyf(unsigned k) {
  unsigned b = (k & 0x80000000u) ? (k ^ 0x80000000u) : ~k;
  return __uint_as_float(b);
}
__device__ __forceinline__ void unpack8(uint4 v, float* f) {
  f[0] = bflo(v.x); f[1] = bfhi(v.x); f[2] = bflo(v.y); f[3] = bfhi(v.y);
  f[4] = bflo(v.z); f[5] = bfhi(v.z); f[6] = bflo(v.w); f[7] = bfhi(v.w);
}

__device__ __forceinline__ void prep_mod(const Params& p, float* smem) {
  float* sc = smem;
  float* red = smem + 9 * 1024;
  const int tid = opaque_tid();
  const float* c = p.in[4];
  const float* cctx = p.in[5];
  for (int i = tid; i < 9 * 1024; i += 256) {
    int m = i >> 10, k = i & 1023;
    float v = (m == 0) ? cctx[k] : c[(m - 1) * 1024 + k];
    sc[i] = v / (1.f + expf(-v));
  }
  __syncthreads();
  float* modv = (float*)(p.ws + OFF_MOD);
  const int cl = tid & 63, kg = tid >> 6;
  for (int u = blockIdx.x; u < 4 * 96; u += gridDim.x) {
    const int l = u / 96, nb = (u % 96) * 64;
    const float* W = p.in[6] + (size_t)l * 1024 * 6144 + nb + cl;
    float acc[9];
#pragma unroll
    for (int m = 0; m < 9; ++m) acc[m] = 0.f;
#pragma unroll 16
    for (int k = kg * 256; k < kg * 256 + 256; ++k) {
      float w = W[(size_t)k * 6144];
#pragma unroll
      for (int m = 0; m < 9; ++m) acc[m] += sc[m * 1024 + k] * w;
    }
#pragma unroll
    for (int m = 0; m < 9; ++m) red[(kg * 9 + m) * 64 + cl] = acc[m];
    __syncthreads();
    for (int i = tid; i < 9 * 64; i += 256) {
      int m = i >> 6, c2 = i & 63;
      float s = red[(0 * 9 + m) * 64 + c2] + red[(1 * 9 + m) * 64 + c2] + red[(2 * 9 + m) * 64 + c2] + red[(3 * 9 + m) * 64 + c2];
      int nn = nb + c2;
      modv[(size_t)(l * 9 + m) * 6144 + nn] = s + p.in[7][l * 6144 + nn];
    }
    __syncthreads();
  }
}

__device__ __forceinline__ void prep_transpose(const float* src, bf16_t* dst, int N, int Npad, float* tile) {
  const int tid = opaque_tid();
  const int ntn = Npad / 64;
  const int units = ntn * 16;
  for (int u = blockIdx.x; u < units; u += gridDim.x) {
    const int nt = u % ntn, kt = u / ntn;
    const int n0 = nt * 64, k0 = kt * 64;
    {
      const int c = tid & 63;
      const int n = n0 + c;
      const int nc = n < N ? n : N - 1;
      float tv[16];
#pragma unroll
      for (int i = 0; i < 16; ++i) tv[i] = src[(size_t)(k0 + (tid >> 6) + 4 * i) * N + nc];
#pragma unroll
      for (int i = 0; i < 16; ++i) tile[((tid >> 6) + 4 * i) * 65 + c] = (n < N) ? tv[i] : 0.f;
    }
    __syncthreads();
#pragma unroll 4
    for (int i = 0; i < 16; ++i) {
      int rr = (tid >> 6) + 4 * i, cc = tid & 63;
      dst[(size_t)(n0 + rr) * 1024 + k0 + cc] = f2bf(tile[cc * 65 + rr]);
    }
    __syncthreads();
  }
}

__device__ __forceinline__ void prep_convert(const float* src, bf16_t* dst, size_t n4) {
  const size_t stride = (size_t)gridDim.x * 256;
  for (size_t i0 = (size_t)blockIdx.x * 256 + threadIdx.x; i0 < n4; i0 += stride * 8) {
    float4 v[8];
#pragma unroll
    for (int j = 0; j < 8; ++j) { const size_t i = i0 + j * stride; const size_t ic = i < n4 ? i : n4 - 1; v[j] = ((const float4*)src)[ic]; }
#pragma unroll
    for (int j = 0; j < 8; ++j) {
      const size_t i = i0 + j * stride;
      if (i < n4) { uint2 o; o.x = pack2(v[j].x, v[j].y); o.y = pack2(v[j].z, v[j].w); ((uint2*)dst)[i] = o; }
    }
  }
}

__device__ __forceinline__ void prep_convert_fp8(const float* src, unsigned* dst, size_t n4, float scale) {
  const size_t stride = (size_t)gridDim.x * 256;
  for (size_t i0 = (size_t)blockIdx.x * 256 + threadIdx.x; i0 < n4; i0 += stride * 8) {
    float4 v[8];
#pragma unroll
    for (int j = 0; j < 8; ++j) { const size_t i = i0 + j * stride; const size_t ic = i < n4 ? i : n4 - 1; f32x4 t4 = __builtin_nontemporal_load((const f32x4*)src + ic); v[j] = make_float4(t4[0], t4[1], t4[2], t4[3]); }
#pragma unroll
    for (int j = 0; j < 8; ++j) {
      const size_t i = i0 + j * stride;
      if (i < n4) {
        unsigned w = __builtin_amdgcn_cvt_pk_fp8_f32(v[j].x * scale, v[j].y * scale, 0, false);
        w = __builtin_amdgcn_cvt_pk_fp8_f32(v[j].z * scale, v[j].w * scale, w, true);
        dst[i] = w;
      }
    }
  }
}
__device__ __forceinline__ void prep_convert_fp4(const float* src, unsigned* dst, size_t n8, float scale, int W) {
  const size_t stride = (size_t)gridDim.x * 256;
  for (size_t i0 = (size_t)blockIdx.x * 256 + threadIdx.x; i0 < n8; i0 += stride * 4) {
    f32x4 va[4], vb[4];
#pragma unroll
    for (int j = 0; j < 4; ++j) {
      const size_t i = i0 + j * stride; const size_t ic = i < n8 ? i : n8 - 1;
      va[j] = __builtin_nontemporal_load((const f32x4*)src + 2 * ic);
      vb[j] = __builtin_nontemporal_load((const f32x4*)src + 2 * ic + 1);
    }
#pragma unroll
    for (int j = 0; j < 4; ++j) {
      const size_t i = i0 + j * stride;
      if (i < n8) {
        unsigned w = 0;
        w = __builtin_amdgcn_cvt_scalef32_pk_fp4_f32(w, va[j][0] * scale, va[j][1] * scale, 1.0f, 0);
        w = __builtin_amdgcn_cvt_scalef32_pk_fp4_f32(w, va[j][2] * scale, va[j][3] * scale, 1.0f, 1);
        w = __builtin_amdgcn_cvt_scalef32_pk_fp4_f32(w, vb[j][0] * scale, vb[j][1] * scale, 1.0f, 2);
        w = __builtin_amdgcn_cvt_scalef32_pk_fp4_f32(w, vb[j][2] * scale, vb[j][3] * scale, 1.0f, 3);
        const size_t el = i * 8;
        const size_t lay = el >> 24, e = (el >> 10) & 16383, d0 = el & 1023;
        const size_t off = lay * (16384ull * 512) + (d0 / W) * (16384ull * (W / 2)) + e * (W / 2) + ((d0 % W) >> 1);
        *(unsigned*)((unsigned char*)dst + off) = w;
      }
    }
  }
}
__device__ __forceinline__ void unpack16_fp4(unsigned w0, unsigned w1, f32x2* f) {
  f[0] = __builtin_amdgcn_cvt_scalef32_pk_f32_fp4(w0, 1.0f, 0);
  f[1] = __builtin_amdgcn_cvt_scalef32_pk_f32_fp4(w0, 1.0f, 1);
  f[2] = __builtin_amdgcn_cvt_scalef32_pk_f32_fp4(w0, 1.0f, 2);
  f[3] = __builtin_amdgcn_cvt_scalef32_pk_f32_fp4(w0, 1.0f, 3);
  f[4] = __builtin_amdgcn_cvt_scalef32_pk_f32_fp4(w1, 1.0f, 0);
  f[5] = __builtin_amdgcn_cvt_scalef32_pk_f32_fp4(w1, 1.0f, 1);
  f[6] = __builtin_amdgcn_cvt_scalef32_pk_f32_fp4(w1, 1.0f, 2);
  f[7] = __builtin_amdgcn_cvt_scalef32_pk_f32_fp4(w1, 1.0f, 3);
}
__device__ __forceinline__ void unpack16_fp8(u32x4 v, float* f) {
#pragma unroll
  for (int i = 0; i < 4; ++i) {
    f32x2 lo = __builtin_amdgcn_cvt_pk_f32_fp8(v[i], false);
    f32x2 hi = __builtin_amdgcn_cvt_pk_f32_fp8(v[i], true);
    f[4 * i + 0] = lo.x; f[4 * i + 1] = lo.y; f[4 * i + 2] = hi.x; f[4 * i + 3] = hi.y;
  }
}
#define U_SCALE 64.f
#define V_SCALE 20.f
__device__ __forceinline__ void phase_prep_a(const Params& p, unsigned char* smem) {
  float* fs = (float*)smem;
  prep_mod(p, fs);
  {
    float2* rope = (float2*)(p.ws + OFF_ROPE);
    int i = blockIdx.x * 256 + threadIdx.x;
    if (i < 64 * 16) {
      int pos = i >> 4, f = i & 15;
      float fr = powf(10000.f, -(float)f / 16.f);
      float ang = (float)pos * fr;
      rope[i] = make_float2(cosf(ang), sinf(ang));
    }
  }
  for (int i = 0; i < 2; ++i) {
    prep_transpose(p.in[11] + (size_t)i * 1024 * 3072, (bf16_t*)(p.ws + OFF_WIN_EV) + (size_t)i * 3072 * 1024, 3072, 3072, fs);
    prep_transpose(p.in[16] + (size_t)i * 1024 * 3088, (bf16_t*)(p.ws + OFF_WIN_OD) + (size_t)i * 3328 * 1024, 3088, 3328, fs);
    prep_transpose(p.in[12] + (size_t)i * 1024 * 1024, (bf16_t*)(p.ws + OFF_WOUT) + (size_t)(2 * i) * 1024 * 1024, 1024, 1024, fs);
    prep_transpose(p.in[17] + (size_t)i * 1024 * 1024, (bf16_t*)(p.ws + OFF_WOUT) + (size_t)(2 * i + 1) * 1024 * 1024, 1024, 1024, fs);
  }
  for (int l = 0; l < 4; ++l)
    prep_transpose(p.in[26] + (size_t)l * 1024 * 2048, (bf16_t*)(p.ws + OFF_WQ) + (size_t)l * 2048 * 1024, 2048, 2048, fs);
  prep_convert(p.in[27], (bf16_t*)(p.ws + OFF_KEYS), (size_t)4 * 8 * 2 * 128 * 128 / 4);
  prep_convert_fp4(p.in[28], (unsigned*)(p.ws + OFF_UB), (size_t)4 * 16384 * 1024 / 8, U_SCALE, 128);
  prep_convert_fp4(p.in[29], (unsigned*)(p.ws + OFF_VB), (size_t)4 * 16384 * 1024 / 8, V_SCALE, 1024);
}

__device__ __forceinline__ void norm_token(const float* xrow, const float* g, const float* scale, const float* shift,
                                           bf16_t* hrow, float* copy_dst, int lane, unsigned char* h8row = nullptr) {
  float4 v[4];
  float ss = 0.f;
#pragma unroll
  for (int i = 0; i < 4; ++i) {
    v[i] = *(const float4*)(xrow + i * 256 + lane * 4);
    ss += v[i].x * v[i].x + v[i].y * v[i].y + v[i].z * v[i].z + v[i].w * v[i].w;
  }
  ss = wave_sum(ss);
  const float rs = rsqrtf(ss * (1.f / 1024.f) + EPSV);
#pragma unroll
  for (int i = 0; i < 4; ++i) {
    const int idx = i * 256 + lane * 4;
    if (copy_dst) *(float4*)(copy_dst + idx) = v[i];
    float4 gg = *(const float4*)(g + idx);
    float4 sc = *(const float4*)(scale + idx);
    float4 sh = *(const float4*)(shift + idx);
    float a = v[i].x * rs * gg.x * (1.f + sc.x) + sh.x;
    float b = v[i].y * rs * gg.y * (1.f + sc.y) + sh.y;
    float c = v[i].z * rs * gg.z * (1.f + sc.z) + sh.z;
    float d = v[i].w * rs * gg.w * (1.f + sc.w) + sh.w;
    uint2 o;
    o.x = pack2(a, b);
    o.y = pack2(c, d);
    *(uint2*)(hrow + idx) = o;
    if (h8row) {
      unsigned w4 = 0;
      w4 = __builtin_amdgcn_cvt_scalef32_pk_fp4_f32(w4, a * X_SCALE, b * X_SCALE, 1.0f, 0);
      w4 = __builtin_amdgcn_cvt_scalef32_pk_fp4_f32(w4, c * X_SCALE, d * X_SCALE, 1.0f, 1);
      *(unsigned short*)(h8row + (idx >> 1)) = (unsigned short)w4;
    }
  }
}

__device__ __forceinline__ void phase_prep_b(const Params& p) {
  const int tid_ = opaque_tid(); const int lane = tid_ & 63, wv = tid_ >> 6;
  const float* modv = (const float*)(p.ws + OFF_MOD);
  bf16_t* H = (bf16_t*)(p.ws + OFF_H);
  for (int t = blockIdx.x * 4 + wv; t < NTOK; t += gridDim.x * 4) {
    const float* xr = (t < NPROMPT) ? p.in[0] + (size_t)t * 1024 : p.in[1] + (size_t)(t - NPROMPT) * 1024;
    const float* md = modv + (size_t)(0 * 9 + tok_mod(t)) * 6144;
    norm_token(xr, p.in[8], md + 1024, md, H + (size_t)t * 1024, p.out + (size_t)t * 1024, lane);
  }
}

__device__ __forceinline__ void phase_norm2(const Params& p, int l) {
  const int tid_ = opaque_tid(); const int lane = tid_ & 63, wv = tid_ >> 6;
  const float* modv = (const float*)(p.ws + OFF_MOD);
  bf16_t* H = (bf16_t*)(p.ws + OFF_H);
  for (int t = blockIdx.x * 4 + wv; t < NTOK; t += gridDim.x * 4) {
    const float* md = modv + (size_t)(l * 9 + tok_mod(t)) * 6144;
    norm_token(p.out + (size_t)t * 1024, p.in[9] + l * 1024, md + 4096, md + 3072, H + (size_t)t * 1024, nullptr, lane,
               p.ws + OFF_H8 + (size_t)t * 512);
  }
}

template <int EPI, int NJ, int BK>
__device__ __forceinline__ void gemm_phase(const bf16_t* __restrict__ A, const bf16_t* __restrict__ Bt, int ntiles_n,
                           bf16_t* __restrict__ C, int ldc, float* __restrict__ X, const float* __restrict__ ga,
                           unsigned char* smem, int dry = 0) {
  constexpr int TN = 32 * NJ;
  constexpr int LS = BK + 8;
  constexpr int TPR = BK / 8;
  constexpr int RPP = 256 / TPR;
  constexpr int NA = 128 / RPP, NB = TN / RPP;
  bf16_t* As = (bf16_t*)smem;
  bf16_t* Bs = As + 128 * LS;
  const int tid = opaque_tid(), lane = tid & 63, w = tid >> 6, quad = lane >> 4, l15 = lane & 15;
  const int wm = w >> 1, wn = w & 1;
  const int lr = tid / TPR, lseg = (tid % TPR) * 8;
  const int units = 192 * ntiles_n;
  for (int u = blockIdx.x; u < units; u += gridDim.x) {
    const int mt = u % 192, nt = u / 192;
    const int m0 = mt * 128, n0 = nt * TN;
    f32x4 acc[4][NJ];
#pragma unroll
    for (int i = 0; i < 4; ++i)
#pragma unroll
      for (int j = 0; j < NJ; ++j) acc[i][j] = (f32x4){0.f, 0.f, 0.f, 0.f};
    const bf16_t* Ag = A + (size_t)(m0 + lr) * 1024 + lseg;
    const bf16_t* Bg = Bt + (size_t)(n0 + lr) * 1024 + lseg;
    u32x4 ra[NA], rb[NB];
#pragma unroll
    for (int i = 0; i < NA; ++i) ra[i] = *(const u32x4*)(Ag + (size_t)i * RPP * 1024);
#pragma unroll
    for (int i = 0; i < NB; ++i) rb[i] = *(const u32x4*)(Bg + (size_t)i * RPP * 1024);
    for (int kt = 0; kt < 1024 / BK; ++kt) {
#pragma unroll
      for (int i = 0; i < NA; ++i) *(u32x4*)(As + (lr + RPP * i) * LS + lseg) = ra[i];
#pragma unroll
      for (int i = 0; i < NB; ++i) *(u32x4*)(Bs + (lr + RPP * i) * LS + lseg) = rb[i];
      __syncthreads();
      if (kt + 1 < 1024 / BK) {
        const bf16_t* An = Ag + (kt + 1) * BK;
        const bf16_t* Bn = Bg + (kt + 1) * BK;
#pragma unroll
        for (int i = 0; i < NA; ++i) ra[i] = *(const u32x4*)(An + (size_t)i * RPP * 1024);
#pragma unroll
        for (int i = 0; i < NB; ++i) rb[i] = *(const u32x4*)(Bn + (size_t)i * RPP * 1024);
      }
#pragma unroll
      for (int kk = 0; kk < BK / 32; ++kk) {
        bf16x8 af[4];
#pragma unroll
        for (int i = 0; i < 4; ++i) af[i] = ldfrag(As + (wm * 64 + i * 16 + l15) * LS + kk * 32 + quad * 8);
#pragma unroll
        for (int j = 0; j < NJ; ++j) {
          const bf16x8 bfr = ldfrag(Bs + (wn * (16 * NJ) + j * 16 + l15) * LS + kk * 32 + quad * 8);
#pragma unroll
          for (int i = 0; i < 4; ++i) acc[i][j] = mfma16(af[i], bfr, acc[i][j]);
        }
      }
      __syncthreads();
    }
    if (EPI == 0) {
#pragma unroll
      for (int i = 0; i < 4; ++i)
#pragma unroll
        for (int j = 0; j < NJ; ++j) {
          const int col = n0 + wn * (16 * NJ) + j * 16 + l15;
          if (col < ldc) {
#pragma unroll
            for (int jj = 0; jj < 4; ++jj) {
              int row = m0 + wm * 64 + i * 16 + quad * 4 + jj;
              C[(size_t)row * ldc + col] = f2bf(acc[i][j][jj]);
            }
          }
        }
    } else {
      const float* gam = ga + (size_t)tok_mod(m0) * 6144;
#pragma unroll
      for (int i = 0; i < 4; ++i)
#pragma unroll
        for (int j = 0; j < NJ; ++j)
#pragma unroll
          for (int jj = 0; jj < 4; ++jj) {
            int row = m0 + wm * 64 + i * 16 + quad * 4 + jj;
            int col = n0 + wn * (16 * NJ) + j * 16 + l15;
            float* xp = X + (size_t)row * 1024 + col;
            const float nv = *xp + gam[col] * acc[i][j][jj];
            if (!dry) *xp = nv;
          }
    }
  }
}

struct ChainItem {
  bool lng; int sl, dir, h, sq, tok0, nc;
};
__device__ __forceinline__ ChainItem decode_item(int it) {
  ChainItem c;
  c.lng = it < 256;
  int idx = c.lng ? it : it - 256;
  c.sl = idx & 3; c.dir = (idx >> 2) & 1; c.h = (idx >> 3) & 3; c.sq = idx >> 5;
  c.tok0 = c.lng ? NPROMPT + c.sq * 2048 : c.sq * 256;
  c.nc = c.lng ? 32 : 4;
  return c;
}

__device__ __forceinline__ void phase_ret_chain(const Params& p, int l, unsigned char* smem) {
  const int il = l >> 1;
  bf16_t* qs = (bf16_t*)smem;
  bf16_t* ks = qs + 64 * 72;
  bf16_t* kT = ks + 64 * 72;
  bf16_t* vT = kT + 64 * 72;
  bf16_t* intra = vT + 32 * 72;
  bf16_t* ST = intra + 64 * 72;
  const bf16_t* P = (const bf16_t*)(p.ws + OFF_P);
  float* odir = (float*)(p.ws + OFF_ODIR);
  const float2* rope = (const float2*)(p.ws + OFF_ROPE);
  const int tid = opaque_tid(), lane = tid & 63, w = tid >> 6, quad = lane >> 4, l15 = lane & 15;
  const int nlb = (gridDim.x >= 512) ? 256 : ((gridDim.x >= 2) ? (int)(gridDim.x / 2) : 0);
  const bool longblk = (nlb > 0) ? ((int)blockIdx.x < nlb) : true;
  const int it_lo = (nlb > 0) ? (longblk ? (int)blockIdx.x : 256 + ((int)blockIdx.x - nlb)) : (int)blockIdx.x;
  const int it_hi = (nlb > 0) ? (longblk ? 256 : 1280) : 1280;
  const int it_st = (nlb > 0) ? (longblk ? nlb : ((int)gridDim.x - nlb)) : (int)gridDim.x;
  for (int it = it_lo; it < it_hi; it += it_st) {
    const ChainItem ci = decode_item(it);
    const int sl = ci.sl, dir = ci.dir, h = ci.h;
    const float xg = p.in[13][(il * 2 + dir) * 4 + h];
    const float lg = -log1pf(expf(-xg));
    const float g64 = expf(lg * 64.f);
    f32x4 S[2];
    if (ci.lng) {
      const float* s0 = p.in[2] + ((((size_t)ci.sq * 2 + il) * 2 + dir) * 4 + h) * 8192;
#pragma unroll
      for (int ct = 0; ct < 2; ++ct)
#pragma unroll
        for (int jj = 0; jj < 4; ++jj) S[ct][jj] = s0[(16 * w + quad * 4 + jj) * 128 + sl * 32 + ct * 16 + l15];
    } else {
      S[0] = (f32x4){0.f, 0.f, 0.f, 0.f};
      S[1] = (f32x4){0.f, 0.f, 0.f, 0.f};
    }
    for (int n = 0; n < ci.nc; ++n) {
      const int cn = dir ? ci.nc - 1 - n : n;
      const int tb = ci.tok0 + cn * 64;
      {
        const int i = tid >> 2, mq = tid & 3;
        const int t = tb + (dir ? 63 - i : i);
        const bf16_t* pr = P + (size_t)t * PSTRIDE;
        float qa[8], qb[8], ka[8], kb[8];
        unpack8(*(const uint4*)(pr + h * 64 + mq * 8), qa);
        unpack8(*(const uint4*)(pr + h * 64 + 32 + mq * 8), qb);
        unpack8(*(const uint4*)(pr + 256 + h * 64 + mq * 8), ka);
        unpack8(*(const uint4*)(pr + 256 + h * 64 + 32 + mq * 8), kb);
        if (ci.lng) {
          const int pos = (mq < 2) ? cn : (t - tb);
          const int f0 = (mq & 1) * 8;
#pragma unroll
          for (int e = 0; e < 8; ++e) {
            float2 cs = rope[pos * 16 + f0 + e];
            float a = qa[e], b = qb[e];
            qa[e] = a * cs.x - b * cs.y; qb[e] = b * cs.x + a * cs.y;
            a = ka[e]; b = kb[e];
            ka[e] = a * cs.x - b * cs.y; kb[e] = b * cs.x + a * cs.y;
          }
        }
        const float wend = expf(lg * (float)(63 - i));
        uint4 o;
        o.x = pack2(qa[0], qa[1]); o.y = pack2(qa[2], qa[3]); o.z = pack2(qa[4], qa[5]); o.w = pack2(qa[6], qa[7]);
        *(uint4*)(qs + i * 72 + mq * 8) = o;
        o.x = pack2(qb[0], qb[1]); o.y = pack2(qb[2], qb[3]); o.z = pack2(qb[4], qb[5]); o.w = pack2(qb[6], qb[7]);
        *(uint4*)(qs + i * 72 + 32 + mq * 8) = o;
#pragma unroll
        for (int e = 0; e < 8; ++e) { ka[e] *= 0.125f; kb[e] *= 0.125f; }
        o.x = pack2(ka[0], ka[1]); o.y = pack2(ka[2], ka[3]); o.z = pack2(ka[4], ka[5]); o.w = pack2(ka[6], ka[7]);
        *(uint4*)(ks + i * 72 + mq * 8) = o;
        o.x = pack2(kb[0], kb[1]); o.y = pack2(kb[2], kb[3]); o.z = pack2(kb[4], kb[5]); o.w = pack2(kb[6], kb[7]);
        *(uint4*)(ks + i * 72 + 32 + mq * 8) = o;
#pragma unroll
        for (int e = 0; e < 8; ++e) {
          kT[(mq * 8 + e) * 72 + i] = f2bf(ka[e] * wend);
          kT[(32 + mq * 8 + e) * 72 + i] = f2bf(kb[e] * wend);
        }
        uint4 v8 = *(const uint4*)(pr + 512 + h * 128 + sl * 32 + mq * 8);
        vT[(mq * 8 + 0) * 72 + i] = (bf16_t)(v8.x & 0xffff); vT[(mq * 8 + 1) * 72 + i] = (bf16_t)(v8.x >> 16);
        vT[(mq * 8 + 2) * 72 + i] = (bf16_t)(v8.y & 0xffff); vT[(mq * 8 + 3) * 72 + i] = (bf16_t)(v8.y >> 16);
        vT[(mq * 8 + 4) * 72 + i] = (bf16_t)(v8.z & 0xffff); vT[(mq * 8 + 5) * 72 + i] = (bf16_t)(v8.z >> 16);
        vT[(mq * 8 + 6) * 72 + i] = (bf16_t)(v8.w & 0xffff); vT[(mq * 8 + 7) * 72 + i] = (bf16_t)(v8.w >> 16);
      }
      __syncthreads();
      const bf16x8 a0 = ldfrag(qs + (16 * w + l15) * 72 + quad * 8);
      const bf16x8 a1 = ldfrag(qs + (16 * w + l15) * 72 + 32 + quad * 8);
#pragma unroll
      for (int ct = 0; ct < 4; ++ct) {
        bf16x8 b0 = ldfrag(ks + (ct * 16 + l15) * 72 + quad * 8);
        bf16x8 b1 = ldfrag(ks + (ct * 16 + l15) * 72 + 32 + quad * 8);
        f32x4 c = (f32x4){0.f, 0.f, 0.f, 0.f};
        c = mfma16(a0, b0, c);
        c = mfma16(a1, b1, c);
#pragma unroll
        for (int jj = 0; jj < 4; ++jj) {
          int i = 16 * w + quad * 4 + jj, j = ct * 16 + l15;
          float val = (i >= j) ? c[jj] * expf(lg * (float)(i - j)) : 0.f;
          intra[i * 72 + j] = f2bf(val);
        }
      }
#pragma unroll
      for (int ct = 0; ct < 2; ++ct)
#pragma unroll
        for (int jj = 0; jj < 4; ++jj) ST[(ct * 16 + l15) * 72 + 16 * w + quad * 4 + jj] = f2bf(S[ct][jj]);
      __syncthreads();
      const bf16x8 ai0 = ldfrag(intra + (16 * w + l15) * 72 + quad * 8);
      const bf16x8 ai1 = ldfrag(intra + (16 * w + l15) * 72 + 32 + quad * 8);
      const bf16x8 ak0 = ldfrag(kT + (16 * w + l15) * 72 + quad * 8);
      const bf16x8 ak1 = ldfrag(kT + (16 * w + l15) * 72 + 32 + quad * 8);
#pragma unroll
      for (int ct = 0; ct < 2; ++ct) {
        bf16x8 bv0 = ldfrag(vT + (ct * 16 + l15) * 72 + quad * 8);
        bf16x8 bv1 = ldfrag(vT + (ct * 16 + l15) * 72 + 32 + quad * 8);
        bf16x8 bs0 = ldfrag(ST + (ct * 16 + l15) * 72 + quad * 8);
        bf16x8 bs1 = ldfrag(ST + (ct * 16 + l15) * 72 + 32 + quad * 8);
        f32x4 ci_ = (f32x4){0.f, 0.f, 0.f, 0.f}, cc = (f32x4){0.f, 0.f, 0.f, 0.f};
        ci_ = mfma16(ai0, bv0, ci_);
        ci_ = mfma16(ai1, bv1, ci_);
        cc = mfma16(a0, bs0, cc);
        cc = mfma16(a1, bs1, cc);
#pragma unroll
        for (int jj = 0; jj < 4; ++jj) {
          int i = 16 * w + quad * 4 + jj;
          int t = tb + (dir ? 63 - i : i);
          float o = ci_[jj] + expf(lg * (float)(i + 1)) * cc[jj];
          odir[((size_t)dir * NTOK + t) * 512 + h * 128 + sl * 32 + ct * 16 + l15] = o;
        }
        f32x4 s = S[ct];
        s[0] *= g64; s[1] *= g64; s[2] *= g64; s[3] *= g64;
        s = mfma16(ak0, bv0, s);
        s = mfma16(ak1, bv1, s);
        S[ct] = s;
      }
      __syncthreads();
    }
    if (!ci.lng) {
      float* so = p.out + 25165824 + ((((size_t)ci.sq * 2 + il) * 2 + dir) * 4 + h) * 8192;
#pragma unroll
      for (int ct = 0; ct < 2; ++ct)
#pragma unroll
        for (int jj = 0; jj < 4; ++jj) so[(16 * w + quad * 4 + jj) * 128 + sl * 32 + ct * 16 + l15] = S[ct][jj];
    }
  }
}

__device__ __forceinline__ void gdn_prep_item(const Params& p, int l, int pi, unsigned char* smem, int plvl) {
  const int il = l >> 1;
  bf16_t* ks = (bf16_t*)smem;
  bf16_t* vs = ks + 64 * 136;
  float* Am = (float*)(vs + 64 * 136);
  float* rq = Am + 4096;
  float* rk = rq + 64;
  float* gcs = rk + 64;
  float* bet = gcs + 64;
  float* fac = bet + 64;
  bf16_t* qs = (bf16_t*)(fac + 128);
  const bf16_t* P = (const bf16_t*)(p.ws + OFF_P);
  unsigned char* gp = p.ws + OFF_GPREP + (size_t)pi * GP_ITEM;
  bf16_t* Wb = (bf16_t*)gp;
  bf16_t* QG = Wb + 8192;
  bf16_t* KDT = QG + 8192;
  bf16_t* Ub = KDT + 8192;
  bf16_t* ATT = Ub + 8192;
  float* EGL = (float*)(p.ws + OFF_EGL);
  const int tid = opaque_tid(), lane = tid & 63, w = tid >> 6, quad = lane >> 4, l15 = lane & 15;
  const int dir = pi & 1, h = (pi >> 1) & 3, c = pi >> 3;
  int tb, seq_lo, seq_hi;
  if (c < 128) { tb = c * 64; seq_lo = (c >> 2) * 256; seq_hi = seq_lo + 256; }
  else { int cc = c - 128; tb = NPROMPT + cc * 64; seq_lo = NPROMPT + (cc >> 5) * 2048; seq_hi = seq_lo + 2048; }
  const float SCALE = 0.08838834764831845f;
  {
    const int cg_ = tid & 127, rh = tid >> 7;
#pragma unroll
    for (int mat = 0; mat < 3; ++mat) {
      const int col = mat * 512 + h * 128 + cg_;
      const float* cw = p.in[18] + (size_t)il * 3 * 1536 + col;
      const float w0 = cw[0], w1 = cw[1536], w2 = cw[3072];
      bf16_t* dst = mat == 0 ? qs : (mat == 1 ? ks : vs);
      const int t0 = tb + rh * 32;
      bf16_t raw[34];
#pragma unroll
      for (int o = 0; o < 34; ++o) {
        const int t = t0 - 1 + o;
        const int tc = min(max(t, seq_lo), seq_hi - 1);
        const bf16_t rv = P[(size_t)tc * PSTRIDE + col];
        raw[o] = (t == tc) ? rv : (bf16_t)0;
      }
#pragma unroll
      for (int o = 0; o < 32; ++o) {
        float y = w0 * bf2f(raw[o]) + w1 * bf2f(raw[o + 1]) + w2 * bf2f(raw[o + 2]);
        y = siluf(y);
        const int oi = rh * 32 + o;
        const int i = dir ? 63 - oi : oi;
        dst[i * 136 + cg_] = f2bf(y);
      }
    }
  }
  __syncthreads();
  if (plvl == 4) return;
  {
    const int r = tid >> 2, part = tid & 3;
    float sq_ = 0.f, sk_ = 0.f;
#pragma unroll 8
    for (int e = 0; e < 32; ++e) {
      float a = bf2f(qs[r * 136 + part * 32 + e]);
      float b = bf2f(ks[r * 136 + part * 32 + e]);
      sq_ += a * a; sk_ += b * b;
    }
    sq_ += __shfl_xor(sq_, 1); sq_ += __shfl_xor(sq_, 2);
    sk_ += __shfl_xor(sk_, 1); sk_ += __shfl_xor(sk_, 2);
    if (part == 0) {
      rq[r] = rsqrtf(sq_ + EPSV);
      rk[r] = rsqrtf(sk_ + EPSV);
      const int t = tb + (dir ? 63 - r : r);
      float a = bf2f(P[(size_t)t * PSTRIDE + 2048 + dir * 4 + h]);
      float bbv = bf2f(P[(size_t)t * PSTRIDE + 2056 + dir * 4 + h]);
      float al = p.in[19][(il * 2 + dir) * 4 + h], dtb = p.in[20][(il * 2 + dir) * 4 + h];
      float z = a + dtb;
      float sp = (z > 20.f) ? z : log1pf(expf(z));
      gcs[r] = -expf(al) * sp;
      bet[r] = 1.f / (1.f + expf(-bbv));
    }
  }
  __syncthreads();
  if (tid < 64) {
    float v = gcs[tid];
#pragma unroll
    for (int o = 1; o < 64; o <<= 1) {
      float u = __shfl_up(v, o);
      if (tid >= o) v += u;
    }
    gcs[tid] = v;
  }
  __syncthreads();
  {
    bf16x8 ak[4], aq[4];
#pragma unroll
    for (int kk = 0; kk < 4; ++kk) {
      ak[kk] = ldfrag(ks + (16 * w + l15) * 136 + kk * 32 + quad * 8);
      aq[kk] = ldfrag(qs + (16 * w + l15) * 136 + kk * 32 + quad * 8);
    }
#pragma unroll
    for (int ct = 0; ct < 4; ++ct) {
      f32x4 ckk = (f32x4){0.f, 0.f, 0.f, 0.f}, cqk = (f32x4){0.f, 0.f, 0.f, 0.f};
#pragma unroll
      for (int kk = 0; kk < 4; ++kk) {
        bf16x8 b = ldfrag(ks + (ct * 16 + l15) * 136 + kk * 32 + quad * 8);
        ckk = mfma16(ak[kk], b, ckk);
        cqk = mfma16(aq[kk], b, cqk);
      }
#pragma unroll
      for (int jj = 0; jj < 4; ++jj) {
        const int i = 16 * w + quad * 4 + jj, j = ct * 16 + l15;
        const float dec = (i >= j) ? __expf(gcs[i] - gcs[j]) : 0.f;
        Am[j * 64 + i] = (i > j) ? bet[i] * rk[i] * rk[j] * ckk[jj] * dec : 0.f;
        ATT[i * 64 + j] = f2bf((i >= j) ? SCALE * rq[i] * rk[j] * cqk[jj] * dec : 0.f);
      }
    }
  }
  __syncthreads();
  const float gl = gcs[63];
#pragma unroll 8
  for (int e = tid; e < 64 * 128; e += 256) {
    int i = e >> 7, d = e & 127;
    QG[e] = f2bf(bf2f(qs[i * 136 + d]) * rq[i] * SCALE * __expf(gcs[i]));
  }
#pragma unroll 8
  for (int e = tid; e < 128 * 64; e += 256) {
    int d = e >> 6, i = e & 63;
    KDT[e] = f2bf(bf2f(ks[i * 136 + d]) * rk[i] * __expf(gl - gcs[i]));
  }
  if (tid < 64) {
    fac[tid] = bet[tid];
    fac[64 + tid] = rk[tid] * bet[tid] * __expf(gcs[tid]);
  }
  __syncthreads();
  if (plvl != 3) {
    const int cidx = tid & 127;
    const bf16_t* srcm = ((tid < 128) ? vs : ks) + cidx;
    const float* fc = fac + ((tid < 128) ? 0 : 64);
    bf16_t* dstm = ((tid < 128) ? Ub : Wb) + cidx;
    bf16_t* XB = qs + tid;
#pragma unroll 1
    for (int b = 0; b < 4; ++b) {
      float x[16];
#pragma unroll
      for (int r = 0; r < 16; ++r) x[r] = bf2f(srcm[(16 * b + r) * 136]) * fc[16 * b + r];
      const float* arow = Am + 16 * b;
#pragma unroll 4
      for (int j = 0; j < 16 * b; ++j) {
        const float xv = bf2f(XB[j * 256]);
        const f32x4 a0 = *(const f32x4*)(arow + j * 64), a1 = *(const f32x4*)(arow + j * 64 + 4);
        const f32x4 a2 = *(const f32x4*)(arow + j * 64 + 8), a3 = *(const f32x4*)(arow + j * 64 + 12);
#pragma unroll
        for (int r = 0; r < 4; ++r) {
          x[r] -= a0[r] * xv; x[4 + r] -= a1[r] * xv; x[8 + r] -= a2[r] * xv; x[12 + r] -= a3[r] * xv;
        }
      }
      const float* ablk = Am + (16 * b) * 64 + 16 * b;
#pragma unroll
      for (int jj = 0; jj < 15; ++jj) {
#pragma unroll
        for (int r = jj + 1; r < 16; ++r) x[r] -= ablk[jj * 64 + r] * x[jj];
      }
#pragma unroll
      for (int r = 0; r < 16; ++r) {
        const bf16_t bb = f2bf(x[r]);
        dstm[(16 * b + r) * 128] = bb;
        if (b < 3) XB[(16 * b + r) * 256] = bb;
      }
    }
  }
  if (tid == 0) EGL[pi] = expf(gl);
  __syncthreads();
}

__device__ __forceinline__ void conf_conv_item(const Params& p, int l, int item, unsigned char* smem) {
  const int il = l >> 1;
  float* hc = (float*)smem;
  const bf16_t* P = (const bf16_t*)(p.ws + OFF_P);
  float* convout = (float*)(p.ws + OFF_CONV);
  const int tid = opaque_tid();
  const int tile = item >> 1, ch = (item & 1) * 256 + tid;
  const int t0 = tile * 32;
  int seq_lo, seq_hi;
  if (t0 < NPROMPT) { seq_lo = (t0 >> 8) << 8; seq_hi = seq_lo + 256; }
  else { seq_lo = NPROMPT + (((t0 - NPROMPT) >> 11) << 11); seq_hi = seq_lo + 2048; }
#pragma unroll 31
  for (int r = 0; r < 62; ++r) {
    const int tt = t0 - 15 + r;
    const int tc = min(max(tt, seq_lo), seq_hi - 1);
    float ca = bf2f(P[(size_t)tc * PSTRIDE + 2064 + ch]);
    float cgv = bf2f(P[(size_t)tc * PSTRIDE + 2576 + ch]);
    float v = ca * __builtin_amdgcn_rcpf(1.f + __expf(-cgv));
    hc[r * 256 + tid] = (tt == tc) ? v : 0.f;
  }
  float wk[31];
#pragma unroll
  for (int k = 0; k < 31; ++k) wk[k] = p.in[22][((size_t)il * 31 + k) * 512 + ch];
  const float bias = p.in[23][il * 512 + ch];
  for (int i = 0; i < 32; ++i) {
    float acc = bias;
#pragma unroll
    for (int k = 0; k < 31; ++k) acc += wk[k] * hc[(i + k) * 256 + tid];
    convout[(size_t)(t0 + i) * 512 + ch] = acc;
  }
}

__device__ __forceinline__ void phase_odd_prep(const Params& p, int l, unsigned char* smem, int rep) {
  for (int u = blockIdx.x; u < 3072 + 1536; u += gridDim.x) {
#if PROBE_ODD == 1 || PROBE_ODD >= 3
    if (rep && u >= 3072) break;
#elif PROBE_ODD == 2
    if (rep && u < 3072) continue;
#endif
    if (u < 3072) gdn_prep_item(p, l, u, smem, (PROBE_ODD >= 3 && rep) ? PROBE_ODD : 0);
    else { conf_conv_item(p, l, u - 3072, smem); __syncthreads(); }
  }
}

__device__ __forceinline__ void phase_gdn_chain(const Params& p, int l, unsigned char* smem) {
  const int il = l >> 1;
  bf16_t* ST = (bf16_t*)smem;
  bf16_t* VT = ST + 32 * 136;
  float* odir = (float*)(p.ws + OFF_ODIR);
  const float* EGL = (const float*)(p.ws + OFF_EGL);
  const int tid = opaque_tid(), lane = tid & 63, w = tid >> 6, quad = lane >> 4, l15 = lane & 15;
  const int nlb = (gridDim.x >= 512) ? 256 : ((gridDim.x >= 2) ? (int)(gridDim.x / 2) : 0);
  const bool longblk = (nlb > 0) ? ((int)blockIdx.x < nlb) : true;
  const int it_lo = (nlb > 0) ? (longblk ? (int)blockIdx.x : 256 + ((int)blockIdx.x - nlb)) : (int)blockIdx.x;
  const int it_hi = (nlb > 0) ? (longblk ? 256 : 1280) : 1280;
  const int it_st = (nlb > 0) ? (longblk ? nlb : ((int)gridDim.x - nlb)) : (int)gridDim.x;
  for (int it = it_lo; it < it_hi; it += it_st) {
    const ChainItem ci = decode_item(it);
    const int sl = ci.sl, dir = ci.dir, h = ci.h;
    f32x4 S[2][2];
    if (ci.lng) {
      const float* s0 = p.in[3] + ((((size_t)ci.sq * 2 + il) * 2 + dir) * 4 + h) * 16384;
#pragma unroll
      for (int rb = 0; rb < 2; ++rb)
#pragma unroll
        for (int ct = 0; ct < 2; ++ct)
#pragma unroll
          for (int jj = 0; jj < 4; ++jj)
            S[rb][ct][jj] = s0[(16 * (2 * w + rb) + quad * 4 + jj) * 128 + sl * 32 + ct * 16 + l15];
    } else {
#pragma unroll
      for (int rb = 0; rb < 2; ++rb)
#pragma unroll
        for (int ct = 0; ct < 2; ++ct) S[rb][ct] = (f32x4){0.f, 0.f, 0.f, 0.f};
    }
    bf16x8 naw[4], naqg[4];
    bf16_t nuu[2][4];
    float negl = 0.f;
    for (int n = 0; n < ci.nc; ++n) {
      const int cn = dir ? ci.nc - 1 - n : n;
      const int tb = ci.tok0 + cn * 64;
      const int cglob = ci.lng ? 128 + ci.sq * 32 + cn : ci.sq * 4 + cn;
      const int pi = (cglob * 4 + h) * 2 + dir;
      const unsigned char* gp = p.ws + OFF_GPREP + (size_t)pi * GP_ITEM;
      const bf16_t* Wb = (const bf16_t*)gp;
      const bf16_t* QG = Wb + 8192;
      const bf16_t* KDT = QG + 8192;
      const bf16_t* Ub = KDT + 8192;
      const bf16_t* ATT = Ub + 8192;
      bf16x8 aw[4], aqg[4], aat[2], akd[2][2];
      float uu[2][4];
      float egl;
      if (n == 0) {
#pragma unroll
        for (int kk = 0; kk < 4; ++kk) {
          aw[kk] = ldfrag(Wb + (16 * w + l15) * 128 + kk * 32 + quad * 8);
          aqg[kk] = ldfrag(QG + (16 * w + l15) * 128 + kk * 32 + quad * 8);
        }
#pragma unroll
        for (int kk = 0; kk < 2; ++kk) {
          aat[kk] = ldfrag(ATT + (16 * w + l15) * 64 + kk * 32 + quad * 8);
#pragma unroll
          for (int rb = 0; rb < 2; ++rb) akd[rb][kk] = ldfrag(KDT + (16 * (2 * w + rb) + l15) * 64 + kk * 32 + quad * 8);
        }
#pragma unroll
        for (int ct = 0; ct < 2; ++ct)
#pragma unroll
          for (int jj = 0; jj < 4; ++jj) uu[ct][jj] = bf2f(Ub[(16 * w + quad * 4 + jj) * 128 + sl * 32 + ct * 16 + l15]);
        egl = EGL[pi];
      } else {
#pragma unroll
        for (int kk = 0; kk < 4; ++kk) { aw[kk] = naw[kk]; aqg[kk] = naqg[kk]; }
#pragma unroll
        for (int kk = 0; kk < 2; ++kk) {
          aat[kk] = ldfrag(ATT + (16 * w + l15) * 64 + kk * 32 + quad * 8);
#pragma unroll
          for (int rb = 0; rb < 2; ++rb) akd[rb][kk] = ldfrag(KDT + (16 * (2 * w + rb) + l15) * 64 + kk * 32 + quad * 8);
        }
#pragma unroll
        for (int ct = 0; ct < 2; ++ct)
#pragma unroll
          for (int jj = 0; jj < 4; ++jj) uu[ct][jj] = bf2f(nuu[ct][jj]);
        egl = negl;
      }
      if (n + 1 < ci.nc) {
        const int cn2 = dir ? ci.nc - 2 - n : n + 1;
        const int cglob2 = ci.lng ? 128 + ci.sq * 32 + cn2 : ci.sq * 4 + cn2;
        const int pi2 = (cglob2 * 4 + h) * 2 + dir;
        const bf16_t* Wb2 = (const bf16_t*)(p.ws + OFF_GPREP + (size_t)pi2 * GP_ITEM);
        const bf16_t* QG2 = Wb2 + 8192; const bf16_t* Ub2 = QG2 + 16384;
#pragma unroll
        for (int kk = 0; kk < 4; ++kk) {
          naw[kk] = ldfrag(Wb2 + (16 * w + l15) * 128 + kk * 32 + quad * 8);
          naqg[kk] = ldfrag(QG2 + (16 * w + l15) * 128 + kk * 32 + quad * 8);
        }
#pragma unroll
        for (int ct = 0; ct < 2; ++ct)
#pragma unroll
          for (int jj = 0; jj < 4; ++jj) nuu[ct][jj] = Ub2[(16 * w + quad * 4 + jj) * 128 + sl * 32 + ct * 16 + l15];
        negl = EGL[pi2];
      }
#pragma unroll
      for (int rb = 0; rb < 2; ++rb)
#pragma unroll
        for (int ct = 0; ct < 2; ++ct)
#pragma unroll
          for (int jj = 0; jj < 4; ++jj)
            ST[(ct * 16 + l15) * 136 + 16 * (2 * w + rb) + quad * 4 + jj] = f2bf(S[rb][ct][jj]);
      __syncthreads();
      f32x4 co[2];
#pragma unroll
      for (int ct = 0; ct < 2; ++ct) {
        f32x4 cv = (f32x4){0.f, 0.f, 0.f, 0.f};
        co[ct] = (f32x4){0.f, 0.f, 0.f, 0.f};
#pragma unroll
        for (int kk = 0; kk < 4; ++kk) {
          bf16x8 b = ldfrag(ST + (ct * 16 + l15) * 136 + kk * 32 + quad * 8);
          cv = mfma16(aw[kk], b, cv);
          co[ct] = mfma16(aqg[kk], b, co[ct]);
        }
#pragma unroll
        for (int jj = 0; jj < 4; ++jj) {
          float vn = uu[ct][jj] - cv[jj];
          VT[(ct * 16 + l15) * 72 + 16 * w + quad * 4 + jj] = f2bf(vn);
        }
      }
      __syncthreads();
#pragma unroll
      for (int ct = 0; ct < 2; ++ct) {
        bf16x8 bv[2];
#pragma unroll
        for (int kk = 0; kk < 2; ++kk) {
          bv[kk] = ldfrag(VT + (ct * 16 + l15) * 72 + kk * 32 + quad * 8);
          co[ct] = mfma16(aat[kk], bv[kk], co[ct]);
        }
#pragma unroll
        for (int jj = 0; jj < 4; ++jj) {
          int i = 16 * w + quad * 4 + jj;
          int t = tb + (dir ? 63 - i : i);
          odir[((size_t)dir * NTOK + t) * 512 + h * 128 + sl * 32 + ct * 16 + l15] = co[ct][jj];
        }
#pragma unroll
        for (int rb = 0; rb < 2; ++rb) {
          f32x4 s = S[rb][ct];
          s[0] *= egl; s[1] *= egl; s[2] *= egl; s[3] *= egl;
          s = mfma16(akd[rb][0], bv[0], s);
          s = mfma16(akd[rb][1], bv[1], s);
          S[rb][ct] = s;
        }
      }
    }
    __syncthreads();
    if (!ci.lng) {
      float* so = p.out + 29360128 + ((((size_t)ci.sq * 2 + il) * 2 + dir) * 4 + h) * 16384;
#pragma unroll
      for (int rb = 0; rb < 2; ++rb)
#pragma unroll
        for (int ct = 0; ct < 2; ++ct)
#pragma unroll
          for (int jj = 0; jj < 4; ++jj)
            so[(16 * (2 * w + rb) + quad * 4 + jj) * 128 + sl * 32 + ct * 16 + l15] = S[rb][ct][jj];
    }
  }
}

__device__ __forceinline__ void phase_mix_out(const Params& p, int l) {
  const int il = l >> 1;
  const bool odd = l & 1;
  const int tid_ = opaque_tid(); const int lane = tid_ & 63, wv = tid_ >> 6;
  const bf16_t* P = (const bf16_t*)(p.ws + OFF_P);
  const float* od0 = (const float*)(p.ws + OFF_ODIR);
  const float* od1 = od0 + (size_t)NTOK * 512;
  const float* convout = (const float*)(p.ws + OFF_CONV);
  bf16_t* Y = (bf16_t*)(p.ws + OFF_YMIX);
  for (int t = blockIdx.x * 4 + wv; t < NTOK; t += gridDim.x * 4) {
    const bf16_t* pr = P + (size_t)t * PSTRIDE;
    bf16_t* yr = Y + (size_t)t * 1024;
#pragma unroll
    for (int h = 0; h < 4; ++h) {
      const int idx = h * 128 + lane * 2;
      float2 a = *(const float2*)(od0 + (size_t)t * 512 + idx);
      float2 b = *(const float2*)(od1 + (size_t)t * 512 + idx);
      float o0 = a.x + b.x, o1 = a.y + b.y;
      float ss = wave_sum(o0 * o0 + o1 * o1);
      float rs = rsqrtf(ss * (1.f / 128.f) + EPSV);
      float n0, n1;
      unsigned gz;
      if (!odd) {
        n0 = p.in[14][il * 512 + idx]; n1 = p.in[14][il * 512 + idx + 1];
        gz = *(const unsigned*)(pr + 1024 + idx);
      } else {
        n0 = p.in[21][il * 128 + lane * 2]; n1 = p.in[21][il * 128 + lane * 2 + 1];
        gz = *(const unsigned*)(pr + 1536 + idx);
      }
      float y0 = siluf(bflo(gz)) * o0 * rs * n0;
      float y1 = siluf(bfhi(gz)) * o1 * rs * n1;
      *(unsigned*)(yr + idx) = pack2(y0, y1);
    }
    if (!odd) {
      int seq_lo, seq_hi;
      if (t < NPROMPT) { seq_lo = (t >> 8) << 8; seq_hi = seq_lo + 256; }
      else { seq_lo = NPROMPT + (((t - NPROMPT) >> 11) << 11); seq_hi = seq_lo + 2048; }
      const bool hp = (t - 1 >= seq_lo), hn = (t + 1 < seq_hi);
#pragma unroll
      for (int j = 0; j < 4; ++j) {
        const int c = j * 128 + lane * 2;
        unsigned cg0 = *(const unsigned*)(pr + 2048 + c), hb0 = *(const unsigned*)(pr + 2560 + c);
        const bf16_t* prm = hp ? pr - PSTRIDE : pr;
        const bf16_t* prp = hn ? pr + PSTRIDE : pr;
        unsigned cgm = *(const unsigned*)(prm + 2048 + c), hbm = *(const unsigned*)(prm + 2560 + c);
        unsigned cgp = *(const unsigned*)(prp + 2048 + c), hbp = *(const unsigned*)(prp + 2560 + c);
        if (!hp) { cgm = 0; hbm = 0; }
        if (!hn) { cgp = 0; hbp = 0; }
        unsigned bg = *(const unsigned*)(pr + 1536 + c);
        const float* sw = p.in[15] + (size_t)il * 3 * 512 + c;
        float y0 = bflo(bg) * (sw[0] * bflo(cgm) * bflo(hbm) + sw[512] * bflo(cg0) * bflo(hb0) + sw[1024] * bflo(cgp) * bflo(hbp));
        float y1 = bfhi(bg) * (sw[1] * bfhi(cgm) * bfhi(hbm) + sw[513] * bfhi(cg0) * bfhi(hb0) + sw[1025] * bfhi(cgp) * bfhi(hbp));
        *(unsigned*)(yr + 512 + c) = pack2(y0, y1);
      }
    } else {
      float v[8];
      float s = 0.f;
#pragma unroll
      for (int j = 0; j < 4; ++j) {
        float2 a = *(const float2*)(convout + (size_t)t * 512 + j * 128 + lane * 2);
        v[2 * j] = a.x; v[2 * j + 1] = a.y;
        s += a.x + a.y;
      }
      const float mean = wave_sum(s) * (1.f / 512.f);
      float vs = 0.f;
#pragma unroll
      for (int j = 0; j < 8; ++j) { v[j] -= mean; vs += v[j] * v[j]; }
      const float rstd = rsqrtf(wave_sum(vs) * (1.f / 512.f) + EPSV);
#pragma unroll
      for (int j = 0; j < 4; ++j) {
        const int c = j * 128 + lane * 2;
        float y0 = v[2 * j] * rstd * p.in[24][il * 512 + c] + p.in[25][il * 512 + c];
        float y1 = v[2 * j + 1] * rstd * p.in[24][il * 512 + c + 1] + p.in[25][il * 512 + c + 1];
        *(unsigned*)(yr + 512 + c) = pack2(siluf(y0), siluf(y1));
      }
    }
  }
}

#define WAVE_LDS_SYNC() { asm volatile("s_waitcnt lgkmcnt(0)" ::: "memory"); __builtin_amdgcn_wave_barrier(); }
#define CE_DESC(a, b) { unsigned _mx = max(a, b), _mn = min(a, b); a = _mx; b = _mn; }
#define CE_ASC(a, b) { unsigned _mx = max(a, b), _mn = min(a, b); a = _mn; b = _mx; }
__device__ __forceinline__ void sort16_desc(unsigned* v) {
#pragma unroll
  for (int k = 2; k <= 16; k <<= 1) {
#pragma unroll
    for (int j = k >> 1; j > 0; j >>= 1) {
#pragma unroll
      for (int i = 0; i < 16; ++i) {
        const int l = i ^ j;
        if (l > i) {
          if ((i & k) == 0) CE_DESC(v[i], v[l]) else CE_ASC(v[i], v[l])
        }
      }
    }
  }
}
__device__ __forceinline__ void merge16_top(unsigned* a, const unsigned* b) {
#pragma unroll
  for (int i = 0; i < 16; ++i) a[i] = max(a[i], b[15 - i]);
#pragma unroll
  for (int j = 8; j > 0; j >>= 1) {
#pragma unroll
    for (int i = 0; i < 16; ++i) {
      const int l = i ^ j;
      if (l > i) CE_DESC(a[i], a[l])
    }
  }
}
__device__ __forceinline__ void phase_peer_score(const Params& p, int l, unsigned char* smem) {
  const int tid = opaque_tid(), lane = tid & 63, w = tid >> 6, quad = lane >> 4, l15 = lane & 15;
  unsigned* scw = (unsigned*)smem + w * (32 * 132 + 512);
  unsigned* sel = scw + 32 * 132;
  const bf16_t* Q = (const bf16_t*)(p.ws + OFF_Q);
  const bf16_t* KB = (const bf16_t*)(p.ws + OFF_KEYS) + (size_t)l * 8 * 2 * 128 * 128;
  int* EI = (int*)(p.ws + OFF_EIDX);
  float* GT = (float*)(p.ws + OFF_GATE);
  unsigned cab[13];
  {
    const int sub = lane & 3;
#pragma unroll
    for (int i = 0; i < 13; ++i) { const int cidx = sub + 4 * i; cab[i] = (unsigned)CAND_A[cidx] | ((unsigned)CAND_B[cidx] << 4); }
  }
  bf16x8 qa[2][4];
  if (blockIdx.x < 3072) {
    const int t0f = (blockIdx.x >> 1) * 16, hf_ = (blockIdx.x & 1) * 4 + w;
#pragma unroll
    for (int pp = 0; pp < 2; ++pp)
#pragma unroll
      for (int kk = 0; kk < 4; ++kk) qa[pp][kk] = ldfrag(Q + (size_t)(t0f + l15) * 2048 + hf_ * 256 + pp * 128 + kk * 32 + quad * 8);
  }
  for (int u = blockIdx.x; u < 3072; u += gridDim.x) {
    const int tt = u >> 1, h = (u & 1) * 4 + w;
    const int t0 = tt * 16;
#pragma unroll
    for (int pp = 0; pp < 2; ++pp) {
      bf16x8 a[4];
#pragma unroll
      for (int kk = 0; kk < 4; ++kk) a[kk] = qa[pp][kk];
      const bf16_t* kb = KB + (size_t)((h * 2 + pp) * 128) * 128;
#pragma unroll
      for (int ct = 0; ct < 8; ++ct) {
        f32x4 c = (f32x4){0.f, 0.f, 0.f, 0.f};
#pragma unroll
        for (int kk = 0; kk < 4; ++kk) {
          bf16x8 b = ldfrag(kb + (ct * 16 + l15) * 128 + kk * 32 + quad * 8);
          c = mfma16(a[kk], b, c);
        }
#pragma unroll
        for (int jj = 0; jj < 4; ++jj) {
          const int row = pp * 16 + quad * 4 + jj, col = ct * 16 + l15;
          unsigned key = (fkey(c[jj]) & ~127u) | (unsigned)(127 - col);
          scw[row * 132 + col] = key;
        }
      }
    }
    {
      const int un = u + gridDim.x;
      if (un < 3072) {
        const int t0n = (un >> 1) * 16, hn = (un & 1) * 4 + w;
#pragma unroll
        for (int pp = 0; pp < 2; ++pp)
#pragma unroll
          for (int kk = 0; kk < 4; ++kk) qa[pp][kk] = ldfrag(Q + (size_t)(t0n + l15) * 2048 + hn * 256 + pp * 128 + kk * 32 + quad * 8);
      }
    }
    WAVE_LDS_SYNC();
    {
      const int row = lane >> 1, hf = lane & 1;
      const u32x4* rp = (const u32x4*)(scw + row * 132 + hf * 64);
      unsigned g0[16], g1[16];
#pragma unroll
      for (int q = 0; q < 4; ++q) { u32x4 t4 = rp[q]; g0[4 * q] = t4[0]; g0[4 * q + 1] = t4[1]; g0[4 * q + 2] = t4[2]; g0[4 * q + 3] = t4[3]; }
#pragma unroll
      for (int q = 0; q < 4; ++q) { u32x4 t4 = rp[4 + q]; g1[4 * q] = t4[0]; g1[4 * q + 1] = t4[1]; g1[4 * q + 2] = t4[2]; g1[4 * q + 3] = t4[3]; }
      sort16_desc(g0);
      sort16_desc(g1);
      merge16_top(g0, g1);
#pragma unroll
      for (int q = 0; q < 4; ++q) { u32x4 t4 = rp[8 + q]; g1[4 * q] = t4[0]; g1[4 * q + 1] = t4[1]; g1[4 * q + 2] = t4[2]; g1[4 * q + 3] = t4[3]; }
      sort16_desc(g1);
      merge16_top(g0, g1);
#pragma unroll
      for (int q = 0; q < 4; ++q) { u32x4 t4 = rp[12 + q]; g1[4 * q] = t4[0]; g1[4 * q + 1] = t4[1]; g1[4 * q + 2] = t4[2]; g1[4 * q + 3] = t4[3]; }
      sort16_desc(g1);
      merge16_top(g0, g1);
#pragma unroll
      for (int i = 0; i < 16; ++i) g1[i] = (unsigned)__builtin_amdgcn_update_dpp(0, (int)g0[i], 0xB1, 0xF, 0xF, true);
      merge16_top(g0, g1);
      if (hf == 0) {
#pragma unroll
        for (int q = 0; q < 4; ++q) {
          u32x4 t4 = {g0[4 * q], g0[4 * q + 1], g0[4 * q + 2], g0[4 * q + 3]};
          *(u32x4*)(sel + row * 16 + 4 * q) = t4;
        }
      }
    }
    WAVE_LDS_SYNC();
    {
      const int tok = lane >> 2, sub = lane & 3;
      const unsigned* s1 = sel + tok * 16;
      const unsigned* s2 = sel + (16 + tok) * 16;
      unsigned ck[16];
#pragma unroll
      for (int i = 0; i < 13; ++i) {
        const int cidx = sub + 4 * i;
        const int a = cab[i] & 15, b = cab[i] >> 4;
        float s = keyf(s1[a] & ~127u) + keyf(s2[b] & ~127u);
        unsigned k = (fkey(s) & ~255u) | (unsigned)(255 - (a * 16 + b));
        ck[i] = (cidx < 50) ? k : 0u;
      }
      ck[13] = 0u; ck[14] = 0u; ck[15] = 0u;
      sort16_desc(ck);
      {
        unsigned g1[16];
#pragma unroll
        for (int i = 0; i < 16; ++i) g1[i] = (unsigned)__builtin_amdgcn_update_dpp(0, (int)ck[i], 0xB1, 0xF, 0xF, true);
        merge16_top(ck, g1);
#pragma unroll
        for (int i = 0; i < 16; ++i) g1[i] = (unsigned)__builtin_amdgcn_update_dpp(0, (int)ck[i], 0x4E, 0xF, 0xF, true);
        merge16_top(ck, g1);
      }
      const float mx = keyf(ck[0] & ~255u);
      float sv[4];
      int ev[4];
#pragma unroll
      for (int j = 0; j < 4; ++j) {
        const unsigned k0_ = ck[j], k1_ = ck[4 + j], k2_ = ck[8 + j], k3_ = ck[12 + j];
        const unsigned ka_ = (sub & 1) ? k1_ : k0_;
        const unsigned kb_ = (sub & 1) ? k3_ : k2_;
        const unsigned key = (sub & 2) ? kb_ : ka_;
        const int cidx = 255 - (int)(key & 255u);
        const int a = cidx >> 4, b = cidx & 15;
        const unsigned k1 = s1[a], k2 = s2[b];
        sv[j] = __expf(keyf(k1 & ~127u) + keyf(k2 & ~127u) - mx);
        ev[j] = (127 - (int)(k1 & 127u)) * 128 + (127 - (int)(k2 & 127u));
      }
      float sum = (sv[0] + sv[1]) + (sv[2] + sv[3]);
      sum += __uint_as_float((unsigned)__builtin_amdgcn_update_dpp(0, (int)__float_as_uint(sum), 0xB1, 0xF, 0xF, true));
      sum += __uint_as_float((unsigned)__builtin_amdgcn_update_dpp(0, (int)__float_as_uint(sum), 0x4E, 0xF, 0xF, true));
      const float inv = 1.f / sum;
      const size_t ob = (size_t)(t0 + tok) * 128 + h * 16 + sub * 4;
      *(int4*)(EI + ob) = make_int4(ev[0], ev[1], ev[2], ev[3]);
      *(float4*)(GT + ob) = make_float4(sv[0] * inv, sv[1] * inv, sv[2] * inv, sv[3] * inv);
    }
    WAVE_LDS_SYNC();
  }
}

__device__ __forceinline__ float gelu_tanh(float x) {
  return 0.5f * x * (1.f + tanhf(0.7978845608028654f * (x + 0.044715f * x * x * x)));
}
__device__ __forceinline__ float butterfly8(const float* d, int lane) {
  const bool b5 = lane & 32, b4 = lane & 16, b3 = lane & 8;
  float e4[4], e2[2], e1;
#pragma unroll
  for (int j = 0; j < 4; ++j) {
    float snd = b5 ? d[j] : d[j + 4];
    float kep = b5 ? d[j + 4] : d[j];
    e4[j] = kep + __shfl_xor(snd, 32);
  }
#pragma unroll
  for (int j = 0; j < 2; ++j) {
    float snd = b4 ? e4[j] : e4[j + 2];
    float kep = b4 ? e4[j + 2] : e4[j];
    e2[j] = kep + __shfl_xor(snd, 16);
  }
  {
    float snd = b3 ? e2[0] : e2[1];
    float kep = b3 ? e2[1] : e2[0];
    e1 = kep + __shfl_xor(snd, 8);
  }
  e1 += __shfl_xor(e1, 4);
  e1 += __shfl_xor(e1, 2);
  e1 += __shfl_xor(e1, 1);
  const int jj = lane & 7;
  const int srcl = ((jj >> 2) & 1) * 32 + ((jj >> 1) & 1) * 16 + (jj & 1) * 8;
  return __shfl(e1, srcl);
}
__device__ __forceinline__ void phase_peer_gather(const Params& p, int l, int dry, unsigned char* smem) {
  const int tid_ = opaque_tid(); const int lane = tid_ & 63, wv = tid_ >> 6;
  const bf16_t* H = (const bf16_t*)(p.ws + OFF_H);
  bf16_t* Hw = (bf16_t*)(p.ws + OFF_H);
  const unsigned char* UB = p.ws + OFF_UB + (size_t)l * 16384 * 512;
  const unsigned char* VB = p.ws + OFF_VB + (size_t)l * 16384 * 512;
  const int* EI = (const int*)(p.ws + OFF_EIDX);
  const float* GT = (const float*)(p.ws + OFF_GATE);
  const float* modv = (const float*)(p.ws + OFF_MOD);
  float* actw = (float*)smem + wv * (24 * 128);
  const int tstride = gridDim.x * 4, tfirst = blockIdx.x * 4 + wv;
  int ntok = (tfirst < NTOK) ? (NTOK - 1 - tfirst) / tstride + 1 : 0;
  if (ntok > 24) ntok = 24;
  for (int i = lane; i < ntok * 128; i += 64) actw[i] = 0.f;
  WAVE_LDS_SYNC();
  {
    const int q_ = lane >> 4, n_ = lane & 15;
    for (int kk = 0; kk < 8; ++kk) {
      const unsigned char* ubs = UB + (size_t)kk * (16384 * 64) + q_ * 16;
      int pe0 = 0, pe1 = 0; u32x4 pxa = {0u, 0u, 0u, 0u};
      if (ntok > 0) {
        pe0 = EI[(size_t)tfirst * 128 + lane]; pe1 = EI[(size_t)tfirst * 128 + 64 + lane];
        pxa = *(const u32x4*)(p.ws + OFF_H8 + (size_t)tfirst * 512 + kk * 64 + q_ * 16);
      }
      for (int ti = 0; ti < ntok; ++ti) {
        const int ev0 = pe0, ev1 = pe1;
        const u32x4 xa4 = pxa;
        if (ti + 1 < ntok) {
          const size_t tn = (size_t)(tfirst + (ti + 1) * tstride);
          pe0 = EI[tn * 128 + lane]; pe1 = EI[tn * 128 + 64 + lane];
          pxa = *(const u32x4*)(p.ws + OFF_H8 + tn * 512 + kk * 64 + q_ * 16);
        }
        u32x4 bq[8];
#pragma unroll
        for (int g = 0; g < 8; ++g) {
          const int e_ = __shfl((g < 4) ? ev0 : ev1, (g & 3) * 16 + n_);
          bq[g] = *(const u32x4*)(ubs + (size_t)e_ * 64);
        }
        const v8i32 aa = {(int)xa4[0], (int)xa4[1], (int)xa4[2], (int)xa4[3], 0, 0, 0, 0};
#pragma unroll
        for (int g = 0; g < 8; ++g) {
          const v8i32 bb = {(int)bq[g][0], (int)bq[g][1], (int)bq[g][2], (int)bq[g][3], 0, 0, 0, 0};
          f32x4 ac = (f32x4){0.f, 0.f, 0.f, 0.f};
          ac = __builtin_amdgcn_mfma_scale_f32_16x16x128_f8f6f4(aa, bb, ac, 4, 4, 0, 0, 0, 0);
          if (q_ == (g & 3)) actw[ti * 128 + g * 16 + n_] += ac[0];
        }
      }
    }
  }
  WAVE_LDS_SYNC();
  int ti_ = 0;
  uint4 nx0 = make_uint4(0, 0, 0, 0), nx1 = nx0; int nev0 = 0, nev1 = 0; float ngv0 = 0.f, ngv1 = 0.f;
  {
    const int tf = blockIdx.x * 4 + wv;
    if (tf < NTOK) {
      nx0 = *(const uint4*)(H + (size_t)tf * 1024 + lane * 16); nx1 = *(const uint4*)(H + (size_t)tf * 1024 + lane * 16 + 8);
      nev0 = EI[(size_t)tf * 128 + lane]; nev1 = EI[(size_t)tf * 128 + 64 + lane];
      ngv0 = GT[(size_t)tf * 128 + lane]; ngv1 = GT[(size_t)tf * 128 + 64 + lane];
    }
  }
  for (int t = blockIdx.x * 4 + wv; t < NTOK; t += gridDim.x * 4) {
    float xf[16];
    unpack8(nx0, xf);
    unpack8(nx1, xf + 8);
    f32x2 xf2[8], out2[8];
#pragma unroll
    for (int e = 0; e < 8; ++e) { xf2[e] = (f32x2){xf[2 * e], xf[2 * e + 1]}; out2[e] = (f32x2){0.f, 0.f}; }
    const int ev0 = nev0, ev1 = nev1;
    const float gv0 = ngv0, gv1 = ngv1;
    {
      const int tn = t + gridDim.x * 4;
      if (tn < NTOK) {
        nx0 = *(const uint4*)(H + (size_t)tn * 1024 + lane * 16); nx1 = *(const uint4*)(H + (size_t)tn * 1024 + lane * 16 + 8);
        nev0 = EI[(size_t)tn * 128 + lane]; nev1 = EI[(size_t)tn * 128 + 64 + lane];
        ngv0 = GT[(size_t)tn * 128 + lane]; ngv1 = GT[(size_t)tn * 128 + 64 + lane];
      }
    }
    float cacc0 = 0.f, cacc1 = 0.f, coef0 = 0.f, coef1 = 0.f;
    uint2 bufA[16], bufB[16], bufC[16];
    const f32x2 zero2_ = {(float)dry, (float)dry};
#define GLOAD(buf, bb) { \
      const unsigned char* tb_ = ((bb) < 8) ? UB : VB; \
      const int evv_ = (((bb) & 7) < 4) ? ev0 : ev1; \
      _Pragma("unroll") for (int j = 0; j < 16; ++j) { \
        const int e_ = __builtin_amdgcn_readlane(evv_, ((bb) & 3) * 16 + j); \
        buf[j] = *(const uint2*)(tb_ + (size_t)e_ * 512 + lane * 8); } }
#define GCOMP(buf, bb) { \
      if ((bb) < 8) { \
        float d_[16]; \
        _Pragma("unroll") for (int j = 0; j < 16; ++j) { \
          f32x2 uf_[8]; unpack16_fp4(buf[j].x, buf[j].y, uf_); \
          f32x2 sa_ = uf_[0] * xf2[0]; \
          if (PROBE_CVT) { f32x2 ug_[8]; \
            ug_[0] = __builtin_amdgcn_cvt_scalef32_pk_f32_fp4(buf[j].x, 2.0f, 0); ug_[1] = __builtin_amdgcn_cvt_scalef32_pk_f32_fp4(buf[j].x, 2.0f, 1); \
            ug_[2] = __builtin_amdgcn_cvt_scalef32_pk_f32_fp4(buf[j].x, 2.0f, 2); ug_[3] = __builtin_amdgcn_cvt_scalef32_pk_f32_fp4(buf[j].x, 2.0f, 3); \
            ug_[4] = __builtin_amdgcn_cvt_scalef32_pk_f32_fp4(buf[j].y, 2.0f, 0); ug_[5] = __builtin_amdgcn_cvt_scalef32_pk_f32_fp4(buf[j].y, 2.0f, 1); \
            ug_[6] = __builtin_amdgcn_cvt_scalef32_pk_f32_fp4(buf[j].y, 2.0f, 2); ug_[7] = __builtin_amdgcn_cvt_scalef32_pk_f32_fp4(buf[j].y, 2.0f, 3); \
            _Pragma("unroll") for (int q = 0; q < 8; ++q) sa_ = __builtin_elementwise_fma(ug_[q], zero2_, sa_); } \
          _Pragma("unroll") for (int q = 1; q < 8; ++q) sa_ = __builtin_elementwise_fma(uf_[q], xf2[q], sa_); \
          d_[j] = sa_.x + sa_.y; } \
        const float t0_ = butterfly8(d_, lane), t1_ = butterfly8(d_ + 8, lane); \
        const int k0_ = ((bb) & 3) * 16; \
        if (((bb) & 7) < 4) { if ((lane >> 3) == (k0_ >> 3)) cacc0 = t0_; if ((lane >> 3) == (k0_ >> 3) + 1) cacc0 = t1_; } \
        else { if ((lane >> 3) == (k0_ >> 3)) cacc1 = t0_; if ((lane >> 3) == (k0_ >> 3) + 1) cacc1 = t1_; } \
        if ((bb) == 7) { coef0 = gelu_tanh(cacc0 * (1.f / U_SCALE)) * gv0 * (1.f / V_SCALE); coef1 = gelu_tanh(cacc1 * (1.f / U_SCALE)) * gv1 * (1.f / V_SCALE); } \
      } else { \
        const float cfv_ = (((bb) & 7) < 4) ? coef0 : coef1; \
        _Pragma("unroll") for (int j = 0; j < 16; ++j) { \
          const float cf_ = __uint_as_float((unsigned)__builtin_amdgcn_readlane((int)__float_as_uint(cfv_), ((bb) & 3) * 16 + j)); \
          f32x2 vf_[8]; unpack16_fp4(buf[j].x, buf[j].y, vf_); \
          const f32x2 c2_ = {cf_, cf_}; \
          _Pragma("unroll") for (int q = 0; q < 8; ++q) out2[q] = __builtin_elementwise_fma(vf_[q], c2_, out2[q]); } \
      } }
#if GATHER_CHECK
    GLOAD(bufA, 0)
#pragma unroll
    for (int b = 0; b < 8; b += 2) {
      GLOAD(bufB, b + 1)
      GCOMP(bufA, b)
      if (b + 2 < 8) GLOAD(bufA, b + 2)
      GCOMP(bufB, b + 1)
    }
    const float vacc0 = cacc0, vacc1 = cacc1;
#endif
#if !GATHER_CHECK
    GLOAD(bufA, 8)
#endif
    cacc0 = actw[ti_ * 128 + lane] * (1.f / X_SCALE);
    cacc1 = actw[ti_ * 128 + 64 + lane] * (1.f / X_SCALE);
    ++ti_;
#if GATHER_CHECK
    {
      const bool bad0 = fabsf(cacc0 - vacc0) > 0.15f * fabsf(vacc0) + 45.f;
      const bool bad1 = fabsf(cacc1 - vacc1) > 0.15f * fabsf(vacc1) + 45.f;
      const unsigned long long m0 = __ballot(bad0), m1 = __ballot(bad1);
      if (__popcll(m0) + __popcll(m1) > 32) out2[0] = (f32x2){__builtin_nanf(""), __builtin_nanf("")};
    }
#endif
    coef0 = gelu_tanh(cacc0 * (1.f / U_SCALE)) * gv0 * (1.f / V_SCALE);
    coef1 = gelu_tanh(cacc1 * (1.f / U_SCALE)) * gv1 * (1.f / V_SCALE);
#if GATHER_CHECK
    GLOAD(bufA, 8)
#endif
    GLOAD(bufB, 9)
#pragma unroll
    for (int b = 8; b < 14; b += 3) {
      GLOAD(bufC, b + 2)
      GCOMP(bufA, b)
      GLOAD(bufA, b + 3)
      GCOMP(bufB, b + 1)
      GLOAD(bufB, b + 4)
      GCOMP(bufC, b + 2)
    }
    GCOMP(bufA, 14)
    GCOMP(bufB, 15)
#undef GLOAD
#undef GCOMP
    float out[16];
#pragma unroll
    for (int e = 0; e < 8; ++e) { out[2 * e] = out2[e].x; out[2 * e + 1] = out2[e].y; }
    const int m = tok_mod(t);
    const float* ga2 = modv + (size_t)(l * 9 + m) * 6144 + 5120;
    float* xr = p.out + (size_t)t * 1024 + lane * 16;
    float xn[16];
    float ss = 0.f;
#pragma unroll
    for (int q4 = 0; q4 < 4; ++q4) {
      float4 xv = *(const float4*)(xr + q4 * 4);
      float4 gg = *(const float4*)(ga2 + lane * 16 + q4 * 4);
      const int o = q4 * 4;
      xn[o + 0] = xv.x + gg.x * out[o + 0];
      xn[o + 1] = xv.y + gg.y * out[o + 1];
      xn[o + 2] = xv.z + gg.z * out[o + 2];
      xn[o + 3] = xv.w + gg.w * out[o + 3];
      ss += xn[o] * xn[o] + xn[o + 1] * xn[o + 1] + xn[o + 2] * xn[o + 2] + xn[o + 3] * xn[o + 3];
    }
    ss = wave_sum(ss);
    const float rs = rsqrtf(ss * (1.f / 1024.f) + EPSV);
    if (dry) continue;
    if (l < 3) {
      const float* md = modv + (size_t)((l + 1) * 9 + m) * 6144 + lane * 16;
      const float* g = p.in[8] + (l + 1) * 1024 + lane * 16;
      float hv[16];
#pragma unroll
      for (int q = 0; q < 16; ++q) hv[q] = xn[q] * rs * g[q] * (1.f + md[1024 + q]) + md[q];
      uint4 o;
      o.x = pack2(hv[0], hv[1]); o.y = pack2(hv[2], hv[3]); o.z = pack2(hv[4], hv[5]); o.w = pack2(hv[6], hv[7]);
      *(uint4*)(Hw + (size_t)t * 1024 + lane * 16) = o;
      o.x = pack2(hv[8], hv[9]); o.y = pack2(hv[10], hv[11]); o.z = pack2(hv[12], hv[13]); o.w = pack2(hv[14], hv[15]);
      *(uint4*)(Hw + (size_t)t * 1024 + lane * 16 + 8) = o;
#pragma unroll
      for (int q4 = 0; q4 < 4; ++q4) *(float4*)(xr + q4 * 4) = make_float4(xn[q4 * 4], xn[q4 * 4 + 1], xn[q4 * 4 + 2], xn[q4 * 4 + 3]);
    } else {
      const float* g = p.in[10] + lane * 16;
#pragma unroll
      for (int q4 = 0; q4 < 4; ++q4)
        *(float4*)(xr + q4 * 4) = make_float4(xn[q4 * 4] * rs * g[q4 * 4], xn[q4 * 4 + 1] * rs * g[q4 * 4 + 1],
                                              xn[q4 * 4 + 2] * rs * g[q4 * 4 + 2], xn[q4 * 4 + 3] * rs * g[q4 * 4 + 3]);
    }
  }
}

#define XB_TMO      128
#define XB_XCNT(j)  (256  + 64 * (j))
#define XB_XSUB(j)  (1280 + 64 * (j))
#define XB_XGEN(j)  (2304 + 64 * (j))
#define XB_TOP      3328
#define XB_TOPGEN   3392
#define XCD_BAR_WORDS 3456
#define XB_SPIN_CAP (1u << 18)
#define LAS __attribute__((address_space(3)))

__device__ __forceinline__ unsigned xb_ld(unsigned* p)              { return __hip_atomic_load(p, __ATOMIC_RELAXED, __HIP_MEMORY_SCOPE_AGENT); }
__device__ __forceinline__ unsigned xb_add(unsigned* p, unsigned v) { return __hip_atomic_fetch_add(p, v, __ATOMIC_RELAXED, __HIP_MEMORY_SCOPE_AGENT); }
__device__ __forceinline__ unsigned xb_xcc_id() { return (unsigned)__builtin_amdgcn_s_getreg((3 << 11) | 20) & 0xFu; }
#define XB_SPIN(cond, bar) do { unsigned _sp = 0; while (cond) { __builtin_amdgcn_s_sleep(1); \
    if ((++_sp & 255u) == 0u) { if (xb_ld(&(bar)[XB_TMO])) break; if (_sp > XB_SPIN_CAP) { atomicAdd(&(bar)[XB_TMO], 1u); break; } } } } while (0)

struct XcdBarrier {
    unsigned* bar; unsigned x;
    volatile LAS unsigned* st;
};

__device__ __forceinline__ XcdBarrier xcd_barrier_post(unsigned* bar, volatile LAS unsigned* st) {
    XcdBarrier b; b.bar = bar; b.x = xb_xcc_id(); b.st = st;
    if (threadIdx.x == 0) (void)xb_add(&bar[XB_XCNT(b.x)], 1u);
    return b;
}
__device__ __forceinline__ void xcd_barrier_complete(unsigned* bar, unsigned x, unsigned& nloc, unsigned& nx) {
    const unsigned G = gridDim.x * gridDim.y * gridDim.z;
    unsigned sum, cnt, mine, sp = 0u;
    for (;;) {
        sum = 0u; cnt = 0u; mine = 0u;
#pragma unroll
        for (unsigned j = 0; j < 16; ++j) { const unsigned c = xb_ld(&bar[XB_XCNT(j)]); sum += c; cnt += (c > 0u) ? 1u : 0u; mine = (j == x) ? c : mine; }
        if (sum == G) break;
        __builtin_amdgcn_s_sleep(1);
        if ((++sp & 255u) == 0u) { if (xb_ld(&bar[XB_TMO])) break; if (sp > XB_SPIN_CAP) { atomicAdd(&bar[XB_TMO], 1u); break; } }
    }
    nloc = mine > 0u ? mine : 1u; nx = cnt > 0u ? cnt : 1u;
}

__device__ __forceinline__ void xcd_barrier(const XcdBarrier& b) {
    asm volatile("s_waitcnt vmcnt(0)" ::: "memory");
    __syncthreads();
    if (threadIdx.x == 0) {
        unsigned* bar = b.bar;
        __builtin_amdgcn_s_waitcnt(0);
        unsigned nloc = b.st[0], nx = b.st[1];
        if (nloc == 0u) { xcd_barrier_complete(bar, b.x, nloc, nx); b.st[0] = nloc; b.st[1] = nx; }
        const unsigned old = xb_add(&bar[XB_XSUB(b.x)], 1u);
        const unsigned gen = old / nloc;
        if (old + 1u == (gen + 1u) * nloc) {
            __builtin_amdgcn_fence(__ATOMIC_RELEASE, "agent");
            asm volatile("s_waitcnt vmcnt(0)" ::: "memory");
            const unsigned og = xb_add(&bar[XB_TOP], 1u);
            const unsigned tg = og / nx;
            if (og + 1u == (tg + 1u) * nx) xb_add(&bar[XB_TOPGEN], 1u);
            else XB_SPIN(xb_ld(&bar[XB_TOPGEN]) == tg, bar);
            __builtin_amdgcn_fence(__ATOMIC_ACQUIRE, "agent");
            xb_add(&bar[XB_XGEN(b.x)], 1u);
            asm volatile("s_waitcnt vmcnt(0)" ::: "memory");
        } else {
            XB_SPIN(xb_ld(&bar[XB_XGEN(b.x)]) == gen, bar);
            __builtin_amdgcn_fence(__ATOMIC_ACQUIRE, "agent");
            asm volatile("s_waitcnt vmcnt(0)" ::: "memory");
        }
    }
    __syncthreads();
}

__global__ void __launch_bounds__(256, 2) mega(Params p, int ph_lo, int ph_hi) {
  __shared__ __attribute__((aligned(16))) unsigned char smem[77312];
  cg::grid_group grid = cg::this_grid();
  __shared__ uint4 xb_words;
  if (threadIdx.x == 0) xb_words = make_uint4(0u, 0u, 0u, 0u);
  __syncthreads();
  XcdBarrier xb = xcd_barrier_post((unsigned*)(p.ws + OFF_BAR), (volatile LAS unsigned*)&xb_words);
  if (ph_hi > 100000) grid.sync();
  for (int ph = ph_lo; ph < ph_hi; ++ph) {
#if PROBE_MASK
    const int pcode = ph < 2 ? ph : 2 + (ph - 2) % 9;
    const int nrep = ((PROBE_MASK >> pcode) & 1) ? 2 : 1;
    for (int rep = 0; rep < nrep; ++rep) {
    if (rep) xcd_barrier(xb);
#endif
    bool did = true;
#if PROBE_MASK
    const int prep_rep = rep; const int nrep_ = nrep;
#else
    const int prep_rep = 0; const int nrep_ = 1;
#endif
    if (ph == 0) phase_prep_a(p, smem);
    else if (ph == 1) phase_prep_b(p);
    else {
      const int l = (ph - 2) / 9, sub = (ph - 2) % 9;
      const int il = l >> 1;
      const bool odd = l & 1;
      const float* modv = (const float*)(p.ws + OFF_MOD);
      if (sub == 0 || sub == 6) {
        const bf16_t* Bt; int ntn, ldc; bf16_t* C;
        if (sub == 0) {
          Bt = odd ? (const bf16_t*)(p.ws + OFF_WIN_OD) + (size_t)il * 3328 * 1024
                   : (const bf16_t*)(p.ws + OFF_WIN_EV) + (size_t)il * 3072 * 1024;
          ntn = odd ? 13 : 12; ldc = PSTRIDE; C = (bf16_t*)(p.ws + OFF_P);
        } else {
          Bt = (const bf16_t*)(p.ws + OFF_WQ) + (size_t)l * 2048 * 1024;
          ntn = 8; ldc = 2048; C = (bf16_t*)(p.ws + OFF_Q);
        }
        gemm_phase<0, 8, 32>((const bf16_t*)(p.ws + OFF_H), Bt, ntn, C, ldc, nullptr, nullptr, smem);
      } else if (sub == 1) {
        if (odd) phase_odd_prep(p, l, smem, prep_rep); else did = false;
      } else if (sub == 2) {
        if (odd) phase_gdn_chain(p, l, smem); else phase_ret_chain(p, l, smem);
      } else if (sub == 3) {
        phase_mix_out(p, l);
      } else if (sub == 4) {
        gemm_phase<1, 4, 64>((const bf16_t*)(p.ws + OFF_YMIX), (const bf16_t*)(p.ws + OFF_WOUT) + (size_t)l * 1024 * 1024, 8,
                      nullptr, 0, p.out, modv + (size_t)l * 9 * 6144 + 2048, smem, (nrep_ > 1 && prep_rep == 0) ? 1 : 0);
      } else if (sub == 5) {
        phase_norm2(p, l);
      } else if (sub == 7) {
        phase_peer_score(p, l, smem);
      } else {
        phase_peer_gather(p, l, (nrep_ > 1 && prep_rep == 0) ? 1 : 0, smem);
      }
    }
#if PROBE_MASK
    if (rep + 1 < nrep) continue;
#endif
    if (did && ph + 1 < ph_hi) xcd_barrier(xb);
#if PROBE_MASK
    }
#endif
  }
}

extern "C" void kernel_launch(void* const* d_in, const int* in_sizes, int n_in, void* d_out, int out_size,
                              void* d_ws, size_t ws_size, hipStream_t stream) {
  static int grid_blocks = 0;
  if (!grid_blocks) {
    int dev = 0, cus = 0, per_cu = 0;
    (void)hipGetDevice(&dev);
    (void)hipDeviceGetAttribute(&cus, hipDeviceAttributeMultiprocessorCount, dev);
    (void)hipOccupancyMaxActiveBlocksPerMultiprocessor(&per_cu, mega, 256, 0);
    if (per_cu < 1) per_cu = 1;
    if (per_cu > 2) per_cu = 2;
    grid_blocks = cus * per_cu;
    if (ws_size < WS_NEED) fprintf(stderr, "kernel_launch: workspace too small: %zu < %zu\n", ws_size, (size_t)WS_NEED);
  }
  Params p{};
  for (int i = 0; i < 30; ++i) p.in[i] = (const float*)d_in[i];
  p.out = (float*)d_out;
  p.ws = (unsigned char*)d_ws;
  (void)hipMemsetAsync((unsigned char*)d_ws + OFF_BAR, 0, XCD_BAR_WORDS * sizeof(unsigned), stream);
#if SINGLE_LAUNCH
  int lo = 0, hi = NPHASE;
  void* args[] = {&p, &lo, &hi};
  hipError_t e = hipLaunchCooperativeKernel((void*)mega, dim3(grid_blocks), dim3(256), args, 0, stream);
  if (e != hipSuccess) fprintf(stderr, "cooperative launch failed: %s (grid %d)\n", hipGetErrorString(e), grid_blocks);
#else
  for (int ph = 0; ph < NPHASE; ++ph) {
    const int l = (ph - 2) / 9, sub = (ph - 2) % 9;
    if (ph >= 2 && sub == 1 && !(l & 1)) continue;
    hipLaunchKernelGGL(mega, dim3(grid_blocks), dim3(256), 0, stream, p, ph, ph + 1);
  }
#endif
}
```

```cpp
#include <hip/hip_runtime.h>
#include <hip/hip_cooperative_groups.h>
#include <cstdio>
namespace cg = cooperative_groups;

#ifndef PROBE_MASK
#define PROBE_MASK 0
#endif
#ifndef GATHER_CHECK
#define GATHER_CHECK 0
#endif
#ifndef PROBE_CVT
#define PROBE_CVT 0
#endif
#ifndef PROBE_ODD
#define PROBE_ODD 0
#endif
#ifndef SINGLE_LAUNCH
#define SINGLE_LAUNCH 1
#endif

typedef unsigned short bf16_t;
using bf16x8 = __attribute__((ext_vector_type(8))) short;
using f32x4 = __attribute__((ext_vector_type(4))) float;
using f32x2 = __attribute__((ext_vector_type(2))) float;
using u32x4 = __attribute__((ext_vector_type(4))) unsigned;
using v8i32 = __attribute__((ext_vector_type(8))) int;

#define NTOK 24576
#define NPROMPT 8192
#define PSTRIDE 3200
#define EPSV 1e-6f
#define NPHASE 38
#define WQ_SCALE 32.f
#define X_SCALE 1.5f

constexpr size_t OFF_MOD = 0;
constexpr size_t OFF_ROPE = 1u << 20;
constexpr size_t OFF_WIN_EV = OFF_ROPE + 65536;
constexpr size_t OFF_WIN_OD = OFF_WIN_EV + 2ull * 3072 * 1024 * 2;
constexpr size_t OFF_WOUT = OFF_WIN_OD + 2ull * 3328 * 1024 * 2;
constexpr size_t OFF_WQ = OFF_WOUT + 4ull * 1024 * 1024 * 2;
constexpr size_t OFF_KEYS = OFF_WQ + 4ull * 2048 * 1024 * 2;
constexpr size_t OFF_UB = OFF_KEYS + 4ull * 8 * 2 * 128 * 128 * 2;
constexpr size_t OFF_VB = OFF_UB + 4ull * 16384 * 1024 * 2;
constexpr size_t OFF_H = OFF_VB + 4ull * 16384 * 1024 * 2;
constexpr size_t OFF_P = OFF_H + (size_t)NTOK * 1024 * 2;
constexpr size_t OFF_YMIX = OFF_P + (size_t)NTOK * PSTRIDE * 2;
constexpr size_t OFF_ODIR = OFF_YMIX + (size_t)NTOK * 1024 * 2;
constexpr size_t OFF_Q = OFF_ODIR;
constexpr size_t OFF_EIDX = OFF_ODIR + 2ull * NTOK * 512 * 4;
constexpr size_t OFF_GATE = OFF_EIDX + (size_t)NTOK * 128 * 4;
constexpr size_t GP_ITEM = 73728;
constexpr size_t OFF_GPREP = OFF_GATE + (size_t)NTOK * 128 * 4;
constexpr size_t OFF_EGL = OFF_GPREP + 3072ull * GP_ITEM;
constexpr size_t OFF_CONV = OFF_EGL + 16384;
constexpr size_t OFF_H8 = OFF_CONV;
constexpr size_t OFF_H8F = OFF_CONV + (16u << 20);
constexpr size_t OFF_BAR = OFF_CONV + (size_t)NTOK * 512 * 4;
constexpr size_t WS_NEED = OFF_BAR + 16384;

struct Params {
  const float* in[30];
  float* out;
  unsigned char* ws;
};

__device__ const unsigned char CAND_A[52] = {0,0,0,0,0,0,0,0,0,0,0,0,0,0,0,0,1,1,1,1,1,1,1,1,2,2,2,2,2,3,3,3,3,4,4,4,5,5,6,6,7,7,8,9,10,11,12,13,14,15,0,0};
__device__ const unsigned char CAND_B[52] = {0,1,2,3,4,5,6,7,8,9,10,11,12,13,14,15,0,1,2,3,4,5,6,7,0,1,2,3,4,0,1,2,3,0,1,2,0,1,0,1,0,1,0,0,0,0,0,0,0,0,0,0};

__device__ __forceinline__ int opaque_tid() { int t = threadIdx.x; asm volatile("" : "+v"(t)); return t; }
typedef __bf16 hbf16x2 __attribute__((ext_vector_type(2)));
__device__ __forceinline__ bf16_t f2bf(float f) {
  return __builtin_bit_cast(unsigned short, (__bf16)f);
}
__device__ __forceinline__ float bf2f(bf16_t b) { return __uint_as_float(((unsigned)b) << 16); }
__device__ __forceinline__ float bflo(unsigned u) { return __uint_as_float(u << 16); }
__device__ __forceinline__ float bfhi(unsigned u) { return __uint_as_float(u & 0xffff0000u); }
__device__ __forceinline__ unsigned pack2(float a, float b) {
  f32x2 v = {a, b};
  return __builtin_bit_cast(unsigned, __builtin_convertvector(v, hbf16x2));
}
__device__ __forceinline__ float wave_sum(float v) {
#pragma unroll
  for (int o = 32; o > 0; o >>= 1) v += __shfl_xor(v, o);
  return v;
}
__device__ __forceinline__ f32x4 mfma16(bf16x8 a, bf16x8 b, f32x4 c) {
  return __builtin_amdgcn_mfma_f32_16x16x32_bf16(a, b, c, 0, 0, 0);
}
__device__ __forceinline__ bf16x8 ldfrag(const bf16_t* p) { return *(const bf16x8*)p; }
__device__ __forceinline__ float siluf(float v) { return v * __builtin_amdgcn_rcpf(1.f + __expf(-v)); }
__device__ __forceinline__ int tok_mod(int t) { return t < NPROMPT ? 0 : 1 + ((t - NPROMPT) >> 11); }
__device__ __forceinline__ unsigned fkey(float f) {
  const unsigned u = __float_as_uint(f);
  return u ^ ((unsigned)((int)u >> 31) | 0x80000000u);
}
__device__ __forceinline__ float keyf(unsigned k) {
  unsigned b = (k & 0x80000000u) ? (k ^ 0x80000000u) : ~k;
  return __uint_as_float(b);
}
__device__ __forceinline__ void unpack8(uint4 v, float* f) {
  f[0] = bflo(v.x); f[1] = bfhi(v.x); f[2] = bflo(v.y); f[3] = bfhi(v.y);
  f[4] = bflo(v.z); f[5] = bfhi(v.z); f[6] = bflo(v.w); f[7] = bfhi(v.w);
}

__device__ __forceinline__ void prep_mod(const Params& p, float* smem) {
  float* sc = smem;
  float* red = smem + 9 * 1024;
  const int tid = opaque_tid();
  const float* c = p.in[4];
  const float* cctx = p.in[5];
  for (int i = tid; i < 9 * 1024; i += 256) {
    int m = i >> 10, k = i & 1023;
    float v = (m == 0) ? cctx[k] : c[(m - 1) * 1024 + k];
    sc[i] = v / (1.f + expf(-v));
  }
  __syncthreads();
  float* modv = (float*)(p.ws + OFF_MOD);
  const int cl = tid & 63, kg = tid >> 6;
  for (int u = blockIdx.x; u < 4 * 96; u += gridDim.x) {
    const int l = u / 96, nb = (u % 96) * 64;
    const float* W = p.in[6] + (size_t)l * 1024 * 6144 + nb + cl;
    float acc[9];
#pragma unroll
    for (int m = 0; m < 9; ++m) acc[m] = 0.f;
#pragma unroll 16
    for (int k = kg * 256; k < kg * 256 + 256; ++k) {
      float w = W[(size_t)k * 6144];
#pragma unroll
      for (int m = 0; m < 9; ++m) acc[m] += sc[m * 1024 + k] * w;
    }
#pragma unroll
    for (int m = 0; m < 9; ++m) red[(kg * 9 + m) * 64 + cl] = acc[m];
    __syncthreads();
    for (int i = tid; i < 9 * 64; i += 256) {
      int m = i >> 6, c2 = i & 63;
      float s = red[(0 * 9 + m) * 64 + c2] + red[(1 * 9 + m) * 64 + c2] + red[(2 * 9 + m) * 64 + c2] + red[(3 * 9 + m) * 64 + c2];
      int nn = nb + c2;
      modv[(size_t)(l * 9 + m) * 6144 + nn] = s + p.in[7][l * 6144 + nn];
    }
    __syncthreads();
  }
}

__device__ __forceinline__ void prep_transpose(const float* src, bf16_t* dst, int N, int Npad, float* tile, unsigned char* dst8 = nullptr, float scale8 = 1.f) {
  const int tid = opaque_tid();
  const int ntn = Npad / 64;
  const int units = ntn * 16;
  for (int u = blockIdx.x; u < units; u += gridDim.x) {
    const int nt = u % ntn, kt = u / ntn;
    const int n0 = nt * 64, k0 = kt * 64;
    {
      const int c = tid & 63;
      const int n = n0 + c;
      const int nc = n < N ? n : N - 1;
      float tv[16];
#pragma unroll
      for (int i = 0; i < 16; ++i) tv[i] = src[(size_t)(k0 + (tid >> 6) + 4 * i) * N + nc];
#pragma unroll
      for (int i = 0; i < 16; ++i) tile[((tid >> 6) + 4 * i) * 65 + c] = (n < N) ? tv[i] : 0.f;
    }
    __syncthreads();
#pragma unroll 4
    for (int i = 0; i < 16; ++i) {
      int rr = (tid >> 6) + 4 * i, cc = tid & 63;
      if (dst8) dst8[(size_t)(n0 + rr) * 1024 + k0 + cc] = (unsigned char)__builtin_amdgcn_cvt_pk_fp8_f32(tile[cc * 65 + rr] * scale8, 0.f, 0, false);
      else dst[(size_t)(n0 + rr) * 1024 + k0 + cc] = f2bf(tile[cc * 65 + rr]);
    }
    __syncthreads();
  }
}

__device__ __forceinline__ void prep_convert(const float* src, bf16_t* dst, size_t n4) {
  const size_t stride = (size_t)gridDim.x * 256;
  for (size_t i0 = (size_t)blockIdx.x * 256 + opaque_tid(); i0 < n4; i0 += stride * 8) {
    float4 v[8];
#pragma unroll
    for (int j = 0; j < 8; ++j) { const size_t i = i0 + j * stride; const size_t ic = i < n4 ? i : n4 - 1; v[j] = ((const float4*)src)[ic]; }
#pragma unroll
    for (int j = 0; j < 8; ++j) {
      const size_t i = i0 + j * stride;
      if (i < n4) { uint2 o; o.x = pack2(v[j].x, v[j].y); o.y = pack2(v[j].z, v[j].w); ((uint2*)dst)[i] = o; }
    }
  }
}

__device__ __forceinline__ void prep_convert_fp8(const float* src, unsigned* dst, size_t n4, float scale) {
  const size_t stride = (size_t)gridDim.x * 256;
  for (size_t i0 = (size_t)blockIdx.x * 256 + opaque_tid(); i0 < n4; i0 += stride * 8) {
    float4 v[8];
#pragma unroll
    for (int j = 0; j < 8; ++j) { const size_t i = i0 + j * stride; const size_t ic = i < n4 ? i : n4 - 1; f32x4 t4 = __builtin_nontemporal_load((const f32x4*)src + ic); v[j] = make_float4(t4[0], t4[1], t4[2], t4[3]); }
#pragma unroll
    for (int j = 0; j < 8; ++j) {
      const size_t i = i0 + j * stride;
      if (i < n4) {
        unsigned w = __builtin_amdgcn_cvt_pk_fp8_f32(v[j].x * scale, v[j].y * scale, 0, false);
        w = __builtin_amdgcn_cvt_pk_fp8_f32(v[j].z * scale, v[j].w * scale, w, true);
        dst[i] = w;
      }
    }
  }
}
__device__ __forceinline__ void prep_convert_fp4(const float* src, unsigned* dst, size_t n8, float scale, int W) {
  const size_t stride = (size_t)gridDim.x * 256;
  for (size_t i0 = (size_t)blockIdx.x * 256 + opaque_tid(); i0 < n8; i0 += stride * 4) {
    f32x4 va[4], vb[4];
#pragma unroll
    for (int j = 0; j < 4; ++j) {
      const size_t i = i0 + j * stride; const size_t ic = i < n8 ? i : n8 - 1;
      va[j] = __builtin_nontemporal_load((const f32x4*)src + 2 * ic);
      vb[j] = __builtin_nontemporal_load((const f32x4*)src + 2 * ic + 1);
    }
#pragma unroll
    for (int j = 0; j < 4; ++j) {
      const size_t i = i0 + j * stride;
      if (i < n8) {
        unsigned w = 0;
        w = __builtin_amdgcn_cvt_scalef32_pk_fp4_f32(w, va[j][0] * scale, va[j][1] * scale, 1.0f, 0);
        w = __builtin_amdgcn_cvt_scalef32_pk_fp4_f32(w, va[j][2] * scale, va[j][3] * scale, 1.0f, 1);
        w = __builtin_amdgcn_cvt_scalef32_pk_fp4_f32(w, vb[j][0] * scale, vb[j][1] * scale, 1.0f, 2);
        w = __builtin_amdgcn_cvt_scalef32_pk_fp4_f32(w, vb[j][2] * scale, vb[j][3] * scale, 1.0f, 3);
        const size_t el = i * 8;
        const size_t lay = el >> 24, e = (el >> 10) & 16383, d0 = el & 1023;
        const size_t off = lay * (16384ull * 512) + (d0 / W) * (16384ull * (W / 2)) + e * (W / 2) + ((d0 % W) >> 1);
        *(unsigned*)((unsigned char*)dst + off) = w;
      }
    }
  }
}
__device__ __forceinline__ void unpack16_fp4(unsigned w0, unsigned w1, f32x2* f) {
  f[0] = __builtin_amdgcn_cvt_scalef32_pk_f32_fp4(w0, 1.0f, 0);
  f[1] = __builtin_amdgcn_cvt_scalef32_pk_f32_fp4(w0, 1.0f, 1);
  f[2] = __builtin_amdgcn_cvt_scalef32_pk_f32_fp4(w0, 1.0f, 2);
  f[3] = __builtin_amdgcn_cvt_scalef32_pk_f32_fp4(w0, 1.0f, 3);
  f[4] = __builtin_amdgcn_cvt_scalef32_pk_f32_fp4(w1, 1.0f, 0);
  f[5] = __builtin_amdgcn_cvt_scalef32_pk_f32_fp4(w1, 1.0f, 1);
  f[6] = __builtin_amdgcn_cvt_scalef32_pk_f32_fp4(w1, 1.0f, 2);
  f[7] = __builtin_amdgcn_cvt_scalef32_pk_f32_fp4(w1, 1.0f, 3);
}
__device__ __forceinline__ void unpack16_fp8(u32x4 v, float* f) {
#pragma unroll
  for (int i = 0; i < 4; ++i) {
    f32x2 lo = __builtin_amdgcn_cvt_pk_f32_fp8(v[i], false);
    f32x2 hi = __builtin_amdgcn_cvt_pk_f32_fp8(v[i], true);
    f[4 * i + 0] = lo.x; f[4 * i + 1] = lo.y; f[4 * i + 2] = hi.x; f[4 * i + 3] = hi.y;
  }
}
#define U_SCALE 64.f
#define V_SCALE 20.f
__device__ __forceinline__ void phase_prep_a(const Params& p, unsigned char* smem) {
  float* fs = (float*)smem;
  prep_mod(p, fs);
  {
    float2* rope = (float2*)(p.ws + OFF_ROPE);
    int i = blockIdx.x * 256 + opaque_tid();
    if (i < 64 * 16) {
      int pos = i >> 4, f = i & 15;
      float fr = powf(10000.f, -(float)f / 16.f);
      float ang = (float)pos * fr;
      rope[i] = make_float2(cosf(ang), sinf(ang));
    }
  }
  for (int i = 0; i < 2; ++i) {
    prep_transpose(p.in[11] + (size_t)i * 1024 * 3072, (bf16_t*)(p.ws + OFF_WIN_EV) + (size_t)i * 3072 * 1024, 3072, 3072, fs);
    prep_transpose(p.in[16] + (size_t)i * 1024 * 3088, (bf16_t*)(p.ws + OFF_WIN_OD) + (size_t)i * 3328 * 1024, 3088, 3328, fs);
    prep_transpose(p.in[12] + (size_t)i * 1024 * 1024, (bf16_t*)(p.ws + OFF_WOUT) + (size_t)(2 * i) * 1024 * 1024, 1024, 1024, fs);
    prep_transpose(p.in[17] + (size_t)i * 1024 * 1024, (bf16_t*)(p.ws + OFF_WOUT) + (size_t)(2 * i + 1) * 1024 * 1024, 1024, 1024, fs);
  }
  for (int l = 0; l < 4; ++l)
    prep_transpose(p.in[26] + (size_t)l * 1024 * 2048, nullptr, 2048, 2048, fs, p.ws + OFF_WQ + (size_t)l * 2048 * 1024, WQ_SCALE);
  prep_convert(p.in[27], (bf16_t*)(p.ws + OFF_KEYS), (size_t)4 * 8 * 2 * 128 * 128 / 4);
  prep_convert_fp4(p.in[28], (unsigned*)(p.ws + OFF_UB), (size_t)4 * 16384 * 1024 / 8, U_SCALE, 128);
  prep_convert_fp4(p.in[29], (unsigned*)(p.ws + OFF_VB), (size_t)4 * 16384 * 1024 / 8, V_SCALE, 1024);
}

__device__ __forceinline__ void norm_token(const float* xrow, const float* g, const float* scale, const float* shift,
                                           bf16_t* hrow, float* copy_dst, int lane, unsigned char* h8row = nullptr,
                                           unsigned char* hf8row = nullptr) {
  float4 v[4];
  float ss = 0.f;
#pragma unroll
  for (int i = 0; i < 4; ++i) {
    v[i] = *(const float4*)(xrow + i * 256 + lane * 4);
    ss += v[i].x * v[i].x + v[i].y * v[i].y + v[i].z * v[i].z + v[i].w * v[i].w;
  }
  ss = wave_sum(ss);
  const float rs = rsqrtf(ss * (1.f / 1024.f) + EPSV);
#pragma unroll
  for (int i = 0; i < 4; ++i) {
    const int idx = i * 256 + lane * 4;
    if (copy_dst) *(float4*)(copy_dst + idx) = v[i];
    float4 gg = *(const float4*)(g + idx);
    float4 sc = *(const float4*)(scale + idx);
    float4 sh = *(const float4*)(shift + idx);
    float a = v[i].x * rs * gg.x * (1.f + sc.x) + sh.x;
    float b = v[i].y * rs * gg.y * (1.f + sc.y) + sh.y;
    float c = v[i].z * rs * gg.z * (1.f + sc.z) + sh.z;
    float d = v[i].w * rs * gg.w * (1.f + sc.w) + sh.w;
    uint2 o;
    o.x = pack2(a, b);
    o.y = pack2(c, d);
    *(uint2*)(hrow + idx) = o;
    if (h8row) {
      unsigned w4 = 0;
      w4 = __builtin_amdgcn_cvt_scalef32_pk_fp4_f32(w4, a * X_SCALE, b * X_SCALE, 1.0f, 0);
      w4 = __builtin_amdgcn_cvt_scalef32_pk_fp4_f32(w4, c * X_SCALE, d * X_SCALE, 1.0f, 1);
      *(unsigned short*)(h8row + (idx >> 1)) = (unsigned short)w4;
    }
    if (hf8row) {
      unsigned w8 = __builtin_amdgcn_cvt_pk_fp8_f32(a, b, 0, false);
      w8 = __builtin_amdgcn_cvt_pk_fp8_f32(c, d, w8, true);
      *(unsigned*)(hf8row + idx) = w8;
    }
  }
}

__device__ __forceinline__ void phase_prep_b(const Params& p) {
  const int tid_ = opaque_tid(); const int lane = tid_ & 63, wv = tid_ >> 6;
  const float* modv = (const float*)(p.ws + OFF_MOD);
  bf16_t* H = (bf16_t*)(p.ws + OFF_H);
  for (int t = blockIdx.x * 4 + wv; t < NTOK; t += gridDim.x * 4) {
    const float* xr = (t < NPROMPT) ? p.in[0] + (size_t)t * 1024 : p.in[1] + (size_t)(t - NPROMPT) * 1024;
    const float* md = modv + (size_t)(0 * 9 + tok_mod(t)) * 6144;
    norm_token(xr, p.in[8], md + 1024, md, H + (size_t)t * 1024, p.out + (size_t)t * 1024, lane);
  }
}

__device__ __forceinline__ void phase_norm2(const Params& p, int l) {
  const int tid_ = opaque_tid(); const int lane = tid_ & 63, wv = tid_ >> 6;
  const float* modv = (const float*)(p.ws + OFF_MOD);
  bf16_t* H = (bf16_t*)(p.ws + OFF_H);
  for (int t = blockIdx.x * 4 + wv; t < NTOK; t += gridDim.x * 4) {
    const float* md = modv + (size_t)(l * 9 + tok_mod(t)) * 6144;
    norm_token(p.out + (size_t)t * 1024, p.in[9] + l * 1024, md + 4096, md + 3072, H + (size_t)t * 1024, nullptr, lane,
               p.ws + OFF_H8 + (size_t)t * 512, p.ws + OFF_H8F + (size_t)t * 1024);
  }
}

template <int EPI, int NJ, int BK>
__device__ __forceinline__ void gemm_phase(const bf16_t* __restrict__ A, const bf16_t* __restrict__ Bt, int ntiles_n,
                           bf16_t* __restrict__ C, int ldc, float* __restrict__ X, const float* __restrict__ ga,
                           unsigned char* smem, int dry = 0) {
  constexpr int TN = 32 * NJ;
  constexpr int LS = BK + 8;
  constexpr int TPR = BK / 8;
  constexpr int RPP = 256 / TPR;
  constexpr int NA = 128 / RPP, NB = TN / RPP;
  bf16_t* As = (bf16_t*)smem;
  bf16_t* Bs = As + 128 * LS;
  const int tid = opaque_tid(), lane = tid & 63, w = tid >> 6, quad = lane >> 4, l15 = lane & 15;
  const int wm = w >> 1, wn = w & 1;
  const int lr = tid / TPR, lseg = (tid % TPR) * 8;
  const int units = 192 * ntiles_n;
  for (int u = blockIdx.x; u < units; u += gridDim.x) {
    const int mt = u % 192, nt = u / 192;
    const int m0 = mt * 128, n0 = nt * TN;
    f32x4 acc[4][NJ];
#pragma unroll
    for (int i = 0; i < 4; ++i)
#pragma unroll
      for (int j = 0; j < NJ; ++j) acc[i][j] = (f32x4){0.f, 0.f, 0.f, 0.f};
    const unsigned char* Ab = (const unsigned char*)(A + (size_t)m0 * 1024);
    const unsigned char* Bb = (const unsigned char*)(Bt + (size_t)n0 * 1024);
    const unsigned voff = (unsigned)(lr * 2048 + lseg * 2);
    u32x4 ra[NA], rb[NB];
#pragma unroll
    for (int i = 0; i < NA; ++i) ra[i] = *(const u32x4*)(Ab + (size_t)(i * RPP * 2048) + voff);
#pragma unroll
    for (int i = 0; i < NB; ++i) rb[i] = *(const u32x4*)(Bb + (size_t)(i * RPP * 2048) + voff);
#pragma unroll 1
    for (int kt = 0; kt < 1024 / BK; ++kt) {
#pragma unroll
      for (int i = 0; i < NA; ++i) *(u32x4*)(As + (lr + RPP * i) * LS + lseg) = ra[i];
#pragma unroll
      for (int i = 0; i < NB; ++i) *(u32x4*)(Bs + (lr + RPP * i) * LS + lseg) = rb[i];
      __syncthreads();
      if (kt + 1 < 1024 / BK) {
        const unsigned char* An = Ab + (size_t)((kt + 1) * BK * 2);
        const unsigned char* Bn = Bb + (size_t)((kt + 1) * BK * 2);
#pragma unroll
        for (int i = 0; i < NA; ++i) ra[i] = *(const u32x4*)(An + (size_t)(i * RPP * 2048) + voff);
#pragma unroll
        for (int i = 0; i < NB; ++i) rb[i] = *(const u32x4*)(Bn + (size_t)(i * RPP * 2048) + voff);
      }
#pragma unroll
      for (int kk = 0; kk < BK / 32; ++kk) {
        bf16x8 af[4];
#pragma unroll
        for (int i = 0; i < 4; ++i) af[i] = ldfrag(As + (wm * 64 + i * 16 + l15) * LS + kk * 32 + quad * 8);
#pragma unroll
        for (int j = 0; j < NJ; ++j) {
          const bf16x8 bfr = ldfrag(Bs + (wn * (16 * NJ) + j * 16 + l15) * LS + kk * 32 + quad * 8);
#pragma unroll
          for (int i = 0; i < 4; ++i) acc[i][j] = mfma16(af[i], bfr, acc[i][j]);
        }
      }
      __syncthreads();
    }
    if (EPI == 0) {
#pragma unroll
      for (int i = 0; i < 4; ++i)
#pragma unroll
        for (int j = 0; j < NJ; ++j) {
          const int col = n0 + wn * (16 * NJ) + j * 16 + l15;
          if (col < ldc) {
#pragma unroll
            for (int jj = 0; jj < 4; ++jj) {
              int row = m0 + wm * 64 + i * 16 + quad * 4 + jj;
              C[(size_t)row * ldc + col] = f2bf(acc[i][j][jj]);
            }
          }
        }
    } else {
      const float* gam = ga + (size_t)tok_mod(m0) * 6144;
#pragma unroll
      for (int i = 0; i < 4; ++i)
#pragma unroll
        for (int j = 0; j < NJ; ++j)
#pragma unroll
          for (int jj = 0; jj < 4; ++jj) {
            int row = m0 + wm * 64 + i * 16 + quad * 4 + jj;
            int col = n0 + wn * (16 * NJ) + j * 16 + l15;
            float* xp = X + (size_t)row * 1024 + col;
            const float nv = *xp + gam[col] * acc[i][j][jj];
            if (!dry) *xp = nv;
          }
    }
  }
}

__device__ __forceinline__ void gemm_q_fp8(const unsigned char* __restrict__ A, const unsigned char* __restrict__ Bt,
                                           bf16_t* __restrict__ C, unsigned char* smem) {
  constexpr int LSB = 144;
  unsigned char* As = smem;
  unsigned char* Bs = smem + 128 * LSB;
  const int tid = opaque_tid(), lane = tid & 63, w = tid >> 6, quad = lane >> 4, l15 = lane & 15;
  const int wm = w >> 1, wn = w & 1;
  const int lr = tid >> 3, lseg = (tid & 7) * 16;
  for (int u = blockIdx.x; u < 192 * 16; u += gridDim.x) {
    const int mt = u % 192, nt = u / 192;
    const int m0 = mt * 128, n0 = nt * 128;
    f32x4 acc[4][4];
#pragma unroll
    for (int i = 0; i < 4; ++i)
#pragma unroll
      for (int j = 0; j < 4; ++j) acc[i][j] = (f32x4){0.f, 0.f, 0.f, 0.f};
    const unsigned char* Ag = A + (size_t)(m0 + lr * 4) * 1024 + lseg;
    const unsigned char* Bg = Bt + (size_t)(n0 + lr * 4) * 1024 + lseg;
    u32x4 ra[4], rb[4];
#pragma unroll
    for (int i = 0; i < 4; ++i) ra[i] = *(const u32x4*)(Ag + i * 1024);
#pragma unroll
    for (int i = 0; i < 4; ++i) rb[i] = *(const u32x4*)(Bg + i * 1024);
#pragma unroll 1
    for (int kt = 0; kt < 8; ++kt) {
#pragma unroll
      for (int i = 0; i < 4; ++i) *(u32x4*)(As + (lr * 4 + i) * LSB + lseg) = ra[i];
#pragma unroll
      for (int i = 0; i < 4; ++i) *(u32x4*)(Bs + (lr * 4 + i) * LSB + lseg) = rb[i];
      __syncthreads();
      if (kt + 1 < 8) {
#pragma unroll
        for (int i = 0; i < 4; ++i) ra[i] = *(const u32x4*)(Ag + i * 1024 + (kt + 1) * 128);
#pragma unroll
        for (int i = 0; i < 4; ++i) rb[i] = *(const u32x4*)(Bg + i * 1024 + (kt + 1) * 128);
      }
#pragma unroll
      for (int kk = 0; kk < 4; ++kk) {
        long af[4];
#pragma unroll
        for (int i = 0; i < 4; ++i) af[i] = *(const long*)(As + (wm * 64 + i * 16 + l15) * LSB + kk * 32 + quad * 8);
#pragma unroll
        for (int j = 0; j < 4; ++j) {
          const long bfr = *(const long*)(Bs + (wn * 64 + j * 16 + l15) * LSB + kk * 32 + quad * 8);
#pragma unroll
          for (int i = 0; i < 4; ++i) acc[i][j] = __builtin_amdgcn_mfma_f32_16x16x32_fp8_fp8(af[i], bfr, acc[i][j], 0, 0, 0);
        }
      }
      __syncthreads();
    }
#pragma unroll
    for (int i = 0; i < 4; ++i)
#pragma unroll
      for (int j = 0; j < 4; ++j) {
        const int col = n0 + wn * 64 + j * 16 + l15;
#pragma unroll
        for (int jj = 0; jj < 4; ++jj) {
          const int row = m0 + wm * 64 + i * 16 + quad * 4 + jj;
          C[(size_t)row * 2048 + col] = f2bf(acc[i][j][jj] * (1.f / WQ_SCALE));
        }
      }
  }
}

struct ChainItem {
  bool lng; int sl, dir, h, sq, tok0, nc;
};
__device__ __forceinline__ ChainItem decode_item(int it) {
  ChainItem c;
  c.lng = it < 256;
  int idx = c.lng ? it : it - 256;
  c.sl = idx & 3; c.dir = (idx >> 2) & 1; c.h = (idx >> 3) & 3; c.sq = idx >> 5;
  c.tok0 = c.lng ? NPROMPT + c.sq * 2048 : c.sq * 256;
  c.nc = c.lng ? 32 : 4;
  return c;
}

__device__ __forceinline__ void phase_ret_chain(const Params& p, int l, unsigned char* smem) {
  const int il = l >> 1;
  bf16_t* qs = (bf16_t*)smem;
  bf16_t* ks = qs + 64 * 72;
  bf16_t* kT = ks + 64 * 72;
  bf16_t* vT = kT + 64 * 72;
  bf16_t* intra = vT + 32 * 72;
  bf16_t* ST = intra + 64 * 72;
  const bf16_t* P = (const bf16_t*)(p.ws + OFF_P);
  float* odir = (float*)(p.ws + OFF_ODIR);
  const float2* rope = (const float2*)(p.ws + OFF_ROPE);
  const int tid = opaque_tid(), lane = tid & 63, w = tid >> 6, quad = lane >> 4, l15 = lane & 15;
  const int nlb = (gridDim.x >= 512) ? 256 : ((gridDim.x >= 2) ? (int)(gridDim.x / 2) : 0);
  const bool longblk = (nlb > 0) ? ((int)blockIdx.x < nlb) : true;
  const int it_lo = (nlb > 0) ? (longblk ? (int)blockIdx.x : 256 + ((int)blockIdx.x - nlb)) : (int)blockIdx.x;
  const int it_hi = (nlb > 0) ? (longblk ? 256 : 1280) : 1280;
  const int it_st = (nlb > 0) ? (longblk ? nlb : ((int)gridDim.x - nlb)) : (int)gridDim.x;
  for (int it = it_lo; it < it_hi; it += it_st) {
    const ChainItem ci = decode_item(it);
    const int sl = ci.sl, dir = ci.dir, h = ci.h;
    const float xg = p.in[13][(il * 2 + dir) * 4 + h];
    const float lg = -log1pf(expf(-xg));
    const float g64 = expf(lg * 64.f);
    f32x4 S[2];
    if (ci.lng) {
      const float* s0 = p.in[2] + ((((size_t)ci.sq * 2 + il) * 2 + dir) * 4 + h) * 8192;
#pragma unroll
      for (int ct = 0; ct < 2; ++ct)
#pragma unroll
        for (int jj = 0; jj < 4; ++jj) S[ct][jj] = s0[(16 * w + quad * 4 + jj) * 128 + sl * 32 + ct * 16 + l15];
    } else {
      S[0] = (f32x4){0.f, 0.f, 0.f, 0.f};
      S[1] = (f32x4){0.f, 0.f, 0.f, 0.f};
    }
    for (int n = 0; n < ci.nc; ++n) {
      const int cn = dir ? ci.nc - 1 - n : n;
      const int tb = ci.tok0 + cn * 64;
      {
        const int i = tid >> 2, mq = tid & 3;
        const int t = tb + (dir ? 63 - i : i);
        const bf16_t* pr = P + (size_t)t * PSTRIDE;
        float qa[8], qb[8], ka[8], kb[8];
        unpack8(*(const uint4*)(pr + h * 64 + mq * 8), qa);
        unpack8(*(const uint4*)(pr + h * 64 + 32 + mq * 8), qb);
        unpack8(*(const uint4*)(pr + 256 + h * 64 + mq * 8), ka);
        unpack8(*(const uint4*)(pr + 256 + h * 64 + 32 + mq * 8), kb);
        if (ci.lng) {
          const int pos = (mq < 2) ? cn : (t - tb);
          const int f0 = (mq & 1) * 8;
#pragma unroll
          for (int e = 0; e < 8; ++e) {
            float2 cs = rope[pos * 16 + f0 + e];
            float a = qa[e], b = qb[e];
            qa[e] = a * cs.x - b * cs.y; qb[e] = b * cs.x + a * cs.y;
            a = ka[e]; b = kb[e];
            ka[e] = a * cs.x - b * cs.y; kb[e] = b * cs.x + a * cs.y;
          }
        }
        const float wend = expf(lg * (float)(63 - i));
        uint4 o;
        o.x = pack2(qa[0], qa[1]); o.y = pack2(qa[2], qa[3]); o.z = pack2(qa[4], qa[5]); o.w = pack2(qa[6], qa[7]);
        *(uint4*)(qs + i * 72 + mq * 8) = o;
        o.x = pack2(qb[0], qb[1]); o.y = pack2(qb[2], qb[3]); o.z = pack2(qb[4], qb[5]); o.w = pack2(qb[6], qb[7]);
        *(uint4*)(qs + i * 72 + 32 + mq * 8) = o;
#pragma unroll
        for (int e = 0; e < 8; ++e) { ka[e] *= 0.125f; kb[e] *= 0.125f; }
        o.x = pack2(ka[0], ka[1]); o.y = pack2(ka[2], ka[3]); o.z = pack2(ka[4], ka[5]); o.w = pack2(ka[6], ka[7]);
        *(uint4*)(ks + i * 72 + mq * 8) = o;
        o.x = pack2(kb[0], kb[1]); o.y = pack2(kb[2], kb[3]); o.z = pack2(kb[4], kb[5]); o.w = pack2(kb[6], kb[7]);
        *(uint4*)(ks + i * 72 + 32 + mq * 8) = o;
#pragma unroll
        for (int e = 0; e < 8; ++e) {
          kT[(mq * 8 + e) * 72 + i] = f2bf(ka[e] * wend);
          kT[(32 + mq * 8 + e) * 72 + i] = f2bf(kb[e] * wend);
        }
        uint4 v8 = *(const uint4*)(pr + 512 + h * 128 + sl * 32 + mq * 8);
        vT[(mq * 8 + 0) * 72 + i] = (bf16_t)(v8.x & 0xffff); vT[(mq * 8 + 1) * 72 + i] = (bf16_t)(v8.x >> 16);
        vT[(mq * 8 + 2) * 72 + i] = (bf16_t)(v8.y & 0xffff); vT[(mq * 8 + 3) * 72 + i] = (bf16_t)(v8.y >> 16);
        vT[(mq * 8 + 4) * 72 + i] = (bf16_t)(v8.z & 0xffff); vT[(mq * 8 + 5) * 72 + i] = (bf16_t)(v8.z >> 16);
        vT[(mq * 8 + 6) * 72 + i] = (bf16_t)(v8.w & 0xffff); vT[(mq * 8 + 7) * 72 + i] = (bf16_t)(v8.w >> 16);
      }
      __syncthreads();
      const bf16x8 a0 = ldfrag(qs + (16 * w + l15) * 72 + quad * 8);
      const bf16x8 a1 = ldfrag(qs + (16 * w + l15) * 72 + 32 + quad * 8);
#pragma unroll
      for (int ct = 0; ct < 4; ++ct) {
        bf16x8 b0 = ldfrag(ks + (ct * 16 + l15) * 72 + quad * 8);
        bf16x8 b1 = ldfrag(ks + (ct * 16 + l15) * 72 + 32 + quad * 8);
        f32x4 c = (f32x4){0.f, 0.f, 0.f, 0.f};
        c = mfma16(a0, b0, c);
        c = mfma16(a1, b1, c);
#pragma unroll
        for (int jj = 0; jj < 4; ++jj) {
          int i = 16 * w + quad * 4 + jj, j = ct * 16 + l15;
          float val = (i >= j) ? c[jj] * expf(lg * (float)(i - j)) : 0.f;
          intra[i * 72 + j] = f2bf(val);
        }
      }
#pragma unroll
      for (int ct = 0; ct < 2; ++ct)
#pragma unroll
        for (int jj = 0; jj < 4; ++jj) ST[(ct * 16 + l15) * 72 + 16 * w + quad * 4 + jj] = f2bf(S[ct][jj]);
      __syncthreads();
      const bf16x8 ai0 = ldfrag(intra + (16 * w + l15) * 72 + quad * 8);
      const bf16x8 ai1 = ldfrag(intra + (16 * w + l15) * 72 + 32 + quad * 8);
      const bf16x8 ak0 = ldfrag(kT + (16 * w + l15) * 72 + quad * 8);
      const bf16x8 ak1 = ldfrag(kT + (16 * w + l15) * 72 + 32 + quad * 8);
#pragma unroll
      for (int ct = 0; ct < 2; ++ct) {
        bf16x8 bv0 = ldfrag(vT + (ct * 16 + l15) * 72 + quad * 8);
        bf16x8 bv1 = ldfrag(vT + (ct * 16 + l15) * 72 + 32 + quad * 8);
        bf16x8 bs0 = ldfrag(ST + (ct * 16 + l15) * 72 + quad * 8);
        bf16x8 bs1 = ldfrag(ST + (ct * 16 + l15) * 72 + 32 + quad * 8);
        f32x4 ci_ = (f32x4){0.f, 0.f, 0.f, 0.f}, cc = (f32x4){0.f, 0.f, 0.f, 0.f};
        ci_ = mfma16(ai0, bv0, ci_);
        ci_ = mfma16(ai1, bv1, ci_);
        cc = mfma16(a0, bs0, cc);
        cc = mfma16(a1, bs1, cc);
#pragma unroll
        for (int jj = 0; jj < 4; ++jj) {
          int i = 16 * w + quad * 4 + jj;
          int t = tb + (dir ? 63 - i : i);
          float o = ci_[jj] + expf(lg * (float)(i + 1)) * cc[jj];
          odir[((size_t)dir * NTOK + t) * 512 + h * 128 + sl * 32 + ct * 16 + l15] = o;
        }
        f32x4 s = S[ct];
        s[0] *= g64; s[1] *= g64; s[2] *= g64; s[3] *= g64;
        s = mfma16(ak0, bv0, s);
        s = mfma16(ak1, bv1, s);
        S[ct] = s;
      }
      __syncthreads();
    }
    if (!ci.lng) {
      float* so = p.out + 25165824 + ((((size_t)ci.sq * 2 + il) * 2 + dir) * 4 + h) * 8192;
#pragma unroll
      for (int ct = 0; ct < 2; ++ct)
#pragma unroll
        for (int jj = 0; jj < 4; ++jj) so[(16 * w + quad * 4 + jj) * 128 + sl * 32 + ct * 16 + l15] = S[ct][jj];
    }
  }
}

__device__ __forceinline__ void gdn_prep_item(const Params& p, int l, int pi, unsigned char* smem, int plvl) {
  const int il = l >> 1;
  bf16_t* ks = (bf16_t*)smem;
  bf16_t* vs = ks + 64 * 136;
  float* Am = (float*)(vs + 64 * 136);
  float* rq = Am + 4096;
  float* rk = rq + 64;
  float* gcs = rk + 64;
  float* bet = gcs + 64;
  float* fac = bet + 64;
  bf16_t* qs = (bf16_t*)(fac + 128);
  const bf16_t* P = (const bf16_t*)(p.ws + OFF_P);
  unsigned char* gp = p.ws + OFF_GPREP + (size_t)pi * GP_ITEM;
  bf16_t* Wb = (bf16_t*)gp;
  bf16_t* QG = Wb + 8192;
  bf16_t* KDT = QG + 8192;
  bf16_t* Ub = KDT + 8192;
  bf16_t* ATT = Ub + 8192;
  float* EGL = (float*)(p.ws + OFF_EGL);
  const int tid = opaque_tid(), lane = tid & 63, w = tid >> 6, quad = lane >> 4, l15 = lane & 15;
  const int dir = pi & 1, h = (pi >> 1) & 3, c = pi >> 3;
  int tb, seq_lo, seq_hi;
  if (c < 128) { tb = c * 64; seq_lo = (c >> 2) * 256; seq_hi = seq_lo + 256; }
  else { int cc = c - 128; tb = NPROMPT + cc * 64; seq_lo = NPROMPT + (cc >> 5) * 2048; seq_hi = seq_lo + 2048; }
  const float SCALE = 0.08838834764831845f;
  {
    const int cg_ = tid & 127, rh = tid >> 7;
#pragma unroll
    for (int mat = 0; mat < 3; ++mat) {
      const int col = mat * 512 + h * 128 + cg_;
      const float* cw = p.in[18] + (size_t)il * 3 * 1536 + col;
      const float w0 = cw[0], w1 = cw[1536], w2 = cw[3072];
      bf16_t* dst = mat == 0 ? qs : (mat == 1 ? ks : vs);
      const int t0 = tb + rh * 32;
      bf16_t raw[34];
#pragma unroll
      for (int o = 0; o < 34; ++o) {
        const int t = t0 - 1 + o;
        const int tc = min(max(t, seq_lo), seq_hi - 1);
        const bf16_t rv = P[(size_t)tc * PSTRIDE + col];
        raw[o] = (t == tc) ? rv : (bf16_t)0;
      }
#pragma unroll
      for (int o = 0; o < 32; ++o) {
        float y = w0 * bf2f(raw[o]) + w1 * bf2f(raw[o + 1]) + w2 * bf2f(raw[o + 2]);
        y = siluf(y);
        const int oi = rh * 32 + o;
        const int i = dir ? 63 - oi : oi;
        dst[i * 136 + cg_] = f2bf(y);
      }
    }
  }
  __syncthreads();
  if (plvl == 4) return;
  {
    const int r = tid >> 2, part = tid & 3;
    float sq_ = 0.f, sk_ = 0.f;
#pragma unroll 8
    for (int e = 0; e < 32; ++e) {
      float a = bf2f(qs[r * 136 + part * 32 + e]);
      float b = bf2f(ks[r * 136 + part * 32 + e]);
      sq_ += a * a; sk_ += b * b;
    }
    sq_ += __shfl_xor(sq_, 1); sq_ += __shfl_xor(sq_, 2);
    sk_ += __shfl_xor(sk_, 1); sk_ += __shfl_xor(sk_, 2);
    if (part == 0) {
      rq[r] = rsqrtf(sq_ + EPSV);
      rk[r] = rsqrtf(sk_ + EPSV);
      const int t = tb + (dir ? 63 - r : r);
      float a = bf2f(P[(size_t)t * PSTRIDE + 2048 + dir * 4 + h]);
      float bbv = bf2f(P[(size_t)t * PSTRIDE + 2056 + dir * 4 + h]);
      float al = p.in[19][(il * 2 + dir) * 4 + h], dtb = p.in[20][(il * 2 + dir) * 4 + h];
      float z = a + dtb;
      float sp = (z > 20.f) ? z : log1pf(expf(z));
      gcs[r] = -expf(al) * sp;
      bet[r] = 1.f / (1.f + expf(-bbv));
    }
  }
  __syncthreads();
  if (tid < 64) {
    float v = gcs[tid];
#pragma unroll
    for (int o = 1; o < 64; o <<= 1) {
      float u = __shfl_up(v, o);
      if (tid >= o) v += u;
    }
    gcs[tid] = v;
  }
  __syncthreads();
  {
    bf16x8 ak[4], aq[4];
#pragma unroll
    for (int kk = 0; kk < 4; ++kk) {
      ak[kk] = ldfrag(ks + (16 * w + l15) * 136 + kk * 32 + quad * 8);
      aq[kk] = ldfrag(qs + (16 * w + l15) * 136 + kk * 32 + quad * 8);
    }
#pragma unroll
    for (int ct = 0; ct < 4; ++ct) {
      f32x4 ckk = (f32x4){0.f, 0.f, 0.f, 0.f}, cqk = (f32x4){0.f, 0.f, 0.f, 0.f};
#pragma unroll
      for (int kk = 0; kk < 4; ++kk) {
        bf16x8 b = ldfrag(ks + (ct * 16 + l15) * 136 + kk * 32 + quad * 8);
        ckk = mfma16(ak[kk], b, ckk);
        cqk = mfma16(aq[kk], b, cqk);
      }
#pragma unroll
      for (int jj = 0; jj < 4; ++jj) {
        const int i = 16 * w + quad * 4 + jj, j = ct * 16 + l15;
        const float dec = (i >= j) ? __expf(gcs[i] - gcs[j]) : 0.f;
        Am[j * 64 + i] = (i > j) ? bet[i] * rk[i] * rk[j] * ckk[jj] * dec : 0.f;
        ATT[i * 64 + j] = f2bf((i >= j) ? SCALE * rq[i] * rk[j] * cqk[jj] * dec : 0.f);
      }
    }
  }
  __syncthreads();
  const float gl = gcs[63];
#pragma unroll 8
  for (int e = tid; e < 64 * 128; e += 256) {
    int i = e >> 7, d = e & 127;
    QG[e] = f2bf(bf2f(qs[i * 136 + d]) * rq[i] * SCALE * __expf(gcs[i]));
  }
#pragma unroll 8
  for (int e = tid; e < 128 * 64; e += 256) {
    int d = e >> 6, i = e & 63;
    KDT[e] = f2bf(bf2f(ks[i * 136 + d]) * rk[i] * __expf(gl - gcs[i]));
  }
  if (tid < 64) {
    fac[tid] = bet[tid];
    fac[64 + tid] = rk[tid] * bet[tid] * __expf(gcs[tid]);
  }
  __syncthreads();
  if (plvl != 3) {
    const int cidx = tid & 127;
    const bf16_t* srcm = ((tid < 128) ? vs : ks) + cidx;
    const float* fc = fac + ((tid < 128) ? 0 : 64);
    bf16_t* dstm = ((tid < 128) ? Ub : Wb) + cidx;
    bf16_t* XB = qs + tid;
#pragma unroll 1
    for (int b = 0; b < 4; ++b) {
      float x[16];
#pragma unroll
      for (int r = 0; r < 16; ++r) x[r] = bf2f(srcm[(16 * b + r) * 136]) * fc[16 * b + r];
      const float* arow = Am + 16 * b;
#pragma unroll 4
      for (int j = 0; j < 16 * b; ++j) {
        const float xv = bf2f(XB[j * 256]);
        const f32x4 a0 = *(const f32x4*)(arow + j * 64), a1 = *(const f32x4*)(arow + j * 64 + 4);
        const f32x4 a2 = *(const f32x4*)(arow + j * 64 + 8), a3 = *(const f32x4*)(arow + j * 64 + 12);
#pragma unroll
        for (int r = 0; r < 4; ++r) {
          x[r] -= a0[r] * xv; x[4 + r] -= a1[r] * xv; x[8 + r] -= a2[r] * xv; x[12 + r] -= a3[r] * xv;
        }
      }
      const float* ablk = Am + (16 * b) * 64 + 16 * b;
#pragma unroll
      for (int jj = 0; jj < 15; ++jj) {
#pragma unroll
        for (int r = jj + 1; r < 16; ++r) x[r] -= ablk[jj * 64 + r] * x[jj];
      }
#pragma unroll
      for (int r = 0; r < 16; ++r) {
        const bf16_t bb = f2bf(x[r]);
        dstm[(16 * b + r) * 128] = bb;
        if (b < 3) XB[(16 * b + r) * 256] = bb;
      }
    }
  }
  if (tid == 0) EGL[pi] = expf(gl);
  __syncthreads();
}

__device__ __forceinline__ void conf_conv_item(const Params& p, int l, int item, unsigned char* smem) {
  const int il = l >> 1;
  float* hc = (float*)smem;
  const bf16_t* P = (const bf16_t*)(p.ws + OFF_P);
  float* convout = (float*)(p.ws + OFF_CONV);
  const int tid = opaque_tid();
  const int tile = item >> 1, ch = (item & 1) * 256 + tid;
  const int t0 = tile * 32;
  int seq_lo, seq_hi;
  if (t0 < NPROMPT) { seq_lo = (t0 >> 8) << 8; seq_hi = seq_lo + 256; }
  else { seq_lo = NPROMPT + (((t0 - NPROMPT) >> 11) << 11); seq_hi = seq_lo + 2048; }
#pragma unroll 31
  for (int r = 0; r < 62; ++r) {
    const int tt = t0 - 15 + r;
    const int tc = min(max(tt, seq_lo), seq_hi - 1);
    float ca = bf2f(P[(size_t)tc * PSTRIDE + 2064 + ch]);
    float cgv = bf2f(P[(size_t)tc * PSTRIDE + 2576 + ch]);
    float v = ca * __builtin_amdgcn_rcpf(1.f + __expf(-cgv));
    hc[r * 256 + tid] = (tt == tc) ? v : 0.f;
  }
  float wk[31];
#pragma unroll
  for (int k = 0; k < 31; ++k) wk[k] = p.in[22][((size_t)il * 31 + k) * 512 + ch];
  const float bias = p.in[23][il * 512 + ch];
  for (int i = 0; i < 32; ++i) {
    float acc = bias;
#pragma unroll
    for (int k = 0; k < 31; ++k) acc += wk[k] * hc[(i + k) * 256 + tid];
    convout[(size_t)(t0 + i) * 512 + ch] = acc;
  }
}

__device__ __forceinline__ void phase_odd_prep(const Params& p, int l, unsigned char* smem, int rep) {
  for (int u = blockIdx.x; u < 3072 + 1536; u += gridDim.x) {
#if PROBE_ODD == 1 || PROBE_ODD >= 3
    if (rep && u >= 3072) break;
#elif PROBE_ODD == 2
    if (rep && u < 3072) continue;
#endif
    if (u < 3072) gdn_prep_item(p, l, u, smem, (PROBE_ODD >= 3 && rep) ? PROBE_ODD : 0);
    else { conf_conv_item(p, l, u - 3072, smem); __syncthreads(); }
  }
}

__device__ __forceinline__ void phase_gdn_chain(const Params& p, int l, unsigned char* smem) {
  const int il = l >> 1;
  bf16_t* ST = (bf16_t*)smem;
  bf16_t* VT = ST + 32 * 136;
  float* odir = (float*)(p.ws + OFF_ODIR);
  const float* EGL = (const float*)(p.ws + OFF_EGL);
  const int tid = opaque_tid(), lane = tid & 63, w = tid >> 6, quad = lane >> 4, l15 = lane & 15;
  const int nlb = (gridDim.x >= 512) ? 256 : ((gridDim.x >= 2) ? (int)(gridDim.x / 2) : 0);
  const bool longblk = (nlb > 0) ? ((int)blockIdx.x < nlb) : true;
  const int it_lo = (nlb > 0) ? (longblk ? (int)blockIdx.x : 256 + ((int)blockIdx.x - nlb)) : (int)blockIdx.x;
  const int it_hi = (nlb > 0) ? (longblk ? 256 : 1280) : 1280;
  const int it_st = (nlb > 0) ? (longblk ? nlb : ((int)gridDim.x - nlb)) : (int)gridDim.x;
  for (int it = it_lo; it < it_hi; it += it_st) {
    const ChainItem ci = decode_item(it);
    const int sl = ci.sl, dir = ci.dir, h = ci.h;
    f32x4 S[2][2];
    if (ci.lng) {
      const float* s0 = p.in[3] + ((((size_t)ci.sq * 2 + il) * 2 + dir) * 4 + h) * 16384;
#pragma unroll
      for (int rb = 0; rb < 2; ++rb)
#pragma unroll
        for (int ct = 0; ct < 2; ++ct)
#pragma unroll
          for (int jj = 0; jj < 4; ++jj)
            S[rb][ct][jj] = s0[(16 * (2 * w + rb) + quad * 4 + jj) * 128 + sl * 32 + ct * 16 + l15];
    } else {
#pragma unroll
      for (int rb = 0; rb < 2; ++rb)
#pragma unroll
        for (int ct = 0; ct < 2; ++ct) S[rb][ct] = (f32x4){0.f, 0.f, 0.f, 0.f};
    }
    bf16x8 naw[4], naqg[4];
    bf16_t nuu[2][4];
    float negl = 0.f;
    for (int n = 0; n < ci.nc; ++n) {
      const int cn = dir ? ci.nc - 1 - n : n;
      const int tb = ci.tok0 + cn * 64;
      const int cglob = ci.lng ? 128 + ci.sq * 32 + cn : ci.sq * 4 + cn;
      const int pi = (cglob * 4 + h) * 2 + dir;
      const unsigned char* gp = p.ws + OFF_GPREP + (size_t)pi * GP_ITEM;
      const bf16_t* Wb = (const bf16_t*)gp;
      const bf16_t* QG = Wb + 8192;
      const bf16_t* KDT = QG + 8192;
      const bf16_t* Ub = KDT + 8192;
      const bf16_t* ATT = Ub + 8192;
      bf16x8 aw[4], aqg[4], aat[2], akd[2][2];
      float uu[2][4];
      float egl;
      if (n == 0) {
#pragma unroll
        for (int kk = 0; kk < 4; ++kk) {
          aw[kk] = ldfrag(Wb + (16 * w + l15) * 128 + kk * 32 + quad * 8);
          aqg[kk] = ldfrag(QG + (16 * w + l15) * 128 + kk * 32 + quad * 8);
        }
#pragma unroll
        for (int kk = 0; kk < 2; ++kk) {
          aat[kk] = ldfrag(ATT + (16 * w + l15) * 64 + kk * 32 + quad * 8);
#pragma unroll
          for (int rb = 0; rb < 2; ++rb) akd[rb][kk] = ldfrag(KDT + (16 * (2 * w + rb) + l15) * 64 + kk * 32 + quad * 8);
        }
#pragma unroll
        for (int ct = 0; ct < 2; ++ct)
#pragma unroll
          for (int jj = 0; jj < 4; ++jj) uu[ct][jj] = bf2f(Ub[(16 * w + quad * 4 + jj) * 128 + sl * 32 + ct * 16 + l15]);
        egl = EGL[pi];
      } else {
#pragma unroll
        for (int kk = 0; kk < 4; ++kk) { aw[kk] = naw[kk]; aqg[kk] = naqg[kk]; }
#pragma unroll
        for (int kk = 0; kk < 2; ++kk) {
          aat[kk] = ldfrag(ATT + (16 * w + l15) * 64 + kk * 32 + quad * 8);
#pragma unroll
          for (int rb = 0; rb < 2; ++rb) akd[rb][kk] = ldfrag(KDT + (16 * (2 * w + rb) + l15) * 64 + kk * 32 + quad * 8);
        }
#pragma unroll
        for (int ct = 0; ct < 2; ++ct)
#pragma unroll
          for (int jj = 0; jj < 4; ++jj) uu[ct][jj] = bf2f(nuu[ct][jj]);
        egl = negl;
      }
      if (n + 1 < ci.nc) {
        const int cn2 = dir ? ci.nc - 2 - n : n + 1;
        const int cglob2 = ci.lng ? 128 + ci.sq * 32 + cn2 : ci.sq * 4 + cn2;
        const int pi2 = (cglob2 * 4 + h) * 2 + dir;
        const bf16_t* Wb2 = (const bf16_t*)(p.ws + OFF_GPREP + (size_t)pi2 * GP_ITEM);
        const bf16_t* QG2 = Wb2 + 8192; const bf16_t* Ub2 = QG2 + 16384;
#pragma unroll
        for (int kk = 0; kk < 4; ++kk) {
          naw[kk] = ldfrag(Wb2 + (16 * w + l15) * 128 + kk * 32 + quad * 8);
          naqg[kk] = ldfrag(QG2 + (16 * w + l15) * 128 + kk * 32 + quad * 8);
        }
#pragma unroll
        for (int ct = 0; ct < 2; ++ct)
#pragma unroll
          for (int jj = 0; jj < 4; ++jj) nuu[ct][jj] = Ub2[(16 * w + quad * 4 + jj) * 128 + sl * 32 + ct * 16 + l15];
        negl = EGL[pi2];
      }
#pragma unroll
      for (int rb = 0; rb < 2; ++rb)
#pragma unroll
        for (int ct = 0; ct < 2; ++ct)
#pragma unroll
          for (int jj = 0; jj < 4; ++jj)
            ST[(ct * 16 + l15) * 136 + 16 * (2 * w + rb) + quad * 4 + jj] = f2bf(S[rb][ct][jj]);
      __syncthreads();
      f32x4 co[2];
#pragma unroll
      for (int ct = 0; ct < 2; ++ct) {
        f32x4 cv = (f32x4){0.f, 0.f, 0.f, 0.f};
        co[ct] = (f32x4){0.f, 0.f, 0.f, 0.f};
#pragma unroll
        for (int kk = 0; kk < 4; ++kk) {
          bf16x8 b = ldfrag(ST + (ct * 16 + l15) * 136 + kk * 32 + quad * 8);
          cv = mfma16(aw[kk], b, cv);
          co[ct] = mfma16(aqg[kk], b, co[ct]);
        }
#pragma unroll
        for (int jj = 0; jj < 4; ++jj) {
          float vn = uu[ct][jj] - cv[jj];
          VT[(ct * 16 + l15) * 72 + 16 * w + quad * 4 + jj] = f2bf(vn);
        }
      }
      __syncthreads();
#pragma unroll
      for (int ct = 0; ct < 2; ++ct) {
        bf16x8 bv[2];
#pragma unroll
        for (int kk = 0; kk < 2; ++kk) {
          bv[kk] = ldfrag(VT + (ct * 16 + l15) * 72 + kk * 32 + quad * 8);
          co[ct] = mfma16(aat[kk], bv[kk], co[ct]);
        }
#pragma unroll
        for (int jj = 0; jj < 4; ++jj) {
          int i = 16 * w + quad * 4 + jj;
          int t = tb + (dir ? 63 - i : i);
          odir[((size_t)dir * NTOK + t) * 512 + h * 128 + sl * 32 + ct * 16 + l15] = co[ct][jj];
        }
#pragma unroll
        for (int rb = 0; rb < 2; ++rb) {
          f32x4 s = S[rb][ct];
          s[0] *= egl; s[1] *= egl; s[2] *= egl; s[3] *= egl;
          s = mfma16(akd[rb][0], bv[0], s);
          s = mfma16(akd[rb][1], bv[1], s);
          S[rb][ct] = s;
        }
      }
    }
    __syncthreads();
    if (!ci.lng) {
      float* so = p.out + 29360128 + ((((size_t)ci.sq * 2 + il) * 2 + dir) * 4 + h) * 16384;
#pragma unroll
      for (int rb = 0; rb < 2; ++rb)
#pragma unroll
        for (int ct = 0; ct < 2; ++ct)
#pragma unroll
          for (int jj = 0; jj < 4; ++jj)
            so[(16 * (2 * w + rb) + quad * 4 + jj) * 128 + sl * 32 + ct * 16 + l15] = S[rb][ct][jj];
    }
  }
}

__device__ __forceinline__ void phase_mix_out(const Params& p, int l) {
  const int il = l >> 1;
  const bool odd = l & 1;
  const int tid_ = opaque_tid(); const int lane = tid_ & 63, wv = tid_ >> 6;
  const bf16_t* P = (const bf16_t*)(p.ws + OFF_P);
  const float* od0 = (const float*)(p.ws + OFF_ODIR);
  const float* od1 = od0 + (size_t)NTOK * 512;
  const float* convout = (const float*)(p.ws + OFF_CONV);
  bf16_t* Y = (bf16_t*)(p.ws + OFF_YMIX);
  for (int t = blockIdx.x * 4 + wv; t < NTOK; t += gridDim.x * 4) {
    const bf16_t* pr = P + (size_t)t * PSTRIDE;
    bf16_t* yr = Y + (size_t)t * 1024;
#pragma unroll
    for (int h = 0; h < 4; ++h) {
      const int idx = h * 128 + lane * 2;
      float2 a = *(const float2*)(od0 + (size_t)t * 512 + idx);
      float2 b = *(const float2*)(od1 + (size_t)t * 512 + idx);
      float o0 = a.x + b.x, o1 = a.y + b.y;
      float ss = wave_sum(o0 * o0 + o1 * o1);
      float rs = rsqrtf(ss * (1.f / 128.f) + EPSV);
      float n0, n1;
      unsigned gz;
      if (!odd) {
        n0 = p.in[14][il * 512 + idx]; n1 = p.in[14][il * 512 + idx + 1];
        gz = *(const unsigned*)(pr + 1024 + idx);
      } else {
        n0 = p.in[21][il * 128 + lane * 2]; n1 = p.in[21][il * 128 + lane * 2 + 1];
        gz = *(const unsigned*)(pr + 1536 + idx);
      }
      float y0 = siluf(bflo(gz)) * o0 * rs * n0;
      float y1 = siluf(bfhi(gz)) * o1 * rs * n1;
      *(unsigned*)(yr + idx) = pack2(y0, y1);
    }
    if (!odd) {
      int seq_lo, seq_hi;
      if (t < NPROMPT) { seq_lo = (t >> 8) << 8; seq_hi = seq_lo + 256; }
      else { seq_lo = NPROMPT + (((t - NPROMPT) >> 11) << 11); seq_hi = seq_lo + 2048; }
      const bool hp = (t - 1 >= seq_lo), hn = (t + 1 < seq_hi);
#pragma unroll
      for (int j = 0; j < 4; ++j) {
        const int c = j * 128 + lane * 2;
        unsigned cg0 = *(const unsigned*)(pr + 2048 + c), hb0 = *(const unsigned*)(pr + 2560 + c);
        const bf16_t* prm = hp ? pr - PSTRIDE : pr;
        const bf16_t* prp = hn ? pr + PSTRIDE : pr;
        unsigned cgm = *(const unsigned*)(prm + 2048 + c), hbm = *(const unsigned*)(prm + 2560 + c);
        unsigned cgp = *(const unsigned*)(prp + 2048 + c), hbp = *(const unsigned*)(prp + 2560 + c);
        if (!hp) { cgm = 0; hbm = 0; }
        if (!hn) { cgp = 0; hbp = 0; }
        unsigned bg = *(const unsigned*)(pr + 1536 + c);
        const float* sw = p.in[15] + (size_t)il * 3 * 512 + c;
        float y0 = bflo(bg) * (sw[0] * bflo(cgm) * bflo(hbm) + sw[512] * bflo(cg0) * bflo(hb0) + sw[1024] * bflo(cgp) * bflo(hbp));
        float y1 = bfhi(bg) * (sw[1] * bfhi(cgm) * bfhi(hbm) + sw[513] * bfhi(cg0) * bfhi(hb0) + sw[1025] * bfhi(cgp) * bfhi(hbp));
        *(unsigned*)(yr + 512 + c) = pack2(y0, y1);
      }
    } else {
      float v[8];
      float s = 0.f;
#pragma unroll
      for (int j = 0; j < 4; ++j) {
        float2 a = *(const float2*)(convout + (size_t)t * 512 + j * 128 + lane * 2);
        v[2 * j] = a.x; v[2 * j + 1] = a.y;
        s += a.x + a.y;
      }
      const float mean = wave_sum(s) * (1.f / 512.f);
      float vs = 0.f;
#pragma unroll
      for (int j = 0; j < 8; ++j) { v[j] -= mean; vs += v[j] * v[j]; }
      const float rstd = rsqrtf(wave_sum(vs) * (1.f / 512.f) + EPSV);
#pragma unroll
      for (int j = 0; j < 4; ++j) {
        const int c = j * 128 + lane * 2;
        float y0 = v[2 * j] * rstd * p.in[24][il * 512 + c] + p.in[25][il * 512 + c];
        float y1 = v[2 * j + 1] * rstd * p.in[24][il * 512 + c + 1] + p.in[25][il * 512 + c + 1];
        *(unsigned*)(yr + 512 + c) = pack2(siluf(y0), siluf(y1));
      }
    }
  }
}

#define WAVE_LDS_SYNC() { asm volatile("s_waitcnt lgkmcnt(0)" ::: "memory"); __builtin_amdgcn_wave_barrier(); }
#define CE_DESC(a, b) { unsigned _mx = max(a, b), _mn = min(a, b); a = _mx; b = _mn; }
#define CE_ASC(a, b) { unsigned _mx = max(a, b), _mn = min(a, b); a = _mn; b = _mx; }
__device__ __forceinline__ void sort16_desc(unsigned* v) {
#pragma unroll
  for (int k = 2; k <= 16; k <<= 1) {
#pragma unroll
    for (int j = k >> 1; j > 0; j >>= 1) {
#pragma unroll
      for (int i = 0; i < 16; ++i) {
        const int l = i ^ j;
        if (l > i) {
          if ((i & k) == 0) CE_DESC(v[i], v[l]) else CE_ASC(v[i], v[l])
        }
      }
    }
  }
}
__device__ __forceinline__ void merge16_top(unsigned* a, const unsigned* b) {
#pragma unroll
  for (int i = 0; i < 16; ++i) a[i] = max(a[i], b[15 - i]);
#pragma unroll
  for (int j = 8; j > 0; j >>= 1) {
#pragma unroll
    for (int i = 0; i < 16; ++i) {
      const int l = i ^ j;
      if (l > i) CE_DESC(a[i], a[l])
    }
  }
}
__device__ __forceinline__ void phase_peer_score(const Params& p, int l, unsigned char* smem) {
  const int tid = opaque_tid(), lane = tid & 63, w = tid >> 6, quad = lane >> 4, l15 = lane & 15;
  unsigned* scw = (unsigned*)smem + w * (32 * 132 + 512);
  unsigned* sel = scw + 32 * 132;
  const bf16_t* Q = (const bf16_t*)(p.ws + OFF_Q);
  const bf16_t* KB = (const bf16_t*)(p.ws + OFF_KEYS) + (size_t)l * 8 * 2 * 128 * 128;
  int* EI = (int*)(p.ws + OFF_EIDX);
  float* GT = (float*)(p.ws + OFF_GATE);
  unsigned cab[13];
  {
    const int sub = lane & 3;
#pragma unroll
    for (int i = 0; i < 13; ++i) { const int cidx = sub + 4 * i; cab[i] = (unsigned)CAND_A[cidx] | ((unsigned)CAND_B[cidx] << 4); }
  }
  bf16x8 qa[2][4];
  if (blockIdx.x < 3072) {
    const int t0f = (blockIdx.x >> 1) * 16, hf_ = (blockIdx.x & 1) * 4 + w;
#pragma unroll
    for (int pp = 0; pp < 2; ++pp)
#pragma unroll
      for (int kk = 0; kk < 4; ++kk) qa[pp][kk] = ldfrag(Q + (size_t)(t0f + l15) * 2048 + hf_ * 256 + pp * 128 + kk * 32 + quad * 8);
  }
  for (int u = blockIdx.x; u < 3072; u += gridDim.x) {
    const int tt = u >> 1, h = (u & 1) * 4 + w;
    const int t0 = tt * 16;
#pragma unroll
    for (int pp = 0; pp < 2; ++pp) {
      bf16x8 a[4];
#pragma unroll
      for (int kk = 0; kk < 4; ++kk) a[kk] = qa[pp][kk];
      const bf16_t* kb = KB + (size_t)((h * 2 + pp) * 128) * 128;
#pragma unroll
      for (int ct = 0; ct < 8; ++ct) {
        f32x4 c = (f32x4){0.f, 0.f, 0.f, 0.f};
#pragma unroll
        for (int kk = 0; kk < 4; ++kk) {
          bf16x8 b = ldfrag(kb + (ct * 16 + l15) * 128 + kk * 32 + quad * 8);
          c = mfma16(a[kk], b, c);
        }
#pragma unroll
        for (int jj = 0; jj < 4; ++jj) {
          const int row = pp * 16 + quad * 4 + jj, col = ct * 16 + l15;
          unsigned key = (fkey(c[jj]) & ~127u) | (unsigned)(127 - col);
          scw[row * 132 + col] = key;
        }
      }
    }
    {
      const int un = u + gridDim.x;
      if (un < 3072) {
        const int t0n = (un >> 1) * 16, hn = (un & 1) * 4 + w;
#pragma unroll
        for (int pp = 0; pp < 2; ++pp)
#pragma unroll
          for (int kk = 0; kk < 4; ++kk) qa[pp][kk] = ldfrag(Q + (size_t)(t0n + l15) * 2048 + hn * 256 + pp * 128 + kk * 32 + quad * 8);
      }
    }
    WAVE_LDS_SYNC();
    {
      const int row = lane >> 1, hf = lane & 1;
      const u32x4* rp = (const u32x4*)(scw + row * 132 + hf * 64);
      unsigned g0[16], g1[16];
#pragma unroll
      for (int q = 0; q < 4; ++q) { u32x4 t4 = rp[q]; g0[4 * q] = t4[0]; g0[4 * q + 1] = t4[1]; g0[4 * q + 2] = t4[2]; g0[4 * q + 3] = t4[3]; }
#pragma unroll
      for (int q = 0; q < 4; ++q) { u32x4 t4 = rp[4 + q]; g1[4 * q] = t4[0]; g1[4 * q + 1] = t4[1]; g1[4 * q + 2] = t4[2]; g1[4 * q + 3] = t4[3]; }
      sort16_desc(g0);
      sort16_desc(g1);
      merge16_top(g0, g1);
#pragma unroll
      for (int q = 0; q < 4; ++q) { u32x4 t4 = rp[8 + q]; g1[4 * q] = t4[0]; g1[4 * q + 1] = t4[1]; g1[4 * q + 2] = t4[2]; g1[4 * q + 3] = t4[3]; }
      sort16_desc(g1);
      merge16_top(g0, g1);
#pragma unroll
      for (int q = 0; q < 4; ++q) { u32x4 t4 = rp[12 + q]; g1[4 * q] = t4[0]; g1[4 * q + 1] = t4[1]; g1[4 * q + 2] = t4[2]; g1[4 * q + 3] = t4[3]; }
      sort16_desc(g1);
      merge16_top(g0, g1);
#pragma unroll
      for (int i = 0; i < 16; ++i) g1[i] = (unsigned)__builtin_amdgcn_update_dpp(0, (int)g0[i], 0xB1, 0xF, 0xF, true);
      merge16_top(g0, g1);
      if (hf == 0) {
#pragma unroll
        for (int q = 0; q < 4; ++q) {
          u32x4 t4 = {g0[4 * q], g0[4 * q + 1], g0[4 * q + 2], g0[4 * q + 3]};
          *(u32x4*)(sel + row * 16 + 4 * q) = t4;
        }
      }
    }
    WAVE_LDS_SYNC();
    {
      const int tok = lane >> 2, sub = lane & 3;
      const unsigned* s1 = sel + tok * 16;
      const unsigned* s2 = sel + (16 + tok) * 16;
      unsigned ck[16];
#pragma unroll
      for (int i = 0; i < 13; ++i) {
        const int cidx = sub + 4 * i;
        const int a = cab[i] & 15, b = cab[i] >> 4;
        float s = keyf(s1[a] & ~127u) + keyf(s2[b] & ~127u);
        unsigned k = (fkey(s) & ~255u) | (unsigned)(255 - (a * 16 + b));
        ck[i] = (cidx < 50) ? k : 0u;
      }
      ck[13] = 0u; ck[14] = 0u; ck[15] = 0u;
      sort16_desc(ck);
      {
        unsigned g1[16];
#pragma unroll
        for (int i = 0; i < 16; ++i) g1[i] = (unsigned)__builtin_amdgcn_update_dpp(0, (int)ck[i], 0xB1, 0xF, 0xF, true);
        merge16_top(ck, g1);
#pragma unroll
        for (int i = 0; i < 16; ++i) g1[i] = (unsigned)__builtin_amdgcn_update_dpp(0, (int)ck[i], 0x4E, 0xF, 0xF, true);
        merge16_top(ck, g1);
      }
      const float mx = keyf(ck[0] & ~255u);
      float sv[4];
      int ev[4];
#pragma unroll
      for (int j = 0; j < 4; ++j) {
        const unsigned k0_ = ck[j], k1_ = ck[4 + j], k2_ = ck[8 + j], k3_ = ck[12 + j];
        const unsigned ka_ = (sub & 1) ? k1_ : k0_;
        const unsigned kb_ = (sub & 1) ? k3_ : k2_;
        const unsigned key = (sub & 2) ? kb_ : ka_;
        const int cidx = 255 - (int)(key & 255u);
        const int a = cidx >> 4, b = cidx & 15;
        const unsigned k1 = s1[a], k2 = s2[b];
        sv[j] = __expf(keyf(k1 & ~127u) + keyf(k2 & ~127u) - mx);
        ev[j] = (127 - (int)(k1 & 127u)) * 128 + (127 - (int)(k2 & 127u));
      }
      float sum = (sv[0] + sv[1]) + (sv[2] + sv[3]);
      sum += __uint_as_float((unsigned)__builtin_amdgcn_update_dpp(0, (int)__float_as_uint(sum), 0xB1, 0xF, 0xF, true));
      sum += __uint_as_float((unsigned)__builtin_amdgcn_update_dpp(0, (int)__float_as_uint(sum), 0x4E, 0xF, 0xF, true));
      const float inv = 1.f / sum;
      const size_t ob = (size_t)(t0 + tok) * 128 + h * 16 + sub * 4;
      *(int4*)(EI + ob) = make_int4(ev[0], ev[1], ev[2], ev[3]);
      *(float4*)(GT + ob) = make_float4(sv[0] * inv, sv[1] * inv, sv[2] * inv, sv[3] * inv);
    }
    WAVE_LDS_SYNC();
  }
}

__device__ __forceinline__ float gelu_tanh(float x) {
  return 0.5f * x * (1.f + tanhf(0.7978845608028654f * (x + 0.044715f * x * x * x)));
}
__device__ __forceinline__ float butterfly8(const float* d, int lane) {
  const bool b5 = lane & 32, b4 = lane & 16, b3 = lane & 8;
  float e4[4], e2[2], e1;
#pragma unroll
  for (int j = 0; j < 4; ++j) {
    float snd = b5 ? d[j] : d[j + 4];
    float kep = b5 ? d[j + 4] : d[j];
    e4[j] = kep + __shfl_xor(snd, 32);
  }
#pragma unroll
  for (int j = 0; j < 2; ++j) {
    float snd = b4 ? e4[j] : e4[j + 2];
    float kep = b4 ? e4[j + 2] : e4[j];
    e2[j] = kep + __shfl_xor(snd, 16);
  }
  {
    float snd = b3 ? e2[0] : e2[1];
    float kep = b3 ? e2[1] : e2[0];
    e1 = kep + __shfl_xor(snd, 8);
  }
  e1 += __shfl_xor(e1, 4);
  e1 += __shfl_xor(e1, 2);
  e1 += __shfl_xor(e1, 1);
  const int jj = lane & 7;
  const int srcl = ((jj >> 2) & 1) * 32 + ((jj >> 1) & 1) * 16 + (jj & 1) * 8;
  return __shfl(e1, srcl);
}
__device__ __forceinline__ void phase_peer_gather(const Params& p, int l, int dry, unsigned char* smem) {
  const int tid_ = opaque_tid(); const int lane = tid_ & 63, wv = tid_ >> 6;
  const bf16_t* H = (const bf16_t*)(p.ws + OFF_H);
  bf16_t* Hw = (bf16_t*)(p.ws + OFF_H);
  const unsigned char* UB = p.ws + OFF_UB + (size_t)l * 16384 * 512;
  const unsigned char* VB = p.ws + OFF_VB + (size_t)l * 16384 * 512;
  const int* EI = (const int*)(p.ws + OFF_EIDX);
  const float* GT = (const float*)(p.ws + OFF_GATE);
  const float* modv = (const float*)(p.ws + OFF_MOD);
  float* actw = (float*)smem + wv * (24 * 128);
  const int tstride = gridDim.x * 4, tfirst = blockIdx.x * 4 + wv;
  int ntok = (tfirst < NTOK) ? (NTOK - 1 - tfirst) / tstride + 1 : 0;
  if (ntok > 24) ntok = 24;
  for (int i = lane; i < ntok * 128; i += 64) actw[i] = 0.f;
  WAVE_LDS_SYNC();
  {
    const int q_ = lane >> 4, n_ = lane & 15;
    for (int kk = 0; kk < 8; ++kk) {
      const unsigned char* ubs = UB + (size_t)kk * (16384 * 64) + q_ * 16;
      int pe0 = 0, pe1 = 0; u32x4 pxa = {0u, 0u, 0u, 0u};
      if (ntok > 0) {
        pe0 = EI[(size_t)tfirst * 128 + lane]; pe1 = EI[(size_t)tfirst * 128 + 64 + lane];
        pxa = *(const u32x4*)(p.ws + OFF_H8 + (size_t)tfirst * 512 + kk * 64 + q_ * 16);
      }
      for (int ti = 0; ti < ntok; ++ti) {
        const int ev0 = pe0, ev1 = pe1;
        const u32x4 xa4 = pxa;
        if (ti + 1 < ntok) {
          const size_t tn = (size_t)(tfirst + (ti + 1) * tstride);
          pe0 = EI[tn * 128 + lane]; pe1 = EI[tn * 128 + 64 + lane];
          pxa = *(const u32x4*)(p.ws + OFF_H8 + tn * 512 + kk * 64 + q_ * 16);
        }
        u32x4 bq[8];
#pragma unroll
        for (int g = 0; g < 8; ++g) {
          const int e_ = __shfl((g < 4) ? ev0 : ev1, (g & 3) * 16 + n_);
          bq[g] = *(const u32x4*)(ubs + (size_t)e_ * 64);
        }
        const v8i32 aa = {(int)xa4[0], (int)xa4[1], (int)xa4[2], (int)xa4[3], 0, 0, 0, 0};
#pragma unroll
        for (int g = 0; g < 8; ++g) {
          const v8i32 bb = {(int)bq[g][0], (int)bq[g][1], (int)bq[g][2], (int)bq[g][3], 0, 0, 0, 0};
          f32x4 ac = (f32x4){0.f, 0.f, 0.f, 0.f};
          ac = __builtin_amdgcn_mfma_scale_f32_16x16x128_f8f6f4(aa, bb, ac, 4, 4, 0, 0, 0, 0);
          if (q_ == (g & 3)) actw[ti * 128 + g * 16 + n_] += ac[0];
        }
      }
    }
  }
  WAVE_LDS_SYNC();
  int ti_ = 0;
  uint4 nx0 = make_uint4(0, 0, 0, 0), nx1 = nx0; int nev0 = 0, nev1 = 0; float ngv0 = 0.f, ngv1 = 0.f;
  {
    const int tf = blockIdx.x * 4 + wv;
    if (tf < NTOK) {
      nx0 = *(const uint4*)(H + (size_t)tf * 1024 + lane * 16); nx1 = *(const uint4*)(H + (size_t)tf * 1024 + lane * 16 + 8);
      nev0 = EI[(size_t)tf * 128 + lane]; nev1 = EI[(size_t)tf * 128 + 64 + lane];
      ngv0 = GT[(size_t)tf * 128 + lane]; ngv1 = GT[(size_t)tf * 128 + 64 + lane];
    }
  }
  for (int t = blockIdx.x * 4 + wv; t < NTOK; t += gridDim.x * 4) {
    float xf[16];
    unpack8(nx0, xf);
    unpack8(nx1, xf + 8);
    f32x2 xf2[8], out2[8];
#pragma unroll
    for (int e = 0; e < 8; ++e) { xf2[e] = (f32x2){xf[2 * e], xf[2 * e + 1]}; out2[e] = (f32x2){0.f, 0.f}; }
    const int ev0 = nev0, ev1 = nev1;
    const float gv0 = ngv0, gv1 = ngv1;
    {
      const int tn = t + gridDim.x * 4;
      if (tn < NTOK) {
        nx0 = *(const uint4*)(H + (size_t)tn * 1024 + lane * 16); nx1 = *(const uint4*)(H + (size_t)tn * 1024 + lane * 16 + 8);
        nev0 = EI[(size_t)tn * 128 + lane]; nev1 = EI[(size_t)tn * 128 + 64 + lane];
        ngv0 = GT[(size_t)tn * 128 + lane]; ngv1 = GT[(size_t)tn * 128 + 64 + lane];
      }
    }
    float cacc0 = 0.f, cacc1 = 0.f, coef0 = 0.f, coef1 = 0.f;
    uint2 bufA[16], bufB[16], bufC[16];
    const f32x2 zero2_ = {(float)dry, (float)dry};
#define GLOAD(buf, bb) { \
      const unsigned char* tb_ = ((bb) < 8) ? UB : VB; \
      const int evv_ = (((bb) & 7) < 4) ? ev0 : ev1; \
      _Pragma("unroll") for (int j = 0; j < 16; ++j) { \
        const int e_ = __builtin_amdgcn_readlane(evv_, ((bb) & 3) * 16 + j); \
        buf[j] = *(const uint2*)(tb_ + (size_t)e_ * 512 + lane * 8); } }
#define GCOMP(buf, bb) { \
      if ((bb) < 8) { \
        float d_[16]; \
        _Pragma("unroll") for (int j = 0; j < 16; ++j) { \
          f32x2 uf_[8]; unpack16_fp4(buf[j].x, buf[j].y, uf_); \
          f32x2 sa_ = uf_[0] * xf2[0]; \
          if (PROBE_CVT) { f32x2 ug_[8]; \
            ug_[0] = __builtin_amdgcn_cvt_scalef32_pk_f32_fp4(buf[j].x, 2.0f, 0); ug_[1] = __builtin_amdgcn_cvt_scalef32_pk_f32_fp4(buf[j].x, 2.0f, 1); \
            ug_[2] = __builtin_amdgcn_cvt_scalef32_pk_f32_fp4(buf[j].x, 2.0f, 2); ug_[3] = __builtin_amdgcn_cvt_scalef32_pk_f32_fp4(buf[j].x, 2.0f, 3); \
            ug_[4] = __builtin_amdgcn_cvt_scalef32_pk_f32_fp4(buf[j].y, 2.0f, 0); ug_[5] = __builtin_amdgcn_cvt_scalef32_pk_f32_fp4(buf[j].y, 2.0f, 1); \
            ug_[6] = __builtin_amdgcn_cvt_scalef32_pk_f32_fp4(buf[j].y, 2.0f, 2); ug_[7] = __builtin_amdgcn_cvt_scalef32_pk_f32_fp4(buf[j].y, 2.0f, 3); \
            _Pragma("unroll") for (int q = 0; q < 8; ++q) sa_ = __builtin_elementwise_fma(ug_[q], zero2_, sa_); } \
          _Pragma("unroll") for (int q = 1; q < 8; ++q) sa_ = __builtin_elementwise_fma(uf_[q], xf2[q], sa_); \
          d_[j] = sa_.x + sa_.y; } \
        const float t0_ = butterfly8(d_, lane), t1_ = butterfly8(d_ + 8, lane); \
        const int k0_ = ((bb) & 3) * 16; \
        if (((bb) & 7) < 4) { if ((lane >> 3) == (k0_ >> 3)) cacc0 = t0_; if ((lane >> 3) == (k0_ >> 3) + 1) cacc0 = t1_; } \
        else { if ((lane >> 3) == (k0_ >> 3)) cacc1 = t0_; if ((lane >> 3) == (k0_ >> 3) + 1) cacc1 = t1_; } \
        if ((bb) == 7) { coef0 = gelu_tanh(cacc0 * (1.f / U_SCALE)) * gv0 * (1.f / V_SCALE); coef1 = gelu_tanh(cacc1 * (1.f / U_SCALE)) * gv1 * (1.f / V_SCALE); } \
      } else { \
        const float cfv_ = (((bb) & 7) < 4) ? coef0 : coef1; \
        _Pragma("unroll") for (int j = 0; j < 16; ++j) { \
          const float cf_ = __uint_as_float((unsigned)__builtin_amdgcn_readlane((int)__float_as_uint(cfv_), ((bb) & 3) * 16 + j)); \
          f32x2 vf_[8]; unpack16_fp4(buf[j].x, buf[j].y, vf_); \
          const f32x2 c2_ = {cf_, cf_}; \
          _Pragma("unroll") for (int q = 0; q < 8; ++q) out2[q] = __builtin_elementwise_fma(vf_[q], c2_, out2[q]); } \
      } }
#if GATHER_CHECK
    GLOAD(bufA, 0)
#pragma unroll
    for (int b = 0; b < 8; b += 2) {
      GLOAD(bufB, b + 1)
      GCOMP(bufA, b)
      if (b + 2 < 8) GLOAD(bufA, b + 2)
      GCOMP(bufB, b + 1)
    }
    const float vacc0 = cacc0, vacc1 = cacc1;
#endif
#if !GATHER_CHECK
    GLOAD(bufA, 8)
#endif
    cacc0 = actw[ti_ * 128 + lane] * (1.f / X_SCALE);
    cacc1 = actw[ti_ * 128 + 64 + lane] * (1.f / X_SCALE);
    ++ti_;
#if GATHER_CHECK
    {
      const bool bad0 = fabsf(cacc0 - vacc0) > 0.15f * fabsf(vacc0) + 45.f;
      const bool bad1 = fabsf(cacc1 - vacc1) > 0.15f * fabsf(vacc1) + 45.f;
      const unsigned long long m0 = __ballot(bad0), m1 = __ballot(bad1);
      if (__popcll(m0) + __popcll(m1) > 32) out2[0] = (f32x2){__builtin_nanf(""), __builtin_nanf("")};
    }
#endif
    coef0 = gelu_tanh(cacc0 * (1.f / U_SCALE)) * gv0 * (1.f / V_SCALE);
    coef1 = gelu_tanh(cacc1 * (1.f / U_SCALE)) * gv1 * (1.f / V_SCALE);
#if GATHER_CHECK
    GLOAD(bufA, 8)
#endif
    GLOAD(bufB, 9)
#pragma unroll
    for (int b = 8; b < 14; b += 3) {
      GLOAD(bufC, b + 2)
      GCOMP(bufA, b)
      GLOAD(bufA, b + 3)
      GCOMP(bufB, b + 1)
      GLOAD(bufB, b + 4)
      GCOMP(bufC, b + 2)
    }
    GCOMP(bufA, 14)
    GCOMP(bufB, 15)
#undef GLOAD
#undef GCOMP
    float out[16];
#pragma unroll
    for (int e = 0; e < 8; ++e) { out[2 * e] = out2[e].x; out[2 * e + 1] = out2[e].y; }
    const int m = tok_mod(t);
    const float* ga2 = modv + (size_t)(l * 9 + m) * 6144 + 5120;
    float* xr = p.out + (size_t)t * 1024 + lane * 16;
    float xn[16];
    float ss = 0.f;
#pragma unroll
    for (int q4 = 0; q4 < 4; ++q4) {
      float4 xv = *(const float4*)(xr + q4 * 4);
      float4 gg = *(const float4*)(ga2 + lane * 16 + q4 * 4);
      const int o = q4 * 4;
      xn[o + 0] = xv.x + gg.x * out[o + 0];
      xn[o + 1] = xv.y + gg.y * out[o + 1];
      xn[o + 2] = xv.z + gg.z * out[o + 2];
      xn[o + 3] = xv.w + gg.w * out[o + 3];
      ss += xn[o] * xn[o] + xn[o + 1] * xn[o + 1] + xn[o + 2] * xn[o + 2] + xn[o + 3] * xn[o + 3];
    }
    ss = wave_sum(ss);
    const float rs = rsqrtf(ss * (1.f / 1024.f) + EPSV);
    if (dry) continue;
    if (l < 3) {
      const float* md = modv + (size_t)((l + 1) * 9 + m) * 6144 + lane * 16;
      const float* g = p.in[8] + (l + 1) * 1024 + lane * 16;
      float hv[16];
#pragma unroll
      for (int q = 0; q < 16; ++q) hv[q] = xn[q] * rs * g[q] * (1.f + md[1024 + q]) + md[q];
      uint4 o;
      o.x = pack2(hv[0], hv[1]); o.y = pack2(hv[2], hv[3]); o.z = pack2(hv[4], hv[5]); o.w = pack2(hv[6], hv[7]);
      *(uint4*)(Hw + (size_t)t * 1024 + lane * 16) = o;
      o.x = pack2(hv[8], hv[9]); o.y = pack2(hv[10], hv[11]); o.z = pack2(hv[12], hv[13]); o.w = pack2(hv[14], hv[15]);
      *(uint4*)(Hw + (size_t)t * 1024 + lane * 16 + 8) = o;
#pragma unroll
      for (int q4 = 0; q4 < 4; ++q4) *(float4*)(xr + q4 * 4) = make_float4(xn[q4 * 4], xn[q4 * 4 + 1], xn[q4 * 4 + 2], xn[q4 * 4 + 3]);
    } else {
      const float* g = p.in[10] + lane * 16;
#pragma unroll
      for (int q4 = 0; q4 < 4; ++q4)
        *(float4*)(xr + q4 * 4) = make_float4(xn[q4 * 4] * rs * g[q4 * 4], xn[q4 * 4 + 1] * rs * g[q4 * 4 + 1],
                                              xn[q4 * 4 + 2] * rs * g[q4 * 4 + 2], xn[q4 * 4 + 3] * rs * g[q4 * 4 + 3]);
    }
  }
}

#define XB_TMO      128
#define XB_XCNT(j)  (256  + 64 * (j))
#define XB_XSUB(j)  (1280 + 64 * (j))
#define XB_XGEN(j)  (2304 + 64 * (j))
#define XB_TOP      3328
#define XB_TOPGEN   3392
#define XCD_BAR_WORDS 3456
#define XB_SPIN_CAP (1u << 18)
#define LAS __attribute__((address_space(3)))

__device__ __forceinline__ unsigned xb_ld(unsigned* p)              { return __hip_atomic_load(p, __ATOMIC_RELAXED, __HIP_MEMORY_SCOPE_AGENT); }
__device__ __forceinline__ unsigned xb_add(unsigned* p, unsigned v) { return __hip_atomic_fetch_add(p, v, __ATOMIC_RELAXED, __HIP_MEMORY_SCOPE_AGENT); }
__device__ __forceinline__ unsigned xb_xcc_id() { return (unsigned)__builtin_amdgcn_s_getreg((3 << 11) | 20) & 0xFu; }
#define XB_SPIN(cond, bar) do { unsigned _sp = 0; while (cond) { __builtin_amdgcn_s_sleep(1); \
    if ((++_sp & 255u) == 0u) { if (xb_ld(&(bar)[XB_TMO])) break; if (_sp > XB_SPIN_CAP) { atomicAdd(&(bar)[XB_TMO], 1u); break; } } } } while (0)

struct XcdBarrier {
    unsigned* bar; unsigned x;
    volatile LAS unsigned* st;
};

__device__ __forceinline__ XcdBarrier xcd_barrier_post(unsigned* bar, volatile LAS unsigned* st) {
    XcdBarrier b; b.bar = bar; b.x = xb_xcc_id(); b.st = st;
    if (threadIdx.x == 0) (void)xb_add(&bar[XB_XCNT(b.x)], 1u);
    return b;
}
__device__ __forceinline__ void xcd_barrier_complete(unsigned* bar, unsigned x, unsigned& nloc, unsigned& nx) {
    const unsigned G = gridDim.x * gridDim.y * gridDim.z;
    unsigned sum, cnt, mine, sp = 0u;
    for (;;) {
        sum = 0u; cnt = 0u; mine = 0u;
#pragma unroll
        for (unsigned j = 0; j < 16; ++j) { const unsigned c = xb_ld(&bar[XB_XCNT(j)]); sum += c; cnt += (c > 0u) ? 1u : 0u; mine = (j == x) ? c : mine; }
        if (sum == G) break;
        __builtin_amdgcn_s_sleep(1);
        if ((++sp & 255u) == 0u) { if (xb_ld(&bar[XB_TMO])) break; if (sp > XB_SPIN_CAP) { atomicAdd(&bar[XB_TMO], 1u); break; } }
    }
    nloc = mine > 0u ? mine : 1u; nx = cnt > 0u ? cnt : 1u;
}

__device__ __forceinline__ void xcd_barrier(const XcdBarrier& b) {
    asm volatile("s_waitcnt vmcnt(0)" ::: "memory");
    __syncthreads();
    if (threadIdx.x == 0) {
        unsigned* bar = b.bar;
        __builtin_amdgcn_s_waitcnt(0);
        unsigned nloc = b.st[0], nx = b.st[1];
        if (nloc == 0u) { xcd_barrier_complete(bar, b.x, nloc, nx); b.st[0] = nloc; b.st[1] = nx; }
        const unsigned old = xb_add(&bar[XB_XSUB(b.x)], 1u);
        const unsigned gen = old / nloc;
        if (old + 1u == (gen + 1u) * nloc) {
            __builtin_amdgcn_fence(__ATOMIC_RELEASE, "agent");
            asm volatile("s_waitcnt vmcnt(0)" ::: "memory");
            const unsigned og = xb_add(&bar[XB_TOP], 1u);
            const unsigned tg = og / nx;
            if (og + 1u == (tg + 1u) * nx) xb_add(&bar[XB_TOPGEN], 1u);
            else XB_SPIN(xb_ld(&bar[XB_TOPGEN]) == tg, bar);
            __builtin_amdgcn_fence(__ATOMIC_ACQUIRE, "agent");
            xb_add(&bar[XB_XGEN(b.x)], 1u);
            asm volatile("s_waitcnt vmcnt(0)" ::: "memory");
        } else {
            XB_SPIN(xb_ld(&bar[XB_XGEN(b.x)]) == gen, bar);
            __builtin_amdgcn_fence(__ATOMIC_ACQUIRE, "agent");
            asm volatile("s_waitcnt vmcnt(0)" ::: "memory");
        }
    }
    __syncthreads();
}

__global__ void __launch_bounds__(256, 2) mega(Params p, int ph_lo, int ph_hi) {
  __shared__ __attribute__((aligned(16))) unsigned char smem[77312];
  cg::grid_group grid = cg::this_grid();
  __shared__ uint4 xb_words;
  if (threadIdx.x == 0) xb_words = make_uint4(0u, 0u, 0u, 0u);
  __syncthreads();
  XcdBarrier xb = xcd_barrier_post((unsigned*)(p.ws + OFF_BAR), (volatile LAS unsigned*)&xb_words);
  if (ph_hi > 100000) grid.sync();
  for (int ph = ph_lo; ph < ph_hi; ++ph) {
#if PROBE_MASK
    const int pcode = ph < 2 ? ph : 2 + (ph - 2) % 9;
    const int nrep = ((PROBE_MASK >> pcode) & 1) ? 2 : 1;
    for (int rep = 0; rep < nrep; ++rep) {
    if (rep) xcd_barrier(xb);
#endif
    bool did = true;
#if PROBE_MASK
    const int prep_rep = rep; const int nrep_ = nrep;
#else
    const int prep_rep = 0; const int nrep_ = 1;
#endif
    if (ph == 0) phase_prep_a(p, smem);
    else if (ph == 1) phase_prep_b(p);
    else {
      const int l = (ph - 2) / 9, sub = (ph - 2) % 9;
      const int il = l >> 1;
      const bool odd = l & 1;
      const float* modv = (const float*)(p.ws + OFF_MOD);
      if (sub == 6) {
        gemm_q_fp8(p.ws + OFF_H8F, p.ws + OFF_WQ + (size_t)l * 2048 * 1024, (bf16_t*)(p.ws + OFF_Q), smem);
      } else if (sub == 0) {
        const bf16_t* Bt; int ntn, ldc; bf16_t* C;
        if (sub == 0) {
          Bt = odd ? (const bf16_t*)(p.ws + OFF_WIN_OD) + (size_t)il * 3328 * 1024
                   : (const bf16_t*)(p.ws + OFF_WIN_EV) + (size_t)il * 3072 * 1024;
          ntn = odd ? 13 : 12; ldc = PSTRIDE; C = (bf16_t*)(p.ws + OFF_P);
        } else {
          Bt = (const bf16_t*)(p.ws + OFF_WQ) + (size_t)l * 2048 * 1024;
          ntn = 8; ldc = 2048; C = (bf16_t*)(p.ws + OFF_Q);
        }
        gemm_phase<0, 8, 64>((const bf16_t*)(p.ws + OFF_H), Bt, ntn, C, ldc, nullptr, nullptr, smem);
      } else if (sub == 1) {
        if (odd) phase_odd_prep(p, l, smem, prep_rep); else did = false;
      } else if (sub == 2) {
        if (odd) phase_gdn_chain(p, l, smem); else phase_ret_chain(p, l, smem);
      } else if (sub == 3) {
        phase_mix_out(p, l);
      } else if (sub == 4) {
        gemm_phase<1, 4, 64>((const bf16_t*)(p.ws + OFF_YMIX), (const bf16_t*)(p.ws + OFF_WOUT) + (size_t)l * 1024 * 1024, 8,
                      nullptr, 0, p.out, modv + (size_t)l * 9 * 6144 + 2048, smem, (nrep_ > 1 && prep_rep == 0) ? 1 : 0);
      } else if (sub == 5) {
        phase_norm2(p, l);
      } else if (sub == 7) {
        phase_peer_score(p, l, smem);
      } else {
        phase_peer_gather(p, l, (nrep_ > 1 && prep_rep == 0) ? 1 : 0, smem);
      }
    }
#if PROBE_MASK
    if (rep + 1 < nrep) continue;
#endif
    if (did && ph + 1 < ph_hi) xcd_barrier(xb);
#if PROBE_MASK
    }
#endif
  }
}

extern "C" void kernel_launch(void* const* d_in, const int* in_sizes, int n_in, void* d_out, int out_size,
                              void* d_ws, size_t ws_size, hipStream_t stream) {
  static int grid_blocks = 0;
  if (!grid_blocks) {
    int dev = 0, cus = 0, per_cu = 0;
    (void)hipGetDevice(&dev);
    (void)hipDeviceGetAttribute(&cus, hipDeviceAttributeMultiprocessorCount, dev);
    (void)hipOccupancyMaxActiveBlocksPerMultiprocessor(&per_cu, mega, 256, 0);
    if (per_cu < 1) per_cu = 1;
    if (per_cu > 2) per_cu = 2;
    grid_blocks = cus * per_cu;
    if (ws_size < WS_NEED) fprintf(stderr, "kernel_launch: workspace too small: %zu < %zu\n", ws_size, (size_t)WS_NEED);
  }
  Params p{};
  for (int i = 0; i < 30; ++i) p.in[i] = (const float*)d_in[i];
  p.out = (float*)d_out;
  p.ws = (unsigned char*)d_ws;
  (void)hipMemsetAsync((unsigned char*)d_ws + OFF_BAR, 0, XCD_BAR_WORDS * sizeof(unsigned), stream);
#if SINGLE_LAUNCH
  int lo = 0, hi = NPHASE;
  void* args[] = {&p, &lo, &hi};
  hipError_t e = hipLaunchCooperativeKernel((void*)mega, dim3(grid_blocks), dim3(256), args, 0, stream);
  if (e != hipSuccess) fprintf(stderr, "cooperative launch failed: %s (grid %d)\n", hipGetErrorString(e), grid_blocks);
#else
  for (int ph = 0; ph < NPHASE; ++ph) {
    const int l = (ph - 2) / 9, sub = (ph - 2) % 9;
    if (ph >= 2 && sub == 1 && !(l & 1)) continue;
    hipLaunchKernelGGL(mega, dim3(grid_blocks), dim3(256), 0, stream, p, ph, ph + 1);
  }
#endif
}
```

```cpp
#include <hip/hip_runtime.h>
#include <hip/hip_cooperative_groups.h>
#include <cstdio>
namespace cg = cooperative_groups;

#ifndef PROBE_MASK
#define PROBE_MASK 0
#endif
#ifndef GATHER_CHECK
#define GATHER_CHECK 0
#endif
#ifndef PROBE_CVT
#define PROBE_CVT 0
#endif
#ifndef PROBE_ODD
#define PROBE_ODD 0
#endif
#ifndef SINGLE_LAUNCH
#define SINGLE_LAUNCH 1
#endif

typedef unsigned short bf16_t;
using bf16x8 = __attribute__((ext_vector_type(8))) short;
using f32x4 = __attribute__((ext_vector_type(4))) float;
using f32x2 = __attribute__((ext_vector_type(2))) float;
using u32x4 = __attribute__((ext_vector_type(4))) unsigned;
using v8i32 = __attribute__((ext_vector_type(8))) int;

#define NTOK 24576
#define NPROMPT 8192
#define PSTRIDE 3200
#define EPSV 1e-6f
#define NPHASE 38
#define WQ_SCALE 32.f
#define X_SCALE 1.5f

constexpr size_t OFF_MOD = 0;
constexpr size_t OFF_ROPE = 1u << 20;
constexpr size_t OFF_WIN_EV = OFF_ROPE + 65536;
constexpr size_t OFF_WIN_OD = OFF_WIN_EV + 2ull * 3072 * 1024 * 2;
constexpr size_t OFF_WOUT = OFF_WIN_OD + 2ull * 3328 * 1024 * 2;
constexpr size_t OFF_WQ = OFF_WOUT + 4ull * 1024 * 1024 * 2;
constexpr size_t OFF_KEYS = OFF_WQ + 4ull * 2048 * 1024 * 2;
constexpr size_t OFF_UB = OFF_KEYS + 4ull * 8 * 2 * 128 * 128 * 2;
constexpr size_t OFF_VB = OFF_UB + 4ull * 16384 * 1024 * 2;
constexpr size_t OFF_H = OFF_VB + 4ull * 16384 * 1024 * 2;
constexpr size_t OFF_P = OFF_H + (size_t)NTOK * 1024 * 2;
constexpr size_t OFF_YMIX = OFF_P + (size_t)NTOK * PSTRIDE * 2;
constexpr size_t OFF_ODIR = OFF_YMIX + (size_t)NTOK * 1024 * 2;
constexpr size_t OFF_Q = OFF_ODIR;
constexpr size_t OFF_EIDX = OFF_ODIR + 2ull * NTOK * 512 * 4;
constexpr size_t OFF_GATE = OFF_EIDX + (size_t)NTOK * 128 * 4;
constexpr size_t GP_ITEM = 73728;
constexpr size_t OFF_GPREP = OFF_GATE + (size_t)NTOK * 128 * 4;
constexpr size_t OFF_EGL = OFF_GPREP + 3072ull * GP_ITEM;
constexpr size_t OFF_CONV = OFF_EGL + 16384;
constexpr size_t OFF_H8 = OFF_CONV;
constexpr size_t OFF_H8F = OFF_CONV + (16u << 20);
constexpr size_t OFF_BAR = OFF_CONV + (size_t)NTOK * 512 * 4;
constexpr size_t WS_NEED = OFF_BAR + 16384;

struct Params {
  const float* in[30];
  float* out;
  unsigned char* ws;
};

__device__ const unsigned char CAND_A[52] = {0,0,0,0,0,0,0,0,0,0,0,0,0,0,0,0,1,1,1,1,1,1,1,1,2,2,2,2,2,3,3,3,3,4,4,4,5,5,6,6,7,7,8,9,10,11,12,13,14,15,0,0};
__device__ const unsigned char CAND_B[52] = {0,1,2,3,4,5,6,7,8,9,10,11,12,13,14,15,0,1,2,3,4,5,6,7,0,1,2,3,4,0,1,2,3,0,1,2,0,1,0,1,0,1,0,0,0,0,0,0,0,0,0,0};

__device__ __forceinline__ int opaque_tid() { int t = threadIdx.x; asm volatile("" : "+v"(t)); return t; }
typedef __bf16 hbf16x2 __attribute__((ext_vector_type(2)));
__device__ __forceinline__ bf16_t f2bf(float f) {
  return __builtin_bit_cast(unsigned short, (__bf16)f);
}
__device__ __forceinline__ float bf2f(bf16_t b) { return __uint_as_float(((unsigned)b) << 16); }
__device__ __forceinline__ float bflo(unsigned u) { return __uint_as_float(u << 16); }
__device__ __forceinline__ float bfhi(unsigned u) { return __uint_as_float(u & 0xffff0000u); }
__device__ __forceinline__ unsigned pack2(float a, float b) {
  f32x2 v = {a, b};
  return __builtin_bit_cast(unsigned, __builtin_convertvector(v, hbf16x2));
}
__device__ __forceinline__ float wave_sum(float v) {
#pragma unroll
  for (int o = 32; o > 0; o >>= 1) v += __shfl_xor(v, o);
  return v;
}
__device__ __forceinline__ f32x4 mfma16(bf16x8 a, bf16x8 b, f32x4 c) {
  return __builtin_amdgcn_mfma_f32_16x16x32_bf16(a, b, c, 0, 0, 0);
}
__device__ __forceinline__ bf16x8 ldfrag(const bf16_t* p) { return *(const bf16x8*)p; }
__device__ __forceinline__ float siluf(float v) { return v * __builtin_amdgcn_rcpf(1.f + __expf(-v)); }
__device__ __forceinline__ int tok_mod(int t) { return t < NPROMPT ? 0 : 1 + ((t - NPROMPT) >> 11); }
__device__ __forceinline__ unsigned fkey(float f) {
  const unsigned u = __float_as_uint(f);
  return u ^ ((unsigned)((int)u >> 31) | 0x80000000u);
}
__device__ __forceinline__ float keyf(unsigned k) {
  unsigned b = (k & 0x80000000u) ? (k ^ 0x80000000u) : ~k;
  return __uint_as_float(b);
}
__device__ __forceinline__ void unpack8(uint4 v, float* f) {
  f[0] = bflo(v.x); f[1] = bfhi(v.x); f[2] = bflo(v.y); f[3] = bfhi(v.y);
  f[4] = bflo(v.z); f[5] = bfhi(v.z); f[6] = bflo(v.w); f[7] = bfhi(v.w);
}

__device__ __forceinline__ void prep_mod(const Params& p, float* smem) {
  float* sc = smem;
  float* red = smem + 9 * 1024;
  const int tid = opaque_tid();
  const float* c = p.in[4];
  const float* cctx = p.in[5];
  for (int i = tid; i < 9 * 1024; i += 256) {
    int m = i >> 10, k = i & 1023;
    float v = (m == 0) ? cctx[k] : c[(m - 1) * 1024 + k];
    sc[i] = v / (1.f + expf(-v));
  }
  __syncthreads();
  float* modv = (float*)(p.ws + OFF_MOD);
  const int cl = tid & 63, kg = tid >> 6;
  for (int u = blockIdx.x; u < 4 * 96; u += gridDim.x) {
    const int l = u / 96, nb = (u % 96) * 64;
    const float* W = p.in[6] + (size_t)l * 1024 * 6144 + nb + cl;
    float acc[9];
#pragma unroll
    for (int m = 0; m < 9; ++m) acc[m] = 0.f;
#pragma unroll 16
    for (int k = kg * 256; k < kg * 256 + 256; ++k) {
      float w = W[(size_t)k * 6144];
#pragma unroll
      for (int m = 0; m < 9; ++m) acc[m] += sc[m * 1024 + k] * w;
    }
#pragma unroll
    for (int m = 0; m < 9; ++m) red[(kg * 9 + m) * 64 + cl] = acc[m];
    __syncthreads();
    for (int i = tid; i < 9 * 64; i += 256) {
      int m = i >> 6, c2 = i & 63;
      float s = red[(0 * 9 + m) * 64 + c2] + red[(1 * 9 + m) * 64 + c2] + red[(2 * 9 + m) * 64 + c2] + red[(3 * 9 + m) * 64 + c2];
      int nn = nb + c2;
      modv[(size_t)(l * 9 + m) * 6144 + nn] = s + p.in[7][l * 6144 + nn];
    }
    __syncthreads();
  }
}

__device__ __forceinline__ void prep_transpose(const float* src, bf16_t* dst, int N, int Npad, float* tile, unsigned char* dst8 = nullptr, float scale8 = 1.f) {
  const int tid = opaque_tid();
  const int ntn = Npad / 64;
  const int units = ntn * 16;
  for (int u = blockIdx.x; u < units; u += gridDim.x) {
    const int nt = u % ntn, kt = u / ntn;
    const int n0 = nt * 64, k0 = kt * 64;
    {
      const int c = tid & 63;
      const int n = n0 + c;
      const int nc = n < N ? n : N - 1;
      float tv[16];
#pragma unroll
      for (int i = 0; i < 16; ++i) tv[i] = src[(size_t)(k0 + (tid >> 6) + 4 * i) * N + nc];
#pragma unroll
      for (int i = 0; i < 16; ++i) tile[((tid >> 6) + 4 * i) * 65 + c] = (n < N) ? tv[i] : 0.f;
    }
    __syncthreads();
#pragma unroll 4
    for (int i = 0; i < 16; ++i) {
      int rr = (tid >> 6) + 4 * i, cc = tid & 63;
      if (dst8) dst8[(size_t)(n0 + rr) * 1024 + k0 + cc] = (unsigned char)__builtin_amdgcn_cvt_pk_fp8_f32(tile[cc * 65 + rr] * scale8, 0.f, 0, false);
      else dst[(size_t)(n0 + rr) * 1024 + k0 + cc] = f2bf(tile[cc * 65 + rr]);
    }
    __syncthreads();
  }
}

__device__ __forceinline__ void prep_convert(const float* src, bf16_t* dst, size_t n4) {
  const size_t stride = (size_t)gridDim.x * 256;
  for (size_t i0 = (size_t)blockIdx.x * 256 + opaque_tid(); i0 < n4; i0 += stride * 8) {
    float4 v[8];
#pragma unroll
    for (int j = 0; j < 8; ++j) { const size_t i = i0 + j * stride; const size_t ic = i < n4 ? i : n4 - 1; v[j] = ((const float4*)src)[ic]; }
#pragma unroll
    for (int j = 0; j < 8; ++j) {
      const size_t i = i0 + j * stride;
      if (i < n4) { uint2 o; o.x = pack2(v[j].x, v[j].y); o.y = pack2(v[j].z, v[j].w); ((uint2*)dst)[i] = o; }
    }
  }
}

__device__ __forceinline__ void prep_convert_fp8(const float* src, unsigned* dst, size_t n4, float scale) {
  const size_t stride = (size_t)gridDim.x * 256;
  for (size_t i0 = (size_t)blockIdx.x * 256 + opaque_tid(); i0 < n4; i0 += stride * 8) {
    float4 v[8];
#pragma unroll
    for (int j = 0; j < 8; ++j) { const size_t i = i0 + j * stride; const size_t ic = i < n4 ? i : n4 - 1; f32x4 t4 = __builtin_nontemporal_load((const f32x4*)src + ic); v[j] = make_float4(t4[0], t4[1], t4[2], t4[3]); }
#pragma unroll
    for (int j = 0; j < 8; ++j) {
      const size_t i = i0 + j * stride;
      if (i < n4) {
        unsigned w = __builtin_amdgcn_cvt_pk_fp8_f32(v[j].x * scale, v[j].y * scale, 0, false);
        w = __builtin_amdgcn_cvt_pk_fp8_f32(v[j].z * scale, v[j].w * scale, w, true);
        dst[i] = w;
      }
    }
  }
}
__device__ __forceinline__ void prep_convert_fp4(const float* src, unsigned* dst, size_t n8, float scale, int W) {
  const size_t stride = (size_t)gridDim.x * 256;
  for (size_t i0 = (size_t)blockIdx.x * 256 + opaque_tid(); i0 < n8; i0 += stride * 4) {
    f32x4 va[4], vb[4];
#pragma unroll
    for (int j = 0; j < 4; ++j) {
      const size_t i = i0 + j * stride; const size_t ic = i < n8 ? i : n8 - 1;
      va[j] = __builtin_nontemporal_load((const f32x4*)src + 2 * ic);
      vb[j] = __builtin_nontemporal_load((const f32x4*)src + 2 * ic + 1);
    }
#pragma unroll
    for (int j = 0; j < 4; ++j) {
      const size_t i = i0 + j * stride;
      if (i < n8) {
        unsigned w = 0;
        w = __builtin_amdgcn_cvt_scalef32_pk_fp4_f32(w, va[j][0] * scale, va[j][1] * scale, 1.0f, 0);
        w = __builtin_amdgcn_cvt_scalef32_pk_fp4_f32(w, va[j][2] * scale, va[j][3] * scale, 1.0f, 1);
        w = __builtin_amdgcn_cvt_scalef32_pk_fp4_f32(w, vb[j][0] * scale, vb[j][1] * scale, 1.0f, 2);
        w = __builtin_amdgcn_cvt_scalef32_pk_fp4_f32(w, vb[j][2] * scale, vb[j][3] * scale, 1.0f, 3);
        const size_t el = i * 8;
        const size_t lay = el >> 24, e = (el >> 10) & 16383, d0 = el & 1023;
        const size_t off = lay * (16384ull * 512) + (d0 / W) * (16384ull * (W / 2)) + e * (W / 2) + ((d0 % W) >> 1);
        *(unsigned*)((unsigned char*)dst + off) = w;
      }
    }
  }
}
__device__ __forceinline__ void unpack16_fp4(unsigned w0, unsigned w1, f32x2* f) {
  f[0] = __builtin_amdgcn_cvt_scalef32_pk_f32_fp4(w0, 1.0f, 0);
  f[1] = __builtin_amdgcn_cvt_scalef32_pk_f32_fp4(w0, 1.0f, 1);
  f[2] = __builtin_amdgcn_cvt_scalef32_pk_f32_fp4(w0, 1.0f, 2);
  f[3] = __builtin_amdgcn_cvt_scalef32_pk_f32_fp4(w0, 1.0f, 3);
  f[4] = __builtin_amdgcn_cvt_scalef32_pk_f32_fp4(w1, 1.0f, 0);
  f[5] = __builtin_amdgcn_cvt_scalef32_pk_f32_fp4(w1, 1.0f, 1);
  f[6] = __builtin_amdgcn_cvt_scalef32_pk_f32_fp4(w1, 1.0f, 2);
  f[7] = __builtin_amdgcn_cvt_scalef32_pk_f32_fp4(w1, 1.0f, 3);
}
__device__ __forceinline__ void unpack16_fp8(u32x4 v, float* f) {
#pragma unroll
  for (int i = 0; i < 4; ++i) {
    f32x2 lo = __builtin_amdgcn_cvt_pk_f32_fp8(v[i], false);
    f32x2 hi = __builtin_amdgcn_cvt_pk_f32_fp8(v[i], true);
    f[4 * i + 0] = lo.x; f[4 * i + 1] = lo.y; f[4 * i + 2] = hi.x; f[4 * i + 3] = hi.y;
  }
}
#define U_SCALE 64.f
#define V_SCALE 20.f
__device__ __forceinline__ void phase_prep_a(const Params& p, unsigned char* smem) {
  float* fs = (float*)smem;
  prep_mod(p, fs);
  {
    float2* rope = (float2*)(p.ws + OFF_ROPE);
    int i = blockIdx.x * 256 + opaque_tid();
    if (i < 64 * 16) {
      int pos = i >> 4, f = i & 15;
      float fr = powf(10000.f, -(float)f / 16.f);
      float ang = (float)pos * fr;
      rope[i] = make_float2(cosf(ang), sinf(ang));
    }
  }
  for (int i = 0; i < 2; ++i) {
    prep_transpose(p.in[11] + (size_t)i * 1024 * 3072, (bf16_t*)(p.ws + OFF_WIN_EV) + (size_t)i * 3072 * 1024, 3072, 3072, fs);
    prep_transpose(p.in[16] + (size_t)i * 1024 * 3088, (bf16_t*)(p.ws + OFF_WIN_OD) + (size_t)i * 3328 * 1024, 3088, 3328, fs);
    prep_transpose(p.in[12] + (size_t)i * 1024 * 1024, (bf16_t*)(p.ws + OFF_WOUT) + (size_t)(2 * i) * 1024 * 1024, 1024, 1024, fs);
    prep_transpose(p.in[17] + (size_t)i * 1024 * 1024, (bf16_t*)(p.ws + OFF_WOUT) + (size_t)(2 * i + 1) * 1024 * 1024, 1024, 1024, fs);
  }
  for (int l = 0; l < 4; ++l)
    prep_transpose(p.in[26] + (size_t)l * 1024 * 2048, nullptr, 2048, 2048, fs, p.ws + OFF_WQ + (size_t)l * 2048 * 1024, WQ_SCALE);
  prep_convert(p.in[27], (bf16_t*)(p.ws + OFF_KEYS), (size_t)4 * 8 * 2 * 128 * 128 / 4);
  prep_convert_fp4(p.in[28], (unsigned*)(p.ws + OFF_UB), (size_t)4 * 16384 * 1024 / 8, U_SCALE, 128);
  prep_convert_fp4(p.in[29], (unsigned*)(p.ws + OFF_VB), (size_t)4 * 16384 * 1024 / 8, V_SCALE, 1024);
}

__device__ __forceinline__ void norm_token(const float* xrow, const float* g, const float* scale, const float* shift,
                                           bf16_t* hrow, float* copy_dst, int lane, unsigned char* h8row = nullptr,
                                           unsigned char* hf8row = nullptr) {
  float4 v[4];
  float ss = 0.f;
#pragma unroll
  for (int i = 0; i < 4; ++i) {
    v[i] = *(const float4*)(xrow + i * 256 + lane * 4);
    ss += v[i].x * v[i].x + v[i].y * v[i].y + v[i].z * v[i].z + v[i].w * v[i].w;
  }
  ss = wave_sum(ss);
  const float rs = rsqrtf(ss * (1.f / 1024.f) + EPSV);
#pragma unroll
  for (int i = 0; i < 4; ++i) {
    const int idx = i * 256 + lane * 4;
    if (copy_dst) *(float4*)(copy_dst + idx) = v[i];
    float4 gg = *(const float4*)(g + idx);
    float4 sc = *(const float4*)(scale + idx);
    float4 sh = *(const float4*)(shift + idx);
    float a = v[i].x * rs * gg.x * (1.f + sc.x) + sh.x;
    float b = v[i].y * rs * gg.y * (1.f + sc.y) + sh.y;
    float c = v[i].z * rs * gg.z * (1.f + sc.z) + sh.z;
    float d = v[i].w * rs * gg.w * (1.f + sc.w) + sh.w;
    uint2 o;
    o.x = pack2(a, b);
    o.y = pack2(c, d);
    if (hrow) *(uint2*)(hrow + idx) = o;
    if (h8row) {
      unsigned w4 = 0;
      w4 = __builtin_amdgcn_cvt_scalef32_pk_fp4_f32(w4, a * X_SCALE, b * X_SCALE, 1.0f, 0);
      w4 = __builtin_amdgcn_cvt_scalef32_pk_fp4_f32(w4, c * X_SCALE, d * X_SCALE, 1.0f, 1);
      *(unsigned short*)(h8row + (idx >> 1)) = (unsigned short)w4;
    }
    if (hf8row) {
      unsigned w8 = __builtin_amdgcn_cvt_pk_fp8_f32(a, b, 0, false);
      w8 = __builtin_amdgcn_cvt_pk_fp8_f32(c, d, w8, true);
      *(unsigned*)(hf8row + idx) = w8;
    }
  }
}

__device__ __forceinline__ void phase_prep_b(const Params& p) {
  const int tid_ = opaque_tid(); const int lane = tid_ & 63, wv = tid_ >> 6;
  const float* modv = (const float*)(p.ws + OFF_MOD);
  bf16_t* H = (bf16_t*)(p.ws + OFF_H);
  for (int t = blockIdx.x * 4 + wv; t < NTOK; t += gridDim.x * 4) {
    const float* xr = (t < NPROMPT) ? p.in[0] + (size_t)t * 1024 : p.in[1] + (size_t)(t - NPROMPT) * 1024;
    const float* md = modv + (size_t)(0 * 9 + tok_mod(t)) * 6144;
    norm_token(xr, p.in[8], md + 1024, md, H + (size_t)t * 1024, p.out + (size_t)t * 1024, lane);
  }
}

__device__ __forceinline__ void phase_norm2(const Params& p, int l) {
  const int tid_ = opaque_tid(); const int lane = tid_ & 63, wv = tid_ >> 6;
  const float* modv = (const float*)(p.ws + OFF_MOD);
  bf16_t* H = (bf16_t*)(p.ws + OFF_H);
  for (int t = blockIdx.x * 4 + wv; t < NTOK; t += gridDim.x * 4) {
    const float* md = modv + (size_t)(l * 9 + tok_mod(t)) * 6144;
    norm_token(p.out + (size_t)t * 1024, p.in[9] + l * 1024, md + 4096, md + 3072, nullptr, nullptr, lane,
               p.ws + OFF_H8 + (size_t)t * 512, p.ws + OFF_H8F + (size_t)t * 1024);
  }
}

template <int EPI, int NJ, int BK>
__device__ __forceinline__ void gemm_phase(const bf16_t* __restrict__ A, const bf16_t* __restrict__ Bt, int ntiles_n,
                           bf16_t* __restrict__ C, int ldc, float* __restrict__ X, const float* __restrict__ ga,
                           unsigned char* smem, int dry = 0) {
  constexpr int TN = 32 * NJ;
  constexpr int LS = BK + 8;
  constexpr int TPR = BK / 8;
  constexpr int RPP = 256 / TPR;
  constexpr int NA = 128 / RPP, NB = TN / RPP;
  bf16_t* As = (bf16_t*)smem;
  bf16_t* Bs = As + 128 * LS;
  const int tid = opaque_tid(), lane = tid & 63, w = tid >> 6, quad = lane >> 4, l15 = lane & 15;
  const int wm = w >> 1, wn = w & 1;
  const int lr = tid / TPR, lseg = (tid % TPR) * 8;
  const int units = 192 * ntiles_n;
  for (int u = blockIdx.x; u < units; u += gridDim.x) {
    const int mt = u % 192, nt = u / 192;
    const int m0 = mt * 128, n0 = nt * TN;
    f32x4 acc[4][NJ];
#pragma unroll
    for (int i = 0; i < 4; ++i)
#pragma unroll
      for (int j = 0; j < NJ; ++j) acc[i][j] = (f32x4){0.f, 0.f, 0.f, 0.f};
    const unsigned char* Ab = (const unsigned char*)(A + (size_t)m0 * 1024);
    const unsigned char* Bb = (const unsigned char*)(Bt + (size_t)n0 * 1024);
    const unsigned voff = (unsigned)(lr * 2048 + lseg * 2);
    u32x4 ra[NA], rb[NB];
#pragma unroll
    for (int i = 0; i < NA; ++i) ra[i] = *(const u32x4*)(Ab + (size_t)(i * RPP * 2048) + voff);
#pragma unroll
    for (int i = 0; i < NB; ++i) rb[i] = *(const u32x4*)(Bb + (size_t)(i * RPP * 2048) + voff);
#pragma unroll 1
    for (int kt = 0; kt < 1024 / BK; ++kt) {
#pragma unroll
      for (int i = 0; i < NA; ++i) *(u32x4*)(As + (lr + RPP * i) * LS + lseg) = ra[i];
#pragma unroll
      for (int i = 0; i < NB; ++i) *(u32x4*)(Bs + (lr + RPP * i) * LS + lseg) = rb[i];
      __syncthreads();
      if (kt + 1 < 1024 / BK) {
        const unsigned char* An = Ab + (size_t)((kt + 1) * BK * 2);
        const unsigned char* Bn = Bb + (size_t)((kt + 1) * BK * 2);
#pragma unroll
        for (int i = 0; i < NA; ++i) ra[i] = *(const u32x4*)(An + (size_t)(i * RPP * 2048) + voff);
#pragma unroll
        for (int i = 0; i < NB; ++i) rb[i] = *(const u32x4*)(Bn + (size_t)(i * RPP * 2048) + voff);
      }
#pragma unroll
      for (int kk = 0; kk < BK / 32; ++kk) {
        bf16x8 af[4];
#pragma unroll
        for (int i = 0; i < 4; ++i) af[i] = ldfrag(As + (wm * 64 + i * 16 + l15) * LS + kk * 32 + quad * 8);
#pragma unroll
        for (int j = 0; j < NJ; ++j) {
          const bf16x8 bfr = ldfrag(Bs + (wn * (16 * NJ) + j * 16 + l15) * LS + kk * 32 + quad * 8);
#pragma unroll
          for (int i = 0; i < 4; ++i) acc[i][j] = mfma16(af[i], bfr, acc[i][j]);
        }
      }
      __syncthreads();
    }
    if (EPI == 0) {
#pragma unroll
      for (int i = 0; i < 4; ++i)
#pragma unroll
        for (int j = 0; j < NJ; ++j) {
          const int col = n0 + wn * (16 * NJ) + j * 16 + l15;
          if (col < ldc) {
#pragma unroll
            for (int jj = 0; jj < 4; ++jj) {
              int row = m0 + wm * 64 + i * 16 + quad * 4 + jj;
              C[(size_t)row * ldc + col] = f2bf(acc[i][j][jj]);
            }
          }
        }
    } else {
      const float* gam = ga + (size_t)tok_mod(m0) * 6144;
#pragma unroll
      for (int i = 0; i < 4; ++i)
#pragma unroll
        for (int j = 0; j < NJ; ++j)
#pragma unroll
          for (int jj = 0; jj < 4; ++jj) {
            int row = m0 + wm * 64 + i * 16 + quad * 4 + jj;
            int col = n0 + wn * (16 * NJ) + j * 16 + l15;
            float* xp = X + (size_t)row * 1024 + col;
            const float nv = *xp + gam[col] * acc[i][j][jj];
            if (!dry) *xp = nv;
          }
    }
  }
}

__device__ __forceinline__ void gemm_q_fp8(const unsigned char* __restrict__ A, const unsigned char* __restrict__ Bt,
                                           bf16_t* __restrict__ C, unsigned char* smem) {
  constexpr int LSB = 144;
  unsigned char* As = smem;
  unsigned char* Bs = smem + 128 * LSB;
  const int tid = opaque_tid(), lane = tid & 63, w = tid >> 6, quad = lane >> 4, l15 = lane & 15;
  const int wm = w >> 1, wn = w & 1;
  const int lr = tid >> 3, lseg = (tid & 7) * 16;
  for (int u = blockIdx.x; u < 192 * 16; u += gridDim.x) {
    const int mt = u % 192, nt = u / 192;
    const int m0 = mt * 128, n0 = nt * 128;
    f32x4 acc[4][4];
#pragma unroll
    for (int i = 0; i < 4; ++i)
#pragma unroll
      for (int j = 0; j < 4; ++j) acc[i][j] = (f32x4){0.f, 0.f, 0.f, 0.f};
    const unsigned char* Ag = A + (size_t)(m0 + lr * 4) * 1024 + lseg;
    const unsigned char* Bg = Bt + (size_t)(n0 + lr * 4) * 1024 + lseg;
    u32x4 ra[4], rb[4];
#pragma unroll
    for (int i = 0; i < 4; ++i) ra[i] = *(const u32x4*)(Ag + i * 1024);
#pragma unroll
    for (int i = 0; i < 4; ++i) rb[i] = *(const u32x4*)(Bg + i * 1024);
#pragma unroll 1
    for (int kt = 0; kt < 8; ++kt) {
#pragma unroll
      for (int i = 0; i < 4; ++i) *(u32x4*)(As + (lr * 4 + i) * LSB + lseg) = ra[i];
#pragma unroll
      for (int i = 0; i < 4; ++i) *(u32x4*)(Bs + (lr * 4 + i) * LSB + lseg) = rb[i];
      __syncthreads();
      if (kt + 1 < 8) {
#pragma unroll
        for (int i = 0; i < 4; ++i) ra[i] = *(const u32x4*)(Ag + i * 1024 + (kt + 1) * 128);
#pragma unroll
        for (int i = 0; i < 4; ++i) rb[i] = *(const u32x4*)(Bg + i * 1024 + (kt + 1) * 128);
      }
#pragma unroll
      for (int kk = 0; kk < 4; ++kk) {
        long af[4];
#pragma unroll
        for (int i = 0; i < 4; ++i) af[i] = *(const long*)(As + (wm * 64 + i * 16 + l15) * LSB + kk * 32 + quad * 8);
#pragma unroll
        for (int j = 0; j < 4; ++j) {
          const long bfr = *(const long*)(Bs + (wn * 64 + j * 16 + l15) * LSB + kk * 32 + quad * 8);
#pragma unroll
          for (int i = 0; i < 4; ++i) acc[i][j] = __builtin_amdgcn_mfma_f32_16x16x32_fp8_fp8(af[i], bfr, acc[i][j], 0, 0, 0);
        }
      }
      __syncthreads();
    }
#pragma unroll
    for (int i = 0; i < 4; ++i)
#pragma unroll
      for (int j = 0; j < 4; ++j) {
        const int col = n0 + wn * 64 + j * 16 + l15;
#pragma unroll
        for (int jj = 0; jj < 4; ++jj) {
          const int row = m0 + wm * 64 + i * 16 + quad * 4 + jj;
          C[(size_t)row * 2048 + col] = f2bf(acc[i][j][jj] * (1.f / WQ_SCALE));
        }
      }
  }
}

struct ChainItem {
  bool lng; int sl, dir, h, sq, tok0, nc;
};
__device__ __forceinline__ ChainItem decode_item(int it) {
  ChainItem c;
  c.lng = it < 256;
  int idx = c.lng ? it : it - 256;
  c.sl = idx & 3; c.dir = (idx >> 2) & 1; c.h = (idx >> 3) & 3; c.sq = idx >> 5;
  c.tok0 = c.lng ? NPROMPT + c.sq * 2048 : c.sq * 256;
  c.nc = c.lng ? 32 : 4;
  return c;
}

__device__ __forceinline__ void phase_ret_chain(const Params& p, int l, unsigned char* smem) {
  const int il = l >> 1;
  bf16_t* qs = (bf16_t*)smem;
  bf16_t* ks = qs + 64 * 72;
  bf16_t* kT = ks + 64 * 72;
  bf16_t* vT = kT + 64 * 72;
  bf16_t* intra = vT + 32 * 72;
  bf16_t* ST = intra + 64 * 72;
  const bf16_t* P = (const bf16_t*)(p.ws + OFF_P);
  float* odir = (float*)(p.ws + OFF_ODIR);
  const float2* rope = (const float2*)(p.ws + OFF_ROPE);
  const int tid = opaque_tid(), lane = tid & 63, w = tid >> 6, quad = lane >> 4, l15 = lane & 15;
  const int nlb = (gridDim.x >= 512) ? 256 : ((gridDim.x >= 2) ? (int)(gridDim.x / 2) : 0);
  const bool longblk = (nlb > 0) ? ((int)blockIdx.x < nlb) : true;
  const int it_lo = (nlb > 0) ? (longblk ? (int)blockIdx.x : 256 + ((int)blockIdx.x - nlb)) : (int)blockIdx.x;
  const int it_hi = (nlb > 0) ? (longblk ? 256 : 1280) : 1280;
  const int it_st = (nlb > 0) ? (longblk ? nlb : ((int)gridDim.x - nlb)) : (int)gridDim.x;
  for (int it = it_lo; it < it_hi; it += it_st) {
    const ChainItem ci = decode_item(it);
    const int sl = ci.sl, dir = ci.dir, h = ci.h;
    const float xg = p.in[13][(il * 2 + dir) * 4 + h];
    const float lg = -log1pf(expf(-xg));
    const float g64 = expf(lg * 64.f);
    f32x4 S[2];
    if (ci.lng) {
      const float* s0 = p.in[2] + ((((size_t)ci.sq * 2 + il) * 2 + dir) * 4 + h) * 8192;
#pragma unroll
      for (int ct = 0; ct < 2; ++ct)
#pragma unroll
        for (int jj = 0; jj < 4; ++jj) S[ct][jj] = s0[(16 * w + quad * 4 + jj) * 128 + sl * 32 + ct * 16 + l15];
    } else {
      S[0] = (f32x4){0.f, 0.f, 0.f, 0.f};
      S[1] = (f32x4){0.f, 0.f, 0.f, 0.f};
    }
    for (int n = 0; n < ci.nc; ++n) {
      const int cn = dir ? ci.nc - 1 - n : n;
      const int tb = ci.tok0 + cn * 64;
      {
        const int i = tid >> 2, mq = tid & 3;
        const int t = tb + (dir ? 63 - i : i);
        const bf16_t* pr = P + (size_t)t * PSTRIDE;
        float qa[8], qb[8], ka[8], kb[8];
        unpack8(*(const uint4*)(pr + h * 64 + mq * 8), qa);
        unpack8(*(const uint4*)(pr + h * 64 + 32 + mq * 8), qb);
        unpack8(*(const uint4*)(pr + 256 + h * 64 + mq * 8), ka);
        unpack8(*(const uint4*)(pr + 256 + h * 64 + 32 + mq * 8), kb);
        if (ci.lng) {
          const int pos = (mq < 2) ? cn : (t - tb);
          const int f0 = (mq & 1) * 8;
#pragma unroll
          for (int e = 0; e < 8; ++e) {
            float2 cs = rope[pos * 16 + f0 + e];
            float a = qa[e], b = qb[e];
            qa[e] = a * cs.x - b * cs.y; qb[e] = b * cs.x + a * cs.y;
            a = ka[e]; b = kb[e];
            ka[e] = a * cs.x - b * cs.y; kb[e] = b * cs.x + a * cs.y;
          }
        }
        const float wend = expf(lg * (float)(63 - i));
        uint4 o;
        o.x = pack2(qa[0], qa[1]); o.y = pack2(qa[2], qa[3]); o.z = pack2(qa[4], qa[5]); o.w = pack2(qa[6], qa[7]);
        *(uint4*)(qs + i * 72 + mq * 8) = o;
        o.x = pack2(qb[0], qb[1]); o.y = pack2(qb[2], qb[3]); o.z = pack2(qb[4], qb[5]); o.w = pack2(qb[6], qb[7]);
        *(uint4*)(qs + i * 72 + 32 + mq * 8) = o;
#pragma unroll
        for (int e = 0; e < 8; ++e) { ka[e] *= 0.125f; kb[e] *= 0.125f; }
        o.x = pack2(ka[0], ka[1]); o.y = pack2(ka[2], ka[3]); o.z = pack2(ka[4], ka[5]); o.w = pack2(ka[6], ka[7]);
        *(uint4*)(ks + i * 72 + mq * 8) = o;
        o.x = pack2(kb[0], kb[1]); o.y = pack2(kb[2], kb[3]); o.z = pack2(kb[4], kb[5]); o.w = pack2(kb[6], kb[7]);
        *(uint4*)(ks + i * 72 + 32 + mq * 8) = o;
#pragma unroll
        for (int e = 0; e < 8; ++e) {
          kT[(mq * 8 + e) * 72 + i] = f2bf(ka[e] * wend);
          kT[(32 + mq * 8 + e) * 72 + i] = f2bf(kb[e] * wend);
        }
        uint4 v8 = *(const uint4*)(pr + 512 + h * 128 + sl * 32 + mq * 8);
        vT[(mq * 8 + 0) * 72 + i] = (bf16_t)(v8.x & 0xffff); vT[(mq * 8 + 1) * 72 + i] = (bf16_t)(v8.x >> 16);
        vT[(mq * 8 + 2) * 72 + i] = (bf16_t)(v8.y & 0xffff); vT[(mq * 8 + 3) * 72 + i] = (bf16_t)(v8.y >> 16);
        vT[(mq * 8 + 4) * 72 + i] = (bf16_t)(v8.z & 0xffff); vT[(mq * 8 + 5) * 72 + i] = (bf16_t)(v8.z >> 16);
        vT[(mq * 8 + 6) * 72 + i] = (bf16_t)(v8.w & 0xffff); vT[(mq * 8 + 7) * 72 + i] = (bf16_t)(v8.w >> 16);
      }
      __syncthreads();
      const bf16x8 a0 = ldfrag(qs + (16 * w + l15) * 72 + quad * 8);
      const bf16x8 a1 = ldfrag(qs + (16 * w + l15) * 72 + 32 + quad * 8);
#pragma unroll
      for (int ct = 0; ct < 4; ++ct) {
        bf16x8 b0 = ldfrag(ks + (ct * 16 + l15) * 72 + quad * 8);
        bf16x8 b1 = ldfrag(ks + (ct * 16 + l15) * 72 + 32 + quad * 8);
        f32x4 c = (f32x4){0.f, 0.f, 0.f, 0.f};
        c = mfma16(a0, b0, c);
        c = mfma16(a1, b1, c);
#pragma unroll
        for (int jj = 0; jj < 4; ++jj) {
          int i = 16 * w + quad * 4 + jj, j = ct * 16 + l15;
          float val = (i >= j) ? c[jj] * expf(lg * (float)(i - j)) : 0.f;
          intra[i * 72 + j] = f2bf(val);
        }
      }
#pragma unroll
      for (int ct = 0; ct < 2; ++ct)
#pragma unroll
        for (int jj = 0; jj < 4; ++jj) ST[(ct * 16 + l15) * 72 + 16 * w + quad * 4 + jj] = f2bf(S[ct][jj]);
      __syncthreads();
      const bf16x8 ai0 = ldfrag(intra + (16 * w + l15) * 72 + quad * 8);
      const bf16x8 ai1 = ldfrag(intra + (16 * w + l15) * 72 + 32 + quad * 8);
      const bf16x8 ak0 = ldfrag(kT + (16 * w + l15) * 72 + quad * 8);
      const bf16x8 ak1 = ldfrag(kT + (16 * w + l15) * 72 + 32 + quad * 8);
#pragma unroll
      for (int ct = 0; ct < 2; ++ct) {
        bf16x8 bv0 = ldfrag(vT + (ct * 16 + l15) * 72 + quad * 8);
        bf16x8 bv1 = ldfrag(vT + (ct * 16 + l15) * 72 + 32 + quad * 8);
        bf16x8 bs0 = ldfrag(ST + (ct * 16 + l15) * 72 + quad * 8);
        bf16x8 bs1 = ldfrag(ST + (ct * 16 + l15) * 72 + 32 + quad * 8);
        f32x4 ci_ = (f32x4){0.f, 0.f, 0.f, 0.f}, cc = (f32x4){0.f, 0.f, 0.f, 0.f};
        ci_ = mfma16(ai0, bv0, ci_);
        ci_ = mfma16(ai1, bv1, ci_);
        cc = mfma16(a0, bs0, cc);
        cc = mfma16(a1, bs1, cc);
#pragma unroll
        for (int jj = 0; jj < 4; ++jj) {
          int i = 16 * w + quad * 4 + jj;
          int t = tb + (dir ? 63 - i : i);
          float o = ci_[jj] + expf(lg * (float)(i + 1)) * cc[jj];
          odir[((size_t)dir * NTOK + t) * 512 + h * 128 + sl * 32 + ct * 16 + l15] = o;
        }
        f32x4 s = S[ct];
        s[0] *= g64; s[1] *= g64; s[2] *= g64; s[3] *= g64;
        s = mfma16(ak0, bv0, s);
        s = mfma16(ak1, bv1, s);
        S[ct] = s;
      }
      __syncthreads();
    }
    if (!ci.lng) {
      float* so = p.out + 25165824 + ((((size_t)ci.sq * 2 + il) * 2 + dir) * 4 + h) * 8192;
#pragma unroll
      for (int ct = 0; ct < 2; ++ct)
#pragma unroll
        for (int jj = 0; jj < 4; ++jj) so[(16 * w + quad * 4 + jj) * 128 + sl * 32 + ct * 16 + l15] = S[ct][jj];
    }
  }
}

__device__ __forceinline__ void gdn_prep_item(const Params& p, int l, int pi, unsigned char* smem, int plvl) {
  const int il = l >> 1;
  bf16_t* ks = (bf16_t*)smem;
  bf16_t* vs = ks + 64 * 136;
  float* Am = (float*)(vs + 64 * 136);
  float* rq = Am + 4096;
  float* rk = rq + 64;
  float* gcs = rk + 64;
  float* bet = gcs + 64;
  float* fac = bet + 64;
  bf16_t* qs = (bf16_t*)(fac + 128);
  const bf16_t* P = (const bf16_t*)(p.ws + OFF_P);
  unsigned char* gp = p.ws + OFF_GPREP + (size_t)pi * GP_ITEM;
  bf16_t* Wb = (bf16_t*)gp;
  bf16_t* QG = Wb + 8192;
  bf16_t* KDT = QG + 8192;
  bf16_t* Ub = KDT + 8192;
  bf16_t* ATT = Ub + 8192;
  float* EGL = (float*)(p.ws + OFF_EGL);
  const int tid = opaque_tid(), lane = tid & 63, w = tid >> 6, quad = lane >> 4, l15 = lane & 15;
  const int dir = pi & 1, h = (pi >> 1) & 3, c = pi >> 3;
  int tb, seq_lo, seq_hi;
  if (c < 128) { tb = c * 64; seq_lo = (c >> 2) * 256; seq_hi = seq_lo + 256; }
  else { int cc = c - 128; tb = NPROMPT + cc * 64; seq_lo = NPROMPT + (cc >> 5) * 2048; seq_hi = seq_lo + 2048; }
  const float SCALE = 0.08838834764831845f;
  {
    const int cg_ = tid & 127, rh = tid >> 7;
#pragma unroll
    for (int mat = 0; mat < 3; ++mat) {
      const int col = mat * 512 + h * 128 + cg_;
      const float* cw = p.in[18] + (size_t)il * 3 * 1536 + col;
      const float w0 = cw[0], w1 = cw[1536], w2 = cw[3072];
      bf16_t* dst = mat == 0 ? qs : (mat == 1 ? ks : vs);
      const int t0 = tb + rh * 32;
      bf16_t raw[34];
#pragma unroll
      for (int o = 0; o < 34; ++o) {
        const int t = t0 - 1 + o;
        const int tc = min(max(t, seq_lo), seq_hi - 1);
        const bf16_t rv = P[(size_t)tc * PSTRIDE + col];
        raw[o] = (t == tc) ? rv : (bf16_t)0;
      }
#pragma unroll
      for (int o = 0; o < 32; ++o) {
        float y = w0 * bf2f(raw[o]) + w1 * bf2f(raw[o + 1]) + w2 * bf2f(raw[o + 2]);
        y = siluf(y);
        const int oi = rh * 32 + o;
        const int i = dir ? 63 - oi : oi;
        dst[i * 136 + cg_] = f2bf(y);
      }
    }
  }
  __syncthreads();
  if (plvl == 4) return;
  {
    const int r = tid >> 2, part = tid & 3;
    float sq_ = 0.f, sk_ = 0.f;
#pragma unroll 8
    for (int e = 0; e < 32; ++e) {
      float a = bf2f(qs[r * 136 + part * 32 + e]);
      float b = bf2f(ks[r * 136 + part * 32 + e]);
      sq_ += a * a; sk_ += b * b;
    }
    sq_ += __shfl_xor(sq_, 1); sq_ += __shfl_xor(sq_, 2);
    sk_ += __shfl_xor(sk_, 1); sk_ += __shfl_xor(sk_, 2);
    if (part == 0) {
      rq[r] = rsqrtf(sq_ + EPSV);
      rk[r] = rsqrtf(sk_ + EPSV);
      const int t = tb + (dir ? 63 - r : r);
      float a = bf2f(P[(size_t)t * PSTRIDE + 2048 + dir * 4 + h]);
      float bbv = bf2f(P[(size_t)t * PSTRIDE + 2056 + dir * 4 + h]);
      float al = p.in[19][(il * 2 + dir) * 4 + h], dtb = p.in[20][(il * 2 + dir) * 4 + h];
      float z = a + dtb;
      float sp = (z > 20.f) ? z : log1pf(expf(z));
      gcs[r] = -expf(al) * sp;
      bet[r] = 1.f / (1.f + expf(-bbv));
    }
  }
  __syncthreads();
  if (tid < 64) {
    float v = gcs[tid];
#pragma unroll
    for (int o = 1; o < 64; o <<= 1) {
      float u = __shfl_up(v, o);
      if (tid >= o) v += u;
    }
    gcs[tid] = v;
  }
  __syncthreads();
  {
    bf16x8 ak[4], aq[4];
#pragma unroll
    for (int kk = 0; kk < 4; ++kk) {
      ak[kk] = ldfrag(ks + (16 * w + l15) * 136 + kk * 32 + quad * 8);
      aq[kk] = ldfrag(qs + (16 * w + l15) * 136 + kk * 32 + quad * 8);
    }
#pragma unroll
    for (int ct = 0; ct < 4; ++ct) {
      f32x4 ckk = (f32x4){0.f, 0.f, 0.f, 0.f}, cqk = (f32x4){0.f, 0.f, 0.f, 0.f};
#pragma unroll
      for (int kk = 0; kk < 4; ++kk) {
        bf16x8 b = ldfrag(ks + (ct * 16 + l15) * 136 + kk * 32 + quad * 8);
        ckk = mfma16(ak[kk], b, ckk);
        cqk = mfma16(aq[kk], b, cqk);
      }
#pragma unroll
      for (int jj = 0; jj < 4; ++jj) {
        const int i = 16 * w + quad * 4 + jj, j = ct * 16 + l15;
        const float dec = (i >= j) ? __expf(gcs[i] - gcs[j]) : 0.f;
        Am[j * 64 + i] = (i > j) ? bet[i] * rk[i] * rk[j] * ckk[jj] * dec : 0.f;
        ATT[i * 64 + j] = f2bf((i >= j) ? SCALE * rq[i] * rk[j] * cqk[jj] * dec : 0.f);
      }
    }
  }
  __syncthreads();
  const float gl = gcs[63];
#pragma unroll 8
  for (int e = tid; e < 64 * 128; e += 256) {
    int i = e >> 7, d = e & 127;
    QG[e] = f2bf(bf2f(qs[i * 136 + d]) * rq[i] * SCALE * __expf(gcs[i]));
  }
#pragma unroll 8
  for (int e = tid; e < 128 * 64; e += 256) {
    int d = e >> 6, i = e & 63;
    KDT[e] = f2bf(bf2f(ks[i * 136 + d]) * rk[i] * __expf(gl - gcs[i]));
  }
  if (tid < 64) {
    fac[tid] = bet[tid];
    fac[64 + tid] = rk[tid] * bet[tid] * __expf(gcs[tid]);
  }
  __syncthreads();
  if (plvl != 3) {
    const int cidx = tid & 127;
    const bf16_t* srcm = ((tid < 128) ? vs : ks) + cidx;
    const float* fc = fac + ((tid < 128) ? 0 : 64);
    bf16_t* dstm = ((tid < 128) ? Ub : Wb) + cidx;
    bf16_t* XB = qs + tid;
#pragma unroll 1
    for (int b = 0; b < 4; ++b) {
      float x[16];
#pragma unroll
      for (int r = 0; r < 16; ++r) x[r] = bf2f(srcm[(16 * b + r) * 136]) * fc[16 * b + r];
      const float* arow = Am + 16 * b;
#pragma unroll 4
      for (int j = 0; j < 16 * b; ++j) {
        const float xv = bf2f(XB[j * 256]);
        const f32x4 a0 = *(const f32x4*)(arow + j * 64), a1 = *(const f32x4*)(arow + j * 64 + 4);
        const f32x4 a2 = *(const f32x4*)(arow + j * 64 + 8), a3 = *(const f32x4*)(arow + j * 64 + 12);
#pragma unroll
        for (int r = 0; r < 4; ++r) {
          x[r] -= a0[r] * xv; x[4 + r] -= a1[r] * xv; x[8 + r] -= a2[r] * xv; x[12 + r] -= a3[r] * xv;
        }
      }
      const float* ablk = Am + (16 * b) * 64 + 16 * b;
#pragma unroll
      for (int jj = 0; jj < 15; ++jj) {
#pragma unroll
        for (int r = jj + 1; r < 16; ++r) x[r] -= ablk[jj * 64 + r] * x[jj];
      }
#pragma unroll
      for (int r = 0; r < 16; ++r) {
        const bf16_t bb = f2bf(x[r]);
        dstm[(16 * b + r) * 128] = bb;
        if (b < 3) XB[(16 * b + r) * 256] = bb;
      }
    }
  }
  if (tid == 0) EGL[pi] = expf(gl);
  __syncthreads();
}

__device__ __forceinline__ void conf_conv_item(const Params& p, int l, int item, unsigned char* smem) {
  const int il = l >> 1;
  float* hc = (float*)smem;
  const bf16_t* P = (const bf16_t*)(p.ws + OFF_P);
  float* convout = (float*)(p.ws + OFF_CONV);
  const int tid = opaque_tid();
  const int tile = item >> 1, ch = (item & 1) * 256 + tid;
  const int t0 = tile * 32;
  int seq_lo, seq_hi;
  if (t0 < NPROMPT) { seq_lo = (t0 >> 8) << 8; seq_hi = seq_lo + 256; }
  else { seq_lo = NPROMPT + (((t0 - NPROMPT) >> 11) << 11); seq_hi = seq_lo + 2048; }
#pragma unroll 31
  for (int r = 0; r < 62; ++r) {
    const int tt = t0 - 15 + r;
    const int tc = min(max(tt, seq_lo), seq_hi - 1);
    float ca = bf2f(P[(size_t)tc * PSTRIDE + 2064 + ch]);
    float cgv = bf2f(P[(size_t)tc * PSTRIDE + 2576 + ch]);
    float v = ca * __builtin_amdgcn_rcpf(1.f + __expf(-cgv));
    hc[r * 256 + tid] = (tt == tc) ? v : 0.f;
  }
  float wk[31];
#pragma unroll
  for (int k = 0; k < 31; ++k) wk[k] = p.in[22][((size_t)il * 31 + k) * 512 + ch];
  const float bias = p.in[23][il * 512 + ch];
  for (int i = 0; i < 32; ++i) {
    float acc = bias;
#pragma unroll
    for (int k = 0; k < 31; ++k) acc += wk[k] * hc[(i + k) * 256 + tid];
    convout[(size_t)(t0 + i) * 512 + ch] = acc;
  }
}

__device__ __forceinline__ void phase_odd_prep(const Params& p, int l, unsigned char* smem, int rep) {
  for (int u = blockIdx.x; u < 3072 + 1536; u += gridDim.x) {
#if PROBE_ODD == 1 || PROBE_ODD >= 3
    if (rep && u >= 3072) break;
#elif PROBE_ODD == 2
    if (rep && u < 3072) continue;
#endif
    if (u < 3072) gdn_prep_item(p, l, u, smem, (PROBE_ODD >= 3 && rep) ? PROBE_ODD : 0);
    else { conf_conv_item(p, l, u - 3072, smem); __syncthreads(); }
  }
}

__device__ __forceinline__ void phase_gdn_chain(const Params& p, int l, unsigned char* smem) {
  const int il = l >> 1;
  bf16_t* ST = (bf16_t*)smem;
  bf16_t* VT = ST + 32 * 136;
  float* odir = (float*)(p.ws + OFF_ODIR);
  const float* EGL = (const float*)(p.ws + OFF_EGL);
  const int tid = opaque_tid(), lane = tid & 63, w = tid >> 6, quad = lane >> 4, l15 = lane & 15;
  const int nlb = (gridDim.x >= 512) ? 256 : ((gridDim.x >= 2) ? (int)(gridDim.x / 2) : 0);
  const bool longblk = (nlb > 0) ? ((int)blockIdx.x < nlb) : true;
  const int it_lo = (nlb > 0) ? (longblk ? (int)blockIdx.x : 256 + ((int)blockIdx.x - nlb)) : (int)blockIdx.x;
  const int it_hi = (nlb > 0) ? (longblk ? 256 : 1280) : 1280;
  const int it_st = (nlb > 0) ? (longblk ? nlb : ((int)gridDim.x - nlb)) : (int)gridDim.x;
  for (int it = it_lo; it < it_hi; it += it_st) {
    const ChainItem ci = decode_item(it);
    const int sl = ci.sl, dir = ci.dir, h = ci.h;
    f32x4 S[2][2];
    if (ci.lng) {
      const float* s0 = p.in[3] + ((((size_t)ci.sq * 2 + il) * 2 + dir) * 4 + h) * 16384;
#pragma unroll
      for (int rb = 0; rb < 2; ++rb)
#pragma unroll
        for (int ct = 0; ct < 2; ++ct)
#pragma unroll
          for (int jj = 0; jj < 4; ++jj)
            S[rb][ct][jj] = s0[(16 * (2 * w + rb) + quad * 4 + jj) * 128 + sl * 32 + ct * 16 + l15];
    } else {
#pragma unroll
      for (int rb = 0; rb < 2; ++rb)
#pragma unroll
        for (int ct = 0; ct < 2; ++ct) S[rb][ct] = (f32x4){0.f, 0.f, 0.f, 0.f};
    }
    bf16x8 naw[4], naqg[4];
    bf16_t nuu[2][4];
    float negl = 0.f;
    for (int n = 0; n < ci.nc; ++n) {
      const int cn = dir ? ci.nc - 1 - n : n;
      const int tb = ci.tok0 + cn * 64;
      const int cglob = ci.lng ? 128 + ci.sq * 32 + cn : ci.sq * 4 + cn;
      const int pi = (cglob * 4 + h) * 2 + dir;
      const unsigned char* gp = p.ws + OFF_GPREP + (size_t)pi * GP_ITEM;
      const bf16_t* Wb = (const bf16_t*)gp;
      const bf16_t* QG = Wb + 8192;
      const bf16_t* KDT = QG + 8192;
      const bf16_t* Ub = KDT + 8192;
      const bf16_t* ATT = Ub + 8192;
      bf16x8 aw[4], aqg[4], aat[2], akd[2][2];
      float uu[2][4];
      float egl;
      if (n == 0) {
#pragma unroll
        for (int kk = 0; kk < 4; ++kk) {
          aw[kk] = ldfrag(Wb + (16 * w + l15) * 128 + kk * 32 + quad * 8);
          aqg[kk] = ldfrag(QG + (16 * w + l15) * 128 + kk * 32 + quad * 8);
        }
#pragma unroll
        for (int kk = 0; kk < 2; ++kk) {
          aat[kk] = ldfrag(ATT + (16 * w + l15) * 64 + kk * 32 + quad * 8);
#pragma unroll
          for (int rb = 0; rb < 2; ++rb) akd[rb][kk] = ldfrag(KDT + (16 * (2 * w + rb) + l15) * 64 + kk * 32 + quad * 8);
        }
#pragma unroll
        for (int ct = 0; ct < 2; ++ct)
#pragma unroll
          for (int jj = 0; jj < 4; ++jj) uu[ct][jj] = bf2f(Ub[(16 * w + quad * 4 + jj) * 128 + sl * 32 + ct * 16 + l15]);
        egl = EGL[pi];
      } else {
#pragma unroll
        for (int kk = 0; kk < 4; ++kk) { aw[kk] = naw[kk]; aqg[kk] = naqg[kk]; }
#pragma unroll
        for (int kk = 0; kk < 2; ++kk) {
          aat[kk] = ldfrag(ATT + (16 * w + l15) * 64 + kk * 32 + quad * 8);
#pragma unroll
          for (int rb = 0; rb < 2; ++rb) akd[rb][kk] = ldfrag(KDT + (16 * (2 * w + rb) + l15) * 64 + kk * 32 + quad * 8);
        }
#pragma unroll
        for (int ct = 0; ct < 2; ++ct)
#pragma unroll
          for (int jj = 0; jj < 4; ++jj) uu[ct][jj] = bf2f(nuu[ct][jj]);
        egl = negl;
      }
      if (n + 1 < ci.nc) {
        const int cn2 = dir ? ci.nc - 2 - n : n + 1;
        const int cglob2 = ci.lng ? 128 + ci.sq * 32 + cn2 : ci.sq * 4 + cn2;
        const int pi2 = (cglob2 * 4 + h) * 2 + dir;
        const bf16_t* Wb2 = (const bf16_t*)(p.ws + OFF_GPREP + (size_t)pi2 * GP_ITEM);
        const bf16_t* QG2 = Wb2 + 8192; const bf16_t* Ub2 = QG2 + 16384;
#pragma unroll
        for (int kk = 0; kk < 4; ++kk) {
          naw[kk] = ldfrag(Wb2 + (16 * w + l15) * 128 + kk * 32 + quad * 8);
          naqg[kk] = ldfrag(QG2 + (16 * w + l15) * 128 + kk * 32 + quad * 8);
        }
#pragma unroll
        for (int ct = 0; ct < 2; ++ct)
#pragma unroll
          for (int jj = 0; jj < 4; ++jj) nuu[ct][jj] = Ub2[(16 * w + quad * 4 + jj) * 128 + sl * 32 + ct * 16 + l15];
        negl = EGL[pi2];
      }
#pragma unroll
      for (int rb = 0; rb < 2; ++rb)
#pragma unroll
        for (int ct = 0; ct < 2; ++ct)
#pragma unroll
          for (int jj = 0; jj < 4; ++jj)
            ST[(ct * 16 + l15) * 136 + 16 * (2 * w + rb) + quad * 4 + jj] = f2bf(S[rb][ct][jj]);
      __syncthreads();
      f32x4 co[2];
#pragma unroll
      for (int ct = 0; ct < 2; ++ct) {
        f32x4 cv = (f32x4){0.f, 0.f, 0.f, 0.f};
        co[ct] = (f32x4){0.f, 0.f, 0.f, 0.f};
#pragma unroll
        for (int kk = 0; kk < 4; ++kk) {
          bf16x8 b = ldfrag(ST + (ct * 16 + l15) * 136 + kk * 32 + quad * 8);
          cv = mfma16(aw[kk], b, cv);
          co[ct] = mfma16(aqg[kk], b, co[ct]);
        }
#pragma unroll
        for (int jj = 0; jj < 4; ++jj) {
          float vn = uu[ct][jj] - cv[jj];
          VT[(ct * 16 + l15) * 72 + 16 * w + quad * 4 + jj] = f2bf(vn);
        }
      }
      __syncthreads();
#pragma unroll
      for (int ct = 0; ct < 2; ++ct) {
        bf16x8 bv[2];
#pragma unroll
        for (int kk = 0; kk < 2; ++kk) {
          bv[kk] = ldfrag(VT + (ct * 16 + l15) * 72 + kk * 32 + quad * 8);
          co[ct] = mfma16(aat[kk], bv[kk], co[ct]);
        }
#pragma unroll
        for (int jj = 0; jj < 4; ++jj) {
          int i = 16 * w + quad * 4 + jj;
          int t = tb + (dir ? 63 - i : i);
          odir[((size_t)dir * NTOK + t) * 512 + h * 128 + sl * 32 + ct * 16 + l15] = co[ct][jj];
        }
#pragma unroll
        for (int rb = 0; rb < 2; ++rb) {
          f32x4 s = S[rb][ct];
          s[0] *= egl; s[1] *= egl; s[2] *= egl; s[3] *= egl;
          s = mfma16(akd[rb][0], bv[0], s);
          s = mfma16(akd[rb][1], bv[1], s);
          S[rb][ct] = s;
        }
      }
    }
    __syncthreads();
    if (!ci.lng) {
      float* so = p.out + 29360128 + ((((size_t)ci.sq * 2 + il) * 2 + dir) * 4 + h) * 16384;
#pragma unroll
      for (int rb = 0; rb < 2; ++rb)
#pragma unroll
        for (int ct = 0; ct < 2; ++ct)
#pragma unroll
          for (int jj = 0; jj < 4; ++jj)
            so[(16 * (2 * w + rb) + quad * 4 + jj) * 128 + sl * 32 + ct * 16 + l15] = S[rb][ct][jj];
    }
  }
}

__device__ __forceinline__ void phase_mix_out(const Params& p, int l) {
  const int il = l >> 1;
  const bool odd = l & 1;
  const int tid_ = opaque_tid(); const int lane = tid_ & 63, wv = tid_ >> 6;
  const bf16_t* P = (const bf16_t*)(p.ws + OFF_P);
  const float* od0 = (const float*)(p.ws + OFF_ODIR);
  const float* od1 = od0 + (size_t)NTOK * 512;
  const float* convout = (const float*)(p.ws + OFF_CONV);
  bf16_t* Y = (bf16_t*)(p.ws + OFF_YMIX);
  for (int t = blockIdx.x * 4 + wv; t < NTOK; t += gridDim.x * 4) {
    const bf16_t* pr = P + (size_t)t * PSTRIDE;
    bf16_t* yr = Y + (size_t)t * 1024;
#pragma unroll
    for (int h = 0; h < 4; ++h) {
      const int idx = h * 128 + lane * 2;
      float2 a = *(const float2*)(od0 + (size_t)t * 512 + idx);
      float2 b = *(const float2*)(od1 + (size_t)t * 512 + idx);
      float o0 = a.x + b.x, o1 = a.y + b.y;
      float ss = wave_sum(o0 * o0 + o1 * o1);
      float rs = rsqrtf(ss * (1.f / 128.f) + EPSV);
      float n0, n1;
      unsigned gz;
      if (!odd) {
        n0 = p.in[14][il * 512 + idx]; n1 = p.in[14][il * 512 + idx + 1];
        gz = *(const unsigned*)(pr + 1024 + idx);
      } else {
        n0 = p.in[21][il * 128 + lane * 2]; n1 = p.in[21][il * 128 + lane * 2 + 1];
        gz = *(const unsigned*)(pr + 1536 + idx);
      }
      float y0 = siluf(bflo(gz)) * o0 * rs * n0;
      float y1 = siluf(bfhi(gz)) * o1 * rs * n1;
      *(unsigned*)(yr + idx) = pack2(y0, y1);
    }
    if (!odd) {
      int seq_lo, seq_hi;
      if (t < NPROMPT) { seq_lo = (t >> 8) << 8; seq_hi = seq_lo + 256; }
      else { seq_lo = NPROMPT + (((t - NPROMPT) >> 11) << 11); seq_hi = seq_lo + 2048; }
      const bool hp = (t - 1 >= seq_lo), hn = (t + 1 < seq_hi);
#pragma unroll
      for (int j = 0; j < 4; ++j) {
        const int c = j * 128 + lane * 2;
        unsigned cg0 = *(const unsigned*)(pr + 2048 + c), hb0 = *(const unsigned*)(pr + 2560 + c);
        const bf16_t* prm = hp ? pr - PSTRIDE : pr;
        const bf16_t* prp = hn ? pr + PSTRIDE : pr;
        unsigned cgm = *(const unsigned*)(prm + 2048 + c), hbm = *(const unsigned*)(prm + 2560 + c);
        unsigned cgp = *(const unsigned*)(prp + 2048 + c), hbp = *(const unsigned*)(prp + 2560 + c);
        if (!hp) { cgm = 0; hbm = 0; }
        if (!hn) { cgp = 0; hbp = 0; }
        unsigned bg = *(const unsigned*)(pr + 1536 + c);
        const float* sw = p.in[15] + (size_t)il * 3 * 512 + c;
        float y0 = bflo(bg) * (sw[0] * bflo(cgm) * bflo(hbm) + sw[512] * bflo(cg0) * bflo(hb0) + sw[1024] * bflo(cgp) * bflo(hbp));
        float y1 = bfhi(bg) * (sw[1] * bfhi(cgm) * bfhi(hbm) + sw[513] * bfhi(cg0) * bfhi(hb0) + sw[1025] * bfhi(cgp) * bfhi(hbp));
        *(unsigned*)(yr + 512 + c) = pack2(y0, y1);
      }
    } else {
      float v[8];
      float s = 0.f;
#pragma unroll
      for (int j = 0; j < 4; ++j) {
        float2 a = *(const float2*)(convout + (size_t)t * 512 + j * 128 + lane * 2);
        v[2 * j] = a.x; v[2 * j + 1] = a.y;
        s += a.x + a.y;
      }
      const float mean = wave_sum(s) * (1.f / 512.f);
      float vs = 0.f;
#pragma unroll
      for (int j = 0; j < 8; ++j) { v[j] -= mean; vs += v[j] * v[j]; }
      const float rstd = rsqrtf(wave_sum(vs) * (1.f / 512.f) + EPSV);
#pragma unroll
      for (int j = 0; j < 4; ++j) {
        const int c = j * 128 + lane * 2;
        float y0 = v[2 * j] * rstd * p.in[24][il * 512 + c] + p.in[25][il * 512 + c];
        float y1 = v[2 * j + 1] * rstd * p.in[24][il * 512 + c + 1] + p.in[25][il * 512 + c + 1];
        *(unsigned*)(yr + 512 + c) = pack2(siluf(y0), siluf(y1));
      }
    }
  }
}

#define WAVE_LDS_SYNC() { asm volatile("s_waitcnt lgkmcnt(0)" ::: "memory"); __builtin_amdgcn_wave_barrier(); }
#define CE_DESC(a, b) { unsigned _mx = max(a, b), _mn = min(a, b); a = _mx; b = _mn; }
#define CE_ASC(a, b) { unsigned _mx = max(a, b), _mn = min(a, b); a = _mn; b = _mx; }
__device__ __forceinline__ void sort16_desc(unsigned* v) {
#pragma unroll
  for (int k = 2; k <= 16; k <<= 1) {
#pragma unroll
    for (int j = k >> 1; j > 0; j >>= 1) {
#pragma unroll
      for (int i = 0; i < 16; ++i) {
        const int l = i ^ j;
        if (l > i) {
          if ((i & k) == 0) CE_DESC(v[i], v[l]) else CE_ASC(v[i], v[l])
        }
      }
    }
  }
}
__device__ __forceinline__ void merge16_top(unsigned* a, const unsigned* b) {
#pragma unroll
  for (int i = 0; i < 16; ++i) a[i] = max(a[i], b[15 - i]);
#pragma unroll
  for (int j = 8; j > 0; j >>= 1) {
#pragma unroll
    for (int i = 0; i < 16; ++i) {
      const int l = i ^ j;
      if (l > i) CE_DESC(a[i], a[l])
    }
  }
}
__device__ __forceinline__ void phase_peer_score(const Params& p, int l, unsigned char* smem) {
  const int tid = opaque_tid(), lane = tid & 63, w = tid >> 6, quad = lane >> 4, l15 = lane & 15;
  unsigned* scw = (unsigned*)smem + w * (32 * 132 + 512);
  unsigned* sel = scw + 32 * 132;
  const bf16_t* Q = (const bf16_t*)(p.ws + OFF_Q);
  const bf16_t* KB = (const bf16_t*)(p.ws + OFF_KEYS) + (size_t)l * 8 * 2 * 128 * 128;
  int* EI = (int*)(p.ws + OFF_EIDX);
  float* GT = (float*)(p.ws + OFF_GATE);
  unsigned cab[13];
  {
    const int sub = lane & 3;
#pragma unroll
    for (int i = 0; i < 13; ++i) { const int cidx = sub + 4 * i; cab[i] = (unsigned)CAND_A[cidx] | ((unsigned)CAND_B[cidx] << 4); }
  }
  bf16x8 qa[2][4];
  if (blockIdx.x < 3072) {
    const int t0f = (blockIdx.x >> 1) * 16, hf_ = (blockIdx.x & 1) * 4 + w;
#pragma unroll
    for (int pp = 0; pp < 2; ++pp)
#pragma unroll
      for (int kk = 0; kk < 4; ++kk) qa[pp][kk] = ldfrag(Q + (size_t)(t0f + l15) * 2048 + hf_ * 256 + pp * 128 + kk * 32 + quad * 8);
  }
  for (int u = blockIdx.x; u < 3072; u += gridDim.x) {
    const int tt = u >> 1, h = (u & 1) * 4 + w;
    const int t0 = tt * 16;
#pragma unroll
    for (int pp = 0; pp < 2; ++pp) {
      bf16x8 a[4];
#pragma unroll
      for (int kk = 0; kk < 4; ++kk) a[kk] = qa[pp][kk];
      const bf16_t* kb = KB + (size_t)((h * 2 + pp) * 128) * 128;
#pragma unroll
      for (int ct = 0; ct < 8; ++ct) {
        f32x4 c = (f32x4){0.f, 0.f, 0.f, 0.f};
#pragma unroll
        for (int kk = 0; kk < 4; ++kk) {
          bf16x8 b = ldfrag(kb + (ct * 16 + l15) * 128 + kk * 32 + quad * 8);
          c = mfma16(a[kk], b, c);
        }
#pragma unroll
        for (int jj = 0; jj < 4; ++jj) {
          const int row = pp * 16 + quad * 4 + jj, col = ct * 16 + l15;
          unsigned key = (fkey(c[jj]) & ~127u) | (unsigned)(127 - col);
          scw[row * 132 + col] = key;
        }
      }
    }
    {
      const int un = u + gridDim.x;
      if (un < 3072) {
        const int t0n = (un >> 1) * 16, hn = (un & 1) * 4 + w;
#pragma unroll
        for (int pp = 0; pp < 2; ++pp)
#pragma unroll
          for (int kk = 0; kk < 4; ++kk) qa[pp][kk] = ldfrag(Q + (size_t)(t0n + l15) * 2048 + hn * 256 + pp * 128 + kk * 32 + quad * 8);
      }
    }
    WAVE_LDS_SYNC();
    {
      const int row = lane >> 1, hf = lane & 1;
      const u32x4* rp = (const u32x4*)(scw + row * 132 + hf * 64);
      unsigned g0[16], g1[16];
#pragma unroll
      for (int q = 0; q < 4; ++q) { u32x4 t4 = rp[q]; g0[4 * q] = t4[0]; g0[4 * q + 1] = t4[1]; g0[4 * q + 2] = t4[2]; g0[4 * q + 3] = t4[3]; }
#pragma unroll
      for (int q = 0; q < 4; ++q) { u32x4 t4 = rp[4 + q]; g1[4 * q] = t4[0]; g1[4 * q + 1] = t4[1]; g1[4 * q + 2] = t4[2]; g1[4 * q + 3] = t4[3]; }
      sort16_desc(g0);
      sort16_desc(g1);
      merge16_top(g0, g1);
#pragma unroll
      for (int q = 0; q < 4; ++q) { u32x4 t4 = rp[8 + q]; g1[4 * q] = t4[0]; g1[4 * q + 1] = t4[1]; g1[4 * q + 2] = t4[2]; g1[4 * q + 3] = t4[3]; }
      sort16_desc(g1);
      merge16_top(g0, g1);
#pragma unroll
      for (int q = 0; q < 4; ++q) { u32x4 t4 = rp[12 + q]; g1[4 * q] = t4[0]; g1[4 * q + 1] = t4[1]; g1[4 * q + 2] = t4[2]; g1[4 * q + 3] = t4[3]; }
      sort16_desc(g1);
      merge16_top(g0, g1);
#pragma unroll
      for (int i = 0; i < 16; ++i) g1[i] = (unsigned)__builtin_amdgcn_update_dpp(0, (int)g0[i], 0xB1, 0xF, 0xF, true);
      merge16_top(g0, g1);
      if (hf == 0) {
#pragma unroll
        for (int q = 0; q < 4; ++q) {
          u32x4 t4 = {g0[4 * q], g0[4 * q + 1], g0[4 * q + 2], g0[4 * q + 3]};
          *(u32x4*)(sel + row * 16 + 4 * q) = t4;
        }
      }
    }
    WAVE_LDS_SYNC();
    {
      const int tok = lane >> 2, sub = lane & 3;
      const unsigned* s1 = sel + tok * 16;
      const unsigned* s2 = sel + (16 + tok) * 16;
      unsigned ck[16];
#pragma unroll
      for (int i = 0; i < 13; ++i) {
        const int cidx = sub + 4 * i;
        const int a = cab[i] & 15, b = cab[i] >> 4;
        float s = keyf(s1[a] & ~127u) + keyf(s2[b] & ~127u);
        unsigned k = (fkey(s) & ~255u) | (unsigned)(255 - (a * 16 + b));
        ck[i] = (cidx < 50) ? k : 0u;
      }
      ck[13] = 0u; ck[14] = 0u; ck[15] = 0u;
      sort16_desc(ck);
      {
        unsigned g1[16];
#pragma unroll
        for (int i = 0; i < 16; ++i) g1[i] = (unsigned)__builtin_amdgcn_update_dpp(0, (int)ck[i], 0xB1, 0xF, 0xF, true);
        merge16_top(ck, g1);
#pragma unroll
        for (int i = 0; i < 16; ++i) g1[i] = (unsigned)__builtin_amdgcn_update_dpp(0, (int)ck[i], 0x4E, 0xF, 0xF, true);
        merge16_top(ck, g1);
      }
      const float mx = keyf(ck[0] & ~255u);
      float sv[4];
      int ev[4];
#pragma unroll
      for (int j = 0; j < 4; ++j) {
        const unsigned k0_ = ck[j], k1_ = ck[4 + j], k2_ = ck[8 + j], k3_ = ck[12 + j];
        const unsigned ka_ = (sub & 1) ? k1_ : k0_;
        const unsigned kb_ = (sub & 1) ? k3_ : k2_;
        const unsigned key = (sub & 2) ? kb_ : ka_;
        const int cidx = 255 - (int)(key & 255u);
        const int a = cidx >> 4, b = cidx & 15;
        const unsigned k1 = s1[a], k2 = s2[b];
        sv[j] = __expf(keyf(k1 & ~127u) + keyf(k2 & ~127u) - mx);
        ev[j] = (127 - (int)(k1 & 127u)) * 128 + (127 - (int)(k2 & 127u));
      }
      float sum = (sv[0] + sv[1]) + (sv[2] + sv[3]);
      sum += __uint_as_float((unsigned)__builtin_amdgcn_update_dpp(0, (int)__float_as_uint(sum), 0xB1, 0xF, 0xF, true));
      sum += __uint_as_float((unsigned)__builtin_amdgcn_update_dpp(0, (int)__float_as_uint(sum), 0x4E, 0xF, 0xF, true));
      const float inv = 1.f / sum;
      const size_t ob = (size_t)(t0 + tok) * 128 + h * 16 + sub * 4;
      *(int4*)(EI + ob) = make_int4(ev[0], ev[1], ev[2], ev[3]);
      *(float4*)(GT + ob) = make_float4(sv[0] * inv, sv[1] * inv, sv[2] * inv, sv[3] * inv);
    }
    WAVE_LDS_SYNC();
  }
}

__device__ __forceinline__ float gelu_tanh(float x) {
  return 0.5f * x * (1.f + tanhf(0.7978845608028654f * (x + 0.044715f * x * x * x)));
}
__device__ __forceinline__ float butterfly8(const float* d, int lane) {
  const bool b5 = lane & 32, b4 = lane & 16, b3 = lane & 8;
  float e4[4], e2[2], e1;
#pragma unroll
  for (int j = 0; j < 4; ++j) {
    float snd = b5 ? d[j] : d[j + 4];
    float kep = b5 ? d[j + 4] : d[j];
    e4[j] = kep + __shfl_xor(snd, 32);
  }
#pragma unroll
  for (int j = 0; j < 2; ++j) {
    float snd = b4 ? e4[j] : e4[j + 2];
    float kep = b4 ? e4[j + 2] : e4[j];
    e2[j] = kep + __shfl_xor(snd, 16);
  }
  {
    float snd = b3 ? e2[0] : e2[1];
    float kep = b3 ? e2[1] : e2[0];
    e1 = kep + __shfl_xor(snd, 8);
  }
  e1 += __shfl_xor(e1, 4);
  e1 += __shfl_xor(e1, 2);
  e1 += __shfl_xor(e1, 1);
  const int jj = lane & 7;
  const int srcl = ((jj >> 2) & 1) * 32 + ((jj >> 1) & 1) * 16 + (jj & 1) * 8;
  return __shfl(e1, srcl);
}
__device__ __forceinline__ void phase_peer_gather(const Params& p, int l, int dry, unsigned char* smem) {
  const int tid_ = opaque_tid(); const int lane = tid_ & 63, wv = tid_ >> 6;
  const bf16_t* H = (const bf16_t*)(p.ws + OFF_H);
  bf16_t* Hw = (bf16_t*)(p.ws + OFF_H);
  const unsigned char* UB = p.ws + OFF_UB + (size_t)l * 16384 * 512;
  const unsigned char* VB = p.ws + OFF_VB + (size_t)l * 16384 * 512;
  const int* EI = (const int*)(p.ws + OFF_EIDX);
  const float* GT = (const float*)(p.ws + OFF_GATE);
  const float* modv = (const float*)(p.ws + OFF_MOD);
  float* actw = (float*)smem + wv * (24 * 128);
  const int tstride = gridDim.x * 4, tfirst = blockIdx.x * 4 + wv;
  int ntok = (tfirst < NTOK) ? (NTOK - 1 - tfirst) / tstride + 1 : 0;
  if (ntok > 24) ntok = 24;
  for (int i = lane; i < ntok * 128; i += 64) actw[i] = 0.f;
  WAVE_LDS_SYNC();
  {
    const int q_ = lane >> 4, n_ = lane & 15;
    for (int kk = 0; kk < 8; ++kk) {
      const unsigned char* ubs = UB + (size_t)kk * (16384 * 64) + q_ * 16;
      int pe0 = 0, pe1 = 0; u32x4 pxa = {0u, 0u, 0u, 0u};
      if (ntok > 0) {
        pe0 = EI[(size_t)tfirst * 128 + lane]; pe1 = EI[(size_t)tfirst * 128 + 64 + lane];
        pxa = *(const u32x4*)(p.ws + OFF_H8 + (size_t)tfirst * 512 + kk * 64 + q_ * 16);
      }
      for (int ti = 0; ti < ntok; ++ti) {
        const int ev0 = pe0, ev1 = pe1;
        const u32x4 xa4 = pxa;
        if (ti + 1 < ntok) {
          const size_t tn = (size_t)(tfirst + (ti + 1) * tstride);
          pe0 = EI[tn * 128 + lane]; pe1 = EI[tn * 128 + 64 + lane];
          pxa = *(const u32x4*)(p.ws + OFF_H8 + tn * 512 + kk * 64 + q_ * 16);
        }
        u32x4 bq[8];
#pragma unroll
        for (int g = 0; g < 8; ++g) {
          const int e_ = __shfl((g < 4) ? ev0 : ev1, (g & 3) * 16 + n_);
          bq[g] = *(const u32x4*)(ubs + (size_t)e_ * 64);
        }
        const v8i32 aa = {(int)xa4[0], (int)xa4[1], (int)xa4[2], (int)xa4[3], 0, 0, 0, 0};
#pragma unroll
        for (int g = 0; g < 8; ++g) {
          const v8i32 bb = {(int)bq[g][0], (int)bq[g][1], (int)bq[g][2], (int)bq[g][3], 0, 0, 0, 0};
          f32x4 ac = (f32x4){0.f, 0.f, 0.f, 0.f};
          ac = __builtin_amdgcn_mfma_scale_f32_16x16x128_f8f6f4(aa, bb, ac, 4, 4, 0, 0, 0, 0);
          if (q_ == (g & 3)) actw[ti * 128 + g * 16 + n_] += ac[0];
        }
      }
    }
  }
  WAVE_LDS_SYNC();
  int ti_ = 0;
  uint4 nx0 = make_uint4(0, 0, 0, 0), nx1 = nx0; int nev0 = 0, nev1 = 0; float ngv0 = 0.f, ngv1 = 0.f;
  {
    const int tf = blockIdx.x * 4 + wv;
    if (tf < NTOK) {
      nx0 = *(const uint4*)(H + (size_t)tf * 1024 + lane * 16); nx1 = *(const uint4*)(H + (size_t)tf * 1024 + lane * 16 + 8);
      nev0 = EI[(size_t)tf * 128 + lane]; nev1 = EI[(size_t)tf * 128 + 64 + lane];
      ngv0 = GT[(size_t)tf * 128 + lane]; ngv1 = GT[(size_t)tf * 128 + 64 + lane];
    }
  }
  for (int t = blockIdx.x * 4 + wv; t < NTOK; t += gridDim.x * 4) {
    float xf[16];
    unpack8(nx0, xf);
    unpack8(nx1, xf + 8);
    f32x2 xf2[8], out2[8];
#pragma unroll
    for (int e = 0; e < 8; ++e) { xf2[e] = (f32x2){xf[2 * e], xf[2 * e + 1]}; out2[e] = (f32x2){0.f, 0.f}; }
    const int ev0 = nev0, ev1 = nev1;
    const float gv0 = ngv0, gv1 = ngv1;
    {
      const int tn = t + gridDim.x * 4;
      if (tn < NTOK) {
        nx0 = *(const uint4*)(H + (size_t)tn * 1024 + lane * 16); nx1 = *(const uint4*)(H + (size_t)tn * 1024 + lane * 16 + 8);
        nev0 = EI[(size_t)tn * 128 + lane]; nev1 = EI[(size_t)tn * 128 + 64 + lane];
        ngv0 = GT[(size_t)tn * 128 + lane]; ngv1 = GT[(size_t)tn * 128 + 64 + lane];
      }
    }
    float cacc0 = 0.f, cacc1 = 0.f, coef0 = 0.f, coef1 = 0.f;
    uint2 bufA[16], bufB[16], bufC[16];
    const f32x2 zero2_ = {(float)dry, (float)dry};
#define GLOAD(buf, bb) { \
      const unsigned char* tb_ = ((bb) < 8) ? UB : VB; \
      const int evv_ = (((bb) & 7) < 4) ? ev0 : ev1; \
      _Pragma("unroll") for (int j = 0; j < 16; ++j) { \
        const int e_ = __builtin_amdgcn_readlane(evv_, ((bb) & 3) * 16 + j); \
        buf[j] = *(const uint2*)(tb_ + (size_t)e_ * 512 + lane * 8); } }
#define GCOMP(buf, bb) { \
      if ((bb) < 8) { \
        float d_[16]; \
        _Pragma("unroll") for (int j = 0; j < 16; ++j) { \
          f32x2 uf_[8]; unpack16_fp4(buf[j].x, buf[j].y, uf_); \
          f32x2 sa_ = uf_[0] * xf2[0]; \
          if (PROBE_CVT) { f32x2 ug_[8]; \
            ug_[0] = __builtin_amdgcn_cvt_scalef32_pk_f32_fp4(buf[j].x, 2.0f, 0); ug_[1] = __builtin_amdgcn_cvt_scalef32_pk_f32_fp4(buf[j].x, 2.0f, 1); \
            ug_[2] = __builtin_amdgcn_cvt_scalef32_pk_f32_fp4(buf[j].x, 2.0f, 2); ug_[3] = __builtin_amdgcn_cvt_scalef32_pk_f32_fp4(buf[j].x, 2.0f, 3); \
            ug_[4] = __builtin_amdgcn_cvt_scalef32_pk_f32_fp4(buf[j].y, 2.0f, 0); ug_[5] = __builtin_amdgcn_cvt_scalef32_pk_f32_fp4(buf[j].y, 2.0f, 1); \
            ug_[6] = __builtin_amdgcn_cvt_scalef32_pk_f32_fp4(buf[j].y, 2.0f, 2); ug_[7] = __builtin_amdgcn_cvt_scalef32_pk_f32_fp4(buf[j].y, 2.0f, 3); \
            _Pragma("unroll") for (int q = 0; q < 8; ++q) sa_ = __builtin_elementwise_fma(ug_[q], zero2_, sa_); } \
          _Pragma("unroll") for (int q = 1; q < 8; ++q) sa_ = __builtin_elementwise_fma(uf_[q], xf2[q], sa_); \
          d_[j] = sa_.x + sa_.y; } \
        const float t0_ = butterfly8(d_, lane), t1_ = butterfly8(d_ + 8, lane); \
        const int k0_ = ((bb) & 3) * 16; \
        if (((bb) & 7) < 4) { if ((lane >> 3) == (k0_ >> 3)) cacc0 = t0_; if ((lane >> 3) == (k0_ >> 3) + 1) cacc0 = t1_; } \
        else { if ((lane >> 3) == (k0_ >> 3)) cacc1 = t0_; if ((lane >> 3) == (k0_ >> 3) + 1) cacc1 = t1_; } \
        if ((bb) == 7) { coef0 = gelu_tanh(cacc0 * (1.f / U_SCALE)) * gv0 * (1.f / V_SCALE); coef1 = gelu_tanh(cacc1 * (1.f / U_SCALE)) * gv1 * (1.f / V_SCALE); } \
      } else { \
        const float cfv_ = (((bb) & 7) < 4) ? coef0 : coef1; \
        _Pragma("unroll") for (int j = 0; j < 16; ++j) { \
          const float cf_ = __uint_as_float((unsigned)__builtin_amdgcn_readlane((int)__float_as_uint(cfv_), ((bb) & 3) * 16 + j)); \
          f32x2 vf_[8]; unpack16_fp4(buf[j].x, buf[j].y, vf_); \
          const f32x2 c2_ = {cf_, cf_}; \
          _Pragma("unroll") for (int q = 0; q < 8; ++q) out2[q] = __builtin_elementwise_fma(vf_[q], c2_, out2[q]); } \
      } }
#if GATHER_CHECK
    GLOAD(bufA, 0)
#pragma unroll
    for (int b = 0; b < 8; b += 2) {
      GLOAD(bufB, b + 1)
      GCOMP(bufA, b)
      if (b + 2 < 8) GLOAD(bufA, b + 2)
      GCOMP(bufB, b + 1)
    }
    const float vacc0 = cacc0, vacc1 = cacc1;
#endif
#if !GATHER_CHECK
    GLOAD(bufA, 8)
#endif
    cacc0 = actw[ti_ * 128 + lane] * (1.f / X_SCALE);
    cacc1 = actw[ti_ * 128 + 64 + lane] * (1.f / X_SCALE);
    ++ti_;
#if GATHER_CHECK
    {
      const bool bad0 = fabsf(cacc0 - vacc0) > 0.15f * fabsf(vacc0) + 45.f;
      const bool bad1 = fabsf(cacc1 - vacc1) > 0.15f * fabsf(vacc1) + 45.f;
      const unsigned long long m0 = __ballot(bad0), m1 = __ballot(bad1);
      if (__popcll(m0) + __popcll(m1) > 32) out2[0] = (f32x2){__builtin_nanf(""), __builtin_nanf("")};
    }
#endif
    coef0 = gelu_tanh(cacc0 * (1.f / U_SCALE)) * gv0 * (1.f / V_SCALE);
    coef1 = gelu_tanh(cacc1 * (1.f / U_SCALE)) * gv1 * (1.f / V_SCALE);
#if GATHER_CHECK
    GLOAD(bufA, 8)
#endif
    GLOAD(bufB, 9)
#pragma unroll
    for (int b = 8; b < 14; b += 3) {
      GLOAD(bufC, b + 2)
      GCOMP(bufA, b)
      GLOAD(bufA, b + 3)
      GCOMP(bufB, b + 1)
      GLOAD(bufB, b + 4)
      GCOMP(bufC, b + 2)
    }
    GCOMP(bufA, 14)
    GCOMP(bufB, 15)
#undef GLOAD
#undef GCOMP
    float out[16];
#pragma unroll
    for (int e = 0; e < 8; ++e) { out[2 * e] = out2[e].x; out[2 * e + 1] = out2[e].y; }
    const int m = tok_mod(t);
    const float* ga2 = modv + (size_t)(l * 9 + m) * 6144 + 5120;
    float* xr = p.out + (size_t)t * 1024 + lane * 16;
    float xn[16];
    float ss = 0.f;
#pragma unroll
    for (int q4 = 0; q4 < 4; ++q4) {
      float4 xv = *(const float4*)(xr + q4 * 4);
      float4 gg = *(const float4*)(ga2 + lane * 16 + q4 * 4);
      const int o = q4 * 4;
      xn[o + 0] = xv.x + gg.x * out[o + 0];
      xn[o + 1] = xv.y + gg.y * out[o + 1];
      xn[o + 2] = xv.z + gg.z * out[o + 2];
      xn[o + 3] = xv.w + gg.w * out[o + 3];
      ss += xn[o] * xn[o] + xn[o + 1] * xn[o + 1] + xn[o + 2] * xn[o + 2] + xn[o + 3] * xn[o + 3];
    }
    ss = wave_sum(ss);
    const float rs = rsqrtf(ss * (1.f / 1024.f) + EPSV);
    if (dry) continue;
    if (l < 3) {
      const float* md = modv + (size_t)((l + 1) * 9 + m) * 6144 + lane * 16;
      const float* g = p.in[8] + (l + 1) * 1024 + lane * 16;
      float hv[16];
#pragma unroll
      for (int q = 0; q < 16; ++q) hv[q] = xn[q] * rs * g[q] * (1.f + md[1024 + q]) + md[q];
      uint4 o;
      o.x = pack2(hv[0], hv[1]); o.y = pack2(hv[2], hv[3]); o.z = pack2(hv[4], hv[5]); o.w = pack2(hv[6], hv[7]);
      *(uint4*)(Hw + (size_t)t * 1024 + lane * 16) = o;
      o.x = pack2(hv[8], hv[9]); o.y = pack2(hv[10], hv[11]); o.z = pack2(hv[12], hv[13]); o.w = pack2(hv[14], hv[15]);
      *(uint4*)(Hw + (size_t)t * 1024 + lane * 16 + 8) = o;
#pragma unroll
      for (int q4 = 0; q4 < 4; ++q4) *(float4*)(xr + q4 * 4) = make_float4(xn[q4 * 4], xn[q4 * 4 + 1], xn[q4 * 4 + 2], xn[q4 * 4 + 3]);
    } else {
      const float* g = p.in[10] + lane * 16;
#pragma unroll
      for (int q4 = 0; q4 < 4; ++q4)
        *(float4*)(xr + q4 * 4) = make_float4(xn[q4 * 4] * rs * g[q4 * 4], xn[q4 * 4 + 1] * rs * g[q4 * 4 + 1],
                                              xn[q4 * 4 + 2] * rs * g[q4 * 4 + 2], xn[q4 * 4 + 3] * rs * g[q4 * 4 + 3]);
    }
  }
}

#define XB_TMO      128
#define XB_XCNT(j)  (256  + 64 * (j))
#define XB_XSUB(j)  (1280 + 64 * (j))
#define XB_XGEN(j)  (2304 + 64 * (j))
#define XB_TOP      3328
#define XB_TOPGEN   3392
#define XCD_BAR_WORDS 3456
#define XB_SPIN_CAP (1u << 18)
#define LAS __attribute__((address_space(3)))

__device__ __forceinline__ unsigned xb_ld(unsigned* p)              { return __hip_atomic_load(p, __ATOMIC_RELAXED, __HIP_MEMORY_SCOPE_AGENT); }
__device__ __forceinline__ unsigned xb_add(unsigned* p, unsigned v) { return __hip_atomic_fetch_add(p, v, __ATOMIC_RELAXED, __HIP_MEMORY_SCOPE_AGENT); }
__device__ __forceinline__ unsigned xb_xcc_id() { return (unsigned)__builtin_amdgcn_s_getreg((3 << 11) | 20) & 0xFu; }
#define XB_SPIN(cond, bar) do { unsigned _sp = 0; while (cond) { __builtin_amdgcn_s_sleep(1); \
    if ((++_sp & 255u) == 0u) { if (xb_ld(&(bar)[XB_TMO])) break; if (_sp > XB_SPIN_CAP) { atomicAdd(&(bar)[XB_TMO], 1u); break; } } } } while (0)

struct XcdBarrier {
    unsigned* bar; unsigned x;
    volatile LAS unsigned* st;
};

__device__ __forceinline__ XcdBarrier xcd_barrier_post(unsigned* bar, volatile LAS unsigned* st) {
    XcdBarrier b; b.bar = bar; b.x = xb_xcc_id(); b.st = st;
    if (threadIdx.x == 0) (void)xb_add(&bar[XB_XCNT(b.x)], 1u);
    return b;
}
__device__ __forceinline__ void xcd_barrier_complete(unsigned* bar, unsigned x, unsigned& nloc, unsigned& nx) {
    const unsigned G = gridDim.x * gridDim.y * gridDim.z;
    unsigned sum, cnt, mine, sp = 0u;
    for (;;) {
        sum = 0u; cnt = 0u; mine = 0u;
#pragma unroll
        for (unsigned j = 0; j < 16; ++j) { const unsigned c = xb_ld(&bar[XB_XCNT(j)]); sum += c; cnt += (c > 0u) ? 1u : 0u; mine = (j == x) ? c : mine; }
        if (sum == G) break;
        __builtin_amdgcn_s_sleep(1);
        if ((++sp & 255u) == 0u) { if (xb_ld(&bar[XB_TMO])) break; if (sp > XB_SPIN_CAP) { atomicAdd(&bar[XB_TMO], 1u); break; } }
    }
    nloc = mine > 0u ? mine : 1u; nx = cnt > 0u ? cnt : 1u;
}

__device__ __forceinline__ void xcd_barrier(const XcdBarrier& b) {
    asm volatile("s_waitcnt vmcnt(0)" ::: "memory");
    __syncthreads();
    if (threadIdx.x == 0) {
        unsigned* bar = b.bar;
        __builtin_amdgcn_s_waitcnt(0);
        unsigned nloc = b.st[0], nx = b.st[1];
        if (nloc == 0u) { xcd_barrier_complete(bar, b.x, nloc, nx); b.st[0] = nloc; b.st[1] = nx; }
        const unsigned old = xb_add(&bar[XB_XSUB(b.x)], 1u);
        const unsigned gen = old / nloc;
        if (old + 1u == (gen + 1u) * nloc) {
            __builtin_amdgcn_fence(__ATOMIC_RELEASE, "agent");
            asm volatile("s_waitcnt vmcnt(0)" ::: "memory");
            const unsigned og = xb_add(&bar[XB_TOP], 1u);
            const unsigned tg = og / nx;
            if (og + 1u == (tg + 1u) * nx) xb_add(&bar[XB_TOPGEN], 1u);
            else XB_SPIN(xb_ld(&bar[XB_TOPGEN]) == tg, bar);
            __builtin_amdgcn_fence(__ATOMIC_ACQUIRE, "agent");
            xb_add(&bar[XB_XGEN(b.x)], 1u);
            asm volatile("s_waitcnt vmcnt(0)" ::: "memory");
        } else {
            XB_SPIN(xb_ld(&bar[XB_XGEN(b.x)]) == gen, bar);
            __builtin_amdgcn_fence(__ATOMIC_ACQUIRE, "agent");
            asm volatile("s_waitcnt vmcnt(0)" ::: "memory");
        }
    }
    __syncthreads();
}

__global__ void __launch_bounds__(256, 2) mega(Params p, int ph_lo, int ph_hi) {
  __shared__ __attribute__((aligned(16))) unsigned char smem[77312];
  cg::grid_group grid = cg::this_grid();
  __shared__ uint4 xb_words;
  if (threadIdx.x == 0) xb_words = make_uint4(0u, 0u, 0u, 0u);
  __syncthreads();
  XcdBarrier xb = xcd_barrier_post((unsigned*)(p.ws + OFF_BAR), (volatile LAS unsigned*)&xb_words);
  if (ph_hi > 100000) grid.sync();
  for (int ph = ph_lo; ph < ph_hi; ++ph) {
#if PROBE_MASK
    const int pcode = ph < 2 ? ph : 2 + (ph - 2) % 9;
    const int nrep = ((PROBE_MASK >> pcode) & 1) ? 2 : 1;
    for (int rep = 0; rep < nrep; ++rep) {
    if (rep) xcd_barrier(xb);
#endif
    bool did = true;
#if PROBE_MASK
    const int prep_rep = rep; const int nrep_ = nrep;
#else
    const int prep_rep = 0; const int nrep_ = 1;
#endif
    if (ph == 0) phase_prep_a(p, smem);
    else if (ph == 1) phase_prep_b(p);
    else {
      const int l = (ph - 2) / 9, sub = (ph - 2) % 9;
      const int il = l >> 1;
      const bool odd = l & 1;
      const float* modv = (const float*)(p.ws + OFF_MOD);
      if (sub == 6) {
        gemm_q_fp8(p.ws + OFF_H8F, p.ws + OFF_WQ + (size_t)l * 2048 * 1024, (bf16_t*)(p.ws + OFF_Q), smem);
      } else if (sub == 0) {
        const bf16_t* Bt; int ntn, ldc; bf16_t* C;
        if (sub == 0) {
          Bt = odd ? (const bf16_t*)(p.ws + OFF_WIN_OD) + (size_t)il * 3328 * 1024
                   : (const bf16_t*)(p.ws + OFF_WIN_EV) + (size_t)il * 3072 * 1024;
          ntn = odd ? 13 : 12; ldc = PSTRIDE; C = (bf16_t*)(p.ws + OFF_P);
        } else {
          Bt = (const bf16_t*)(p.ws + OFF_WQ) + (size_t)l * 2048 * 1024;
          ntn = 8; ldc = 2048; C = (bf16_t*)(p.ws + OFF_Q);
        }
        gemm_phase<0, 8, 64>((const bf16_t*)(p.ws + OFF_H), Bt, ntn, C, ldc, nullptr, nullptr, smem);
      } else if (sub == 1) {
        if (odd) phase_odd_prep(p, l, smem, prep_rep); else did = false;
      } else if (sub == 2) {
        if (odd) phase_gdn_chain(p, l, smem); else phase_ret_chain(p, l, smem);
      } else if (sub == 3) {
        phase_mix_out(p, l);
      } else if (sub == 4) {
        gemm_phase<1, 4, 64>((const bf16_t*)(p.ws + OFF_YMIX), (const bf16_t*)(p.ws + OFF_WOUT) + (size_t)l * 1024 * 1024, 8,
                      nullptr, 0, p.out, modv + (size_t)l * 9 * 6144 + 2048, smem, (nrep_ > 1 && prep_rep == 0) ? 1 : 0);
      } else if (sub == 5) {
        phase_norm2(p, l);
      } else if (sub == 7) {
        phase_peer_score(p, l, smem);
      } else {
        phase_peer_gather(p, l, (nrep_ > 1 && prep_rep == 0) ? 1 : 0, smem);
      }
    }
#if PROBE_MASK
    if (rep + 1 < nrep) continue;
#endif
    if (did && ph + 1 < ph_hi) xcd_barrier(xb);
#if PROBE_MASK
    }
#endif
  }
}

extern "C" void kernel_launch(void* const* d_in, const int* in_sizes, int n_in, void* d_out, int out_size,
                              void* d_ws, size_t ws_size, hipStream_t stream) {
  static int grid_blocks = 0;
  if (!grid_blocks) {
    int dev = 0, cus = 0, per_cu = 0;
    (void)hipGetDevice(&dev);
    (void)hipDeviceGetAttribute(&cus, hipDeviceAttributeMultiprocessorCount, dev);
    (void)hipOccupancyMaxActiveBlocksPerMultiprocessor(&per_cu, mega, 256, 0);
    if (per_cu < 1) per_cu = 1;
    if (per_cu > 2) per_cu = 2;
    grid_blocks = cus * per_cu;
    if (ws_size < WS_NEED) fprintf(stderr, "kernel_launch: workspace too small: %zu < %zu\n", ws_size, (size_t)WS_NEED);
  }
  Params p{};
  for (int i = 0; i < 30; ++i) p.in[i] = (const float*)d_in[i];
  p.out = (float*)d_out;
  p.ws = (unsigned char*)d_ws;
  (void)hipMemsetAsync((unsigned char*)d_ws + OFF_BAR, 0, XCD_BAR_WORDS * sizeof(unsigned), stream);
#if SINGLE_LAUNCH
  int lo = 0, hi = NPHASE;
  void* args[] = {&p, &lo, &hi};
  hipError_t e = hipLaunchCooperativeKernel((void*)mega, dim3(grid_blocks), dim3(256), args, 0, stream);
  if (e != hipSuccess) fprintf(stderr, "cooperative launch failed: %s (grid %d)\n", hipGetErrorString(e), grid_blocks);
#else
  for (int ph = 0; ph < NPHASE; ++ph) {
    const int l = (ph - 2) / 9, sub = (ph - 2) % 9;
    if (ph >= 2 && sub == 1 && !(l & 1)) continue;
    hipLaunchKernelGGL(mega, dim3(grid_blocks), dim3(256), 0, stream, p, ph, ph + 1);
  }
#endif
}
```

```cpp
#include <hip/hip_runtime.h>
#include <hip/hip_cooperative_groups.h>
#include <cstdio>
namespace cg = cooperative_groups;

#ifndef PROBE_MASK
#define PROBE_MASK 0
#endif
#ifndef GATHER_CHECK
#define GATHER_CHECK 0
#endif
#ifndef PROBE_CVT
#define PROBE_CVT 0
#endif
#ifndef PROBE_ODD
#define PROBE_ODD 0
#endif
#ifndef SINGLE_LAUNCH
#define SINGLE_LAUNCH 1
#endif

typedef unsigned short bf16_t;
using bf16x8 = __attribute__((ext_vector_type(8))) short;
using f32x4 = __attribute__((ext_vector_type(4))) float;
using f32x2 = __attribute__((ext_vector_type(2))) float;
using u32x4 = __attribute__((ext_vector_type(4))) unsigned;
using v8i32 = __attribute__((ext_vector_type(8))) int;

#define NTOK 24576
#define NPROMPT 8192
#define PSTRIDE 3200
#define EPSV 1e-6f
#define NPHASE 38
#define WQ_SCALE 32.f
#define X_SCALE 1.5f

constexpr size_t OFF_MOD = 0;
constexpr size_t OFF_ROPE = 1u << 20;
constexpr size_t OFF_WIN_EV = OFF_ROPE + 65536;
constexpr size_t OFF_WIN_OD = OFF_WIN_EV + 2ull * 3072 * 1024 * 2;
constexpr size_t OFF_WOUT = OFF_WIN_OD + 2ull * 3328 * 1024 * 2;
constexpr size_t OFF_WQ = OFF_WOUT + 4ull * 1024 * 1024 * 2;
constexpr size_t OFF_KEYS = OFF_WQ + 4ull * 2048 * 1024 * 2;
constexpr size_t OFF_UB = OFF_KEYS + 4ull * 8 * 2 * 128 * 128 * 2;
constexpr size_t OFF_VB = OFF_UB + 4ull * 16384 * 1024 * 2;
constexpr size_t OFF_H = OFF_VB + 4ull * 16384 * 1024 * 2;
constexpr size_t OFF_P = OFF_H + (size_t)NTOK * 1024 * 2;
constexpr size_t OFF_YMIX = OFF_P + (size_t)NTOK * PSTRIDE * 2;
constexpr size_t OFF_ODIR = OFF_YMIX + (size_t)NTOK * 1024 * 2;
constexpr size_t OFF_Q = OFF_ODIR;
constexpr size_t OFF_EIDX = OFF_ODIR + 2ull * NTOK * 512 * 4;
constexpr size_t OFF_GATE = OFF_EIDX + (size_t)NTOK * 128 * 4;
constexpr size_t GP_ITEM = 73728;
constexpr size_t OFF_GPREP = OFF_GATE + (size_t)NTOK * 128 * 4;
constexpr size_t OFF_EGL = OFF_GPREP + 3072ull * GP_ITEM;
constexpr size_t OFF_CONV = OFF_EGL + 16384;
constexpr size_t OFF_H8 = OFF_CONV;
constexpr size_t OFF_H8F = OFF_CONV + (16u << 20);
constexpr size_t OFF_BAR = OFF_CONV + (size_t)NTOK * 512 * 4;
constexpr size_t WS_NEED = OFF_BAR + 16384;

struct Params {
  const float* in[30];
  float* out;
  unsigned char* ws;
};

__device__ const unsigned char CAND_A[52] = {0,0,0,0,0,0,0,0,0,0,0,0,0,0,0,0,1,1,1,1,1,1,1,1,2,2,2,2,2,3,3,3,3,4,4,4,5,5,6,6,7,7,8,9,10,11,12,13,14,15,0,0};
__device__ const unsigned char CAND_B[52] = {0,1,2,3,4,5,6,7,8,9,10,11,12,13,14,15,0,1,2,3,4,5,6,7,0,1,2,3,4,0,1,2,3,0,1,2,0,1,0,1,0,1,0,0,0,0,0,0,0,0,0,0};

__device__ __forceinline__ int opaque_tid() { int t = threadIdx.x; asm volatile("" : "+v"(t)); return t; }
typedef __bf16 hbf16x2 __attribute__((ext_vector_type(2)));
__device__ __forceinline__ bf16_t f2bf(float f) {
  return __builtin_bit_cast(unsigned short, (__bf16)f);
}
__device__ __forceinline__ float bf2f(bf16_t b) { return __uint_as_float(((unsigned)b) << 16); }
__device__ __forceinline__ float bflo(unsigned u) { return __uint_as_float(u << 16); }
__device__ __forceinline__ float bfhi(unsigned u) { return __uint_as_float(u & 0xffff0000u); }
__device__ __forceinline__ unsigned pack2(float a, float b) {
  f32x2 v = {a, b};
  return __builtin_bit_cast(unsigned, __builtin_convertvector(v, hbf16x2));
}
__device__ __forceinline__ float wave_sum(float v) {
#pragma unroll
  for (int o = 32; o > 0; o >>= 1) v += __shfl_xor(v, o);
  return v;
}
__device__ __forceinline__ f32x4 mfma16(bf16x8 a, bf16x8 b, f32x4 c) {
  return __builtin_amdgcn_mfma_f32_16x16x32_bf16(a, b, c, 0, 0, 0);
}
__device__ __forceinline__ bf16x8 ldfrag(const bf16_t* p) { return *(const bf16x8*)p; }
__device__ __forceinline__ float siluf(float v) { return v * __builtin_amdgcn_rcpf(1.f + __expf(-v)); }
__device__ __forceinline__ int tok_mod(int t) { return t < NPROMPT ? 0 : 1 + ((t - NPROMPT) >> 11); }
__device__ __forceinline__ unsigned fkey(float f) {
  const unsigned u = __float_as_uint(f);
  return u ^ ((unsigned)((int)u >> 31) | 0x80000000u);
}
__device__ __forceinline__ float keyf(unsigned k) {
  unsigned b = (k & 0x80000000u) ? (k ^ 0x80000000u) : ~k;
  return __uint_as_float(b);
}
__device__ __forceinline__ void unpack8(uint4 v, float* f) {
  f[0] = bflo(v.x); f[1] = bfhi(v.x); f[2] = bflo(v.y); f[3] = bfhi(v.y);
  f[4] = bflo(v.z); f[5] = bfhi(v.z); f[6] = bflo(v.w); f[7] = bfhi(v.w);
}

__device__ __forceinline__ void prep_mod(const Params& p, float* smem) {
  float* sc = smem;
  float* red = smem + 9 * 1024;
  const int tid = opaque_tid();
  const float* c = p.in[4];
  const float* cctx = p.in[5];
  for (int i = tid; i < 9 * 1024; i += 256) {
    int m = i >> 10, k = i & 1023;
    float v = (m == 0) ? cctx[k] : c[(m - 1) * 1024 + k];
    sc[i] = v / (1.f + expf(-v));
  }
  __syncthreads();
  float* modv = (float*)(p.ws + OFF_MOD);
  const int cl = tid & 63, kg = tid >> 6;
  for (int u = blockIdx.x; u < 4 * 96; u += gridDim.x) {
    const int l = u / 96, nb = (u % 96) * 64;
    const float* W = p.in[6] + (size_t)l * 1024 * 6144 + nb + cl;
    float acc[9];
#pragma unroll
    for (int m = 0; m < 9; ++m) acc[m] = 0.f;
#pragma unroll 16
    for (int k = kg * 256; k < kg * 256 + 256; ++k) {
      float w = W[(size_t)k * 6144];
#pragma unroll
      for (int m = 0; m < 9; ++m) acc[m] += sc[m * 1024 + k] * w;
    }
#pragma unroll
    for (int m = 0; m < 9; ++m) red[(kg * 9 + m) * 64 + cl] = acc[m];
    __syncthreads();
    for (int i = tid; i < 9 * 64; i += 256) {
      int m = i >> 6, c2 = i & 63;
      float s = red[(0 * 9 + m) * 64 + c2] + red[(1 * 9 + m) * 64 + c2] + red[(2 * 9 + m) * 64 + c2] + red[(3 * 9 + m) * 64 + c2];
      int nn = nb + c2;
      modv[(size_t)(l * 9 + m) * 6144 + nn] = s + p.in[7][l * 6144 + nn];
    }
    __syncthreads();
  }
}

__device__ __forceinline__ void prep_transpose(const float* src, bf16_t* dst, int N, int Npad, float* tile, unsigned char* dst8 = nullptr, float scale8 = 1.f) {
  const int tid = opaque_tid();
  const int ntn = Npad / 64;
  const int units = ntn * 16;
  for (int u = blockIdx.x; u < units; u += gridDim.x) {
    const int nt = u % ntn, kt = u / ntn;
    const int n0 = nt * 64, k0 = kt * 64;
    {
      const int c = tid & 63;
      const int n = n0 + c;
      const int nc = n < N ? n : N - 1;
      float tv[16];
#pragma unroll
      for (int i = 0; i < 16; ++i) tv[i] = src[(size_t)(k0 + (tid >> 6) + 4 * i) * N + nc];
#pragma unroll
      for (int i = 0; i < 16; ++i) tile[((tid >> 6) + 4 * i) * 65 + c] = (n < N) ? tv[i] : 0.f;
    }
    __syncthreads();
#pragma unroll 4
    for (int i = 0; i < 16; ++i) {
      int rr = (tid >> 6) + 4 * i, cc = tid & 63;
      if (dst8) dst8[(size_t)(n0 + rr) * 1024 + k0 + cc] = (unsigned char)__builtin_amdgcn_cvt_pk_fp8_f32(tile[cc * 65 + rr] * scale8, 0.f, 0, false);
      else dst[(size_t)(n0 + rr) * 1024 + k0 + cc] = f2bf(tile[cc * 65 + rr]);
    }
    __syncthreads();
  }
}

__device__ __forceinline__ void prep_convert(const float* src, bf16_t* dst, size_t n4) {
  const size_t stride = (size_t)gridDim.x * 256;
  for (size_t i0 = (size_t)blockIdx.x * 256 + opaque_tid(); i0 < n4; i0 += stride * 8) {
    float4 v[8];
#pragma unroll
    for (int j = 0; j < 8; ++j) { const size_t i = i0 + j * stride; const size_t ic = i < n4 ? i : n4 - 1; v[j] = ((const float4*)src)[ic]; }
#pragma unroll
    for (int j = 0; j < 8; ++j) {
      const size_t i = i0 + j * stride;
      if (i < n4) { uint2 o; o.x = pack2(v[j].x, v[j].y); o.y = pack2(v[j].z, v[j].w); ((uint2*)dst)[i] = o; }
    }
  }
}

__device__ __forceinline__ void prep_convert_fp8(const float* src, unsigned* dst, size_t n4, float scale) {
  const size_t stride = (size_t)gridDim.x * 256;
  for (size_t i0 = (size_t)blockIdx.x * 256 + opaque_tid(); i0 < n4; i0 += stride * 8) {
    float4 v[8];
#pragma unroll
    for (int j = 0; j < 8; ++j) { const size_t i = i0 + j * stride; const size_t ic = i < n4 ? i : n4 - 1; f32x4 t4 = __builtin_nontemporal_load((const f32x4*)src + ic); v[j] = make_float4(t4[0], t4[1], t4[2], t4[3]); }
#pragma unroll
    for (int j = 0; j < 8; ++j) {
      const size_t i = i0 + j * stride;
      if (i < n4) {
        unsigned w = __builtin_amdgcn_cvt_pk_fp8_f32(v[j].x * scale, v[j].y * scale, 0, false);
        w = __builtin_amdgcn_cvt_pk_fp8_f32(v[j].z * scale, v[j].w * scale, w, true);
        dst[i] = w;
      }
    }
  }
}
__device__ __forceinline__ void prep_convert_fp4(const float* src, unsigned* dst, size_t n8, float scale, int W) {
  const size_t stride = (size_t)gridDim.x * 256;
  for (size_t i0 = (size_t)blockIdx.x * 256 + opaque_tid(); i0 < n8; i0 += stride * 4) {
    f32x4 va[4], vb[4];
#pragma unroll
    for (int j = 0; j < 4; ++j) {
      const size_t i = i0 + j * stride; const size_t ic = i < n8 ? i : n8 - 1;
      va[j] = __builtin_nontemporal_load((const f32x4*)src + 2 * ic);
      vb[j] = __builtin_nontemporal_load((const f32x4*)src + 2 * ic + 1);
    }
#pragma unroll
    for (int j = 0; j < 4; ++j) {
      const size_t i = i0 + j * stride;
      if (i < n8) {
        unsigned w = 0;
        w = __builtin_amdgcn_cvt_scalef32_pk_fp4_f32(w, va[j][0] * scale, va[j][1] * scale, 1.0f, 0);
        w = __builtin_amdgcn_cvt_scalef32_pk_fp4_f32(w, va[j][2] * scale, va[j][3] * scale, 1.0f, 1);
        w = __builtin_amdgcn_cvt_scalef32_pk_fp4_f32(w, vb[j][0] * scale, vb[j][1] * scale, 1.0f, 2);
        w = __builtin_amdgcn_cvt_scalef32_pk_fp4_f32(w, vb[j][2] * scale, vb[j][3] * scale, 1.0f, 3);
        const size_t el = i * 8;
        const size_t lay = el >> 24, e = (el >> 10) & 16383, d0 = el & 1023;
        const size_t off = lay * (16384ull * 512) + (d0 / W) * (16384ull * (W / 2)) + e * (W / 2) + ((d0 % W) >> 1);
        *(unsigned*)((unsigned char*)dst + off) = w;
      }
    }
  }
}
__device__ __forceinline__ void unpack16_fp4(unsigned w0, unsigned w1, f32x2* f) {
  f[0] = __builtin_amdgcn_cvt_scalef32_pk_f32_fp4(w0, 1.0f, 0);
  f[1] = __builtin_amdgcn_cvt_scalef32_pk_f32_fp4(w0, 1.0f, 1);
  f[2] = __builtin_amdgcn_cvt_scalef32_pk_f32_fp4(w0, 1.0f, 2);
  f[3] = __builtin_amdgcn_cvt_scalef32_pk_f32_fp4(w0, 1.0f, 3);
  f[4] = __builtin_amdgcn_cvt_scalef32_pk_f32_fp4(w1, 1.0f, 0);
  f[5] = __builtin_amdgcn_cvt_scalef32_pk_f32_fp4(w1, 1.0f, 1);
  f[6] = __builtin_amdgcn_cvt_scalef32_pk_f32_fp4(w1, 1.0f, 2);
  f[7] = __builtin_amdgcn_cvt_scalef32_pk_f32_fp4(w1, 1.0f, 3);
}
__device__ __forceinline__ void unpack16_fp8(u32x4 v, float* f) {
#pragma unroll
  for (int i = 0; i < 4; ++i) {
    f32x2 lo = __builtin_amdgcn_cvt_pk_f32_fp8(v[i], false);
    f32x2 hi = __builtin_amdgcn_cvt_pk_f32_fp8(v[i], true);
    f[4 * i + 0] = lo.x; f[4 * i + 1] = lo.y; f[4 * i + 2] = hi.x; f[4 * i + 3] = hi.y;
  }
}
#define U_SCALE 64.f
#define V_SCALE 20.f
__device__ __forceinline__ void phase_prep_a(const Params& p, unsigned char* smem) {
  float* fs = (float*)smem;
  prep_mod(p, fs);
  {
    float2* rope = (float2*)(p.ws + OFF_ROPE);
    int i = blockIdx.x * 256 + opaque_tid();
    if (i < 64 * 16) {
      int pos = i >> 4, f = i & 15;
      float fr = powf(10000.f, -(float)f / 16.f);
      float ang = (float)pos * fr;
      rope[i] = make_float2(cosf(ang), sinf(ang));
    }
  }
  for (int i = 0; i < 2; ++i) {
    prep_transpose(p.in[11] + (size_t)i * 1024 * 3072, (bf16_t*)(p.ws + OFF_WIN_EV) + (size_t)i * 3072 * 1024, 3072, 3072, fs);
    prep_transpose(p.in[16] + (size_t)i * 1024 * 3088, (bf16_t*)(p.ws + OFF_WIN_OD) + (size_t)i * 3328 * 1024, 3088, 3328, fs);
    prep_transpose(p.in[12] + (size_t)i * 1024 * 1024, (bf16_t*)(p.ws + OFF_WOUT) + (size_t)(2 * i) * 1024 * 1024, 1024, 1024, fs);
    prep_transpose(p.in[17] + (size_t)i * 1024 * 1024, (bf16_t*)(p.ws + OFF_WOUT) + (size_t)(2 * i + 1) * 1024 * 1024, 1024, 1024, fs);
  }
  for (int l = 0; l < 4; ++l)
    prep_transpose(p.in[26] + (size_t)l * 1024 * 2048, nullptr, 2048, 2048, fs, p.ws + OFF_WQ + (size_t)l * 2048 * 1024, WQ_SCALE);
  prep_convert(p.in[27], (bf16_t*)(p.ws + OFF_KEYS), (size_t)4 * 8 * 2 * 128 * 128 / 4);
  prep_convert_fp4(p.in[28], (unsigned*)(p.ws + OFF_UB), (size_t)4 * 16384 * 1024 / 8, U_SCALE, 128);
  prep_convert_fp4(p.in[29], (unsigned*)(p.ws + OFF_VB), (size_t)4 * 16384 * 1024 / 8, V_SCALE, 1024);
}

__device__ __forceinline__ void norm_token(const float* xrow, const float* g, const float* scale, const float* shift,
                                           bf16_t* hrow, float* copy_dst, int lane, unsigned char* h8row = nullptr,
                                           unsigned char* hf8row = nullptr) {
  float4 v[4];
  float ss = 0.f;
#pragma unroll
  for (int i = 0; i < 4; ++i) {
    v[i] = *(const float4*)(xrow + i * 256 + lane * 4);
    ss += v[i].x * v[i].x + v[i].y * v[i].y + v[i].z * v[i].z + v[i].w * v[i].w;
  }
  ss = wave_sum(ss);
  const float rs = rsqrtf(ss * (1.f / 1024.f) + EPSV);
#pragma unroll
  for (int i = 0; i < 4; ++i) {
    const int idx = i * 256 + lane * 4;
    if (copy_dst) *(float4*)(copy_dst + idx) = v[i];
    float4 gg = *(const float4*)(g + idx);
    float4 sc = *(const float4*)(scale + idx);
    float4 sh = *(const float4*)(shift + idx);
    float a = v[i].x * rs * gg.x * (1.f + sc.x) + sh.x;
    float b = v[i].y * rs * gg.y * (1.f + sc.y) + sh.y;
    float c = v[i].z * rs * gg.z * (1.f + sc.z) + sh.z;
    float d = v[i].w * rs * gg.w * (1.f + sc.w) + sh.w;
    uint2 o;
    o.x = pack2(a, b);
    o.y = pack2(c, d);
    if (hrow) *(uint2*)(hrow + idx) = o;
    if (h8row) {
      unsigned w4 = 0;
      w4 = __builtin_amdgcn_cvt_scalef32_pk_fp4_f32(w4, a * X_SCALE, b * X_SCALE, 1.0f, 0);
      w4 = __builtin_amdgcn_cvt_scalef32_pk_fp4_f32(w4, c * X_SCALE, d * X_SCALE, 1.0f, 1);
      *(unsigned short*)(h8row + (idx >> 1)) = (unsigned short)w4;
    }
    if (hf8row) {
      unsigned w8 = __builtin_amdgcn_cvt_pk_fp8_f32(a, b, 0, false);
      w8 = __builtin_amdgcn_cvt_pk_fp8_f32(c, d, w8, true);
      *(unsigned*)(hf8row + idx) = w8;
    }
  }
}

__device__ __forceinline__ void phase_prep_b(const Params& p) {
  const int tid_ = opaque_tid(); const int lane = tid_ & 63, wv = tid_ >> 6;
  const float* modv = (const float*)(p.ws + OFF_MOD);
  bf16_t* H = (bf16_t*)(p.ws + OFF_H);
  for (int t = blockIdx.x * 4 + wv; t < NTOK; t += gridDim.x * 4) {
    const float* xr = (t < NPROMPT) ? p.in[0] + (size_t)t * 1024 : p.in[1] + (size_t)(t - NPROMPT) * 1024;
    const float* md = modv + (size_t)(0 * 9 + tok_mod(t)) * 6144;
    norm_token(xr, p.in[8], md + 1024, md, H + (size_t)t * 1024, p.out + (size_t)t * 1024, lane);
  }
}

__device__ __forceinline__ void phase_norm2(const Params& p, int l) {
  const int tid_ = opaque_tid(); const int lane = tid_ & 63, wv = tid_ >> 6;
  const float* modv = (const float*)(p.ws + OFF_MOD);
  bf16_t* H = (bf16_t*)(p.ws + OFF_H);
  for (int t = blockIdx.x * 4 + wv; t < NTOK; t += gridDim.x * 4) {
    const float* md = modv + (size_t)(l * 9 + tok_mod(t)) * 6144;
    norm_token(p.out + (size_t)t * 1024, p.in[9] + l * 1024, md + 4096, md + 3072, nullptr, nullptr, lane,
               p.ws + OFF_H8 + (size_t)t * 512, p.ws + OFF_H8F + (size_t)t * 1024);
  }
}

template <int EPI, int NJ, int BK>
__device__ __forceinline__ void gemm_phase(const bf16_t* __restrict__ A, const bf16_t* __restrict__ Bt, int ntiles_n,
                           bf16_t* __restrict__ C, int ldc, float* __restrict__ X, const float* __restrict__ ga,
                           unsigned char* smem, int dry = 0) {
  constexpr int TN = 32 * NJ;
  constexpr int LS = BK + 8;
  constexpr int TPR = BK / 8;
  constexpr int RPP = 256 / TPR;
  constexpr int NA = 128 / RPP, NB = TN / RPP;
  bf16_t* As = (bf16_t*)smem;
  bf16_t* Bs = As + 128 * LS;
  const int tid = opaque_tid(), lane = tid & 63, w = tid >> 6, quad = lane >> 4, l15 = lane & 15;
  const int wm = w >> 1, wn = w & 1;
  const int lr = tid / TPR, lseg = (tid % TPR) * 8;
  const int units = 192 * ntiles_n;
  for (int u = blockIdx.x; u < units; u += gridDim.x) {
    const int mt = u % 192, nt = u / 192;
    const int m0 = mt * 128, n0 = nt * TN;
    f32x4 acc[4][NJ];
#pragma unroll
    for (int i = 0; i < 4; ++i)
#pragma unroll
      for (int j = 0; j < NJ; ++j) acc[i][j] = (f32x4){0.f, 0.f, 0.f, 0.f};
    const unsigned char* Ab = (const unsigned char*)(A + (size_t)m0 * 1024);
    const unsigned char* Bb = (const unsigned char*)(Bt + (size_t)n0 * 1024);
    const unsigned voff = (unsigned)(lr * 2048 + lseg * 2);
    u32x4 ra[NA], rb[NB];
#pragma unroll
    for (int i = 0; i < NA; ++i) ra[i] = *(const u32x4*)(Ab + (size_t)(i * RPP * 2048) + voff);
#pragma unroll
    for (int i = 0; i < NB; ++i) rb[i] = *(const u32x4*)(Bb + (size_t)(i * RPP * 2048) + voff);
#pragma unroll 1
    for (int kt = 0; kt < 1024 / BK; ++kt) {
#pragma unroll
      for (int i = 0; i < NA; ++i) *(u32x4*)(As + (lr + RPP * i) * LS + lseg) = ra[i];
#pragma unroll
      for (int i = 0; i < NB; ++i) *(u32x4*)(Bs + (lr + RPP * i) * LS + lseg) = rb[i];
      __syncthreads();
      if (kt + 1 < 1024 / BK) {
        const unsigned char* An = Ab + (size_t)((kt + 1) * BK * 2);
        const unsigned char* Bn = Bb + (size_t)((kt + 1) * BK * 2);
#pragma unroll
        for (int i = 0; i < NA; ++i) ra[i] = *(const u32x4*)(An + (size_t)(i * RPP * 2048) + voff);
#pragma unroll
        for (int i = 0; i < NB; ++i) rb[i] = *(const u32x4*)(Bn + (size_t)(i * RPP * 2048) + voff);
      }
#pragma unroll
      for (int kk = 0; kk < BK / 32; ++kk) {
        bf16x8 af[4];
#pragma unroll
        for (int i = 0; i < 4; ++i) af[i] = ldfrag(As + (wm * 64 + i * 16 + l15) * LS + kk * 32 + quad * 8);
#pragma unroll
        for (int j = 0; j < NJ; ++j) {
          const bf16x8 bfr = ldfrag(Bs + (wn * (16 * NJ) + j * 16 + l15) * LS + kk * 32 + quad * 8);
#pragma unroll
          for (int i = 0; i < 4; ++i) acc[i][j] = mfma16(af[i], bfr, acc[i][j]);
        }
      }
      __syncthreads();
    }
    if (EPI == 0) {
#pragma unroll
      for (int i = 0; i < 4; ++i)
#pragma unroll
        for (int j = 0; j < NJ; ++j) {
          const int col = n0 + wn * (16 * NJ) + j * 16 + l15;
          if (col < ldc) {
#pragma unroll
            for (int jj = 0; jj < 4; ++jj) {
              int row = m0 + wm * 64 + i * 16 + quad * 4 + jj;
              C[(size_t)row * ldc + col] = f2bf(acc[i][j][jj]);
            }
          }
        }
    } else {
      const float* gam = ga + (size_t)tok_mod(m0) * 6144;
#pragma unroll
      for (int i = 0; i < 4; ++i)
#pragma unroll
        for (int j = 0; j < NJ; ++j)
#pragma unroll
          for (int jj = 0; jj < 4; ++jj) {
            int row = m0 + wm * 64 + i * 16 + quad * 4 + jj;
            int col = n0 + wn * (16 * NJ) + j * 16 + l15;
            float* xp = X + (size_t)row * 1024 + col;
            const float nv = *xp + gam[col] * acc[i][j][jj];
            if (!dry) *xp = nv;
          }
    }
  }
}

__device__ __forceinline__ void gemm_q_fp8(const unsigned char* __restrict__ A, const unsigned char* __restrict__ Bt,
                                           bf16_t* __restrict__ C, unsigned char* smem) {
  constexpr int LSB = 144;
  unsigned char* As = smem;
  unsigned char* Bs = smem + 128 * LSB;
  const int tid = opaque_tid(), lane = tid & 63, w = tid >> 6, quad = lane >> 4, l15 = lane & 15;
  const int wm = w >> 1, wn = w & 1;
  const int lr = tid >> 3, lseg = (tid & 7) * 16;
  for (int u = blockIdx.x; u < 192 * 16; u += gridDim.x) {
    const int mt = u % 192, nt = u / 192;
    const int m0 = mt * 128, n0 = nt * 128;
    f32x4 acc[4][4];
#pragma unroll
    for (int i = 0; i < 4; ++i)
#pragma unroll
      for (int j = 0; j < 4; ++j) acc[i][j] = (f32x4){0.f, 0.f, 0.f, 0.f};
    const unsigned char* Ag = A + (size_t)(m0 + lr * 4) * 1024 + lseg;
    const unsigned char* Bg = Bt + (size_t)(n0 + lr * 4) * 1024 + lseg;
    u32x4 ra[4], rb[4];
#pragma unroll
    for (int i = 0; i < 4; ++i) ra[i] = *(const u32x4*)(Ag + i * 1024);
#pragma unroll
    for (int i = 0; i < 4; ++i) rb[i] = *(const u32x4*)(Bg + i * 1024);
#pragma unroll 1
    for (int kt = 0; kt < 8; ++kt) {
#pragma unroll
      for (int i = 0; i < 4; ++i) *(u32x4*)(As + (lr * 4 + i) * LSB + lseg) = ra[i];
#pragma unroll
      for (int i = 0; i < 4; ++i) *(u32x4*)(Bs + (lr * 4 + i) * LSB + lseg) = rb[i];
      __syncthreads();
      if (kt + 1 < 8) {
#pragma unroll
        for (int i = 0; i < 4; ++i) ra[i] = *(const u32x4*)(Ag + i * 1024 + (kt + 1) * 128);
#pragma unroll
        for (int i = 0; i < 4; ++i) rb[i] = *(const u32x4*)(Bg + i * 1024 + (kt + 1) * 128);
      }
#pragma unroll
      for (int kk = 0; kk < 4; ++kk) {
        long af[4];
#pragma unroll
        for (int i = 0; i < 4; ++i) af[i] = *(const long*)(As + (wm * 64 + i * 16 + l15) * LSB + kk * 32 + quad * 8);
#pragma unroll
        for (int j = 0; j < 4; ++j) {
          const long bfr = *(const long*)(Bs + (wn * 64 + j * 16 + l15) * LSB + kk * 32 + quad * 8);
#pragma unroll
          for (int i = 0; i < 4; ++i) acc[i][j] = __builtin_amdgcn_mfma_f32_16x16x32_fp8_fp8(af[i], bfr, acc[i][j], 0, 0, 0);
        }
      }
      __syncthreads();
    }
#pragma unroll
    for (int i = 0; i < 4; ++i)
#pragma unroll
      for (int j = 0; j < 4; ++j) {
        const int col = n0 + wn * 64 + j * 16 + l15;
#pragma unroll
        for (int jj = 0; jj < 4; ++jj) {
          const int row = m0 + wm * 64 + i * 16 + quad * 4 + jj;
          C[(size_t)row * 2048 + col] = f2bf(acc[i][j][jj] * (1.f / WQ_SCALE));
        }
      }
  }
}

struct ChainItem {
  bool lng; int sl, dir, h, sq, tok0, nc;
};
__device__ __forceinline__ ChainItem decode_item(int it) {
  ChainItem c;
  c.lng = it < 256;
  int idx = c.lng ? it : it - 256;
  c.sl = idx & 3; c.dir = (idx >> 2) & 1; c.h = (idx >> 3) & 3; c.sq = idx >> 5;
  c.tok0 = c.lng ? NPROMPT + c.sq * 2048 : c.sq * 256;
  c.nc = c.lng ? 32 : 4;
  return c;
}

__device__ __forceinline__ void phase_ret_chain(const Params& p, int l, unsigned char* smem) {
  const int il = l >> 1;
  bf16_t* qs = (bf16_t*)smem;
  bf16_t* ks = qs + 64 * 72;
  bf16_t* kT = ks + 64 * 72;
  bf16_t* vT = kT + 64 * 72;
  bf16_t* intra = vT + 32 * 72;
  bf16_t* ST = intra + 64 * 72;
  const bf16_t* P = (const bf16_t*)(p.ws + OFF_P);
  float* odir = (float*)(p.ws + OFF_ODIR);
  const float2* rope = (const float2*)(p.ws + OFF_ROPE);
  const int tid = opaque_tid(), lane = tid & 63, w = tid >> 6, quad = lane >> 4, l15 = lane & 15;
  const int nlb = (gridDim.x >= 512) ? 256 : ((gridDim.x >= 2) ? (int)(gridDim.x / 2) : 0);
  const bool longblk = (nlb > 0) ? ((int)blockIdx.x < nlb) : true;
  const int it_lo = (nlb > 0) ? (longblk ? (int)blockIdx.x : 256 + ((int)blockIdx.x - nlb)) : (int)blockIdx.x;
  const int it_hi = (nlb > 0) ? (longblk ? 256 : 1280) : 1280;
  const int it_st = (nlb > 0) ? (longblk ? nlb : ((int)gridDim.x - nlb)) : (int)gridDim.x;
  for (int it = it_lo; it < it_hi; it += it_st) {
    const ChainItem ci = decode_item(it);
    const int sl = ci.sl, dir = ci.dir, h = ci.h;
    const float xg = p.in[13][(il * 2 + dir) * 4 + h];
    const float lg = -log1pf(expf(-xg));
    const float g64 = expf(lg * 64.f);
    f32x4 S[2];
    if (ci.lng) {
      const float* s0 = p.in[2] + ((((size_t)ci.sq * 2 + il) * 2 + dir) * 4 + h) * 8192;
#pragma unroll
      for (int ct = 0; ct < 2; ++ct)
#pragma unroll
        for (int jj = 0; jj < 4; ++jj) S[ct][jj] = s0[(16 * w + quad * 4 + jj) * 128 + sl * 32 + ct * 16 + l15];
    } else {
      S[0] = (f32x4){0.f, 0.f, 0.f, 0.f};
      S[1] = (f32x4){0.f, 0.f, 0.f, 0.f};
    }
    for (int n = 0; n < ci.nc; ++n) {
      const int cn = dir ? ci.nc - 1 - n : n;
      const int tb = ci.tok0 + cn * 64;
      {
        const int i = tid >> 2, mq = tid & 3;
        const int t = tb + (dir ? 63 - i : i);
        const bf16_t* pr = P + (size_t)t * PSTRIDE;
        float qa[8], qb[8], ka[8], kb[8];
        unpack8(*(const uint4*)(pr + h * 64 + mq * 8), qa);
        unpack8(*(const uint4*)(pr + h * 64 + 32 + mq * 8), qb);
        unpack8(*(const uint4*)(pr + 256 + h * 64 + mq * 8), ka);
        unpack8(*(const uint4*)(pr + 256 + h * 64 + 32 + mq * 8), kb);
        if (ci.lng) {
          const int pos = (mq < 2) ? cn : (t - tb);
          const int f0 = (mq & 1) * 8;
#pragma unroll
          for (int e = 0; e < 8; ++e) {
            float2 cs = rope[pos * 16 + f0 + e];
            float a = qa[e], b = qb[e];
            qa[e] = a * cs.x - b * cs.y; qb[e] = b * cs.x + a * cs.y;
            a = ka[e]; b = kb[e];
            ka[e] = a * cs.x - b * cs.y; kb[e] = b * cs.x + a * cs.y;
          }
        }
        const float wend = expf(lg * (float)(63 - i));
        uint4 o;
        o.x = pack2(qa[0], qa[1]); o.y = pack2(qa[2], qa[3]); o.z = pack2(qa[4], qa[5]); o.w = pack2(qa[6], qa[7]);
        *(uint4*)(qs + i * 72 + mq * 8) = o;
        o.x = pack2(qb[0], qb[1]); o.y = pack2(qb[2], qb[3]); o.z = pack2(qb[4], qb[5]); o.w = pack2(qb[6], qb[7]);
        *(uint4*)(qs + i * 72 + 32 + mq * 8) = o;
#pragma unroll
        for (int e = 0; e < 8; ++e) { ka[e] *= 0.125f; kb[e] *= 0.125f; }
        o.x = pack2(ka[0], ka[1]); o.y = pack2(ka[2], ka[3]); o.z = pack2(ka[4], ka[5]); o.w = pack2(ka[6], ka[7]);
        *(uint4*)(ks + i * 72 + mq * 8) = o;
        o.x = pack2(kb[0], kb[1]); o.y = pack2(kb[2], kb[3]); o.z = pack2(kb[4], kb[5]); o.w = pack2(kb[6], kb[7]);
        *(uint4*)(ks + i * 72 + 32 + mq * 8) = o;
#pragma unroll
        for (int e = 0; e < 8; ++e) {
          kT[(mq * 8 + e) * 72 + i] = f2bf(ka[e] * wend);
          kT[(32 + mq * 8 + e) * 72 + i] = f2bf(kb[e] * wend);
        }
        uint4 v8 = *(const uint4*)(pr + 512 + h * 128 + sl * 32 + mq * 8);
        vT[(mq * 8 + 0) * 72 + i] = (bf16_t)(v8.x & 0xffff); vT[(mq * 8 + 1) * 72 + i] = (bf16_t)(v8.x >> 16);
        vT[(mq * 8 + 2) * 72 + i] = (bf16_t)(v8.y & 0xffff); vT[(mq * 8 + 3) * 72 + i] = (bf16_t)(v8.y >> 16);
        vT[(mq * 8 + 4) * 72 + i] = (bf16_t)(v8.z & 0xffff); vT[(mq * 8 + 5) * 72 + i] = (bf16_t)(v8.z >> 16);
        vT[(mq * 8 + 6) * 72 + i] = (bf16_t)(v8.w & 0xffff); vT[(mq * 8 + 7) * 72 + i] = (bf16_t)(v8.w >> 16);
      }
      __syncthreads();
      const bf16x8 a0 = ldfrag(qs + (16 * w + l15) * 72 + quad * 8);
      const bf16x8 a1 = ldfrag(qs + (16 * w + l15) * 72 + 32 + quad * 8);
#pragma unroll
      for (int ct = 0; ct < 4; ++ct) {
        bf16x8 b0 = ldfrag(ks + (ct * 16 + l15) * 72 + quad * 8);
        bf16x8 b1 = ldfrag(ks + (ct * 16 + l15) * 72 + 32 + quad * 8);
        f32x4 c = (f32x4){0.f, 0.f, 0.f, 0.f};
        c = mfma16(a0, b0, c);
        c = mfma16(a1, b1, c);
#pragma unroll
        for (int jj = 0; jj < 4; ++jj) {
          int i = 16 * w + quad * 4 + jj, j = ct * 16 + l15;
          float val = (i >= j) ? c[jj] * expf(lg * (float)(i - j)) : 0.f;
          intra[i * 72 + j] = f2bf(val);
        }
      }
#pragma unroll
      for (int ct = 0; ct < 2; ++ct)
#pragma unroll
        for (int jj = 0; jj < 4; ++jj) ST[(ct * 16 + l15) * 72 + 16 * w + quad * 4 + jj] = f2bf(S[ct][jj]);
      __syncthreads();
      const bf16x8 ai0 = ldfrag(intra + (16 * w + l15) * 72 + quad * 8);
      const bf16x8 ai1 = ldfrag(intra + (16 * w + l15) * 72 + 32 + quad * 8);
      const bf16x8 ak0 = ldfrag(kT + (16 * w + l15) * 72 + quad * 8);
      const bf16x8 ak1 = ldfrag(kT + (16 * w + l15) * 72 + 32 + quad * 8);
#pragma unroll
      for (int ct = 0; ct < 2; ++ct) {
        bf16x8 bv0 = ldfrag(vT + (ct * 16 + l15) * 72 + quad * 8);
        bf16x8 bv1 = ldfrag(vT + (ct * 16 + l15) * 72 + 32 + quad * 8);
        bf16x8 bs0 = ldfrag(ST + (ct * 16 + l15) * 72 + quad * 8);
        bf16x8 bs1 = ldfrag(ST + (ct * 16 + l15) * 72 + 32 + quad * 8);
        f32x4 ci_ = (f32x4){0.f, 0.f, 0.f, 0.f}, cc = (f32x4){0.f, 0.f, 0.f, 0.f};
        ci_ = mfma16(ai0, bv0, ci_);
        ci_ = mfma16(ai1, bv1, ci_);
        cc = mfma16(a0, bs0, cc);
        cc = mfma16(a1, bs1, cc);
#pragma unroll
        for (int jj = 0; jj < 4; ++jj) {
          int i = 16 * w + quad * 4 + jj;
          int t = tb + (dir ? 63 - i : i);
          float o = ci_[jj] + expf(lg * (float)(i + 1)) * cc[jj];
          odir[((size_t)dir * NTOK + t) * 512 + h * 128 + sl * 32 + ct * 16 + l15] = o;
        }
        f32x4 s = S[ct];
        s[0] *= g64; s[1] *= g64; s[2] *= g64; s[3] *= g64;
        s = mfma16(ak0, bv0, s);
        s = mfma16(ak1, bv1, s);
        S[ct] = s;
      }
      __syncthreads();
    }
    if (!ci.lng) {
      float* so = p.out + 25165824 + ((((size_t)ci.sq * 2 + il) * 2 + dir) * 4 + h) * 8192;
#pragma unroll
      for (int ct = 0; ct < 2; ++ct)
#pragma unroll
        for (int jj = 0; jj < 4; ++jj) so[(16 * w + quad * 4 + jj) * 128 + sl * 32 + ct * 16 + l15] = S[ct][jj];
    }
  }
}

__device__ __forceinline__ void gdn_prep_item(const Params& p, int l, int pi, unsigned char* smem, int plvl) {
  const int il = l >> 1;
  bf16_t* ks = (bf16_t*)smem;
  bf16_t* vs = ks + 64 * 136;
  float* Am = (float*)(vs + 64 * 136);
  float* rq = Am + 4096;
  float* rk = rq + 64;
  float* gcs = rk + 64;
  float* bet = gcs + 64;
  float* fac = bet + 64;
  bf16_t* qs = (bf16_t*)(fac + 128);
  const bf16_t* P = (const bf16_t*)(p.ws + OFF_P);
  unsigned char* gp = p.ws + OFF_GPREP + (size_t)pi * GP_ITEM;
  bf16_t* Wb = (bf16_t*)gp;
  bf16_t* QG = Wb + 8192;
  bf16_t* KDT = QG + 8192;
  bf16_t* Ub = KDT + 8192;
  bf16_t* ATT = Ub + 8192;
  float* EGL = (float*)(p.ws + OFF_EGL);
  const int tid = opaque_tid(), lane = tid & 63, w = tid >> 6, quad = lane >> 4, l15 = lane & 15;
  const int dir = pi & 1, h = (pi >> 1) & 3, c = pi >> 3;
  int tb, seq_lo, seq_hi;
  if (c < 128) { tb = c * 64; seq_lo = (c >> 2) * 256; seq_hi = seq_lo + 256; }
  else { int cc = c - 128; tb = NPROMPT + cc * 64; seq_lo = NPROMPT + (cc >> 5) * 2048; seq_hi = seq_lo + 2048; }
  const float SCALE = 0.08838834764831845f;
  {
    const int cg_ = tid & 127, rh = tid >> 7;
#pragma unroll
    for (int mat = 0; mat < 3; ++mat) {
      const int col = mat * 512 + h * 128 + cg_;
      const float* cw = p.in[18] + (size_t)il * 3 * 1536 + col;
      const float w0 = cw[0], w1 = cw[1536], w2 = cw[3072];
      bf16_t* dst = mat == 0 ? qs : (mat == 1 ? ks : vs);
      const int t0 = tb + rh * 32;
      bf16_t raw[34];
#pragma unroll
      for (int o = 0; o < 34; ++o) {
        const int t = t0 - 1 + o;
        const int tc = min(max(t, seq_lo), seq_hi - 1);
        const bf16_t rv = P[(size_t)tc * PSTRIDE + col];
        raw[o] = (t == tc) ? rv : (bf16_t)0;
      }
#pragma unroll
      for (int o = 0; o < 32; ++o) {
        float y = w0 * bf2f(raw[o]) + w1 * bf2f(raw[o + 1]) + w2 * bf2f(raw[o + 2]);
        y = siluf(y);
        const int oi = rh * 32 + o;
        const int i = dir ? 63 - oi : oi;
        dst[i * 136 + cg_] = f2bf(y);
      }
    }
  }
  __syncthreads();
  if (plvl == 4) return;
  {
    const int r = tid >> 2, part = tid & 3;
    float sq_ = 0.f, sk_ = 0.f;
#pragma unroll 8
    for (int e = 0; e < 32; ++e) {
      float a = bf2f(qs[r * 136 + part * 32 + e]);
      float b = bf2f(ks[r * 136 + part * 32 + e]);
      sq_ += a * a; sk_ += b * b;
    }
    sq_ += __shfl_xor(sq_, 1); sq_ += __shfl_xor(sq_, 2);
    sk_ += __shfl_xor(sk_, 1); sk_ += __shfl_xor(sk_, 2);
    if (part == 0) {
      rq[r] = rsqrtf(sq_ + EPSV);
      rk[r] = rsqrtf(sk_ + EPSV);
      const int t = tb + (dir ? 63 - r : r);
      float a = bf2f(P[(size_t)t * PSTRIDE + 2048 + dir * 4 + h]);
      float bbv = bf2f(P[(size_t)t * PSTRIDE + 2056 + dir * 4 + h]);
      float al = p.in[19][(il * 2 + dir) * 4 + h], dtb = p.in[20][(il * 2 + dir) * 4 + h];
      float z = a + dtb;
      float sp = (z > 20.f) ? z : log1pf(expf(z));
      gcs[r] = -expf(al) * sp;
      bet[r] = 1.f / (1.f + expf(-bbv));
    }
  }
  __syncthreads();
  if (tid < 64) {
    float v = gcs[tid];
#pragma unroll
    for (int o = 1; o < 64; o <<= 1) {
      float u = __shfl_up(v, o);
      if (tid >= o) v += u;
    }
    gcs[tid] = v;
  }
  __syncthreads();
  {
    bf16x8 ak[4], aq[4];
#pragma unroll
    for (int kk = 0; kk < 4; ++kk) {
      ak[kk] = ldfrag(ks + (16 * w + l15) * 136 + kk * 32 + quad * 8);
      aq[kk] = ldfrag(qs + (16 * w + l15) * 136 + kk * 32 + quad * 8);
    }
#pragma unroll
    for (int ct = 0; ct < 4; ++ct) {
      f32x4 ckk = (f32x4){0.f, 0.f, 0.f, 0.f}, cqk = (f32x4){0.f, 0.f, 0.f, 0.f};
#pragma unroll
      for (int kk = 0; kk < 4; ++kk) {
        bf16x8 b = ldfrag(ks + (ct * 16 + l15) * 136 + kk * 32 + quad * 8);
        ckk = mfma16(ak[kk], b, ckk);
        cqk = mfma16(aq[kk], b, cqk);
      }
#pragma unroll
      for (int jj = 0; jj < 4; ++jj) {
        const int i = 16 * w + quad * 4 + jj, j = ct * 16 + l15;
        const float dec = (i >= j) ? __expf(gcs[i] - gcs[j]) : 0.f;
        Am[j * 64 + i] = (i > j) ? bet[i] * rk[i] * rk[j] * ckk[jj] * dec : 0.f;
        ATT[i * 64 + j] = f2bf((i >= j) ? SCALE * rq[i] * rk[j] * cqk[jj] * dec : 0.f);
      }
    }
  }
  __syncthreads();
  const float gl = gcs[63];
#pragma unroll 8
  for (int e = tid; e < 64 * 128; e += 256) {
    int i = e >> 7, d = e & 127;
    QG[e] = f2bf(bf2f(qs[i * 136 + d]) * rq[i] * SCALE * __expf(gcs[i]));
  }
#pragma unroll 8
  for (int e = tid; e < 128 * 64; e += 256) {
    int d = e >> 6, i = e & 63;
    KDT[e] = f2bf(bf2f(ks[i * 136 + d]) * rk[i] * __expf(gl - gcs[i]));
  }
  if (tid < 64) {
    fac[tid] = bet[tid];
    fac[64 + tid] = rk[tid] * bet[tid] * __expf(gcs[tid]);
  }
  __syncthreads();
  if (plvl != 3) {
    const int cidx = tid & 127;
    const bf16_t* srcm = ((tid < 128) ? vs : ks) + cidx;
    const float* fc = fac + ((tid < 128) ? 0 : 64);
    bf16_t* dstm = ((tid < 128) ? Ub : Wb) + cidx;
    bf16_t* XB = qs + tid;
#pragma unroll 1
    for (int b = 0; b < 4; ++b) {
      float x[16];
#pragma unroll
      for (int r = 0; r < 16; ++r) x[r] = bf2f(srcm[(16 * b + r) * 136]) * fc[16 * b + r];
      const float* arow = Am + 16 * b;
#pragma unroll 4
      for (int j = 0; j < 16 * b; ++j) {
        const float xv = bf2f(XB[j * 256]);
        const f32x4 a0 = *(const f32x4*)(arow + j * 64), a1 = *(const f32x4*)(arow + j * 64 + 4);
        const f32x4 a2 = *(const f32x4*)(arow + j * 64 + 8), a3 = *(const f32x4*)(arow + j * 64 + 12);
#pragma unroll
        for (int r = 0; r < 4; ++r) {
          x[r] -= a0[r] * xv; x[4 + r] -= a1[r] * xv; x[8 + r] -= a2[r] * xv; x[12 + r] -= a3[r] * xv;
        }
      }
      const float* ablk = Am + (16 * b) * 64 + 16 * b;
#pragma unroll
      for (int jj = 0; jj < 15; ++jj) {
#pragma unroll
        for (int r = jj + 1; r < 16; ++r) x[r] -= ablk[jj * 64 + r] * x[jj];
      }
#pragma unroll
      for (int r = 0; r < 16; ++r) {
        const bf16_t bb = f2bf(x[r]);
        dstm[(16 * b + r) * 128] = bb;
        if (b < 3) XB[(16 * b + r) * 256] = bb;
      }
    }
  }
  if (tid == 0) EGL[pi] = expf(gl);
  __syncthreads();
}

__device__ __forceinline__ void conf_conv_item(const Params& p, int l, int item, unsigned char* smem) {
  const int il = l >> 1;
  float* hc = (float*)smem;
  const bf16_t* P = (const bf16_t*)(p.ws + OFF_P);
  float* convout = (float*)(p.ws + OFF_CONV);
  const int tid = opaque_tid();
  const int tile = item >> 1, ch = (item & 1) * 256 + tid;
  const int t0 = tile * 32;
  int seq_lo, seq_hi;
  if (t0 < NPROMPT) { seq_lo = (t0 >> 8) << 8; seq_hi = seq_lo + 256; }
  else { seq_lo = NPROMPT + (((t0 - NPROMPT) >> 11) << 11); seq_hi = seq_lo + 2048; }
#pragma unroll 31
  for (int r = 0; r < 62; ++r) {
    const int tt = t0 - 15 + r;
    const int tc = min(max(tt, seq_lo), seq_hi - 1);
    float ca = bf2f(P[(size_t)tc * PSTRIDE + 2064 + ch]);
    float cgv = bf2f(P[(size_t)tc * PSTRIDE + 2576 + ch]);
    float v = ca * __builtin_amdgcn_rcpf(1.f + __expf(-cgv));
    hc[r * 256 + tid] = (tt == tc) ? v : 0.f;
  }
  float wk[31];
#pragma unroll
  for (int k = 0; k < 31; ++k) wk[k] = p.in[22][((size_t)il * 31 + k) * 512 + ch];
  const float bias = p.in[23][il * 512 + ch];
  for (int i = 0; i < 32; ++i) {
    float acc = bias;
#pragma unroll
    for (int k = 0; k < 31; ++k) acc += wk[k] * hc[(i + k) * 256 + tid];
    convout[(size_t)(t0 + i) * 512 + ch] = acc;
  }
}

__device__ __forceinline__ void phase_odd_prep(const Params& p, int l, unsigned char* smem, int rep) {
  for (int u = blockIdx.x; u < 3072 + 1536; u += gridDim.x) {
#if PROBE_ODD == 1 || PROBE_ODD >= 3
    if (rep && u >= 3072) break;
#elif PROBE_ODD == 2
    if (rep && u < 3072) continue;
#endif
    if (u < 3072) gdn_prep_item(p, l, u, smem, (PROBE_ODD >= 3 && rep) ? PROBE_ODD : 0);
    else { conf_conv_item(p, l, u - 3072, smem); __syncthreads(); }
  }
}

__device__ __forceinline__ void phase_gdn_chain(const Params& p, int l, unsigned char* smem) {
  const int il = l >> 1;
  bf16_t* ST = (bf16_t*)smem;
  bf16_t* VT = ST + 32 * 136;
  float* odir = (float*)(p.ws + OFF_ODIR);
  const float* EGL = (const float*)(p.ws + OFF_EGL);
  const int tid = opaque_tid(), lane = tid & 63, w = tid >> 6, quad = lane >> 4, l15 = lane & 15;
  const int nlb = (gridDim.x >= 512) ? 256 : ((gridDim.x >= 2) ? (int)(gridDim.x / 2) : 0);
  const bool longblk = (nlb > 0) ? ((int)blockIdx.x < nlb) : true;
  const int it_lo = (nlb > 0) ? (longblk ? (int)blockIdx.x : 256 + ((int)blockIdx.x - nlb)) : (int)blockIdx.x;
  const int it_hi = (nlb > 0) ? (longblk ? 256 : 1280) : 1280;
  const int it_st = (nlb > 0) ? (longblk ? nlb : ((int)gridDim.x - nlb)) : (int)gridDim.x;
  for (int it = it_lo; it < it_hi; it += it_st) {
    const ChainItem ci = decode_item(it);
    const int sl = ci.sl, dir = ci.dir, h = ci.h;
    f32x4 S[2][2];
    if (ci.lng) {
      const float* s0 = p.in[3] + ((((size_t)ci.sq * 2 + il) * 2 + dir) * 4 + h) * 16384;
#pragma unroll
      for (int rb = 0; rb < 2; ++rb)
#pragma unroll
        for (int ct = 0; ct < 2; ++ct)
#pragma unroll
          for (int jj = 0; jj < 4; ++jj)
            S[rb][ct][jj] = s0[(16 * (2 * w + rb) + quad * 4 + jj) * 128 + sl * 32 + ct * 16 + l15];
    } else {
#pragma unroll
      for (int rb = 0; rb < 2; ++rb)
#pragma unroll
        for (int ct = 0; ct < 2; ++ct) S[rb][ct] = (f32x4){0.f, 0.f, 0.f, 0.f};
    }
    bf16x8 naw[4], naqg[4];
    bf16_t nuu[2][4];
    float negl = 0.f;
    for (int n = 0; n < ci.nc; ++n) {
      const int cn = dir ? ci.nc - 1 - n : n;
      const int tb = ci.tok0 + cn * 64;
      const int cglob = ci.lng ? 128 + ci.sq * 32 + cn : ci.sq * 4 + cn;
      const int pi = (cglob * 4 + h) * 2 + dir;
      const unsigned char* gp = p.ws + OFF_GPREP + (size_t)pi * GP_ITEM;
      const bf16_t* Wb = (const bf16_t*)gp;
      const bf16_t* QG = Wb + 8192;
      const bf16_t* KDT = QG + 8192;
      const bf16_t* Ub = KDT + 8192;
      const bf16_t* ATT = Ub + 8192;
      bf16x8 aw[4], aqg[4], aat[2], akd[2][2];
      float uu[2][4];
      float egl;
      if (n == 0) {
#pragma unroll
        for (int kk = 0; kk < 4; ++kk) {
          aw[kk] = ldfrag(Wb + (16 * w + l15) * 128 + kk * 32 + quad * 8);
          aqg[kk] = ldfrag(QG + (16 * w + l15) * 128 + kk * 32 + quad * 8);
        }
#pragma unroll
        for (int kk = 0; kk < 2; ++kk) {
          aat[kk] = ldfrag(ATT + (16 * w + l15) * 64 + kk * 32 + quad * 8);
#pragma unroll
          for (int rb = 0; rb < 2; ++rb) akd[rb][kk] = ldfrag(KDT + (16 * (2 * w + rb) + l15) * 64 + kk * 32 + quad * 8);
        }
#pragma unroll
        for (int ct = 0; ct < 2; ++ct)
#pragma unroll
          for (int jj = 0; jj < 4; ++jj) uu[ct][jj] = bf2f(Ub[(16 * w + quad * 4 + jj) * 128 + sl * 32 + ct * 16 + l15]);
        egl = EGL[pi];
      } else {
#pragma unroll
        for (int kk = 0; kk < 4; ++kk) { aw[kk] = naw[kk]; aqg[kk] = naqg[kk]; }
#pragma unroll
        for (int kk = 0; kk < 2; ++kk) {
          aat[kk] = ldfrag(ATT + (16 * w + l15) * 64 + kk * 32 + quad * 8);
#pragma unroll
          for (int rb = 0; rb < 2; ++rb) akd[rb][kk] = ldfrag(KDT + (16 * (2 * w + rb) + l15) * 64 + kk * 32 + quad * 8);
        }
#pragma unroll
        for (int ct = 0; ct < 2; ++ct)
#pragma unroll
          for (int jj = 0; jj < 4; ++jj) uu[ct][jj] = bf2f(nuu[ct][jj]);
        egl = negl;
      }
      if (n + 1 < ci.nc) {
        const int cn2 = dir ? ci.nc - 2 - n : n + 1;
        const int cglob2 = ci.lng ? 128 + ci.sq * 32 + cn2 : ci.sq * 4 + cn2;
        const int pi2 = (cglob2 * 4 + h) * 2 + dir;
        const bf16_t* Wb2 = (const bf16_t*)(p.ws + OFF_GPREP + (size_t)pi2 * GP_ITEM);
        const bf16_t* QG2 = Wb2 + 8192; const bf16_t* Ub2 = QG2 + 16384;
#pragma unroll
        for (int kk = 0; kk < 4; ++kk) {
          naw[kk] = ldfrag(Wb2 + (16 * w + l15) * 128 + kk * 32 + quad * 8);
          naqg[kk] = ldfrag(QG2 + (16 * w + l15) * 128 + kk * 32 + quad * 8);
        }
#pragma unroll
        for (int ct = 0; ct < 2; ++ct)
#pragma unroll
          for (int jj = 0; jj < 4; ++jj) nuu[ct][jj] = Ub2[(16 * w + quad * 4 + jj) * 128 + sl * 32 + ct * 16 + l15];
        negl = EGL[pi2];
      }
#pragma unroll
      for (int rb = 0; rb < 2; ++rb)
#pragma unroll
        for (int ct = 0; ct < 2; ++ct)
#pragma unroll
          for (int jj = 0; jj < 4; ++jj)
            ST[(ct * 16 + l15) * 136 + 16 * (2 * w + rb) + quad * 4 + jj] = f2bf(S[rb][ct][jj]);
      __syncthreads();
      f32x4 co[2];
#pragma unroll
      for (int ct = 0; ct < 2; ++ct) {
        f32x4 cv = (f32x4){0.f, 0.f, 0.f, 0.f};
        co[ct] = (f32x4){0.f, 0.f, 0.f, 0.f};
#pragma unroll
        for (int kk = 0; kk < 4; ++kk) {
          bf16x8 b = ldfrag(ST + (ct * 16 + l15) * 136 + kk * 32 + quad * 8);
          cv = mfma16(aw[kk], b, cv);
          co[ct] = mfma16(aqg[kk], b, co[ct]);
        }
#pragma unroll
        for (int jj = 0; jj < 4; ++jj) {
          float vn = uu[ct][jj] - cv[jj];
          VT[(ct * 16 + l15) * 72 + 16 * w + quad * 4 + jj] = f2bf(vn);
        }
      }
      __syncthreads();
#pragma unroll
      for (int ct = 0; ct < 2; ++ct) {
        bf16x8 bv[2];
#pragma unroll
        for (int kk = 0; kk < 2; ++kk) {
          bv[kk] = ldfrag(VT + (ct * 16 + l15) * 72 + kk * 32 + quad * 8);
          co[ct] = mfma16(aat[kk], bv[kk], co[ct]);
        }
#pragma unroll
        for (int jj = 0; jj < 4; ++jj) {
          int i = 16 * w + quad * 4 + jj;
          int t = tb + (dir ? 63 - i : i);
          odir[((size_t)dir * NTOK + t) * 512 + h * 128 + sl * 32 + ct * 16 + l15] = co[ct][jj];
        }
#pragma unroll
        for (int rb = 0; rb < 2; ++rb) {
          f32x4 s = S[rb][ct];
          s[0] *= egl; s[1] *= egl; s[2] *= egl; s[3] *= egl;
          s = mfma16(akd[rb][0], bv[0], s);
          s = mfma16(akd[rb][1], bv[1], s);
          S[rb][ct] = s;
        }
      }
    }
    __syncthreads();
    if (!ci.lng) {
      float* so = p.out + 29360128 + ((((size_t)ci.sq * 2 + il) * 2 + dir) * 4 + h) * 16384;
#pragma unroll
      for (int rb = 0; rb < 2; ++rb)
#pragma unroll
        for (int ct = 0; ct < 2; ++ct)
#pragma unroll
          for (int jj = 0; jj < 4; ++jj)
            so[(16 * (2 * w + rb) + quad * 4 + jj) * 128 + sl * 32 + ct * 16 + l15] = S[rb][ct][jj];
    }
  }
}

__device__ __forceinline__ void phase_mix_out(const Params& p, int l) {
  const int il = l >> 1;
  const bool odd = l & 1;
  const int tid_ = opaque_tid(); const int lane = tid_ & 63, wv = tid_ >> 6;
  const bf16_t* P = (const bf16_t*)(p.ws + OFF_P);
  const float* od0 = (const float*)(p.ws + OFF_ODIR);
  const float* od1 = od0 + (size_t)NTOK * 512;
  const float* convout = (const float*)(p.ws + OFF_CONV);
  bf16_t* Y = (bf16_t*)(p.ws + OFF_YMIX);
#pragma unroll 2
  for (int t = blockIdx.x * 4 + wv; t < NTOK; t += gridDim.x * 4) {
    const bf16_t* pr = P + (size_t)t * PSTRIDE;
    bf16_t* yr = Y + (size_t)t * 1024;
#pragma unroll
    for (int h = 0; h < 4; ++h) {
      const int idx = h * 128 + lane * 2;
      float2 a = *(const float2*)(od0 + (size_t)t * 512 + idx);
      float2 b = *(const float2*)(od1 + (size_t)t * 512 + idx);
      float o0 = a.x + b.x, o1 = a.y + b.y;
      float ss = wave_sum(o0 * o0 + o1 * o1);
      float rs = rsqrtf(ss * (1.f / 128.f) + EPSV);
      float n0, n1;
      unsigned gz;
      if (!odd) {
        n0 = p.in[14][il * 512 + idx]; n1 = p.in[14][il * 512 + idx + 1];
        gz = *(const unsigned*)(pr + 1024 + idx);
      } else {
        n0 = p.in[21][il * 128 + lane * 2]; n1 = p.in[21][il * 128 + lane * 2 + 1];
        gz = *(const unsigned*)(pr + 1536 + idx);
      }
      float y0 = siluf(bflo(gz)) * o0 * rs * n0;
      float y1 = siluf(bfhi(gz)) * o1 * rs * n1;
      *(unsigned*)(yr + idx) = pack2(y0, y1);
    }
    if (!odd) {
      int seq_lo, seq_hi;
      if (t < NPROMPT) { seq_lo = (t >> 8) << 8; seq_hi = seq_lo + 256; }
      else { seq_lo = NPROMPT + (((t - NPROMPT) >> 11) << 11); seq_hi = seq_lo + 2048; }
      const bool hp = (t - 1 >= seq_lo), hn = (t + 1 < seq_hi);
#pragma unroll
      for (int j = 0; j < 4; ++j) {
        const int c = j * 128 + lane * 2;
        unsigned cg0 = *(const unsigned*)(pr + 2048 + c), hb0 = *(const unsigned*)(pr + 2560 + c);
        const bf16_t* prm = hp ? pr - PSTRIDE : pr;
        const bf16_t* prp = hn ? pr + PSTRIDE : pr;
        unsigned cgm = *(const unsigned*)(prm + 2048 + c), hbm = *(const unsigned*)(prm + 2560 + c);
        unsigned cgp = *(const unsigned*)(prp + 2048 + c), hbp = *(const unsigned*)(prp + 2560 + c);
        if (!hp) { cgm = 0; hbm = 0; }
        if (!hn) { cgp = 0; hbp = 0; }
        unsigned bg = *(const unsigned*)(pr + 1536 + c);
        const float* sw = p.in[15] + (size_t)il * 3 * 512 + c;
        float y0 = bflo(bg) * (sw[0] * bflo(cgm) * bflo(hbm) + sw[512] * bflo(cg0) * bflo(hb0) + sw[1024] * bflo(cgp) * bflo(hbp));
        float y1 = bfhi(bg) * (sw[1] * bfhi(cgm) * bfhi(hbm) + sw[513] * bfhi(cg0) * bfhi(hb0) + sw[1025] * bfhi(cgp) * bfhi(hbp));
        *(unsigned*)(yr + 512 + c) = pack2(y0, y1);
      }
    } else {
      float v[8];
      float s = 0.f;
#pragma unroll
      for (int j = 0; j < 4; ++j) {
        float2 a = *(const float2*)(convout + (size_t)t * 512 + j * 128 + lane * 2);
        v[2 * j] = a.x; v[2 * j + 1] = a.y;
        s += a.x + a.y;
      }
      const float mean = wave_sum(s) * (1.f / 512.f);
      float vs = 0.f;
#pragma unroll
      for (int j = 0; j < 8; ++j) { v[j] -= mean; vs += v[j] * v[j]; }
      const float rstd = rsqrtf(wave_sum(vs) * (1.f / 512.f) + EPSV);
#pragma unroll
      for (int j = 0; j < 4; ++j) {
        const int c = j * 128 + lane * 2;
        float y0 = v[2 * j] * rstd * p.in[24][il * 512 + c] + p.in[25][il * 512 + c];
        float y1 = v[2 * j + 1] * rstd * p.in[24][il * 512 + c + 1] + p.in[25][il * 512 + c + 1];
        *(unsigned*)(yr + 512 + c) = pack2(siluf(y0), siluf(y1));
      }
    }
  }
}

#define WAVE_LDS_SYNC() { asm volatile("s_waitcnt lgkmcnt(0)" ::: "memory"); __builtin_amdgcn_wave_barrier(); }
#define CE_DESC(a, b) { unsigned _mx = max(a, b), _mn = min(a, b); a = _mx; b = _mn; }
#define CE_ASC(a, b) { unsigned _mx = max(a, b), _mn = min(a, b); a = _mn; b = _mx; }
__device__ __forceinline__ void sort16_desc(unsigned* v) {
#pragma unroll
  for (int k = 2; k <= 16; k <<= 1) {
#pragma unroll
    for (int j = k >> 1; j > 0; j >>= 1) {
#pragma unroll
      for (int i = 0; i < 16; ++i) {
        const int l = i ^ j;
        if (l > i) {
          if ((i & k) == 0) CE_DESC(v[i], v[l]) else CE_ASC(v[i], v[l])
        }
      }
    }
  }
}
__device__ __forceinline__ void merge16_top(unsigned* a, const unsigned* b) {
#pragma unroll
  for (int i = 0; i < 16; ++i) a[i] = max(a[i], b[15 - i]);
#pragma unroll
  for (int j = 8; j > 0; j >>= 1) {
#pragma unroll
    for (int i = 0; i < 16; ++i) {
      const int l = i ^ j;
      if (l > i) CE_DESC(a[i], a[l])
    }
  }
}
__device__ __forceinline__ void phase_peer_score(const Params& p, int l, unsigned char* smem) {
  const int tid = opaque_tid(), lane = tid & 63, w = tid >> 6, quad = lane >> 4, l15 = lane & 15;
  unsigned* scw = (unsigned*)smem + w * (32 * 132 + 512);
  unsigned* sel = scw + 32 * 132;
  const bf16_t* Q = (const bf16_t*)(p.ws + OFF_Q);
  const bf16_t* KB = (const bf16_t*)(p.ws + OFF_KEYS) + (size_t)l * 8 * 2 * 128 * 128;
  int* EI = (int*)(p.ws + OFF_EIDX);
  float* GT = (float*)(p.ws + OFF_GATE);
  unsigned cab[13];
  {
    const int sub = lane & 3;
#pragma unroll
    for (int i = 0; i < 13; ++i) { const int cidx = sub + 4 * i; cab[i] = (unsigned)CAND_A[cidx] | ((unsigned)CAND_B[cidx] << 4); }
  }
  bf16x8 qa[2][4];
  if (blockIdx.x < 3072) {
    const int t0f = (blockIdx.x >> 1) * 16, hf_ = (blockIdx.x & 1) * 4 + w;
#pragma unroll
    for (int pp = 0; pp < 2; ++pp)
#pragma unroll
      for (int kk = 0; kk < 4; ++kk) qa[pp][kk] = ldfrag(Q + (size_t)(t0f + l15) * 2048 + hf_ * 256 + pp * 128 + kk * 32 + quad * 8);
  }
  for (int u = blockIdx.x; u < 3072; u += gridDim.x) {
    const int tt = u >> 1, h = (u & 1) * 4 + w;
    const int t0 = tt * 16;
#pragma unroll
    for (int pp = 0; pp < 2; ++pp) {
      bf16x8 a[4];
#pragma unroll
      for (int kk = 0; kk < 4; ++kk) a[kk] = qa[pp][kk];
      const bf16_t* kb = KB + (size_t)((h * 2 + pp) * 128) * 128;
#pragma unroll
      for (int ct = 0; ct < 8; ++ct) {
        f32x4 c = (f32x4){0.f, 0.f, 0.f, 0.f};
#pragma unroll
        for (int kk = 0; kk < 4; ++kk) {
          bf16x8 b = ldfrag(kb + (ct * 16 + l15) * 128 + kk * 32 + quad * 8);
          c = mfma16(a[kk], b, c);
        }
#pragma unroll
        for (int jj = 0; jj < 4; ++jj) {
          const int row = pp * 16 + quad * 4 + jj, col = ct * 16 + l15;
          unsigned key = (fkey(c[jj]) & ~127u) | (unsigned)(127 - col);
          scw[row * 132 + col] = key;
        }
      }
    }
    {
      const int un = u + gridDim.x;
      if (un < 3072) {
        const int t0n = (un >> 1) * 16, hn = (un & 1) * 4 + w;
#pragma unroll
        for (int pp = 0; pp < 2; ++pp)
#pragma unroll
          for (int kk = 0; kk < 4; ++kk) qa[pp][kk] = ldfrag(Q + (size_t)(t0n + l15) * 2048 + hn * 256 + pp * 128 + kk * 32 + quad * 8);
      }
    }
    WAVE_LDS_SYNC();
    {
      const int row = lane >> 1, hf = lane & 1;
      const u32x4* rp = (const u32x4*)(scw + row * 132 + hf * 64);
      unsigned g0[16], g1[16];
#pragma unroll
      for (int q = 0; q < 4; ++q) { u32x4 t4 = rp[q]; g0[4 * q] = t4[0]; g0[4 * q + 1] = t4[1]; g0[4 * q + 2] = t4[2]; g0[4 * q + 3] = t4[3]; }
#pragma unroll
      for (int q = 0; q < 4; ++q) { u32x4 t4 = rp[4 + q]; g1[4 * q] = t4[0]; g1[4 * q + 1] = t4[1]; g1[4 * q + 2] = t4[2]; g1[4 * q + 3] = t4[3]; }
      sort16_desc(g0);
      sort16_desc(g1);
      merge16_top(g0, g1);
#pragma unroll
      for (int q = 0; q < 4; ++q) { u32x4 t4 = rp[8 + q]; g1[4 * q] = t4[0]; g1[4 * q + 1] = t4[1]; g1[4 * q + 2] = t4[2]; g1[4 * q + 3] = t4[3]; }
      sort16_desc(g1);
      merge16_top(g0, g1);
#pragma unroll
      for (int q = 0; q < 4; ++q) { u32x4 t4 = rp[12 + q]; g1[4 * q] = t4[0]; g1[4 * q + 1] = t4[1]; g1[4 * q + 2] = t4[2]; g1[4 * q + 3] = t4[3]; }
      sort16_desc(g1);
      merge16_top(g0, g1);
#pragma unroll
      for (int i = 0; i < 16; ++i) g1[i] = (unsigned)__builtin_amdgcn_update_dpp(0, (int)g0[i], 0xB1, 0xF, 0xF, true);
      merge16_top(g0, g1);
      if (hf == 0) {
#pragma unroll
        for (int q = 0; q < 4; ++q) {
          u32x4 t4 = {g0[4 * q], g0[4 * q + 1], g0[4 * q + 2], g0[4 * q + 3]};
          *(u32x4*)(sel + row * 16 + 4 * q) = t4;
        }
      }
    }
    WAVE_LDS_SYNC();
    {
      const int tok = lane >> 2, sub = lane & 3;
      const unsigned* s1 = sel + tok * 16;
      const unsigned* s2 = sel + (16 + tok) * 16;
      unsigned ck[16];
#pragma unroll
      for (int i = 0; i < 13; ++i) {
        const int cidx = sub + 4 * i;
        const int a = cab[i] & 15, b = cab[i] >> 4;
        float s = keyf(s1[a] & ~127u) + keyf(s2[b] & ~127u);
        unsigned k = (fkey(s) & ~255u) | (unsigned)(255 - (a * 16 + b));
        ck[i] = (cidx < 50) ? k : 0u;
      }
      ck[13] = 0u; ck[14] = 0u; ck[15] = 0u;
      sort16_desc(ck);
      {
        unsigned g1[16];
#pragma unroll
        for (int i = 0; i < 16; ++i) g1[i] = (unsigned)__builtin_amdgcn_update_dpp(0, (int)ck[i], 0xB1, 0xF, 0xF, true);
        merge16_top(ck, g1);
#pragma unroll
        for (int i = 0; i < 16; ++i) g1[i] = (unsigned)__builtin_amdgcn_update_dpp(0, (int)ck[i], 0x4E, 0xF, 0xF, true);
        merge16_top(ck, g1);
      }
      const float mx = keyf(ck[0] & ~255u);
      float sv[4];
      int ev[4];
#pragma unroll
      for (int j = 0; j < 4; ++j) {
        const unsigned k0_ = ck[j], k1_ = ck[4 + j], k2_ = ck[8 + j], k3_ = ck[12 + j];
        const unsigned ka_ = (sub & 1) ? k1_ : k0_;
        const unsigned kb_ = (sub & 1) ? k3_ : k2_;
        const unsigned key = (sub & 2) ? kb_ : ka_;
        const int cidx = 255 - (int)(key & 255u);
        const int a = cidx >> 4, b = cidx & 15;
        const unsigned k1 = s1[a], k2 = s2[b];
        sv[j] = __expf(keyf(k1 & ~127u) + keyf(k2 & ~127u) - mx);
        ev[j] = (127 - (int)(k1 & 127u)) * 128 + (127 - (int)(k2 & 127u));
      }
      float sum = (sv[0] + sv[1]) + (sv[2] + sv[3]);
      sum += __uint_as_float((unsigned)__builtin_amdgcn_update_dpp(0, (int)__float_as_uint(sum), 0xB1, 0xF, 0xF, true));
      sum += __uint_as_float((unsigned)__builtin_amdgcn_update_dpp(0, (int)__float_as_uint(sum), 0x4E, 0xF, 0xF, true));
      const float inv = 1.f / sum;
      const size_t ob = (size_t)(t0 + tok) * 128 + h * 16 + sub * 4;
      *(int4*)(EI + ob) = make_int4(ev[0], ev[1], ev[2], ev[3]);
      *(float4*)(GT + ob) = make_float4(sv[0] * inv, sv[1] * inv, sv[2] * inv, sv[3] * inv);
    }
    WAVE_LDS_SYNC();
  }
}

__device__ __forceinline__ float gelu_tanh(float x) {
  return 0.5f * x * (1.f + tanhf(0.7978845608028654f * (x + 0.044715f * x * x * x)));
}
__device__ __forceinline__ float butterfly8(const float* d, int lane) {
  const bool b5 = lane & 32, b4 = lane & 16, b3 = lane & 8;
  float e4[4], e2[2], e1;
#pragma unroll
  for (int j = 0; j < 4; ++j) {
    float snd = b5 ? d[j] : d[j + 4];
    float kep = b5 ? d[j + 4] : d[j];
    e4[j] = kep + __shfl_xor(snd, 32);
  }
#pragma unroll
  for (int j = 0; j < 2; ++j) {
    float snd = b4 ? e4[j] : e4[j + 2];
    float kep = b4 ? e4[j + 2] : e4[j];
    e2[j] = kep + __shfl_xor(snd, 16);
  }
  {
    float snd = b3 ? e2[0] : e2[1];
    float kep = b3 ? e2[1] : e2[0];
    e1 = kep + __shfl_xor(snd, 8);
  }
  e1 += __shfl_xor(e1, 4);
  e1 += __shfl_xor(e1, 2);
  e1 += __shfl_xor(e1, 1);
  const int jj = lane & 7;
  const int srcl = ((jj >> 2) & 1) * 32 + ((jj >> 1) & 1) * 16 + (jj & 1) * 8;
  return __shfl(e1, srcl);
}
__device__ __forceinline__ void phase_peer_gather(const Params& p, int l, int dry, unsigned char* smem) {
  const int tid_ = opaque_tid(); const int lane = tid_ & 63, wv = tid_ >> 6;
  const bf16_t* H = (const bf16_t*)(p.ws + OFF_H);
  bf16_t* Hw = (bf16_t*)(p.ws + OFF_H);
  const unsigned char* UB = p.ws + OFF_UB + (size_t)l * 16384 * 512;
  const unsigned char* VB = p.ws + OFF_VB + (size_t)l * 16384 * 512;
  const int* EI = (const int*)(p.ws + OFF_EIDX);
  const float* GT = (const float*)(p.ws + OFF_GATE);
  const float* modv = (const float*)(p.ws + OFF_MOD);
  float* actw = (float*)smem + wv * (24 * 128);
  const int tstride = gridDim.x * 4, tfirst = blockIdx.x * 4 + wv;
  int ntok = (tfirst < NTOK) ? (NTOK - 1 - tfirst) / tstride + 1 : 0;
  if (ntok > 24) ntok = 24;
  for (int i = lane; i < ntok * 128; i += 64) actw[i] = 0.f;
  WAVE_LDS_SYNC();
  {
    const int q_ = lane >> 4, n_ = lane & 15;
    for (int kk = 0; kk < 8; ++kk) {
      const unsigned char* ubs = UB + (size_t)kk * (16384 * 64) + q_ * 16;
      int pe0 = 0, pe1 = 0; u32x4 pxa = {0u, 0u, 0u, 0u};
      if (ntok > 0) {
        pe0 = EI[(size_t)tfirst * 128 + lane]; pe1 = EI[(size_t)tfirst * 128 + 64 + lane];
        pxa = *(const u32x4*)(p.ws + OFF_H8 + (size_t)tfirst * 512 + kk * 64 + q_ * 16);
      }
      for (int ti = 0; ti < ntok; ++ti) {
        const int ev0 = pe0, ev1 = pe1;
        const u32x4 xa4 = pxa;
        if (ti + 1 < ntok) {
          const size_t tn = (size_t)(tfirst + (ti + 1) * tstride);
          pe0 = EI[tn * 128 + lane]; pe1 = EI[tn * 128 + 64 + lane];
          pxa = *(const u32x4*)(p.ws + OFF_H8 + tn * 512 + kk * 64 + q_ * 16);
        }
        u32x4 bq[8];
#pragma unroll
        for (int g = 0; g < 8; ++g) {
          const int e_ = __shfl((g < 4) ? ev0 : ev1, (g & 3) * 16 + n_);
          bq[g] = *(const u32x4*)(ubs + (size_t)e_ * 64);
        }
        const v8i32 aa = {(int)xa4[0], (int)xa4[1], (int)xa4[2], (int)xa4[3], 0, 0, 0, 0};
#pragma unroll
        for (int g = 0; g < 8; ++g) {
          const v8i32 bb = {(int)bq[g][0], (int)bq[g][1], (int)bq[g][2], (int)bq[g][3], 0, 0, 0, 0};
          f32x4 ac = (f32x4){0.f, 0.f, 0.f, 0.f};
          ac = __builtin_amdgcn_mfma_scale_f32_16x16x128_f8f6f4(aa, bb, ac, 4, 4, 0, 0, 0, 0);
          if (q_ == (g & 3)) actw[ti * 128 + g * 16 + n_] += ac[0];
        }
      }
    }
  }
  WAVE_LDS_SYNC();
  int ti_ = 0;
  uint4 nx0 = make_uint4(0, 0, 0, 0), nx1 = nx0; int nev0 = 0, nev1 = 0; float ngv0 = 0.f, ngv1 = 0.f;
  {
    const int tf = blockIdx.x * 4 + wv;
    if (tf < NTOK) {
      nx0 = *(const uint4*)(H + (size_t)tf * 1024 + lane * 16); nx1 = *(const uint4*)(H + (size_t)tf * 1024 + lane * 16 + 8);
      nev0 = EI[(size_t)tf * 128 + lane]; nev1 = EI[(size_t)tf * 128 + 64 + lane];
      ngv0 = GT[(size_t)tf * 128 + lane]; ngv1 = GT[(size_t)tf * 128 + 64 + lane];
    }
  }
  for (int t = blockIdx.x * 4 + wv; t < NTOK; t += gridDim.x * 4) {
    float xf[16];
    unpack8(nx0, xf);
    unpack8(nx1, xf + 8);
    f32x2 xf2[8], out2[8];
#pragma unroll
    for (int e = 0; e < 8; ++e) { xf2[e] = (f32x2){xf[2 * e], xf[2 * e + 1]}; out2[e] = (f32x2){0.f, 0.f}; }
    const int ev0 = nev0, ev1 = nev1;
    const float gv0 = ngv0, gv1 = ngv1;
    {
      const int tn = t + gridDim.x * 4;
      if (tn < NTOK) {
        nx0 = *(const uint4*)(H + (size_t)tn * 1024 + lane * 16); nx1 = *(const uint4*)(H + (size_t)tn * 1024 + lane * 16 + 8);
        nev0 = EI[(size_t)tn * 128 + lane]; nev1 = EI[(size_t)tn * 128 + 64 + lane];
        ngv0 = GT[(size_t)tn * 128 + lane]; ngv1 = GT[(size_t)tn * 128 + 64 + lane];
      }
    }
    float cacc0 = 0.f, cacc1 = 0.f, coef0 = 0.f, coef1 = 0.f;
    uint2 bufA[16], bufB[16], bufC[16];
    const f32x2 zero2_ = {(float)dry, (float)dry};
#define GLOAD(buf, bb) { \
      const unsigned char* tb_ = ((bb) < 8) ? UB : VB; \
      const int evv_ = (((bb) & 7) < 4) ? ev0 : ev1; \
      _Pragma("unroll") for (int j = 0; j < 16; ++j) { \
        const int e_ = __builtin_amdgcn_readlane(evv_, ((bb) & 3) * 16 + j); \
        buf[j] = *(const uint2*)(tb_ + (size_t)e_ * 512 + lane * 8); } }
#define GCOMP(buf, bb) { \
      if ((bb) < 8) { \
        float d_[16]; \
        _Pragma("unroll") for (int j = 0; j < 16; ++j) { \
          f32x2 uf_[8]; unpack16_fp4(buf[j].x, buf[j].y, uf_); \
          f32x2 sa_ = uf_[0] * xf2[0]; \
          if (PROBE_CVT) { f32x2 ug_[8]; \
            ug_[0] = __builtin_amdgcn_cvt_scalef32_pk_f32_fp4(buf[j].x, 2.0f, 0); ug_[1] = __builtin_amdgcn_cvt_scalef32_pk_f32_fp4(buf[j].x, 2.0f, 1); \
            ug_[2] = __builtin_amdgcn_cvt_scalef32_pk_f32_fp4(buf[j].x, 2.0f, 2); ug_[3] = __builtin_amdgcn_cvt_scalef32_pk_f32_fp4(buf[j].x, 2.0f, 3); \
            ug_[4] = __builtin_amdgcn_cvt_scalef32_pk_f32_fp4(buf[j].y, 2.0f, 0); ug_[5] = __builtin_amdgcn_cvt_scalef32_pk_f32_fp4(buf[j].y, 2.0f, 1); \
            ug_[6] = __builtin_amdgcn_cvt_scalef32_pk_f32_fp4(buf[j].y, 2.0f, 2); ug_[7] = __builtin_amdgcn_cvt_scalef32_pk_f32_fp4(buf[j].y, 2.0f, 3); \
            _Pragma("unroll") for (int q = 0; q < 8; ++q) sa_ = __builtin_elementwise_fma(ug_[q], zero2_, sa_); } \
          _Pragma("unroll") for (int q = 1; q < 8; ++q) sa_ = __builtin_elementwise_fma(uf_[q], xf2[q], sa_); \
          d_[j] = sa_.x + sa_.y; } \
        const float t0_ = butterfly8(d_, lane), t1_ = butterfly8(d_ + 8, lane); \
        const int k0_ = ((bb) & 3) * 16; \
        if (((bb) & 7) < 4) { if ((lane >> 3) == (k0_ >> 3)) cacc0 = t0_; if ((lane >> 3) == (k0_ >> 3) + 1) cacc0 = t1_; } \
        else { if ((lane >> 3) == (k0_ >> 3)) cacc1 = t0_; if ((lane >> 3) == (k0_ >> 3) + 1) cacc1 = t1_; } \
        if ((bb) == 7) { coef0 = gelu_tanh(cacc0 * (1.f / U_SCALE)) * gv0 * (1.f / V_SCALE); coef1 = gelu_tanh(cacc1 * (1.f / U_SCALE)) * gv1 * (1.f / V_SCALE); } \
      } else { \
        const float cfv_ = (((bb) & 7) < 4) ? coef0 : coef1; \
        _Pragma("unroll") for (int j = 0; j < 16; ++j) { \
          const float cf_ = __uint_as_float((unsigned)__builtin_amdgcn_readlane((int)__float_as_uint(cfv_), ((bb) & 3) * 16 + j)); \
          f32x2 vf_[8]; unpack16_fp4(buf[j].x, buf[j].y, vf_); \
          const f32x2 c2_ = {cf_, cf_}; \
          _Pragma("unroll") for (int q = 0; q < 8; ++q) out2[q] = __builtin_elementwise_fma(vf_[q], c2_, out2[q]); } \
      } }
#if GATHER_CHECK
    GLOAD(bufA, 0)
#pragma unroll
    for (int b = 0; b < 8; b += 2) {
      GLOAD(bufB, b + 1)
      GCOMP(bufA, b)
      if (b + 2 < 8) GLOAD(bufA, b + 2)
      GCOMP(bufB, b + 1)
    }
    const float vacc0 = cacc0, vacc1 = cacc1;
#endif
#if !GATHER_CHECK
    GLOAD(bufA, 8)
#endif
    cacc0 = actw[ti_ * 128 + lane] * (1.f / X_SCALE);
    cacc1 = actw[ti_ * 128 + 64 + lane] * (1.f / X_SCALE);
    ++ti_;
#if GATHER_CHECK
    {
      const bool bad0 = fabsf(cacc0 - vacc0) > 0.15f * fabsf(vacc0) + 45.f;
      const bool bad1 = fabsf(cacc1 - vacc1) > 0.15f * fabsf(vacc1) + 45.f;
      const unsigned long long m0 = __ballot(bad0), m1 = __ballot(bad1);
      if (__popcll(m0) + __popcll(m1) > 32) out2[0] = (f32x2){__builtin_nanf(""), __builtin_nanf("")};
    }
#endif
    coef0 = gelu_tanh(cacc0 * (1.f / U_SCALE)) * gv0 * (1.f / V_SCALE);
    coef1 = gelu_tanh(cacc1 * (1.f / U_SCALE)) * gv1 * (1.f / V_SCALE);
#if GATHER_CHECK
    GLOAD(bufA, 8)
#endif
    GLOAD(bufB, 9)
#pragma unroll
    for (int b = 8; b < 14; b += 3) {
      GLOAD(bufC, b + 2)
      GCOMP(bufA, b)
      GLOAD(bufA, b + 3)
      GCOMP(bufB, b + 1)
      GLOAD(bufB, b + 4)
      GCOMP(bufC, b + 2)
    }
    GCOMP(bufA, 14)
    GCOMP(bufB, 15)
#undef GLOAD
#undef GCOMP
    float out[16];
#pragma unroll
    for (int e = 0; e < 8; ++e) { out[2 * e] = out2[e].x; out[2 * e + 1] = out2[e].y; }
    const int m = tok_mod(t);
    const float* ga2 = modv + (size_t)(l * 9 + m) * 6144 + 5120;
    float* xr = p.out + (size_t)t * 1024 + lane * 16;
    float xn[16];
    float ss = 0.f;
#pragma unroll
    for (int q4 = 0; q4 < 4; ++q4) {
      float4 xv = *(const float4*)(xr + q4 * 4);
      float4 gg = *(const float4*)(ga2 + lane * 16 + q4 * 4);
      const int o = q4 * 4;
      xn[o + 0] = xv.x + gg.x * out[o + 0];
      xn[o + 1] = xv.y + gg.y * out[o + 1];
      xn[o + 2] = xv.z + gg.z * out[o + 2];
      xn[o + 3] = xv.w + gg.w * out[o + 3];
      ss += xn[o] * xn[o] + xn[o + 1] * xn[o + 1] + xn[o + 2] * xn[o + 2] + xn[o + 3] * xn[o + 3];
    }
    ss = wave_sum(ss);
    const float rs = rsqrtf(ss * (1.f / 1024.f) + EPSV);
    if (dry) continue;
    if (l < 3) {
      const float* md = modv + (size_t)((l + 1) * 9 + m) * 6144 + lane * 16;
      const float* g = p.in[8] + (l + 1) * 1024 + lane * 16;
      float hv[16];
#pragma unroll
      for (int q = 0; q < 16; ++q) hv[q] = xn[q] * rs * g[q] * (1.f + md[1024 + q]) + md[q];
      uint4 o;
      o.x = pack2(hv[0], hv[1]); o.y = pack2(hv[2], hv[3]); o.z = pack2(hv[4], hv[5]); o.w = pack2(hv[6], hv[7]);
      *(uint4*)(Hw + (size_t)t * 1024 + lane * 16) = o;
      o.x = pack2(hv[8], hv[9]); o.y = pack2(hv[10], hv[11]); o.z = pack2(hv[12], hv[13]); o.w = pack2(hv[14], hv[15]);
      *(uint4*)(Hw + (size_t)t * 1024 + lane * 16 + 8) = o;
#pragma unroll
      for (int q4 = 0; q4 < 4; ++q4) *(float4*)(xr + q4 * 4) = make_float4(xn[q4 * 4], xn[q4 * 4 + 1], xn[q4 * 4 + 2], xn[q4 * 4 + 3]);
    } else {
      const float* g = p.in[10] + lane * 16;
#pragma unroll
      for (int q4 = 0; q4 < 4; ++q4)
        *(float4*)(xr + q4 * 4) = make_float4(xn[q4 * 4] * rs * g[q4 * 4], xn[q4 * 4 + 1] * rs * g[q4 * 4 + 1],
                                              xn[q4 * 4 + 2] * rs * g[q4 * 4 + 2], xn[q4 * 4 + 3] * rs * g[q4 * 4 + 3]);
    }
  }
}

#define XB_TMO      128
#define XB_XCNT(j)  (256  + 64 * (j))
#define XB_XSUB(j)  (1280 + 64 * (j))
#define XB_XGEN(j)  (2304 + 64 * (j))
#define XB_TOP      3328
#define XB_TOPGEN   3392
#define XCD_BAR_WORDS 3456
#define XB_SPIN_CAP (1u << 18)
#define LAS __attribute__((address_space(3)))

__device__ __forceinline__ unsigned xb_ld(unsigned* p)              { return __hip_atomic_load(p, __ATOMIC_RELAXED, __HIP_MEMORY_SCOPE_AGENT); }
__device__ __forceinline__ unsigned xb_add(unsigned* p, unsigned v) { return __hip_atomic_fetch_add(p, v, __ATOMIC_RELAXED, __HIP_MEMORY_SCOPE_AGENT); }
__device__ __forceinline__ unsigned xb_xcc_id() { return (unsigned)__builtin_amdgcn_s_getreg((3 << 11) | 20) & 0xFu; }
#define XB_SPIN(cond, bar) do { unsigned _sp = 0; while (cond) { __builtin_amdgcn_s_sleep(1); \
    if ((++_sp & 255u) == 0u) { if (xb_ld(&(bar)[XB_TMO])) break; if (_sp > XB_SPIN_CAP) { atomicAdd(&(bar)[XB_TMO], 1u); break; } } } } while (0)

struct XcdBarrier {
    unsigned* bar; unsigned x;
    volatile LAS unsigned* st;
};

__device__ __forceinline__ XcdBarrier xcd_barrier_post(unsigned* bar, volatile LAS unsigned* st) {
    XcdBarrier b; b.bar = bar; b.x = xb_xcc_id(); b.st = st;
    if (threadIdx.x == 0) (void)xb_add(&bar[XB_XCNT(b.x)], 1u);
    return b;
}
__device__ __forceinline__ void xcd_barrier_complete(unsigned* bar, unsigned x, unsigned& nloc, unsigned& nx) {
    const unsigned G = gridDim.x * gridDim.y * gridDim.z;
    unsigned sum, cnt, mine, sp = 0u;
    for (;;) {
        sum = 0u; cnt = 0u; mine = 0u;
#pragma unroll
        for (unsigned j = 0; j < 16; ++j) { const unsigned c = xb_ld(&bar[XB_XCNT(j)]); sum += c; cnt += (c > 0u) ? 1u : 0u; mine = (j == x) ? c : mine; }
        if (sum == G) break;
        __builtin_amdgcn_s_sleep(1);
        if ((++sp & 255u) == 0u) { if (xb_ld(&bar[XB_TMO])) break; if (sp > XB_SPIN_CAP) { atomicAdd(&bar[XB_TMO], 1u); break; } }
    }
    nloc = mine > 0u ? mine : 1u; nx = cnt > 0u ? cnt : 1u;
}

__device__ __forceinline__ void xcd_barrier(const XcdBarrier& b) {
    asm volatile("s_waitcnt vmcnt(0)" ::: "memory");
    __syncthreads();
    if (threadIdx.x == 0) {
        unsigned* bar = b.bar;
        __builtin_amdgcn_s_waitcnt(0);
        unsigned nloc = b.st[0], nx = b.st[1];
        if (nloc == 0u) { xcd_barrier_complete(bar, b.x, nloc, nx); b.st[0] = nloc; b.st[1] = nx; }
        const unsigned old = xb_add(&bar[XB_XSUB(b.x)], 1u);
        const unsigned gen = old / nloc;
        if (old + 1u == (gen + 1u) * nloc) {
            __builtin_amdgcn_fence(__ATOMIC_RELEASE, "agent");
            asm volatile("s_waitcnt vmcnt(0)" ::: "memory");
            const unsigned og = xb_add(&bar[XB_TOP], 1u);
            const unsigned tg = og / nx;
            if (og + 1u == (tg + 1u) * nx) xb_add(&bar[XB_TOPGEN], 1u);
            else XB_SPIN(xb_ld(&bar[XB_TOPGEN]) == tg, bar);
            __builtin_amdgcn_fence(__ATOMIC_ACQUIRE, "agent");
            xb_add(&bar[XB_XGEN(b.x)], 1u);
            asm volatile("s_waitcnt vmcnt(0)" ::: "memory");
        } else {
            XB_SPIN(xb_ld(&bar[XB_XGEN(b.x)]) == gen, bar);
            __builtin_amdgcn_fence(__ATOMIC_ACQUIRE, "agent");
            asm volatile("s_waitcnt vmcnt(0)" ::: "memory");
        }
    }
    __syncthreads();
}

__global__ void __launch_bounds__(256, 2) mega(Params p, int ph_lo, int ph_hi) {
  __shared__ __attribute__((aligned(16))) unsigned char smem[77312];
  cg::grid_group grid = cg::this_grid();
  __shared__ uint4 xb_words;
  if (threadIdx.x == 0) xb_words = make_uint4(0u, 0u, 0u, 0u);
  __syncthreads();
  XcdBarrier xb = xcd_barrier_post((unsigned*)(p.ws + OFF_BAR), (volatile LAS unsigned*)&xb_words);
  if (ph_hi > 100000) grid.sync();
  for (int ph = ph_lo; ph < ph_hi; ++ph) {
#if PROBE_MASK
    const int pcode = ph < 2 ? ph : 2 + (ph - 2) % 9;
    const int nrep = ((PROBE_MASK >> pcode) & 1) ? 2 : 1;
    for (int rep = 0; rep < nrep; ++rep) {
    if (rep) xcd_barrier(xb);
#endif
    bool did = true;
#if PROBE_MASK
    const int prep_rep = rep; const int nrep_ = nrep;
#else
    const int prep_rep = 0; const int nrep_ = 1;
#endif
    if (ph == 0) phase_prep_a(p, smem);
    else if (ph == 1) phase_prep_b(p);
    else {
      const int l = (ph - 2) / 9, sub = (ph - 2) % 9;
      const int il = l >> 1;
      const bool odd = l & 1;
      const float* modv = (const float*)(p.ws + OFF_MOD);
      if (sub == 6) {
        gemm_q_fp8(p.ws + OFF_H8F, p.ws + OFF_WQ + (size_t)l * 2048 * 1024, (bf16_t*)(p.ws + OFF_Q), smem);
      } else if (sub == 0) {
        const bf16_t* Bt; int ntn, ldc; bf16_t* C;
        if (sub == 0) {
          Bt = odd ? (const bf16_t*)(p.ws + OFF_WIN_OD) + (size_t)il * 3328 * 1024
                   : (const bf16_t*)(p.ws + OFF_WIN_EV) + (size_t)il * 3072 * 1024;
          ntn = odd ? 13 : 12; ldc = PSTRIDE; C = (bf16_t*)(p.ws + OFF_P);
        } else {
          Bt = (const bf16_t*)(p.ws + OFF_WQ) + (size_t)l * 2048 * 1024;
          ntn = 8; ldc = 2048; C = (bf16_t*)(p.ws + OFF_Q);
        }
        gemm_phase<0, 8, 64>((const bf16_t*)(p.ws + OFF_H), Bt, ntn, C, ldc, nullptr, nullptr, smem);
      } else if (sub == 1) {
        if (odd) phase_odd_prep(p, l, smem, prep_rep); else did = false;
      } else if (sub == 2) {
        if (odd) phase_gdn_chain(p, l, smem); else phase_ret_chain(p, l, smem);
      } else if (sub == 3) {
        phase_mix_out(p, l);
      } else if (sub == 4) {
        gemm_phase<1, 4, 64>((const bf16_t*)(p.ws + OFF_YMIX), (const bf16_t*)(p.ws + OFF_WOUT) + (size_t)l * 1024 * 1024, 8,
                      nullptr, 0, p.out, modv + (size_t)l * 9 * 6144 + 2048, smem, (nrep_ > 1 && prep_rep == 0) ? 1 : 0);
      } else if (sub == 5) {
        phase_norm2(p, l);
      } else if (sub == 7) {
        phase_peer_score(p, l, smem);
      } else {
        phase_peer_gather(p, l, (nrep_ > 1 && prep_rep == 0) ? 1 : 0, smem);
      }
    }
#if PROBE_MASK
    if (rep + 1 < nrep) continue;
#endif
    if (did && ph + 1 < ph_hi) xcd_barrier(xb);
#if PROBE_MASK
    }
#endif
  }
}

extern "C" void kernel_launch(void* const* d_in, const int* in_sizes, int n_in, void* d_out, int out_size,
                              void* d_ws, size_t ws_size, hipStream_t stream) {
  static int grid_blocks = 0;
  if (!grid_blocks) {
    int dev = 0, cus = 0, per_cu = 0;
    (void)hipGetDevice(&dev);
    (void)hipDeviceGetAttribute(&cus, hipDeviceAttributeMultiprocessorCount, dev);
    (void)hipOccupancyMaxActiveBlocksPerMultiprocessor(&per_cu, mega, 256, 0);
    if (per_cu < 1) per_cu = 1;
    if (per_cu > 2) per_cu = 2;
    grid_blocks = cus * per_cu;
    if (ws_size < WS_NEED) fprintf(stderr, "kernel_launch: workspace too small: %zu < %zu\n", ws_size, (size_t)WS_NEED);
  }
  Params p{};
  for (int i = 0; i < 30; ++i) p.in[i] = (const float*)d_in[i];
  p.out = (float*)d_out;
  p.ws = (unsigned char*)d_ws;
  (void)hipMemsetAsync((unsigned char*)d_ws + OFF_BAR, 0, XCD_BAR_WORDS * sizeof(unsigned), stream);
#if SINGLE_LAUNCH
  int lo = 0, hi = NPHASE;
  void* args[] = {&p, &lo, &hi};
  hipError_t e = hipLaunchCooperativeKernel((void*)mega, dim3(grid_blocks), dim3(256), args, 0, stream);
  if (e != hipSuccess) fprintf(stderr, "cooperative launch failed: %s (grid %d)\n", hipGetErrorString(e), grid_blocks);
#else
  for (int ph = 0; ph < NPHASE; ++ph) {
    const int l = (ph - 2) / 9, sub = (ph - 2) % 9;
    if (ph >= 2 && sub == 1 && !(l & 1)) continue;
    hipLaunchKernelGGL(mega, dim3(grid_blocks), dim3(256), 0, stream, p, ph, ph + 1);
  }
#endif
}
```
